# Optimizing an MI355X kernel written in HIP

```python
import jax
import jax.numpy as jnp
from jax import lax
import numpy as np

D_MODEL = 1024
BATCH = 8
SEQ = 2048
DEPTH = 2

GRID_W = 64
CTX_LEN = 256

A_HEADS = 8
A_HEAD_DIM = 64
D_A = A_HEADS * A_HEAD_DIM
LORA_W = 64
LORA_A = 64
LORA_G = 128

B_HEADS = 8
B_HEAD_DIM = 64
D_B = B_HEADS * B_HEAD_DIM
WIN_H = 8
WIN_W = 16

N_EXPERTS = 16
N_GROUPS = 4
EXPERTS_PER_GROUP = N_EXPERTS // N_GROUPS
TOP_K = 2
D_EXPERT = 512

RMS_EPS = 1e-6
GN_EPS = 64e-5

IN_SPLITS = (D_A, D_A, D_A, 2 * LORA_W, 2 * LORA_A, LORA_G, D_B, D_B, D_B, D_MODEL, D_MODEL)
IN_COLS = sum(IN_SPLITS)
IN_OFFSETS = tuple(int(o) for o in np.cumsum(IN_SPLITS)[:-1])

kernel_name = 'hybrid_rwkv7_natten_moe_dit'


def rms_norm(x, g):
    xf = x.astype(jnp.float32)
    y = xf * lax.rsqrt(jnp.mean(xf * xf, axis=-1, keepdims=True) + RMS_EPS)
    return (y * g.astype(jnp.float32)).astype(x.dtype)


def modulate(h, shift, scale):
    return h * (1.0 + scale) + shift


def split_cols(z):
    return jnp.split(z, IN_OFFSETS, axis=-1)


def rwkv_prep(z, w0, w_lora_b, a0, a_lora_b, k_k, k_a):
    f = jnp.float32
    k, v, lw, la = z[1].astype(f), z[2].astype(f), z[3].astype(f), z[4].astype(f)
    bsz, t = k.shape[:2]
    heads = lambda u: u.reshape(bsz, t, A_HEADS, A_HEAD_DIM)
    lw = jnp.tanh(lw).reshape(bsz, t, 2, LORA_W)
    wl = w0.astype(f) + jnp.einsum('btzr,zrc->btzc', lw, w_lora_b.astype(f))
    decay = jnp.exp(-jnp.exp(-jax.nn.softplus(-wl) - 0.5))
    la = la.reshape(bsz, t, 2, LORA_A)
    a = jax.nn.sigmoid(a0.astype(f) + jnp.einsum('btzr,zrc->btzc', la, a_lora_b.astype(f)))
    kk = heads(k * k_k.astype(f))
    kk = kk * lax.rsqrt(jnp.maximum(jnp.sum(kk * kk, axis=-1, keepdims=True), 1e-12))
    k_dir = k[:, :, None, :] * (1.0 + (a - 1.0) * k_a.astype(f))
    per_dir = [(heads(decay[:, :, d]), heads(k_dir[:, :, d]), heads(a[:, :, d])) for d in range(2)]
    return heads(k), heads(v), kk, per_dir


def rwkv_scan(s0, r, decay, k, v, kk, a, reverse, emit):
    def step(s, inp):
        w_t, k_t, v_t, kk_t, a_t = inp[:5]
        s_kk = jnp.einsum('bhvk,bhk->bhv', s, kk_t)
        s = (s * w_t[:, :, None, :]
             - s_kk[..., None] * (kk_t * a_t)[:, :, None, :]
             + v_t[..., None] * k_t[:, :, None, :])
        y = jnp.einsum('bhvk,bhk->bhv', s, inp[5]) if emit else None
        return s, y
    seq = (decay, k, v, kk, a) + ((r,) if emit else ())
    xs = tuple(jnp.moveaxis(u, 1, 0) for u in seq)
    s_final, ys = lax.scan(step, s0, xs, reverse=reverse)
    return s_final, (jnp.moveaxis(ys, 0, 1) if emit else None)


def rwkv_out(y, r, k, v, lg, r_k, g_lora_b, ln_g, ln_b, out_dtype):
    f = jnp.float32
    bsz, t = y.shape[:2]
    mu = jnp.mean(y, axis=-1, keepdims=True)
    var = jnp.mean(jnp.square(y - mu), axis=-1, keepdims=True)
    yn = ((y - mu) * lax.rsqrt(var + GN_EPS)).reshape(bsz, t, D_A) * ln_g.astype(f) + ln_b.astype(f)
    bonus = (jnp.sum(r * k * r_k.astype(f), axis=-1, keepdims=True) * v).reshape(bsz, t, D_A)
    g = jax.nn.sigmoid(lg.astype(f)) @ g_lora_b.astype(f)
    return ((yn + bonus) * g).astype(out_dtype)


def rwkv_mixer(z_c, z_x, w0, w_lora_b, a0, a_lora_b, g_lora_b, k_k, k_a, r_k, ln_g, ln_b, emit_ctx):
    f = jnp.float32
    k_c, v_c, kk_c, dir_c = rwkv_prep(z_c, w0, w_lora_b, a0, a_lora_b, k_k, k_a)
    k_x, v_x, kk_x, dir_x = rwkv_prep(z_x, w0, w_lora_b, a0, a_lora_b, k_k, k_a)
    bsz, seq = z_x[0].shape[:2]
    r_x = z_x[0].astype(f).reshape(bsz, seq, A_HEADS, A_HEAD_DIM)
    r_c = z_c[0].astype(f).reshape(bsz, z_c[0].shape[1], A_HEADS, A_HEAD_DIM) if emit_ctx else None
    y_x, y_c = 0.0, 0.0
    for d in range(2):
        rev = d == 1
        s0 = jnp.zeros((bsz, A_HEADS, A_HEAD_DIM, A_HEAD_DIM), f)
        w_c, kd_c, a_c = dir_c[d]
        s_c, yc_d = rwkv_scan(s0, r_c, w_c, kd_c, v_c, kk_c, a_c, rev, emit_ctx)
        w_x, kd_x, a_x = dir_x[d]
        _, yx_d = rwkv_scan(s_c, r_x, w_x, kd_x, v_x, kk_x, a_x, rev, True)
        y_x = y_x + yx_d
        if emit_ctx:
            y_c = y_c + yc_d
    out_x = rwkv_out(y_x, r_x, k_x, v_x, z_x[5], r_k, g_lora_b, ln_g, ln_b, z_x[0].dtype)
    out_c = rwkv_out(y_c, r_c, k_c, v_c, z_c[5], r_k, g_lora_b, ln_g, ln_b, z_c[0].dtype) if emit_ctx else None
    return out_c, out_x


def na_mixer(z_c, z_x, q_g, k_g, rpb, need_ctx):
    f = jnp.float32
    scale = B_HEAD_DIM ** -0.5

    def heads(u):
        bsz, t = u.shape[:2]
        return u.reshape(bsz, t, B_HEADS, B_HEAD_DIM).transpose(0, 2, 1, 3)

    k_c, v_c = rms_norm(heads(z_c[7]), k_g), heads(z_c[8])
    q_x = rms_norm(heads(z_x[6]), q_g) * scale
    k_x, v_x = rms_norm(heads(z_x[7]), k_g), heads(z_x[8])
    bsz, _, seq, _ = q_x.shape
    rows = seq // GRID_W
    kh = min(WIN_H, rows)
    kw = WIN_W
    grid = lambda u: u.reshape(bsz, B_HEADS, rows, GRID_W, B_HEAD_DIM)
    q_grid, k_grid, v_grid = grid(q_x), grid(k_x), grid(v_x)

    i = jnp.arange(rows)
    key_rows = jnp.clip(i - kh // 2, 0, rows - kh)[:, None] + jnp.arange(kh)[None, :]
    k_blk = k_grid[:, :, key_rows]
    v_blk = v_grid[:, :, key_rows]
    s_lat = jnp.einsum('bhiqd,bhiakd->bhiqak', q_grid, k_blk).astype(f)

    j = jnp.arange(GRID_W)
    col_start = jnp.clip(j - kw // 2, 0, GRID_W - kw)
    in_win = (j[None, :] >= col_start[:, None]) & (j[None, :] < col_start[:, None] + kw)
    d_row = key_rows - i[:, None] + (WIN_H - 1)
    d_col = jnp.clip(j[None, :] - j[:, None], -(WIN_W - 1), WIN_W - 1) + (WIN_W - 1)
    bias = rpb[:, d_row[:, None, :, None], d_col[None, :, None, :]].astype(f)
    s_lat = jnp.where(in_win[:, None, :], s_lat + bias[None], -jnp.inf)

    s_ctx = jnp.einsum('bhiqd,bhcd->bhiqc', q_grid, k_c).astype(f)
    n_lat = kh * GRID_W
    logits = jnp.concatenate([s_lat.reshape(bsz, B_HEADS, rows, GRID_W, n_lat), s_ctx], axis=-1)
    p = jax.nn.softmax(logits, axis=-1).astype(v_x.dtype)
    p_lat = p[..., :n_lat].reshape(bsz, B_HEADS, rows, GRID_W, kh, GRID_W)
    o = (jnp.einsum('bhiqak,bhiakd->bhiqd', p_lat, v_blk)
         + jnp.einsum('bhiqc,bhcd->bhiqd', p[..., n_lat:], v_c))
    y_x = o.transpose(0, 2, 3, 1, 4).reshape(bsz, seq, D_B)

    y_c = None
    if need_ctx:
        q_c = rms_norm(heads(z_c[6]), q_g) * scale
        p_c = jax.nn.softmax(jnp.einsum('bhqd,bhkd->bhqk', q_c, k_c).astype(f), axis=-1).astype(v_c.dtype)
        y_c = jnp.einsum('bhqk,bhkd->bhqd', p_c, v_c).transpose(0, 2, 1, 3).reshape(bsz, -1, D_B)
    return y_c, y_x


def branch_merge(gate_a, gate_b, y_a, y_b, proj_a, proj_b, w_out):
    merged = jax.nn.sigmoid(gate_a) * (y_a @ proj_a) + jax.nn.sigmoid(gate_b) * (y_b @ proj_b)
    return merged @ w_out


def moe(h, router_w, router_bias, w1, w3, w2):
    f = jnp.float32
    shp = h.shape
    t = h.reshape(-1, shp[-1])
    n = t.shape[0]
    scores = jax.nn.sigmoid(t.astype(f) @ router_w.astype(f))
    sel = scores + router_bias.astype(f)
    grp_score = lax.top_k(sel.reshape(n, N_GROUPS, EXPERTS_PER_GROUP), TOP_K)[0].sum(-1)
    best = jnp.argmax(grp_score, axis=-1)
    in_group = (jnp.arange(N_EXPERTS) // EXPERTS_PER_GROUP)[None, :] == best[:, None]
    _, top_idx = lax.top_k(jnp.where(in_group, sel, -jnp.inf), TOP_K)
    top_s = jnp.take_along_axis(scores, top_idx, axis=-1)
    wts = top_s / jnp.sum(top_s, axis=-1, keepdims=True)
    gate = jnp.sum(jax.nn.one_hot(top_idx, N_EXPERTS, dtype=f) * wts[..., None], axis=1).astype(t.dtype)
    out = jnp.zeros_like(t)
    for e in range(N_EXPERTS):
        hid = jax.nn.silu(t @ w1[e]) * (t @ w3[e])
        out = out + gate[:, e:e + 1] * (hid @ w2[e])
    return out.reshape(shp)


def setup_inputs(seed: int = 0) -> dict:
    key = jax.random.key(seed)
    ks = iter(jax.random.split(key, 40))
    D = D_MODEL

    def nrm(shape, s):
        return jax.random.normal(next(ks), shape, jnp.float32) * s

    inp = {}
    inp['x'] = nrm((BATCH, SEQ, D), 1.0)
    inp['c'] = nrm((BATCH, D), 1.0)
    inp['ctx'] = nrm((BATCH, CTX_LEN, D), 1.0)
    inp['c_ctx'] = nrm((D,), 1.0)
    inp['mod_w'] = nrm((DEPTH, D, 6 * D), 0.5 * D ** -0.5)
    inp['mod_b'] = nrm((DEPTH, 6 * D), 0.02)
    inp['norm1_g'] = 1.0 + nrm((DEPTH, D), 0.05)
    inp['norm2_g'] = 1.0 + nrm((DEPTH, D), 0.05)
    inp['w_in'] = nrm((DEPTH, D, IN_COLS), D ** -0.5)
    inp['rw_w0'] = jax.random.uniform(next(ks), (DEPTH, 2, D_A), jnp.float32, -6.0, 1.0)
    inp['rw_w_lora_b'] = nrm((DEPTH, 2, LORA_W, D_A), 0.5 * LORA_W ** -0.5)
    inp['rw_a0'] = nrm((DEPTH, 2, D_A), 0.5)
    inp['rw_a_lora_b'] = nrm((DEPTH, 2, LORA_A, D_A), 0.5 * LORA_A ** -0.5)
    inp['rw_g_lora_b'] = nrm((DEPTH, LORA_G, D_A), LORA_G ** -0.5)
    inp['rw_k_k'] = 0.85 + nrm((DEPTH, D_A), 0.05)
    inp['rw_k_a'] = 1.0 + nrm((DEPTH, D_A), 0.05)
    inp['rw_r_k'] = nrm((DEPTH, A_HEADS, A_HEAD_DIM), 0.1)
    inp['rw_ln_g'] = 1.0 + nrm((DEPTH, D_A), 0.05)
    inp['rw_ln_b'] = nrm((DEPTH, D_A), 0.02)
    inp['na_q_g'] = 1.0 + nrm((DEPTH, B_HEAD_DIM), 0.1)
    inp['na_k_g'] = 1.0 + nrm((DEPTH, B_HEAD_DIM), 0.1)
    inp['na_rpb'] = nrm((DEPTH, B_HEADS, 2 * WIN_H - 1, 2 * WIN_W - 1), 0.5)
    inp['proj_a'] = nrm((DEPTH, D_A, D), D_A ** -0.5)
    inp['proj_b'] = nrm((DEPTH, D_B, D), D_B ** -0.5)
    inp['w_out'] = nrm((DEPTH, D, D), D ** -0.5)
    inp['router_w'] = nrm((D, N_EXPERTS), D ** -0.5)
    inp['router_bias'] = nrm((N_EXPERTS,), 0.01)
    inp['moe_w1'] = nrm((DEPTH, N_EXPERTS, D, D_EXPERT), D ** -0.5)
    inp['moe_w3'] = nrm((DEPTH, N_EXPERTS, D, D_EXPERT), D ** -0.5)
    inp['moe_w2'] = nrm((DEPTH, N_EXPERTS, D_EXPERT, D), D_EXPERT ** -0.5)
    return inp


def reference(x, c, ctx, c_ctx, mod_w, mod_b, norm1_g, norm2_g, w_in,
              rw_w0, rw_w_lora_b, rw_a0, rw_a_lora_b, rw_g_lora_b, rw_k_k, rw_k_a, rw_r_k,
              rw_ln_g, rw_ln_b, na_q_g, na_k_g, na_rpb, proj_a, proj_b, w_out,
              router_w, router_bias, moe_w1, moe_w3, moe_w2):
    for l in range(DEPTH):
        last = l == DEPTH - 1
        m_x = [m[:, None, :] for m in jnp.split(jax.nn.silu(c) @ mod_w[l] + mod_b[l], 6, axis=-1)]
        m_c = jnp.split(jax.nn.silu(c_ctx) @ mod_w[l] + mod_b[l], 6, axis=-1)

        h_x = modulate(rms_norm(x, norm1_g[l]), m_x[0], m_x[1])
        h_c = modulate(rms_norm(ctx, norm1_g[l]), m_c[0], m_c[1])
        z_x = split_cols(h_x @ w_in[l])
        z_c = split_cols(h_c @ w_in[l])
        ya_c, ya_x = rwkv_mixer(z_c, z_x, rw_w0[l], rw_w_lora_b[l], rw_a0[l], rw_a_lora_b[l],
                                rw_g_lora_b[l], rw_k_k[l], rw_k_a[l], rw_r_k[l], rw_ln_g[l], rw_ln_b[l],
                                emit_ctx=not last)
        yb_c, yb_x = na_mixer(z_c, z_x, na_q_g[l], na_k_g[l], na_rpb[l], need_ctx=not last)
        x = x + m_x[2] * branch_merge(z_x[9], z_x[10], ya_x, yb_x, proj_a[l], proj_b[l], w_out[l])

        h2_x = modulate(rms_norm(x, norm2_g[l]), m_x[3], m_x[4])
        x = x + m_x[5] * moe(h2_x, router_w, router_bias, moe_w1[l], moe_w3[l], moe_w2[l])

        if not last:
            ctx = ctx + m_c[2] * branch_merge(z_c[9], z_c[10], ya_c, yb_c, proj_a[l], proj_b[l], w_out[l])
            h2_c = modulate(rms_norm(ctx, norm2_g[l]), m_c[3], m_c[4])
            ctx = ctx + m_c[5] * moe(h2_c, router_w, router_bias, moe_w1[l], moe_w3[l], moe_w2[l])
    return x
```

```cpp
#include <hip/hip_runtime.h>
#include <stdint.h>
#include <cstdio>

typedef unsigned short bf16_t;
__device__ __forceinline__ float bf2f(bf16_t v) { return __uint_as_float(((unsigned)v) << 16); }
__device__ __forceinline__ bf16_t f2bf(float f) { unsigned u = __float_as_uint(f); return (bf16_t)((u + 0x7fffu + ((u >> 16) & 1u)) >> 16); }

constexpr int DM = 1024, NB = 8, SEQ = 2048, CTXL = 256, GW = 64;
constexpr int NLAT = NB * SEQ, NCTX = NB * CTXL, LR = NLAT + NCTX;
constexpr int ZC = 5504;
constexpr int C_R = 0, C_K = 512, C_V = 1024, C_LW = 1536, C_LA = 1664, C_LG = 1792, C_Q = 1920, C_KB = 2432, C_VB = 2944, C_GA = 3456, C_GB = 4480;
constexpr int NE = 16, DE = 512;
constexpr float RMS_EPS = 1e-6f, GN_EPS = 64e-5f;

constexpr size_t MiB = 1u << 20;
constexpr size_t WS_MOD = 0;
constexpr size_t WS_CTL = 1 * MiB;
constexpr size_t WS_LTOK = 2 * MiB;
constexpr size_t WS_LGATE = 4 * MiB;
constexpr size_t WS_TOKI = 6 * MiB;
constexpr size_t WS_TOKG = 6 * MiB + 512 * 1024;
constexpr size_t WS_CTXS = 8 * MiB;
constexpr size_t WS_Z = 16 * MiB;
constexpr size_t WS_H2 = 16 * MiB;
constexpr size_t WS_TMP1 = 52 * MiB;
constexpr size_t WS_HID = 132 * MiB;
constexpr size_t WS_B = 210 * MiB;
constexpr size_t WS_H = WS_B;
constexpr size_t WS_SW = WS_B;
constexpr size_t WS_SB = WS_B + 36 * MiB;
constexpr size_t WS_SKD = WS_B + 54 * MiB;
constexpr size_t WS_SKK = WS_B + 72 * MiB;
constexpr size_t WS_Y = WS_B + 90 * MiB;
constexpr size_t WS_YB = WS_B + 126 * MiB;
constexpr size_t WS_OUTA = WS_B;
constexpr size_t WS_MERGED = WS_B + 18 * MiB;
constexpr size_t WS_YS = WS_B + 54 * MiB;
constexpr size_t WS_END = WS_B + 144 * MiB;

struct Params {
    const float *x, *c, *ctx, *c_ctx, *mod_w, *mod_b, *norm1_g, *norm2_g, *w_in,
        *rw_w0, *rw_w_lora_b, *rw_a0, *rw_a_lora_b, *rw_g_lora_b, *rw_k_k, *rw_k_a, *rw_r_k, *rw_ln_g, *rw_ln_b,
        *na_q_g, *na_k_g, *na_rpb, *proj_a, *proj_b, *w_out, *router_w, *router_bias, *moe_w1, *moe_w3, *moe_w2;
    float* out; unsigned char* ws;
};

__device__ __forceinline__ float wave_sum(float v) {
#pragma unroll
    for (int o = 1; o < 64; o <<= 1) v += __shfl_xor(v, o);
    return v;
}
__device__ __forceinline__ float wave_max(float v) {
#pragma unroll
    for (int o = 1; o < 64; o <<= 1) v = fmaxf(v, __shfl_xor(v, o));
    return v;
}
__device__ __forceinline__ float sigmoidf_(float x) { return 1.f / (1.f + __expf(-x)); }
__device__ __forceinline__ int mod_row(int r) { return r < NLAT ? (r >> 11) : 8; }
__device__ __forceinline__ const float* in_row(const Params& p, int r) { return r < NLAT ? p.x + (size_t)r * DM : p.ctx + (size_t)(r - NLAT) * DM; }
__device__ __forceinline__ float* st_row(const Params& p, int r) { return r < NLAT ? p.out + (size_t)r * DM : (float*)(p.ws + WS_CTXS) + (size_t)(r - NLAT) * DM; }

__device__ void ph_mod(const Params& p, float* sm, int wg, int nwg) {
    for (int i = threadIdx.x; i < 9 * DM; i += blockDim.x) {
        int j = i >> 10, k = i & 1023; float v = j < 8 ? p.c[j * DM + k] : p.c_ctx[k];
        sm[i] = v * sigmoidf_(v);
    }
    __syncthreads();
    float* MOD = (float*)(p.ws + WS_MOD);
    for (int o = wg * blockDim.x + threadIdx.x; o < 2 * 6144; o += nwg * blockDim.x) {
        int l = o / 6144, n = o % 6144;
        float acc[9];
#pragma unroll
        for (int j = 0; j < 9; ++j) acc[j] = 0.f;
        const float* w = p.mod_w + (size_t)l * DM * 6144 + n;
        for (int k = 0; k < DM; ++k) { float wv = w[(size_t)k * 6144];
#pragma unroll
            for (int j = 0; j < 9; ++j) acc[j] += sm[j * DM + k] * wv; }
        float bb = p.mod_b[l * 6144 + n];
#pragma unroll
        for (int j = 0; j < 9; ++j) MOD[(l * 9 + j) * 6144 + n] = acc[j] + bb;
    }
}

__device__ void ph_norm1(const Params& p, int l, int wg, int nwg) {
    const int lane = threadIdx.x & 63, wv = threadIdx.x >> 6, nwv = blockDim.x >> 6;
    const float* MOD = (const float*)(p.ws + WS_MOD);
    bf16_t* H = (bf16_t*)(p.ws + WS_H);
    for (int r = wg * nwv + wv; r < LR; r += nwg * nwv) {
        const float* xr = l == 0 ? in_row(p, r) : st_row(p, r);
        float v[16]; float ss = 0.f;
#pragma unroll
        for (int i = 0; i < 16; ++i) { v[i] = xr[lane + 64 * i]; ss += v[i] * v[i]; }
        ss = wave_sum(ss);
        const float rs = rsqrtf(ss * (1.f / DM) + RMS_EPS);
        const float* m = MOD + (l * 9 + mod_row(r)) * 6144;
#pragma unroll
        for (int i = 0; i < 16; ++i) { int d = lane + 64 * i;
            float y = v[i] * rs * p.norm1_g[l * DM + d];
            H[(size_t)r * DM + d] = f2bf(y * (1.f + m[DM + d]) + m[d]); }
    }
}

template <typename AT> __device__ __forceinline__ float ldA(const AT* p);
template <> __device__ __forceinline__ float ldA<bf16_t>(const bf16_t* p) { return bf2f(*p); }
template <> __device__ __forceinline__ float ldA<float>(const float* p) { return *p; }

template <typename AT, class Epi>
__device__ void gemm_naive(float* sm, int wg, int nwg, int M, int N, int K, const AT* A, int lda, const int* rowmap, int rowshift,
                           const float* B, int ldb, Epi epi) {
    float* As = sm;
    float* Bs = sm + 16 * 132;
    const int tid = threadIdx.x, ty = tid >> 4, tx = tid & 15;
    const int ntm = (M + 127) / 128, ntn = N / 64;
    for (int tile = wg; tile < ntm * ntn; tile += nwg) {
        const int tm = tile / ntn, tn = tile % ntn, m0 = tm * 128, n0 = tn * 64;
        float acc[4][4];
#pragma unroll
        for (int i = 0; i < 4; ++i)
#pragma unroll
            for (int j = 0; j < 4; ++j) acc[i][j] = 0.f;
        const int ar = m0 + (tid >> 2);
        int arow = -1;
        if (ar < M) arow = rowmap ? (rowmap[ar] >> rowshift) : ar;
        const AT* ap = A + (size_t)(arow < 0 ? 0 : arow) * lda + (tid & 3) * 4;
        const int bk = tid >> 4, bn = (tid & 15) * 4;
        for (int k0 = 0; k0 < K; k0 += 16) {
#pragma unroll
            for (int i = 0; i < 4; ++i) As[((tid & 3) * 4 + i) * 132 + (tid >> 2)] = arow >= 0 ? ldA<AT>(ap + k0 + i) : 0.f;
            if (tid < 256) { const float4 b = *(const float4*)(B + (size_t)(k0 + bk) * ldb + n0 + bn); *(float4*)(Bs + bk * 68 + bn) = b; }
            __syncthreads();
#pragma unroll
            for (int kk = 0; kk < 16; ++kk) {
                const float4 a = *(const float4*)(As + kk * 132 + ty * 4), b = *(const float4*)(Bs + kk * 68 + tx * 4);
                const float av[4] = {a.x, a.y, a.z, a.w}, bv[4] = {b.x, b.y, b.z, b.w};
#pragma unroll
                for (int i = 0; i < 4; ++i)
#pragma unroll
                    for (int j = 0; j < 4; ++j) acc[i][j] += av[i] * bv[j];
            }
            __syncthreads();
        }
#pragma unroll
        for (int i = 0; i < 4; ++i) { const int row = m0 + ty * 4 + i; if (row < M) {
#pragma unroll
            for (int j = 0; j < 4; ++j) epi(row, n0 + tx * 4 + j, acc[i][j]); } }
    }
}

__device__ void ph_win(const Params& p, float* sm, int l, int wg, int nwg) {
    bf16_t* Z = (bf16_t*)(p.ws + WS_Z);
    gemm_naive<bf16_t>(sm, wg, nwg, LR, ZC, DM, (const bf16_t*)(p.ws + WS_H), DM, nullptr, 0, p.w_in + (size_t)l * DM * ZC, ZC,
                       [=](int r, int c, float v) { Z[(size_t)r * ZC + c] = f2bf(v); });
}

__device__ void ph_prep(const Params& p, float* sm, int l, int dir, int wg, int nwg) {
    const bf16_t* Z = (const bf16_t*)(p.ws + WS_Z);
    float* SW = (float*)(p.ws + WS_SW); bf16_t* SB = (bf16_t*)(p.ws + WS_SB); bf16_t* SKD = (bf16_t*)(p.ws + WS_SKD); bf16_t* SKK = (bf16_t*)(p.ws + WS_SKK);
    const int c = threadIdx.x;
    const float* wlb = p.rw_w_lora_b + ((size_t)(l * 2 + dir) * 64) * 512 + c;
    const float* alb = p.rw_a_lora_b + ((size_t)(l * 2 + dir) * 64) * 512 + c;
    const float w0 = p.rw_w0[(l * 2 + dir) * 512 + c], a0 = p.rw_a0[(l * 2 + dir) * 512 + c];
    const float kkc = p.rw_k_k[l * 512 + c], kac = p.rw_k_a[l * 512 + c];
    for (int r = wg; r < LR; r += nwg) {
        __syncthreads();
        if (c < 64) sm[c] = tanhf(bf2f(Z[(size_t)r * ZC + C_LW + dir * 64 + c]));
        else if (c < 128) sm[c] = bf2f(Z[(size_t)r * ZC + C_LA + dir * 64 + (c - 64)]);
        __syncthreads();
        float wl = w0, al = a0;
#pragma unroll 4
        for (int j = 0; j < 64; ++j) { wl += sm[j] * wlb[(size_t)j * 512]; al += sm[64 + j] * alb[(size_t)j * 512]; }
        const float nx = -wl; const float sp = fmaxf(nx, 0.f) + log1pf(expf(-fabsf(nx)));
        const float decay = expf(-expf(-sp - 0.5f));
        const float a = sigmoidf_(al);
        const float k = bf2f(Z[(size_t)r * ZC + C_K + c]);
        const float kv = k * kkc;
        const float n2 = wave_sum(kv * kv);
        const float kk = kv * rsqrtf(fmaxf(n2, 1e-12f));
        SW[(size_t)r * 512 + c] = decay;
        SB[(size_t)r * 512 + c] = f2bf(kk * a);
        SKD[(size_t)r * 512 + c] = f2bf(k * (1.f + (a - 1.f) * kac));
        SKK[(size_t)r * 512 + c] = f2bf(kk);
    }
}

__device__ __forceinline__ int scan_row(int step, int dir, int b) {
    if (step < CTXL) { int t = dir ? (CTXL - 1 - step) : step; return NLAT + b * CTXL + t; }
    int tt = step - CTXL; int t = dir ? (SEQ - 1 - tt) : tt; return b * SEQ + t;
}
__device__ void ph_scan(const Params& p, float* sm, int l, int dir, int wg, int nwg) {
    const bf16_t* Z = (const bf16_t*)(p.ws + WS_Z);
    const float* SW = (const float*)(p.ws + WS_SW); const bf16_t* SB = (const bf16_t*)(p.ws + WS_SB); const bf16_t* SKD = (const bf16_t*)(p.ws + WS_SKD); const bf16_t* SKK = (const bf16_t*)(p.ws + WS_SKK);
    float* Y = (float*)(p.ws + WS_Y);
    const int lane = threadIdx.x & 63, wv = threadIdx.x >> 6, nwv = blockDim.x >> 6;
    const bool last = (l == 1);
    for (int task = wg * nwv + wv; task < 512; task += nwg * nwv) {
        const int b = task >> 6, hd = (task >> 3) & 7, v0 = (task & 7) * 8;
        float s[8];
#pragma unroll
        for (int j = 0; j < 8; ++j) s[j] = 0.f;
        int row = scan_row(0, dir, b);
        float cw = SW[(size_t)row * 512 + hd * 64 + lane], ckk = bf2f(SKK[(size_t)row * 512 + hd * 64 + lane]), cb = bf2f(SB[(size_t)row * 512 + hd * 64 + lane]),
              ckd = bf2f(SKD[(size_t)row * 512 + hd * 64 + lane]), cr = bf2f(Z[(size_t)row * ZC + C_R + hd * 64 + lane]), cv = bf2f(Z[(size_t)row * ZC + C_V + hd * 64 + lane]);
        for (int step = 0; step < CTXL + SEQ; ++step) {
            const int nrow = scan_row(step + 1 < CTXL + SEQ ? step + 1 : step, dir, b);
            const float nw = SW[(size_t)nrow * 512 + hd * 64 + lane], nkk = bf2f(SKK[(size_t)nrow * 512 + hd * 64 + lane]), nb = bf2f(SB[(size_t)nrow * 512 + hd * 64 + lane]),
                        nkd = bf2f(SKD[(size_t)nrow * 512 + hd * 64 + lane]), nr = bf2f(Z[(size_t)nrow * ZC + C_R + hd * 64 + lane]), nv = bf2f(Z[(size_t)nrow * ZC + C_V + hd * 64 + lane]);
            float ysel = 0.f;
#pragma unroll
            for (int j = 0; j < 8; ++j) {
                const float skk = wave_sum(s[j] * ckk);
                const float vj = __shfl(cv, v0 + j);
                s[j] = s[j] * cw - skk * cb + vj * ckd;
                const float y = wave_sum(s[j] * cr);
                if (lane == j) ysel = y;
            }
            const bool isctx = step < CTXL;
            if (!(isctx && last) && lane < 8) {
                float* yp = Y + (size_t)row * 512 + hd * 64 + v0 + lane;
                if (dir == 0) *yp = ysel; else *yp += ysel;
            }
            row = nrow; cw = nw; ckk = nkk; cb = nb; ckd = nkd; cr = nr; cv = nv;
        }
    }
}

__device__ void ph_natt(const Params& p, float* sm, int l, int wg, int nwg) {
    const bf16_t* Z = (const bf16_t*)(p.ws + WS_Z);
    bf16_t* YB = (bf16_t*)(p.ws + WS_YB);
    const int lane = threadIdx.x & 63, wv = threadIdx.x >> 6, nwv = blockDim.x >> 6;
    float* qs = sm + wv * 512;
    float* ps = qs + 64;
    const bool last = (l == 1);
    const int nq = last ? NLAT : LR;
    const float* rpb = p.na_rpb + (size_t)l * 8 * 15 * 31;
    const float kg = p.na_k_g[l * 64 + lane], qg = p.na_q_g[l * 64 + lane];
    for (int task = wg * nwv + wv; task < nq * 8; task += nwg * nwv) {
        const int r = task >> 3, hd = task & 7;
        const bool isl = r < NLAT;
        const int b = isl ? (r >> 11) : ((r - NLAT) >> 8);
        const int t = r & 2047, qi = t >> 6, qj = t & 63;
        const int r0 = min(max(qi - 4, 0), 32 - 8), cs = min(max(qj - 8, 0), 64 - 16);
        const int nkeys = isl ? 384 : 256;
        {
            const float qv = bf2f(Z[(size_t)r * ZC + C_Q + hd * 64 + lane]);
            const float ss = wave_sum(qv * qv);
            qs[lane] = qv * rsqrtf(ss * (1.f / 64.f) + RMS_EPS) * qg * 0.125f * kg;
        }
        float q[64];
#pragma unroll
        for (int d = 0; d < 64; ++d) q[d] = qs[d];
        float lg[6]; float mx = -INFINITY;
#pragma unroll
        for (int i = 0; i < 6; ++i) {
            const int kidx = lane + 64 * i; lg[i] = -INFINITY;
            if (kidx < nkeys) {
                int krow; float bias = 0.f;
                if (isl && kidx < 128) { const int a = kidx >> 4, cc = kidx & 15; krow = b * SEQ + (r0 + a) * 64 + cs + cc;
                    bias = rpb[(hd * 15 + (r0 + a - qi + 7)) * 31 + (cs + cc - qj + 15)]; }
                else krow = NLAT + b * CTXL + (isl ? kidx - 128 : kidx);
                const uint4* kp = (const uint4*)(Z + (size_t)krow * ZC + C_KB + hd * 64);
                float ss = 0.f, dot = 0.f;
#pragma unroll
                for (int u = 0; u < 8; ++u) { const uint4 w = kp[u]; const unsigned ww[4] = {w.x, w.y, w.z, w.w};
#pragma unroll
                    for (int e = 0; e < 4; ++e) { const float k0 = __uint_as_float(ww[e] << 16), k1 = __uint_as_float(ww[e] & 0xffff0000u);
                        ss += k0 * k0 + k1 * k1; dot += k0 * q[u * 8 + e * 2] + k1 * q[u * 8 + e * 2 + 1]; } }
                lg[i] = dot * rsqrtf(ss * (1.f / 64.f) + RMS_EPS) + bias;
                mx = fmaxf(mx, lg[i]);
            }
        }
        mx = wave_max(mx);
        float sum = 0.f;
#pragma unroll
        for (int i = 0; i < 6; ++i) { const int kidx = lane + 64 * i; if (kidx < nkeys) { lg[i] = __expf(lg[i] - mx); sum += lg[i]; } }
        sum = wave_sum(sum);
        const float inv = 1.f / sum;
#pragma unroll
        for (int i = 0; i < 6; ++i) { const int kidx = lane + 64 * i; if (kidx < nkeys) ps[kidx] = lg[i] * inv; }
        float acc = 0.f;
        for (int kidx = 0; kidx < nkeys; ++kidx) {
            int krow;
            if (isl && kidx < 128) krow = b * SEQ + (r0 + (kidx >> 4)) * 64 + cs + (kidx & 15);
            else krow = NLAT + b * CTXL + (isl ? kidx - 128 : kidx);
            acc += ps[kidx] * bf2f(Z[(size_t)krow * ZC + C_VB + hd * 64 + lane]);
        }
        YB[(size_t)r * 512 + hd * 64 + lane] = f2bf(acc);
    }
}

__device__ void ph_rwkvout(const Params& p, float* sm, int l, int wg, int nwg) {
    const bf16_t* Z = (const bf16_t*)(p.ws + WS_Z);
    const float* Y = (const float*)(p.ws + WS_Y);
    bf16_t* OA = (bf16_t*)(p.ws + WS_OUTA);
    const int c = threadIdx.x; const int nrows = (l == 1) ? NLAT : LR;
    const float lng = p.rw_ln_g[l * 512 + c], lnb = p.rw_ln_b[l * 512 + c], rk = p.rw_r_k[l * 512 + c];
    const float* glb = p.rw_g_lora_b + (size_t)l * 128 * 512 + c;
    for (int r = wg; r < nrows; r += nwg) {
        __syncthreads();
        if (c < 128) sm[c] = sigmoidf_(bf2f(Z[(size_t)r * ZC + C_LG + c]));
        __syncthreads();
        const float yv = Y[(size_t)r * 512 + c];
        const float mu = wave_sum(yv) * (1.f / 64.f); const float d = yv - mu; const float var = wave_sum(d * d) * (1.f / 64.f);
        const float yn = d * rsqrtf(var + GN_EPS) * lng + lnb;
        const float rr = bf2f(Z[(size_t)r * ZC + C_R + c]), kk = bf2f(Z[(size_t)r * ZC + C_K + c]), vv = bf2f(Z[(size_t)r * ZC + C_V + c]);
        const float bon = wave_sum(rr * kk * rk) * vv;
        float g = 0.f;
#pragma unroll 4
        for (int j = 0; j < 128; ++j) g += sm[j] * glb[(size_t)j * 512];
        OA[(size_t)r * 512 + c] = f2bf((yn + bon) * g);
    }
}

__device__ void ph_merge(const Params& p, float* sm, int l, int wg, int nwg) {
    const bf16_t* Z = (const bf16_t*)(p.ws + WS_Z);
    bf16_t* MG = (bf16_t*)(p.ws + WS_MERGED);
    float* TMP = (float*)(p.ws + WS_YS);
    const int nrows = (l == 1) ? NLAT : LR;
    gemm_naive<bf16_t>(sm, wg, nwg, nrows, DM, 512, (const bf16_t*)(p.ws + WS_OUTA), 512, nullptr, 0, p.proj_a + (size_t)l * 512 * DM, DM,
                       [=](int r, int c, float v) { TMP[(size_t)r * DM + c] = sigmoidf_(bf2f(Z[(size_t)r * ZC + C_GA + c])) * v; });
    gemm_naive<bf16_t>(sm, wg, nwg, nrows, DM, 512, (const bf16_t*)(p.ws + WS_YB), 512, nullptr, 0, p.proj_b + (size_t)l * 512 * DM, DM,
                       [=](int r, int c, float v) { MG[(size_t)r * DM + c] = f2bf(TMP[(size_t)r * DM + c] + sigmoidf_(bf2f(Z[(size_t)r * ZC + C_GB + c])) * v); });
}

__device__ void ph_wout(const Params& p, float* sm, int l, int wg, int nwg) {
    const float* MOD = (const float*)(p.ws + WS_MOD);
    const int nrows = (l == 1) ? NLAT : LR;
    const Params pp = p;
    gemm_naive<bf16_t>(sm, wg, nwg, nrows, DM, DM, (const bf16_t*)(p.ws + WS_MERGED), DM, nullptr, 0, p.w_out + (size_t)l * DM * DM, DM,
                       [=](int r, int c, float v) { const float base = (l == 0 ? in_row(pp, r) : st_row(pp, r))[c];
                           st_row(pp, r)[c] = base + MOD[(l * 9 + mod_row(r)) * 6144 + 2 * DM + c] * v; });
}

__device__ void ph_route(const Params& p, int l, int wg, int nwg) {
    const int lane = threadIdx.x & 63, wv = threadIdx.x >> 6, nwv = blockDim.x >> 6;
    const float* MOD = (const float*)(p.ws + WS_MOD);
    bf16_t* H2 = (bf16_t*)(p.ws + WS_H2);
    const int nrows = (l == 1) ? NLAT : LR;
    for (int r = wg * nwv + wv; r < nrows; r += nwg * nwv) {
        const float* xr = st_row(p, r);
        float v[16]; float ss = 0.f;
#pragma unroll
        for (int i = 0; i < 16; ++i) { v[i] = xr[lane + 64 * i]; ss += v[i] * v[i]; }
        ss = wave_sum(ss);
        const float rs = rsqrtf(ss * (1.f / DM) + RMS_EPS);
        const float* m = MOD + (l * 9 + mod_row(r)) * 6144;
        float dots[16];
#pragma unroll
        for (int e = 0; e < 16; ++e) dots[e] = 0.f;
#pragma unroll
        for (int i = 0; i < 16; ++i) { const int d = lane + 64 * i;
            const float h = (v[i] * rs * p.norm2_g[l * DM + d]) * (1.f + m[4 * DM + d]) + m[3 * DM + d];
            H2[(size_t)r * DM + d] = f2bf(h);
            const float4* rw = (const float4*)(p.router_w + (size_t)d * 16);
#pragma unroll
            for (int q4 = 0; q4 < 4; ++q4) { const float4 w = rw[q4]; dots[q4 * 4 + 0] += h * w.x; dots[q4 * 4 + 1] += h * w.y; dots[q4 * 4 + 2] += h * w.z; dots[q4 * 4 + 3] += h * w.w; } }
        float sc[16], sel[16];
#pragma unroll
        for (int e = 0; e < 16; ++e) { sc[e] = 1.f / (1.f + expf(-wave_sum(dots[e]))); sel[e] = sc[e] + p.router_bias[e]; }
        int best = 0; float bestv = -INFINITY;
#pragma unroll
        for (int g = 0; g < 4; ++g) { float m1 = -INFINITY, m2 = -INFINITY;
#pragma unroll
            for (int j = 0; j < 4; ++j) { const float s = sel[g * 4 + j]; if (s > m1) { m2 = m1; m1 = s; } else if (s > m2) m2 = s; }
            const float gs = m1 + m2; if (gs > bestv) { bestv = gs; best = g; } }
        int i0 = -1; float v0 = -INFINITY;
#pragma unroll
        for (int e = 0; e < 16; ++e) if ((e >> 2) == best && sel[e] > v0) { v0 = sel[e]; i0 = e; }
        int i1 = -1; float v1 = -INFINITY;
#pragma unroll
        for (int e = 0; e < 16; ++e) if ((e >> 2) == best && e != i0 && sel[e] > v1) { v1 = sel[e]; i1 = e; }
        float s0 = 0.f, s1 = 0.f;
#pragma unroll
        for (int e = 0; e < 16; ++e) { if (e == i0) s0 = sc[e]; if (e == i1) s1 = sc[e]; }
        const float inv = 1.f / (s0 + s1);
        if (lane == 0) {
            ((int*)(p.ws + WS_TOKI))[r] = i0 | (i1 << 8);
            ((float2*)(p.ws + WS_TOKG))[r] = make_float2(s0 * inv, s1 * inv);
        }
    }
}

__device__ void ph_lists(const Params& p, float* sm, int l, int wg, int nwg) {
    int* cnt = (int*)(p.ws + WS_CTL) + l * 16;
    int* LT = (int*)(p.ws + WS_LTOK); float* LGt = (float*)(p.ws + WS_LGATE);
    const int* TI = (const int*)(p.ws + WS_TOKI); const float2* TG = (const float2*)(p.ws + WS_TOKG);
    const int nrows = (l == 1) ? NLAT : LR;
    const int tid = threadIdx.x, lane = tid & 63, wv = tid >> 6;
    int* wcnt = (int*)sm;
    for (int e = wg; e < NE; e += nwg) {
        int base = 0;
        for (int c0 = 0; c0 < nrows; c0 += 512) {
            const int t = c0 + tid;
            int slot = -1; float g = 0.f;
            if (t < nrows) { const int ti = TI[t]; const float2 tg = TG[t];
                if ((ti & 255) == e) { slot = 0; g = tg.x; } else if ((ti >> 8) == e) { slot = 1; g = tg.y; } }
            const unsigned long long bal = __ballot(slot >= 0);
            __syncthreads();
            if (lane == 0) wcnt[wv] = __popcll(bal);
            __syncthreads();
            int woff = 0, tot = 0;
#pragma unroll
            for (int w = 0; w < 8; ++w) { const int c = wcnt[w]; if (w < wv) woff += c; tot += c; }
            if (slot >= 0) { const int pos = base + woff + __popcll(bal & ((1ull << lane) - 1ull));
                LT[e * LR + pos] = t * 2 + slot; LGt[e * LR + pos] = g; }
            base += tot;
        }
        if (tid == 0) cnt[e] = base;
    }
}

__device__ void ph_moe1(const Params& p, float* sm, int l, int wg, int nwg) {
    const int* cnt = (const int*)(p.ws + WS_CTL) + l * 16;
    const int* LT = (const int*)(p.ws + WS_LTOK);
    float* T1 = (float*)(p.ws + WS_TMP1); bf16_t* HID = (bf16_t*)(p.ws + WS_HID);
    int off = 0;
    for (int e = 0; e < NE; ++e) {
        const int M = cnt[e];
        float* t1 = T1 + (size_t)off * DE; bf16_t* hid = HID + (size_t)off * DE;
        gemm_naive<bf16_t>(sm, wg, nwg, M, DE, DM, (const bf16_t*)(p.ws + WS_H2), DM, LT + e * LR, 1, p.moe_w1 + ((size_t)(l * NE + e) * DM) * DE, DE,
                           [=](int r, int c, float v) { t1[(size_t)r * DE + c] = v; });
        gemm_naive<bf16_t>(sm, wg, nwg, M, DE, DM, (const bf16_t*)(p.ws + WS_H2), DM, LT + e * LR, 1, p.moe_w3 + ((size_t)(l * NE + e) * DM) * DE, DE,
                           [=](int r, int c, float v) { const float a = t1[(size_t)r * DE + c]; hid[(size_t)r * DE + c] = f2bf(a * sigmoidf_(a) * v); });
        off += (M + 255) & ~255;
    }
}
__device__ void ph_moe2(const Params& p, float* sm, int l, int wg, int nwg) {
    const int* cnt = (const int*)(p.ws + WS_CTL) + l * 16;
    const int* LT = (const int*)(p.ws + WS_LTOK); const float* LGt = (const float*)(p.ws + WS_LGATE);
    const bf16_t* HID = (const bf16_t*)(p.ws + WS_HID); bf16_t* YS = (bf16_t*)(p.ws + WS_YS);
    int off = 0;
    for (int e = 0; e < NE; ++e) {
        const int M = cnt[e];
        const int* lt = LT + e * LR; const float* lgt = LGt + e * LR;
        gemm_naive<bf16_t>(sm, wg, nwg, M, DM, DE, HID + (size_t)off * DE, DE, nullptr, 0, p.moe_w2 + ((size_t)(l * NE + e) * DE) * DM, DM,
                           [=](int r, int c, float v) { YS[(size_t)lt[r] * DM + c] = f2bf(lgt[r] * v); });
        off += (M + 255) & ~255;
    }
}
__device__ void ph_combine(const Params& p, int l, int wg, int nwg) {
    const float* MOD = (const float*)(p.ws + WS_MOD);
    const bf16_t* YS = (const bf16_t*)(p.ws + WS_YS);
    const int nrows = (l == 1) ? NLAT : LR;
    for (size_t i = (size_t)wg * blockDim.x + threadIdx.x; i < (size_t)nrows * DM; i += (size_t)nwg * blockDim.x) {
        const int r = (int)(i >> 10), d = (int)(i & 1023);
        float* xp = st_row(p, r) + d;
        *xp = *xp + MOD[(l * 9 + mod_row(r)) * 6144 + 5 * DM + d] * (bf2f(YS[(size_t)(2 * r) * DM + d]) + bf2f(YS[(size_t)(2 * r + 1) * DM + d]));
    }
}

enum { PH_MOD = 0, PH_NORM1, PH_WIN, PH_PREP0, PH_SCAN0, PH_PREP1, PH_SCAN1, PH_NATT, PH_RWKVOUT, PH_MERGE, PH_WOUT, PH_ROUTE, PH_LISTS, PH_MOE1, PH_MOE2, PH_COMBINE };

template <int PH> __global__ void __launch_bounds__(512) k_phase(Params p, int l) {
    __shared__ __attribute__((aligned(16))) float sm[9 * 1024];
    const int wg = blockIdx.x, nwg = gridDim.x;
    if (PH == PH_MOD) ph_mod(p, sm, wg, nwg);
    else if (PH == PH_NORM1) ph_norm1(p, l, wg, nwg);
    else if (PH == PH_WIN) ph_win(p, sm, l, wg, nwg);
    else if (PH == PH_PREP0) ph_prep(p, sm, l, 0, wg, nwg);
    else if (PH == PH_SCAN0) ph_scan(p, sm, l, 0, wg, nwg);
    else if (PH == PH_PREP1) ph_prep(p, sm, l, 1, wg, nwg);
    else if (PH == PH_SCAN1) ph_scan(p, sm, l, 1, wg, nwg);
    else if (PH == PH_NATT) ph_natt(p, sm, l, wg, nwg);
    else if (PH == PH_RWKVOUT) ph_rwkvout(p, sm, l, wg, nwg);
    else if (PH == PH_MERGE) ph_merge(p, sm, l, wg, nwg);
    else if (PH == PH_WOUT) ph_wout(p, sm, l, wg, nwg);
    else if (PH == PH_ROUTE) ph_route(p, l, wg, nwg);
    else if (PH == PH_LISTS) ph_lists(p, sm, l, wg, nwg);
    else if (PH == PH_MOE1) ph_moe1(p, sm, l, wg, nwg);
    else if (PH == PH_MOE2) ph_moe2(p, sm, l, wg, nwg);
    else if (PH == PH_COMBINE) ph_combine(p, l, wg, nwg);
}
__global__ void k_zero(float* o, int n) { int i = blockIdx.x * blockDim.x + threadIdx.x; if (i < n) o[i] = 0.f; }

extern "C" void kernel_launch(void* const* d_in, const int* in_sizes, int n_in, void* d_out, int out_size, void* d_ws, size_t ws_size, hipStream_t stream) {
    if (n_in != 30 || ws_size < WS_END || out_size != NLAT * DM) {
        fprintf(stderr, "kernel_launch: unexpected n_in %d / ws_size %zu / out_size %d\n", n_in, ws_size, out_size);
        hipLaunchKernelGGL(k_zero, dim3((out_size + 255) / 256), dim3(256), 0, stream, (float*)d_out, out_size);
        return;
    }
    Params p{};
    const float** pp = (const float**)&p;
    for (int i = 0; i < 30; ++i) pp[i] = (const float*)d_in[i];
    p.out = (float*)d_out; p.ws = (unsigned char*)d_ws;
    hipMemsetAsync((char*)d_ws + WS_CTL, 0, 4096, stream);
#define LAUNCHB(PH, G, B, L) hipLaunchKernelGGL(k_phase<PH>, dim3(G), dim3(B), 0, stream, p, L)
#define LAUNCH(PH, G, L) LAUNCHB(PH, G, 512, L)
    LAUNCH(PH_MOD, 24, 0);
    for (int l = 0; l < 2; ++l) {
        LAUNCH(PH_NORM1, 1024, l);
        LAUNCH(PH_WIN, 2048, l);
        LAUNCH(PH_PREP0, 2048, l);
        LAUNCH(PH_SCAN0, 64, l);
        LAUNCH(PH_PREP1, 2048, l);
        LAUNCH(PH_SCAN1, 64, l);
        LAUNCH(PH_NATT, 2048, l);
        LAUNCH(PH_RWKVOUT, 2048, l);
        LAUNCH(PH_MERGE, 2048, l);
        LAUNCH(PH_WOUT, 2048, l);
        LAUNCH(PH_ROUTE, 1024, l);
        LAUNCH(PH_LISTS, 16, l);
        LAUNCH(PH_MOE1, 1024, l);
        LAUNCH(PH_MOE2, 1024, l);
        LAUNCH(PH_COMBINE, 2048, l);
    }
}
```

```cpp
#include <hip/hip_runtime.h>
#include <stdint.h>
#include <cstdio>

typedef unsigned short bf16_t;
__device__ __forceinline__ float bf2f(bf16_t v) { return __uint_as_float(((unsigned)v) << 16); }
__device__ __forceinline__ bf16_t f2bf(float f) { unsigned u = __float_as_uint(f); return (bf16_t)((u + 0x7fffu + ((u >> 16) & 1u)) >> 16); }

typedef unsigned v4u __attribute__((ext_vector_type(4)));
typedef unsigned v2u __attribute__((ext_vector_type(2)));
typedef float f32x4 __attribute__((ext_vector_type(4)));
__device__ __forceinline__ unsigned pk2(float lo, float hi) { return (unsigned)f2bf(lo) | ((unsigned)f2bf(hi) << 16); }
__device__ __forceinline__ void unpack8(const v4u w, float (&f)[8]) {
#pragma unroll
    for (int i = 0; i < 4; ++i) { f[2 * i] = __uint_as_float(w[i] << 16); f[2 * i + 1] = __uint_as_float(w[i] & 0xffff0000u); }
}
__device__ __forceinline__ void unpack4(const v2u w, float (&f)[4]) { f[0] = __uint_as_float(w.x << 16); f[1] = __uint_as_float(w.x & 0xffff0000u); f[2] = __uint_as_float(w.y << 16); f[3] = __uint_as_float(w.y & 0xffff0000u); }
constexpr int DM = 1024, NB = 8, SEQ = 2048, CTXL = 256, GW = 64;
constexpr int NLAT = NB * SEQ, NCTX = NB * CTXL, LR = NLAT + NCTX;
constexpr int ZC = 5504;
constexpr int C_R = 0, C_K = 512, C_V = 1024, C_LW = 1536, C_LA = 1664, C_LG = 1792, C_Q = 1920, C_KB = 2432, C_VB = 2944, C_GA = 3456, C_GB = 4480;
constexpr int NE = 16, DE = 512;
constexpr float RMS_EPS = 1e-6f, GN_EPS = 64e-5f;

constexpr size_t MiB = 1u << 20;
constexpr size_t WS_MOD = 0;
constexpr size_t WS_CTL = 1 * MiB;
constexpr size_t WS_LTOK = 2 * MiB;
constexpr size_t WS_LGATE = 4 * MiB;
constexpr size_t WS_TOKI = 6 * MiB;
constexpr size_t WS_TOKG = 6 * MiB + 512 * 1024;
constexpr size_t WS_CNTWG = 2 * MiB;
constexpr size_t WS_OFFS = 2 * MiB + 64 * 1024;
constexpr size_t WS_TEXP = 2 * MiB + 68 * 1024;
constexpr size_t WS_ROWDST = 3 * MiB;
constexpr size_t WS_ROWGATE = 3 * MiB + 512 * 1024;
constexpr size_t WS_CTXS = 8 * MiB;
constexpr size_t WS_W = 16 * MiB;
constexpr size_t WS_WIN_T = WS_W;
constexpr size_t WS_PA_T = WS_W + 11 * MiB;
constexpr size_t WS_PB_T = WS_W + 12 * MiB;
constexpr size_t WS_WO_T = WS_W + 13 * MiB;
constexpr size_t WS_GL_T = WS_W + 15 * MiB;
constexpr size_t WS_LW_T = WS_W + 15 * MiB + 256 * 1024;
constexpr size_t WS_LA_T = WS_W + 15 * MiB + 384 * 1024;
constexpr size_t WS_Z = 32 * MiB;
constexpr size_t WS_X1B = WS_Z;
constexpr size_t WS_H2 = WS_Z;
constexpr size_t WS_TMP1 = WS_Z + 36 * MiB;
constexpr size_t WS_HID = WS_Z + 116 * MiB;
constexpr size_t WS_H2S = WS_Z;
constexpr size_t WS_HID2 = WS_Z + 80 * MiB;
constexpr size_t WS_YS2 = WS_Z + 120 * MiB;
constexpr size_t WS_B = 226 * MiB;
constexpr size_t WS_W13T = WS_B;
constexpr size_t WS_W2T = WS_B + 32 * MiB;
constexpr size_t WS_H2T = WS_B + 84 * MiB;
constexpr size_t WS_VT = WS_B + 54 * MiB;
constexpr size_t WS_SG = WS_B + 72 * MiB;
constexpr size_t WS_Y2 = WS_B + 90 * MiB;
constexpr size_t WS_H = WS_B;
constexpr size_t WS_SW = WS_B;
constexpr size_t WS_SB = WS_B + 36 * MiB;
constexpr size_t WS_SKD = WS_B + 54 * MiB;
constexpr size_t WS_SKK = WS_B + 72 * MiB;
constexpr size_t WS_Y = WS_B + 90 * MiB;
constexpr size_t WS_YB = WS_B + 126 * MiB;
constexpr size_t WS_OUTA = WS_B + 54 * MiB;
constexpr size_t WS_MERGED = WS_B + 90 * MiB;
constexpr size_t WS_YS = WS_B + 54 * MiB;
constexpr size_t WS_END = WS_B + 144 * MiB;

struct Params {
    const float *x, *c, *ctx, *c_ctx, *mod_w, *mod_b, *norm1_g, *norm2_g, *w_in,
        *rw_w0, *rw_w_lora_b, *rw_a0, *rw_a_lora_b, *rw_g_lora_b, *rw_k_k, *rw_k_a, *rw_r_k, *rw_ln_g, *rw_ln_b,
        *na_q_g, *na_k_g, *na_rpb, *proj_a, *proj_b, *w_out, *router_w, *router_bias, *moe_w1, *moe_w3, *moe_w2;
    float* out; unsigned char* ws;
};

__device__ __forceinline__ int otid() { int t = threadIdx.x; asm volatile("" : "+v"(t)); return t; }
template <int M> __device__ __forceinline__ float swz_xor(float v) { return __int_as_float(__builtin_amdgcn_ds_swizzle(__float_as_int(v), (M << 10) | 0x1f)); }
__device__ __forceinline__ float xor32_add(float v) { auto rr = __builtin_amdgcn_permlane32_swap(__float_as_uint(v), __float_as_uint(v), false, false); return __uint_as_float(rr[0]) + __uint_as_float(rr[1]); }
__device__ __forceinline__ float xor32_max(float v) { auto rr = __builtin_amdgcn_permlane32_swap(__float_as_uint(v), __float_as_uint(v), false, false); return fmaxf(__uint_as_float(rr[0]), __uint_as_float(rr[1])); }
__device__ __forceinline__ float wave_sum(float v) {
    v += swz_xor<1>(v); v += swz_xor<2>(v); v += swz_xor<4>(v); v += swz_xor<8>(v); v += swz_xor<16>(v);
    return xor32_add(v);
}
__device__ __forceinline__ float wave_max(float v) {
    v = fmaxf(v, swz_xor<1>(v)); v = fmaxf(v, swz_xor<2>(v)); v = fmaxf(v, swz_xor<4>(v)); v = fmaxf(v, swz_xor<8>(v)); v = fmaxf(v, swz_xor<16>(v));
    return xor32_max(v);
}
__device__ __forceinline__ float rdlane(float v, int l) { return __int_as_float(__builtin_amdgcn_readlane(__float_as_int(v), l)); }
__device__ __forceinline__ float sigmoidf_(float x) { return __builtin_amdgcn_rcpf(1.f + __expf(-x)); }
__device__ __forceinline__ int mod_row(int r) { return r < NLAT ? (r >> 11) : 8; }
__device__ __forceinline__ const float* in_row(const Params& p, int r) { return r < NLAT ? p.x + (size_t)r * DM : p.ctx + (size_t)(r - NLAT) * DM; }
__device__ __forceinline__ float* st_row(const Params& p, int r) { return r < NLAT ? p.out + (size_t)r * DM : (float*)(p.ws + WS_CTXS) + (size_t)(r - NLAT) * DM; }

__device__ __forceinline__ void ph_mod(const Params& p, float* sm, int wg, int nwg) {
    for (int i = otid(); i < 9 * DM; i += blockDim.x) {
        int j = i >> 10, k = i & 1023; float v = j < 8 ? p.c[j * DM + k] : p.c_ctx[k];
        sm[i] = v * sigmoidf_(v);
    }
    __syncthreads();
    float* MOD = (float*)(p.ws + WS_MOD);
    for (int o = wg * blockDim.x + otid(); o < 2 * 6144; o += nwg * blockDim.x) {
        int l = o / 6144, n = o % 6144;
        float acc[9];
#pragma unroll
        for (int j = 0; j < 9; ++j) acc[j] = 0.f;
        const float* w = p.mod_w + (size_t)l * DM * 6144 + n;
        for (int k = 0; k < DM; ++k) { float wv = w[(size_t)k * 6144];
#pragma unroll
            for (int j = 0; j < 9; ++j) acc[j] += sm[j * DM + k] * wv; }
        float bb = p.mod_b[l * 6144 + n];
#pragma unroll
        for (int j = 0; j < 9; ++j) MOD[(l * 9 + j) * 6144 + n] = acc[j] + bb;
    }
}

__device__ __forceinline__ void ph_mod2(const Params& p, float* sm, int wg, int nwg) {
    const int tid = otid(), lane = tid & 63, wv = tid >> 6;
    float* sc = sm;
    float* red = sm + 9 * 1024;
    for (int i = tid; i < 9 * DM; i += 512) { const int j = i >> 10, k = i & 1023; const float v = j < 8 ? p.c[j * DM + k] : p.c_ctx[k]; sc[i] = v * sigmoidf_(v); }
    __syncthreads();
    float* MOD = (float*)(p.ws + WS_MOD);
    for (int unit = wg; unit < 192; unit += nwg) {
        const int l = unit / 96, n0 = (unit % 96) * 64;
        const float* w = p.mod_w + ((size_t)l * DM + wv * 128) * 6144 + n0 + lane;
        float acc[9];
#pragma unroll
        for (int j = 0; j < 9; ++j) acc[j] = 0.f;
        for (int k0 = 0; k0 < 128; k0 += 16) {
            float wv_[16];
#pragma unroll
            for (int i = 0; i < 16; ++i) wv_[i] = w[(size_t)(k0 + i) * 6144];
#pragma unroll
            for (int i4 = 0; i4 < 4; ++i4)
#pragma unroll
                for (int j = 0; j < 9; ++j) { const float4 s4 = *(const float4*)(sc + j * DM + wv * 128 + k0 + i4 * 4);
                    acc[j] += s4.x * wv_[i4 * 4] + s4.y * wv_[i4 * 4 + 1] + s4.z * wv_[i4 * 4 + 2] + s4.w * wv_[i4 * 4 + 3]; }
        }
        __syncthreads();
#pragma unroll
        for (int j = 0; j < 9; ++j) red[(wv * 9 + j) * 64 + lane] = acc[j];
        __syncthreads();
        for (int o = tid; o < 9 * 64; o += 512) { const int j = o >> 6, cc = o & 63; float sum = p.mod_b[l * 6144 + n0 + cc];
#pragma unroll
            for (int w8 = 0; w8 < 8; ++w8) sum += red[(w8 * 9 + j) * 64 + cc];
            MOD[(l * 9 + j) * 6144 + n0 + cc] = sum; }
    }
}
__device__ __forceinline__ void norm_row_to_h(const f32x4 (&v)[4], const float* g1, const float* m, bf16_t* hrow, int lane) {
    float ss = 0.f;
#pragma unroll
    for (int j = 0; j < 4; ++j) ss += (v[j][0] * v[j][0] + v[j][1] * v[j][1]) + (v[j][2] * v[j][2] + v[j][3] * v[j][3]);
    ss = wave_sum(ss);
    const float rs = rsqrtf(ss * (1.f / DM) + RMS_EPS);
#pragma unroll
    for (int j = 0; j < 4; ++j) { const int d = 4 * lane + 256 * j;
        const f32x4 g = *(const f32x4*)(g1 + d), sh = *(const f32x4*)(m + d), scl = *(const f32x4*)(m + DM + d);
        const f32x4 y = v[j] * rs * g * (scl + 1.f) + sh;
        v2u w; w.x = pk2(y[0], y[1]); w.y = pk2(y[2], y[3]);
        *(v2u*)(hrow + d) = w; }
}
__device__ __forceinline__ void ph_norm1v(const Params& p, int wg, int nwg) {
    const int lane = otid() & 63, wv = otid() >> 6;
    const float* MOD = (const float*)(p.ws + WS_MOD);
    bf16_t* H = (bf16_t*)(p.ws + WS_H);
    for (int r = wg * 8 + wv; r < LR; r += nwg * 8) {
        const float* xr = in_row(p, r);
        f32x4 v[4];
#pragma unroll
        for (int j = 0; j < 4; ++j) v[j] = *(const f32x4*)(xr + 4 * lane + 256 * j);
        norm_row_to_h(v, p.norm1_g, MOD + (0 * 9 + mod_row(r)) * 6144, H + (size_t)r * DM, lane);
    }
}
__device__ __forceinline__ void ph_combine_norm(const Params& p, int l, int wg, int nwg) {
    const int lane = otid() & 63, wv = otid() >> 6;
    const float* MOD = (const float*)(p.ws + WS_MOD);
    const bf16_t* YS = (const bf16_t*)(p.ws + WS_YS2);
    bf16_t* H = (bf16_t*)(p.ws + WS_H);
    const int nrows = (l == 1) ? NLAT : LR;
    for (int r = wg * 8 + wv; r < nrows; r += nwg * 8) {
        float* xr = st_row(p, r);
        bf16_t* xb = (r < NLAT) ? (bf16_t*)p.out + (size_t)r * DM : (bf16_t*)(p.ws + WS_CTXS) + (size_t)(r - NLAT) * DM;
        const float* m = MOD + (l * 9 + mod_row(r)) * 6144;
        f32x4 v[4];
#pragma unroll
        for (int j = 0; j < 4; ++j) { const int d = 4 * lane + 256 * j;
            float a[4], b[4]; unpack4(*(const v2u*)(YS + (size_t)(2 * r) * DM + d), a); unpack4(*(const v2u*)(YS + (size_t)(2 * r + 1) * DM + d), b);
            const f32x4 gt = *(const f32x4*)(m + 5 * DM + d);
            float x4[4]; unpack4(*(const v2u*)((const bf16_t*)(p.ws + WS_X1B) + (size_t)r * DM + d), x4);
            f32x4 x = {x4[0], x4[1], x4[2], x4[3]};
            x[0] += gt[0] * (a[0] + b[0]); x[1] += gt[1] * (a[1] + b[1]); x[2] += gt[2] * (a[2] + b[2]); x[3] += gt[3] * (a[3] + b[3]);
            if (l == 0) { v2u w; w.x = pk2(x[0], x[1]); w.y = pk2(x[2], x[3]); *(v2u*)(xb + d) = w; } else *(f32x4*)(xr + d) = x;
            v[j] = x; }
        if (l == 0) norm_row_to_h(v, p.norm1_g + DM, MOD + (1 * 9 + mod_row(r)) * 6144, H + (size_t)r * DM, lane);
    }
}

__device__ __forceinline__ void ph_norm1(const Params& p, int l, int wg, int nwg) {
    const int lane = otid() & 63, wv = otid() >> 6, nwv = blockDim.x >> 6;
    const float* MOD = (const float*)(p.ws + WS_MOD);
    bf16_t* H = (bf16_t*)(p.ws + WS_H);
    for (int r = wg * nwv + wv; r < LR; r += nwg * nwv) {
        const float* xr = l == 0 ? in_row(p, r) : st_row(p, r);
        float v[16]; float ss = 0.f;
#pragma unroll
        for (int i = 0; i < 16; ++i) { v[i] = xr[lane + 64 * i]; ss += v[i] * v[i]; }
        ss = wave_sum(ss);
        const float rs = rsqrtf(ss * (1.f / DM) + RMS_EPS);
        const float* m = MOD + (l * 9 + mod_row(r)) * 6144;
#pragma unroll
        for (int i = 0; i < 16; ++i) { int d = lane + 64 * i;
            float y = v[i] * rs * p.norm1_g[l * DM + d];
            H[(size_t)r * DM + d] = f2bf(y * (1.f + m[DM + d]) + m[d]); }
    }
}

namespace pg8 {
#define PG8_LAS __attribute__((address_space(3)))
typedef unsigned short bf16_t;
typedef short bf16x8 __attribute__((ext_vector_type(8)));
typedef float f32x4 __attribute__((ext_vector_type(4)));
typedef unsigned u32x4 __attribute__((ext_vector_type(4)));
constexpr int BM = 256, BK = 64, HALF = 128, HTB = HALF * BK * 2  , STAGE_BYTES = 8 * HTB, NXCD = 8, WGM = 8;

__host__ __device__ __forceinline__ int lds_byte(int r, int c) { const int st = (r >> 4) * 2 + (c >> 5), rr = r & 15, cc = c & 31, ob = rr * 64 + cc * 2; return st * 1024 + (ob ^ (((ob >> 9) & 1) << 5)); }
__host__ __device__ __forceinline__ void stage_rc(int b, int& R, int& C) { const int st = b / 1024, sb = b % 1024, swz = sb ^ (((sb >> 9) & 1) << 5); R = (st >> 1) * 16 + swz / 64; C = (st & 1) * 32 + (swz % 64) / 2; }
__host__ __device__ __forceinline__ int perm32(int rho) { const int n = rho >> 4, i = rho & 15; return 8 * (i >> 2) + 4 * n + (i & 3); }

struct Unit { int pm, pn; unsigned boff; };
struct Gemm { const bf16_t* A; const bf16_t* Bt; int M, N, K; };

struct StaticOrder {
    int nM, nN, nwg, G, c;
    __host__ __device__ void init(int M, int N, int G_, int c_) { nM = M / BM; nN = N / BM; nwg = nM * nN; G = G_; c = c_; }
    __host__ __device__ void unit_of(int L, Unit& u) const {
        int wgid = L; { const int q = nwg / NXCD, r = nwg % NXCD, xcd = wgid % NXCD, off = wgid / NXCD; wgid = (xcd < r ? xcd * (q + 1) : r * (q + 1) + (xcd - r) * q) + off; }
        const int nig = WGM * nN, gid = wgid / nig, fm = gid * WGM, gsz = (nM - fm) < WGM ? (nM - fm) : WGM;
        u.pm = fm + ((wgid % nig) % gsz); u.pn = (wgid % nig) / gsz; u.boff = 0u;
    }
    __host__ __device__ bool next(int i, Unit& u) const {
        const long L = (long)i * G + c; if (L >= nwg) return false;
        unit_of((int)L, u); return true;
    }
    __device__ __forceinline__ void a_ready(const Unit&) const {}
    __device__ __forceinline__ void done(const Unit&) const {}
    static constexpr bool GATHER = false;
    const int* rowsrc = nullptr;
    static constexpr bool DUALK = false;
    long dA = 0, dB = 0;
};

typedef float cvt_f32x2_t __attribute__((ext_vector_type(2))); typedef __bf16 cvt_bf16x2_t __attribute__((ext_vector_type(2)));
__device__ __forceinline__ unsigned cvt_pk_bf16(float lo, float hi) { const cvt_f32x2_t v = {lo, hi}; const cvt_bf16x2_t b = __builtin_convertvector(v, cvt_bf16x2_t); return __builtin_bit_cast(unsigned, b); }
template <class Epi, class Sched, bool ALIGN_EPI = false, bool SP2 = false>
__device__ __forceinline__ void gemm_phase(PG8_LAS unsigned char* lds, const Gemm g, const Sched& S, const Epi& E) {
    const int tid = otid(), wid = __builtin_amdgcn_readfirstlane(tid >> 6), lane = tid & 63, wr = wid >> 2, wc = wid & 3, fr = lane & 15, fq = lane >> 4;
    constexpr bool DUALK = Sched::DUALK;
    const int K = g.K, nt = DUALK ? 2 * (K / BK) : K / BK;
    constexpr bool GATH = Sched::GATHER;
    static_assert(!GATH || SP2, "gather needs the SP2 loop");
    unsigned voffA[2], voffB[2];
#pragma unroll
    for (int i = 0; i < 2; ++i) { int R, C; stage_rc(tid * 16 + i * 8192, R, C); const int Rb = Epi::PERM ? ((R & ~31) + perm32(R & 31)) : R;
        voffA[i] = (unsigned)(R * K + C) * 2u; voffB[i] = (unsigned)(Rb * K + C) * 2u; }
    const size_t kstep = (size_t)(BK * 2);
    const size_t hstep = (size_t)HALF * K * 2;
    const size_t tstep = 2 * hstep;
    const unsigned ldsw = (unsigned)wid * 1024u;
    const int aoff = lds_byte(wr * 64 + fr, fq * 8), boff = lds_byte(wc * 32 + fr, fq * 8);
#define PG8_SA(b, h) (((b) * 2 + (h)) * HTB)
#define PG8_SB(b, h) ((4 + (b) * 2 + (h)) * HTB)
#define PG8_STAGE(bufoff, gbase, voff) do { _Pragma("unroll") for (int _i = 0; _i < 2; ++_i) \
        __builtin_amdgcn_global_load_lds((const unsigned*)((const char*)(gbase) + (voff)[_i]), (PG8_LAS unsigned*)(lds + (bufoff) + ldsw + _i * 8192), 16, 0, 0); } while (0)
#define PG8_STAGEG(bufoff, off2, kb) do { _Pragma("unroll") for (int _i = 0; _i < 2; ++_i) \
        __builtin_amdgcn_global_load_lds((const unsigned*)((const char*)g.A + (kb) + (off2)[_i]), (PG8_LAS unsigned*)(lds + (bufoff) + ldsw + _i * 8192), 16, 0, 0); } while (0)
#define PG8_STA(bufoff, pexpr, hh, usenext, kb) do { if constexpr (GATH) { if (usenext) PG8_STAGEG(bufoff, gn[hh], kb); else PG8_STAGEG(bufoff, go[hh], kb); } else { PG8_STAGE(bufoff, pexpr, voffA); } } while (0)
#define PG8_GOFF(dst, pm_) do { if constexpr (GATH) { _Pragma("unroll") for (int h_ = 0; h_ < 2; ++h_) _Pragma("unroll") for (int i_ = 0; i_ < 2; ++i_) { int R_, C_; stage_rc(tid * 16 + i_ * 8192, R_, C_); \
        const int v_ = S.rowsrc[(pm_) * 256 + h_ * 128 + R_]; dst[h_][i_] = (unsigned)((v_ < 0 ? 0 : v_) >> 1) * (unsigned)(K * 2) + (unsigned)(C_ * 2); } } } while (0)
#define PG8_LDA(dst, b, h) do { _Pragma("unroll") for (int m = 0; m < 4; ++m) _Pragma("unroll") for (int k = 0; k < 2; ++k) dst[m][k] = *(const PG8_LAS bf16x8*)(lds + PG8_SA(b, h) + aoff + m * 2048 + k * 1024); } while (0)
#define PG8_LDB(dst, b, h) do { _Pragma("unroll") for (int n = 0; n < 2; ++n) _Pragma("unroll") for (int k = 0; k < 2; ++k) dst[n][k] = *(const PG8_LAS bf16x8*)(lds + PG8_SB(b, h) + boff + n * 2048 + k * 1024); } while (0)
#define PG8_MMA(ai, bj, At, Bt) do { __builtin_amdgcn_s_setprio(1); _Pragma("unroll") for (int m = 0; m < 4; ++m) _Pragma("unroll") for (int n = 0; n < 2; ++n) _Pragma("unroll") for (int k = 0; k < 2; ++k) \
        acc[ai][bj][m][n] = __builtin_amdgcn_mfma_f32_16x16x32_bf16(Bt[n][k], At[m][k], acc[ai][bj][m][n], 0, 0, 0); __builtin_amdgcn_s_setprio(0); } while (0)
#define PG8_WAIT_V(n) asm volatile("s_waitcnt vmcnt(" #n ")" ::: "memory")
#define PG8_WAIT_L(n) asm volatile("s_waitcnt lgkmcnt(" #n ")" ::: "memory")
#define PG8_BAR __builtin_amdgcn_s_barrier()
#define PG8_SCHED __builtin_amdgcn_sched_barrier(0)
    Unit cur, nxt; int ui = 0;
    if (!S.next(0, cur)) return;
    f32x4 acc[2][2][4][2];
#pragma unroll
    for (int a = 0; a < 2; ++a)
#pragma unroll
        for (int b = 0; b < 2; ++b)
#pragma unroll
            for (int m = 0; m < 4; ++m)
#pragma unroll
                for (int n = 0; n < 2; ++n) acc[a][b][m][n] = (f32x4){0.f, 0.f, 0.f, 0.f};
    bf16x8 At[4][2], B0[2][2], B1[2][2];
    const char* cA = (const char*)g.A + (size_t)cur.pm * tstep; const char* cB = (const char*)g.Bt + cur.boff + (size_t)cur.pn * tstep;
    unsigned go[2][2] = {{0u, 0u}, {0u, 0u}}, gn[2][2] = {{0u, 0u}, {0u, 0u}};
    PG8_GOFF(go, cur.pm);
    S.a_ready(cur);
    if constexpr (SP2) {
        PG8_STAGE(PG8_SB(0, 0), cB, voffB); PG8_STAGE(PG8_SB(0, 1), cB + hstep, voffB); PG8_STA(PG8_SA(0, 0), cA, 0, false, (size_t)0); PG8_STA(PG8_SA(0, 1), cA + hstep, 1, false, (size_t)0);
        if (wr == 1) PG8_BAR;
        PG8_WAIT_V(2); PG8_BAR;
        PG8_STAGE(PG8_SB(1, 0), cB + kstep, voffB); PG8_STA(PG8_SA(1, 0), cA + kstep, 0, false, kstep); PG8_STAGE(PG8_SB(1, 1), cB + hstep + kstep, voffB);
        PG8_WAIT_V(6); PG8_BAR;
    } else {
        PG8_STAGE(PG8_SB(0, 0), cB, voffB); PG8_STAGE(PG8_SA(0, 0), cA, voffA); PG8_STAGE(PG8_SB(0, 1), cB + hstep, voffB); PG8_STAGE(PG8_SA(0, 1), cA + hstep, voffA);
        if (wr == 1) PG8_BAR;
        PG8_WAIT_V(4); PG8_BAR;
        PG8_STAGE(PG8_SB(1, 0), cB + kstep, voffB); PG8_STAGE(PG8_SA(1, 0), cA + kstep, voffA); PG8_STAGE(PG8_SB(1, 1), cB + hstep + kstep, voffB);
        PG8_WAIT_V(6); PG8_BAR;
    }
    for (;;) {
        const bool has_next = S.next(ui + 1, nxt);
        if constexpr (GATH) { if (has_next) PG8_GOFF(gn, nxt.pm); else { _Pragma("unroll") for (int h_ = 0; h_ < 2; ++h_) _Pragma("unroll") for (int i_ = 0; i_ < 2; ++i_) gn[h_][i_] = go[h_][i_]; } }
        const char* nA = has_next ? (const char*)g.A + (size_t)nxt.pm * tstep : cA; const char* nB = has_next ? (const char*)g.Bt + nxt.boff + (size_t)nxt.pn * tstep : cB;
        for (int t = 0; t < nt; t += 2) {
            const bool last = (t == nt - 2);
            const long ja1 = (DUALK && t + 1 >= nt / 2) ? S.dA : 0, ja2 = (DUALK && t + 2 >= nt / 2) ? S.dA : 0, ja3 = (DUALK && t + 3 >= nt / 2) ? S.dA : 0, jb2 = (DUALK && t + 2 >= nt / 2) ? S.dB : 0, jb3 = (DUALK && t + 3 >= nt / 2) ? S.dB : 0;
            const char* a1 = cA + (size_t)(t + 1) * kstep + ja1;
            const char* a2 = last ? nA : cA + (size_t)(t + 2) * kstep + ja2; const char* b2 = last ? nB : cB + (size_t)(t + 2) * kstep + jb2;
            const char* a3 = last ? nA + kstep : cA + (size_t)(t + 3) * kstep + ja3; const char* b3 = last ? nB + kstep : cB + (size_t)(t + 3) * kstep + jb3;
            if constexpr (DUALK) { if (t == nt / 2) E.mid(acc, cur, wr, wc, fr, fq); }
            if (last && has_next) S.a_ready(nxt);
            const size_t kb2 = last ? (size_t)0 : (size_t)(t + 2) * kstep;
            if constexpr (SP2) {
            PG8_LDB(B0, 0, 0); PG8_LDB(B1, 0, 1); PG8_SCHED; PG8_LDA(At, 0, 0); PG8_STA(PG8_SA(1, 1), a1 + hstep, 1, false, (size_t)(t + 1) * kstep);
            PG8_WAIT_V(8); PG8_WAIT_L(0); PG8_BAR; PG8_MMA(0, 0, At, B0); PG8_MMA(0, 1, At, B1); PG8_BAR; PG8_SCHED;
            PG8_LDA(At, 0, 1); PG8_STAGE(PG8_SB(0, 0), b2, voffB); PG8_STAGE(PG8_SB(0, 1), b2 + hstep, voffB); PG8_STA(PG8_SA(0, 0), a2, 0, last, kb2);
            PG8_WAIT_V(8); PG8_WAIT_L(0); PG8_BAR; PG8_MMA(1, 0, At, B0); PG8_MMA(1, 1, At, B1); PG8_BAR; PG8_SCHED;
            PG8_LDB(B0, 1, 0); PG8_LDB(B1, 1, 1); PG8_SCHED; PG8_LDA(At, 1, 0); PG8_STA(PG8_SA(0, 1), a2 + hstep, 1, last, kb2);
            PG8_WAIT_V(8); PG8_WAIT_L(0); PG8_BAR; PG8_MMA(0, 0, At, B0); PG8_MMA(0, 1, At, B1); PG8_BAR; PG8_SCHED;
            PG8_LDA(At, 1, 1); PG8_STAGE(PG8_SB(1, 0), b3, voffB); PG8_STAGE(PG8_SB(1, 1), b3 + hstep, voffB); PG8_STA(PG8_SA(1, 0), a3, 0, last, kb2 + kstep);
            PG8_WAIT_V(8); PG8_WAIT_L(0); PG8_BAR; PG8_MMA(1, 0, At, B0); PG8_MMA(1, 1, At, B1); PG8_BAR; PG8_SCHED;
            } else {
            PG8_LDB(B0, 0, 0); PG8_SCHED; PG8_LDA(At, 0, 0); PG8_STAGE(PG8_SA(1, 1), a1 + hstep, voffA);
            PG8_WAIT_L(8); PG8_BAR; PG8_WAIT_L(0); PG8_MMA(0, 0, At, B0); PG8_BAR; PG8_SCHED;
            PG8_LDB(B1, 0, 1); PG8_STAGE(PG8_SB(0, 0), b2, voffB);
            PG8_BAR; PG8_WAIT_L(0); PG8_MMA(0, 1, At, B1); PG8_BAR;
            PG8_LDA(At, 0, 1); PG8_STAGE(PG8_SA(0, 0), a2, voffA);
            PG8_BAR; PG8_WAIT_L(0); PG8_MMA(1, 0, At, B0); PG8_BAR; PG8_SCHED;
            PG8_STAGE(PG8_SB(0, 1), b2 + hstep, voffB);
            PG8_WAIT_V(6); PG8_BAR; PG8_MMA(1, 1, At, B1); PG8_BAR;
            PG8_LDB(B0, 1, 0); PG8_SCHED; PG8_LDA(At, 1, 0); PG8_STAGE(PG8_SA(0, 1), a2 + hstep, voffA);
            PG8_WAIT_L(8); PG8_BAR; PG8_WAIT_L(0); PG8_MMA(0, 0, At, B0); PG8_BAR; PG8_SCHED;
            PG8_LDB(B1, 1, 1); PG8_STAGE(PG8_SB(1, 0), b3, voffB);
            PG8_BAR; PG8_WAIT_L(0); PG8_MMA(0, 1, At, B1); PG8_BAR;
            PG8_LDA(At, 1, 1); PG8_STAGE(PG8_SA(1, 0), a3, voffA);
            PG8_BAR; PG8_WAIT_L(0); PG8_MMA(1, 0, At, B0); PG8_BAR; PG8_SCHED;
            PG8_STAGE(PG8_SB(1, 1), b3 + hstep, voffB);
            PG8_WAIT_V(6); PG8_BAR; PG8_MMA(1, 1, At, B1); PG8_BAR;
            }
        }
        if constexpr (ALIGN_EPI) { if (wr == 0) PG8_BAR; }
        if constexpr (!Epi::AFTER_DRAIN) { E(acc, cur, wr, wc, fr, fq); S.done(cur); }
        if (!has_next) break;
#pragma unroll
        for (int a = 0; a < 2; ++a)
#pragma unroll
            for (int b = 0; b < 2; ++b)
#pragma unroll
                for (int m = 0; m < 4; ++m)
#pragma unroll
                    for (int n = 0; n < 2; ++n) acc[a][b][m][n] = (f32x4){0.f, 0.f, 0.f, 0.f};
        cur = nxt; cA = nA; cB = nB; ++ui;
        if constexpr (GATH) { _Pragma("unroll") for (int h_ = 0; h_ < 2; ++h_) _Pragma("unroll") for (int i_ = 0; i_ < 2; ++i_) go[h_][i_] = gn[h_][i_]; }
        if constexpr (ALIGN_EPI) { if (wr == 1) PG8_BAR; }
    }
    PG8_WAIT_V(0);
    if constexpr (!ALIGN_EPI) { if (wr == 0) PG8_BAR; }
    PG8_BAR;
    if constexpr (Epi::AFTER_DRAIN) { E.fused(acc, cur, wr, wc, fr, fq, lds, wid, lane); S.done(cur); }
#undef PG8_SA
#undef PG8_SB
#undef PG8_STAGE
#undef PG8_STAGEG
#undef PG8_STA
#undef PG8_GOFF
#undef PG8_LDA
#undef PG8_LDB
#undef PG8_MMA
#undef PG8_WAIT_V
#undef PG8_WAIT_L
#undef PG8_BAR
#undef PG8_SCHED
}
}

#define LAS __attribute__((address_space(3)))
__device__ __forceinline__ void tr_item(const float* W, int ldw, int k0, int n0, bf16_t* WT, int ldt, int dst_row0, LAS float* scr, int lane) {
    const int rr = lane >> 3, c4 = (lane & 7) * 4;
    f32x4 v[8];
#pragma unroll
    for (int i = 0; i < 8; ++i) v[i] = *(const f32x4*)(W + (size_t)(k0 + 8 * i + rr) * ldw + n0 + c4);
#pragma unroll
    for (int i = 0; i < 8; ++i) { LAS float* d = scr + (8 * i + rr) * 33 + c4; d[0] = v[i][0]; d[1] = v[i][1]; d[2] = v[i][2]; d[3] = v[i][3]; }
    asm volatile("s_waitcnt lgkmcnt(0)" ::: "memory");
    const int c = lane & 7;
#pragma unroll
    for (int j = 0; j < 4; ++j) { const int n = (lane >> 3) + 8 * j; const LAS float* sp = scr + (8 * c) * 33 + n;
        v4u o; o.x = pk2(sp[0 * 33], sp[1 * 33]); o.y = pk2(sp[2 * 33], sp[3 * 33]); o.z = pk2(sp[4 * 33], sp[5 * 33]); o.w = pk2(sp[6 * 33], sp[7 * 33]);
        *(v4u*)(WT + (size_t)(dst_row0 + n) * ldt + k0 + 8 * c) = o; }
    asm volatile("s_waitcnt lgkmcnt(0)" ::: "memory");
}
__device__ __forceinline__ void ph_convert_dense(const Params& p, unsigned char* ldsb, int l, int wg, int nwg) {
    const int lane = otid() & 63, wv = __builtin_amdgcn_readfirstlane(otid() >> 6);
    LAS float* scr = (LAS float*)((LAS unsigned char*)ldsb + wv * 16384);
    const int gw = wg * 8 + wv, NGW = nwg * 8;
    constexpr int I_WIN = 16 * 172, I_PA = 8 * 32, I_WO = 16 * 32, I_LO = 64, I_GL = 32, NIT = I_WIN + 2 * I_PA + I_WO + I_LO + I_GL;
    for (int it = gw; it < NIT; it += NGW) {
        int r = it;
        if (r < I_WIN) { const int kb = r / 172, nb = r % 172; tr_item(p.w_in + (size_t)l * DM * ZC, ZC, kb * 64, nb * 32, (bf16_t*)(p.ws + WS_WIN_T), DM, nb * 32, scr, lane); continue; } r -= I_WIN;
        if (r < I_PA) { const int kb = r / 32, nb = r % 32; tr_item(p.proj_a + (size_t)l * 512 * DM, DM, kb * 64, nb * 32, (bf16_t*)(p.ws + WS_PA_T), 512, nb * 32, scr, lane); continue; } r -= I_PA;
        if (r < I_PA) { const int kb = r / 32, nb = r % 32; tr_item(p.proj_b + (size_t)l * 512 * DM, DM, kb * 64, nb * 32, (bf16_t*)(p.ws + WS_PB_T), 512, nb * 32, scr, lane); continue; } r -= I_PA;
        if (r < I_WO) { const int kb = r / 32, nb = r % 32; tr_item(p.w_out + (size_t)l * DM * DM, DM, kb * 64, nb * 32, (bf16_t*)(p.ws + WS_WO_T), DM, nb * 32, scr, lane); continue; } r -= I_WO;
        if (r >= I_LO) { r -= I_LO; const int kb = r >> 4, nb = r & 15;
            tr_item(p.rw_g_lora_b + (size_t)l * 128 * 512, 512, kb * 64, nb * 32, (bf16_t*)(p.ws + WS_GL_T), 256, nb * 32, scr, lane); continue; }
        { const int which = r >> 5, dir = (r >> 4) & 1, nb = r & 15;
          const float* W = (which ? p.rw_a_lora_b : p.rw_w_lora_b) + (size_t)((l * 2 + dir) * 64) * 512;
          tr_item(W, 512, 0, nb * 32, (bf16_t*)(p.ws + (which ? WS_LA_T : WS_LW_T)) + (size_t)dir * 512 * 64, 64, nb * 32, scr, lane); }
    }
    for (int i = wg * 512 + otid(); i < 512 * 16; i += nwg * 512) ((v4u*)(p.ws + WS_GL_T))[(i >> 4) * 32 + 16 + (i & 15)] = (v4u){0u, 0u, 0u, 0u};
    for (int i = wg * 512 + otid(); i < 16384; i += nwg * 512) ((v4u*)(p.ws + WS_WIN_T + (size_t)ZC * DM * 2))[i] = (v4u){0u, 0u, 0u, 0u};
}

struct EpiZ {
    static constexpr bool PERM = true, AFTER_DRAIN = false;
    bf16_t* Z; bf16_t* SG; bf16_t* VT;
    __device__ __forceinline__ void operator()(const f32x4 (&acc)[2][2][4][2], const pg8::Unit& u, int wr, int wc, int fr, int fq) const {
        const int row0 = u.pm * 256 + wr * 64 + fr;
        const bool lat = u.pm < 64;
        const int bb = lat ? (u.pm >> 3) : (u.pm - 64);
#pragma unroll
        for (int ai = 0; ai < 2; ++ai)
#pragma unroll
            for (int m = 0; m < 4; ++m) { const int row = row0 + ai * 128 + m * 16;
#pragma unroll
                for (int bj = 0; bj < 2; ++bj) { const int cb = u.pn * 256 + bj * 128; if (cb >= ZC) continue;
                    const int col = cb + wc * 32 + 8 * fq;
                    const f32x4 v0 = acc[ai][bj][m][0], v1 = acc[ai][bj][m][1];
                    float o[8] = {v0[0], v0[1], v0[2], v0[3], v1[0], v1[1], v1[2], v1[3]};
                    if (cb == C_LG) {
#pragma unroll
                        for (int e = 0; e < 8; ++e) o[e] = sigmoidf_(o[e]);
                        v4u w; w.x = pg8::cvt_pk_bf16(o[0], o[1]); w.y = pg8::cvt_pk_bf16(o[2], o[3]); w.z = pg8::cvt_pk_bf16(o[4], o[5]); w.w = pg8::cvt_pk_bf16(o[6], o[7]);
                        *(v4u*)(SG + (size_t)row * 256 + (col - C_LG)) = w;
                        *(v4u*)(SG + (size_t)row * 256 + 128 + (col - C_LG)) = (v4u){0u, 0u, 0u, 0u};
                    } else if (cb >= C_GA) {
                        unsigned q[8];
#pragma unroll
                        for (int e = 0; e < 8; ++e) q[e] = (unsigned)(sigmoidf_(o[e]) * 255.f + 0.5f);
                        v2u w; w.x = q[0] | (q[1] << 8) | (q[2] << 16) | (q[3] << 24); w.y = q[4] | (q[5] << 8) | (q[6] << 16) | (q[7] << 24);
                        const int gbase = (col >= C_GB) ? C_GB : C_GA;
                        *(v2u*)((unsigned char*)Z + ((size_t)row * ZC + gbase) * 2 + (col - gbase)) = w;
                    } else {
                        if (cb == C_LW) {
#pragma unroll
                            for (int e = 0; e < 8; ++e) { const float ex = __expf(2.f * o[e]); o[e] = 1.f - 2.f * __builtin_amdgcn_rcpf(ex + 1.f); } }
                        v4u w; w.x = pg8::cvt_pk_bf16(o[0], o[1]); w.y = pg8::cvt_pk_bf16(o[2], o[3]); w.z = pg8::cvt_pk_bf16(o[4], o[5]); w.w = pg8::cvt_pk_bf16(o[6], o[7]);
                        if (!(cb >= C_VB && cb < C_VB + 512)) *(v4u*)(Z + (size_t)row * ZC + col) = w;
                        if (cb >= C_VB && cb < C_VB + 512) {
                            const int hd = (col - C_VB) >> 6, d0 = (col - C_VB) & 63;
                            const int tpos = lat ? 256 + (row & 2047) : (row & 255);
                            bf16_t* vt = VT + ((size_t)((bb * 8 + hd) * 64 + d0)) * 2304 + tpos;
#pragma unroll
                            for (int e = 0; e < 8; ++e) vt[(size_t)e * 2304] = (bf16_t)((e & 1) ? (((e >> 1) == 0 ? w.x : (e >> 1) == 1 ? w.y : (e >> 1) == 2 ? w.z : w.w) >> 16) : (((e >> 1) == 0 ? w.x : (e >> 1) == 1 ? w.y : (e >> 1) == 2 ? w.z : w.w) & 0xffffu));
                        }
                    } } }
    }
};
struct DualOrder : pg8::StaticOrder { static constexpr bool DUALK = true; };
struct EpiMergeF {
    static constexpr bool PERM = true, AFTER_DRAIN = false;
    const bf16_t* Z; bf16_t* MG;
    __device__ __forceinline__ void mid(f32x4 (&acc)[2][2][4][2], const pg8::Unit& u, int wr, int wc, int fr, int fq) const {
        int row0 = u.pm * 256 + wr * 64 + fr, colb = u.pn * 256 + wc * 32 + 8 * fq;
        asm volatile("" : "+v"(row0), "+v"(colb));
        v2u qa[2][2][4], qb[2][2][4];
#pragma unroll
        for (int ai = 0; ai < 2; ++ai)
#pragma unroll
            for (int bj = 0; bj < 2; ++bj)
#pragma unroll
                for (int m = 0; m < 4; ++m) { const int row = row0 + ai * 128 + m * 16, col = colb + bj * 128;
                    qa[ai][bj][m] = *(const v2u*)((const unsigned char*)Z + ((size_t)row * ZC + C_GA) * 2 + col);
                    qb[ai][bj][m] = *(const v2u*)((const unsigned char*)Z + ((size_t)row * ZC + C_GB) * 2 + col); }
#pragma unroll
        for (int ai = 0; ai < 2; ++ai)
#pragma unroll
            for (int bj = 0; bj < 2; ++bj)
#pragma unroll
                for (int m = 0; m < 4; ++m)
#pragma unroll
                    for (int e = 0; e < 4; ++e) {
                        const unsigned b0 = (qb[ai][bj][m].x >> (8 * e)) & 255u, b1 = (qb[ai][bj][m].y >> (8 * e)) & 255u;
                        const float r0 = (float)((qa[ai][bj][m].x >> (8 * e)) & 255u) * __builtin_amdgcn_rcpf((float)(b0 ? b0 : 1u));
                        const float r1 = (float)((qa[ai][bj][m].y >> (8 * e)) & 255u) * __builtin_amdgcn_rcpf((float)(b1 ? b1 : 1u));
                        acc[ai][bj][m][0][e] *= r0; acc[ai][bj][m][1][e] *= r1; }
    }
    __device__ __forceinline__ void operator()(const f32x4 (&acc)[2][2][4][2], const pg8::Unit& u, int wr, int wc, int fr, int fq) const {
        const int row0 = u.pm * 256 + wr * 64 + fr, colb = u.pn * 256 + wc * 32 + 8 * fq;
#pragma unroll
        for (int ai = 0; ai < 2; ++ai) {
            v2u qb[2][4];
#pragma unroll
            for (int bj = 0; bj < 2; ++bj)
#pragma unroll
                for (int m = 0; m < 4; ++m) { const int row = row0 + ai * 128 + m * 16, col = colb + bj * 128;
                    qb[bj][m] = *(const v2u*)((const unsigned char*)Z + ((size_t)row * ZC + C_GB) * 2 + col); }
#pragma unroll
            for (int bj = 0; bj < 2; ++bj)
#pragma unroll
                for (int m = 0; m < 4; ++m) { const int row = row0 + ai * 128 + m * 16, col = colb + bj * 128;
                    float o[8];
#pragma unroll
                    for (int e = 0; e < 4; ++e) { const unsigned b0 = (qb[bj][m].x >> (8 * e)) & 255u, b1 = (qb[bj][m].y >> (8 * e)) & 255u;
                        o[e] = acc[ai][bj][m][0][e] * ((float)(b0 ? b0 : 1u) * (1.f / 255.f)); o[4 + e] = acc[ai][bj][m][1][e] * ((float)(b1 ? b1 : 1u) * (1.f / 255.f)); }
                    v4u w; w.x = pg8::cvt_pk_bf16(o[0], o[1]); w.y = pg8::cvt_pk_bf16(o[2], o[3]); w.z = pg8::cvt_pk_bf16(o[4], o[5]); w.w = pg8::cvt_pk_bf16(o[6], o[7]);
                    *(v4u*)(MG + (size_t)row * DM + col) = w; } }
    }
};
struct EpiWout {
    static constexpr bool PERM = true, AFTER_DRAIN = false;
    const float* x; const float* ctx; const float* out; const float* ctxs; const float* mod; bf16_t* x1b; int l;
    __device__ __forceinline__ void operator()(const f32x4 (&acc)[2][2][4][2], const pg8::Unit& u, int wr, int wc, int fr, int fq) const {
        const bool lat = u.pm < 64;
        const float* base = lat ? x + (size_t)u.pm * 256 * DM : ctx + (size_t)(u.pm - 64) * 256 * DM;
        const bf16_t* baseb = lat ? (const bf16_t*)out + (size_t)u.pm * 256 * DM : (const bf16_t*)ctxs + (size_t)(u.pm - 64) * 256 * DM;
        bf16_t* dst = x1b + (size_t)u.pm * 256 * DM;
        const float* g = mod + (l * 9 + (lat ? (u.pm >> 3) : 8)) * 6144 + 2 * DM;
        const int r0 = wr * 64 + fr, col0 = u.pn * 256 + wc * 32 + 8 * fq;
        f32x4 gv[2][2];
#pragma unroll
        for (int bj = 0; bj < 2; ++bj)
#pragma unroll
            for (int n = 0; n < 2; ++n) gv[bj][n] = *(const f32x4*)(g + col0 + bj * 128 + n * 4);
#pragma unroll
        for (int ai = 0; ai < 2; ++ai)
#pragma unroll
            for (int mp = 0; mp < 2; ++mp) {
                f32x4 bs[2][2][2];
#pragma unroll
                for (int mm = 0; mm < 2; ++mm) { const size_t off = (size_t)(r0 + ai * 128 + (2 * mp + mm) * 16) * DM + col0;
#pragma unroll
                    for (int bj = 0; bj < 2; ++bj) {
                        if (l == 0) {
#pragma unroll
                            for (int n = 0; n < 2; ++n) bs[mm][bj][n] = *(const f32x4*)(base + off + bj * 128 + n * 4);
                        } else { float f8[8]; unpack8(*(const v4u*)(baseb + off + bj * 128), f8);
                            bs[mm][bj][0] = (f32x4){f8[0], f8[1], f8[2], f8[3]}; bs[mm][bj][1] = (f32x4){f8[4], f8[5], f8[6], f8[7]}; } } }
#pragma unroll
                for (int mm = 0; mm < 2; ++mm) { const int m = 2 * mp + mm; const size_t off = (size_t)(r0 + ai * 128 + m * 16) * DM + col0;
#pragma unroll
                    for (int bj = 0; bj < 2; ++bj) { const f32x4 v0 = bs[mm][bj][0] + gv[bj][0] * acc[ai][bj][m][0], v1 = bs[mm][bj][1] + gv[bj][1] * acc[ai][bj][m][1];
                        v4u w; w.x = pg8::cvt_pk_bf16(v0[0], v0[1]); w.y = pg8::cvt_pk_bf16(v0[2], v0[3]); w.z = pg8::cvt_pk_bf16(v1[0], v1[1]); w.w = pg8::cvt_pk_bf16(v1[2], v1[3]);
                        *(v4u*)(dst + off + bj * 128) = w; } } }
    }
};

template <typename AT> __device__ __forceinline__ float ldA(const AT* p);
template <> __device__ __forceinline__ float ldA<bf16_t>(const bf16_t* p) { return bf2f(*p); }
template <> __device__ __forceinline__ float ldA<float>(const float* p) { return *p; }

template <typename AT, class Epi>
__device__ __forceinline__ void gemm_naive(float* sm, int wg, int nwg, int M, int N, int K, const AT* A, int lda, const int* rowmap, int rowshift,
                           const float* B, int ldb, Epi epi) {
    float* As = sm;
    float* Bs = sm + 16 * 132;
    const int tid = otid(), ty = tid >> 4, tx = tid & 15;
    const int ntm = (M + 127) / 128, ntn = N / 64;
    for (int tile = wg; tile < ntm * ntn; tile += nwg) {
        const int tm = tile / ntn, tn = tile % ntn, m0 = tm * 128, n0 = tn * 64;
        float acc[4][4];
#pragma unroll
        for (int i = 0; i < 4; ++i)
#pragma unroll
            for (int j = 0; j < 4; ++j) acc[i][j] = 0.f;
        const int ar = m0 + (tid >> 2);
        int arow = -1;
        if (ar < M) arow = rowmap ? (rowmap[ar] >> rowshift) : ar;
        const AT* ap = A + (size_t)(arow < 0 ? 0 : arow) * lda + (tid & 3) * 4;
        const int bk = tid >> 4, bn = (tid & 15) * 4;
        for (int k0 = 0; k0 < K; k0 += 16) {
#pragma unroll
            for (int i = 0; i < 4; ++i) As[((tid & 3) * 4 + i) * 132 + (tid >> 2)] = arow >= 0 ? ldA<AT>(ap + k0 + i) : 0.f;
            if (tid < 256) { const float4 b = *(const float4*)(B + (size_t)(k0 + bk) * ldb + n0 + bn); *(float4*)(Bs + bk * 68 + bn) = b; }
            __syncthreads();
#pragma unroll
            for (int kk = 0; kk < 16; ++kk) {
                const float4 a = *(const float4*)(As + kk * 132 + ty * 4), b = *(const float4*)(Bs + kk * 68 + tx * 4);
                const float av[4] = {a.x, a.y, a.z, a.w}, bv[4] = {b.x, b.y, b.z, b.w};
#pragma unroll
                for (int i = 0; i < 4; ++i)
#pragma unroll
                    for (int j = 0; j < 4; ++j) acc[i][j] += av[i] * bv[j];
            }
            __syncthreads();
        }
#pragma unroll
        for (int i = 0; i < 4; ++i) { const int row = m0 + ty * 4 + i; if (row < M) {
#pragma unroll
            for (int j = 0; j < 4; ++j) epi(row, n0 + tx * 4 + j, acc[i][j]); } }
    }
}

__device__ __forceinline__ void ph_win(const Params& p, float* sm, int l, int wg, int nwg) {
    bf16_t* Z = (bf16_t*)(p.ws + WS_Z);
    gemm_naive<bf16_t>(sm, wg, nwg, LR, ZC, DM, (const bf16_t*)(p.ws + WS_H), DM, nullptr, 0, p.w_in + (size_t)l * DM * ZC, ZC,
                       [=](int r, int c, float v) { Z[(size_t)r * ZC + c] = f2bf(v); });
}

__device__ __forceinline__ void ph_convert_moe(const Params& p, unsigned char* ldsb, int l, int wg, int nwg);
struct WinOrderLast : pg8::StaticOrder {
    __device__ __forceinline__ bool next(int i, pg8::Unit& u) const {
        const int L = i * G + c;
        if (L < nwg) { unit_of(L, u); return true; }
        const int e = L - nwg; if (e >= 96) return false;
        const int t = e % 12; u.pm = 64 + e / 12; u.pn = t < 7 ? t : t + 2; u.boff = 0u; return true;
    }
};
__device__ __forceinline__ void ph_win_mfma(const Params& p, unsigned char* ldsb, int l, int wg, int nwg) {
    pg8::Gemm g{(const bf16_t*)(p.ws + WS_H), (const bf16_t*)(p.ws + WS_WIN_T), LR, 5632, DM};
    EpiZ E{(bf16_t*)(p.ws + WS_Z), (bf16_t*)(p.ws + WS_SG), (bf16_t*)(p.ws + WS_VT)};
    if (l == 1) {
        WinOrderLast S; S.init(NLAT, 5632, nwg, wg);
        pg8::gemm_phase<EpiZ, WinOrderLast, true, true>((LAS unsigned char*)ldsb, g, S, E);
    } else {
        pg8::StaticOrder S; S.init(LR, 5632, nwg, wg);
        pg8::gemm_phase<EpiZ, pg8::StaticOrder, true, true>((LAS unsigned char*)ldsb, g, S, E);
    }
    const int ntail = (72 * 22) % nwg;
    (void)ntail;
}
__device__ __forceinline__ void ph_merge_mfma(const Params& p, unsigned char* ldsb, int l, int wg, int nwg) {
    const int nrows = (l == 1) ? NLAT : LR;
    pg8::Gemm g{(const bf16_t*)(p.ws + WS_OUTA), (const bf16_t*)(p.ws + WS_PA_T), nrows, DM, 512};
    DualOrder S; S.init(nrows, DM, nwg, wg);
    S.dA = (long)WS_YB - (long)WS_OUTA - 8 * 128; S.dB = (long)WS_PB_T - (long)WS_PA_T - 8 * 128;
    EpiMergeF E{(const bf16_t*)(p.ws + WS_Z), (bf16_t*)(p.ws + WS_MERGED)};
    pg8::gemm_phase<EpiMergeF, DualOrder, true, true>((LAS unsigned char*)ldsb, g, S, E);
}
__device__ __forceinline__ void ph_wout_mfma(const Params& p, unsigned char* ldsb, int l, int wg, int nwg) {
    const int nrows = (l == 1) ? NLAT : LR;
    pg8::Gemm g{(const bf16_t*)(p.ws + WS_MERGED), (const bf16_t*)(p.ws + WS_WO_T), nrows, DM, DM};
    pg8::StaticOrder S; S.init(nrows, DM, nwg, wg);
    EpiWout E{p.x, p.ctx, p.out, (const float*)(p.ws + WS_CTXS), (const float*)(p.ws + WS_MOD), (bf16_t*)(p.ws + WS_X1B), l};
    pg8::gemm_phase<EpiWout, pg8::StaticOrder, true, true>((LAS unsigned char*)ldsb, g, S, E);
}

__device__ __forceinline__ void ph_prep(const Params& p, float* sm, int l, int dir, int wg, int nwg) {
    const bf16_t* Z = (const bf16_t*)(p.ws + WS_Z);
    float* SW = (float*)(p.ws + WS_SW); bf16_t* SB = (bf16_t*)(p.ws + WS_SB); bf16_t* SKD = (bf16_t*)(p.ws + WS_SKD); bf16_t* SKK = (bf16_t*)(p.ws + WS_SKK);
    const int c = otid();
    const float* wlb = p.rw_w_lora_b + ((size_t)(l * 2 + dir) * 64) * 512 + c;
    const float* alb = p.rw_a_lora_b + ((size_t)(l * 2 + dir) * 64) * 512 + c;
    const float w0 = p.rw_w0[(l * 2 + dir) * 512 + c], a0 = p.rw_a0[(l * 2 + dir) * 512 + c];
    const float kkc = p.rw_k_k[l * 512 + c], kac = p.rw_k_a[l * 512 + c];
    for (int r = wg; r < LR; r += nwg) {
        __syncthreads();
        if (c < 64) sm[c] = tanhf(bf2f(Z[(size_t)r * ZC + C_LW + dir * 64 + c]));
        else if (c < 128) sm[c] = bf2f(Z[(size_t)r * ZC + C_LA + dir * 64 + (c - 64)]);
        __syncthreads();
        float wl = w0, al = a0;
#pragma unroll 4
        for (int j = 0; j < 64; ++j) { wl += sm[j] * wlb[(size_t)j * 512]; al += sm[64 + j] * alb[(size_t)j * 512]; }
        const float nx = -wl; const float sp = fmaxf(nx, 0.f) + log1pf(expf(-fabsf(nx)));
        const float decay = expf(-expf(-sp - 0.5f));
        const float a = sigmoidf_(al);
        const float k = bf2f(Z[(size_t)r * ZC + C_K + c]);
        const float kv = k * kkc;
        const float n2 = wave_sum(kv * kv);
        const float kk = kv * rsqrtf(fmaxf(n2, 1e-12f));
        SW[(size_t)r * 512 + c] = decay;
        SB[(size_t)r * 512 + c] = f2bf(kk * a);
        SKD[(size_t)r * 512 + c] = f2bf(k * (1.f + (a - 1.f) * kac));
        SKK[(size_t)r * 512 + c] = f2bf(kk);
    }
}

__device__ __forceinline__ int scan_row(int step, int dir, int b) {
    if (step < CTXL) { int t = dir ? (CTXL - 1 - step) : step; return NLAT + b * CTXL + t; }
    int tt = step - CTXL; int t = dir ? (SEQ - 1 - tt) : tt; return b * SEQ + t;
}
__device__ __forceinline__ void ph_scan(const Params& p, float* sm, int l, int dir, int wg, int nwg) {
    const bf16_t* Z = (const bf16_t*)(p.ws + WS_Z);
    const float* SW = (const float*)(p.ws + WS_SW); const bf16_t* SB = (const bf16_t*)(p.ws + WS_SB); const bf16_t* SKD = (const bf16_t*)(p.ws + WS_SKD); const bf16_t* SKK = (const bf16_t*)(p.ws + WS_SKK);
    float* Y = (float*)(p.ws + WS_Y);
    const int lane = otid() & 63, wv = otid() >> 6, nwv = blockDim.x >> 6;
    const bool last = (l == 1);
    for (int task = wg * nwv + wv; task < 512; task += nwg * nwv) {
        const int b = task >> 6, hd = (task >> 3) & 7, v0 = (task & 7) * 8;
        float s[8];
#pragma unroll
        for (int j = 0; j < 8; ++j) s[j] = 0.f;
        int row = scan_row(0, dir, b);
        float cw = SW[(size_t)row * 512 + hd * 64 + lane], ckk = bf2f(SKK[(size_t)row * 512 + hd * 64 + lane]), cb = bf2f(SB[(size_t)row * 512 + hd * 64 + lane]),
              ckd = bf2f(SKD[(size_t)row * 512 + hd * 64 + lane]), cr = bf2f(Z[(size_t)row * ZC + C_R + hd * 64 + lane]), cv = bf2f(Z[(size_t)row * ZC + C_V + hd * 64 + lane]);
        for (int step = 0; step < CTXL + SEQ; ++step) {
            const int nrow = scan_row(step + 1 < CTXL + SEQ ? step + 1 : step, dir, b);
            const float nw = SW[(size_t)nrow * 512 + hd * 64 + lane], nkk = bf2f(SKK[(size_t)nrow * 512 + hd * 64 + lane]), nb = bf2f(SB[(size_t)nrow * 512 + hd * 64 + lane]),
                        nkd = bf2f(SKD[(size_t)nrow * 512 + hd * 64 + lane]), nr = bf2f(Z[(size_t)nrow * ZC + C_R + hd * 64 + lane]), nv = bf2f(Z[(size_t)nrow * ZC + C_V + hd * 64 + lane]);
            float ysel = 0.f;
#pragma unroll
            for (int j = 0; j < 8; ++j) {
                const float skk = wave_sum(s[j] * ckk);
                const float vj = rdlane(cv, __builtin_amdgcn_readfirstlane(v0 + j));
                s[j] = s[j] * cw - skk * cb + vj * ckd;
                const float y = wave_sum(s[j] * cr);
                if (lane == j) ysel = y;
            }
            const bool isctx = step < CTXL;
            if (!(isctx && last) && lane < 8) {
                float* yp = Y + (size_t)row * 512 + hd * 64 + v0 + lane;
                if (dir == 0) *yp = ysel; else *yp += ysel;
            }
            row = nrow; cw = nw; ckk = nkk; cb = nb; ckd = nkd; cr = nr; cv = nv;
        }
    }
}

typedef short bf16x8_t __attribute__((ext_vector_type(8)));
template <int CTRL> __device__ __forceinline__ float dpp_f(float v) { return __int_as_float(__builtin_amdgcn_update_dpp(0, __float_as_int(v), CTRL, 0xf, 0xf, false)); }
__device__ __forceinline__ float row16_sum(float x) {
    x += dpp_f<0xB1>(x);
    x += dpp_f<0x4E>(x);
    x += dpp_f<0x124>(x);
    x += dpp_f<0x128>(x);
    return x;
}
__device__ __forceinline__ int scan_chunk_row(int ci, int j, int dir, int b) {
    if (ci < 8) { const int t = ci * 32 + j; return NLAT + b * CTXL + (dir ? (CTXL - 1 - t) : t); }
    const int t = (ci - 8) * 32 + j; return b * SEQ + (dir ? (SEQ - 1 - t) : t);
}
__device__ __forceinline__ void ph_scan2(const Params& p, unsigned char* ldsb, int l, int wg, int nwg) {
    const int tid = otid(), lane = tid & 63, wv = tid >> 6;
    LAS unsigned char* L = (LAS unsigned char*)ldsb;
    LAS float* sW = (LAS float*)(L + 0);
    LAS float* sKK = (LAS float*)(L + 8192);
    LAS float* sB = (LAS float*)(L + 16384);
    LAS float* sKD = (LAS float*)(L + 24576);
    LAS float* sR = (LAS float*)(L + 32768);
    LAS float* sV = (LAS float*)(L + 40960);
    LAS float* sY = (LAS float*)(L + 45056);
    LAS float* sKF = (LAS float*)(L + 49664);
    LAS float* sRN = (LAS float*)(L + 57856);
    LAS bf16_t* sLW = (LAS bf16_t*)(L + 58112);
    LAS bf16_t* sLA = (LAS bf16_t*)(L + 62208);
    const bf16_t* Z = (const bf16_t*)(p.ws + WS_Z);
    bf16_t* Y = (bf16_t*)(p.ws + WS_Y2);
    const bool last = (l == 1);
    for (int task = wg; task < 256; task += nwg) {
        const int b = task >> 5, h = (task >> 2) & 7, dir = (task >> 1) & 1, half = task & 1;
        const int mb = wv >> 2, nb = wv & 3, fr = lane & 15, fq = lane >> 4;
        const int cch = h * 64 + nb * 16 + fr;
        const float w0c = p.rw_w0[(l * 2 + dir) * 512 + cch], a0c = p.rw_a0[(l * 2 + dir) * 512 + cch];
        const float kkc = p.rw_k_k[l * 512 + cch], kac = p.rw_k_a[l * 512 + cch];
        bf16x8_t Bw[2], Ba[2];
#pragma unroll
        for (int ks = 0; ks < 2; ++ks) {
            Bw[ks] = *(const bf16x8_t*)((const bf16_t*)(p.ws + WS_LW_T) + ((size_t)(dir * 512 + cch) * 64 + 8 * fq + 32 * ks));
            Ba[ks] = *(const bf16x8_t*)((const bf16_t*)(p.ws + WS_LA_T) + ((size_t)(dir * 512 + cch) * 64 + 8 * fq + 32 * ks));
        }
        const int pj = (tid & 255) >> 3, pq = tid & 7;
        const bool roleK = tid < 256;
        const int vj = tid >> 2, vq = tid & 3;
        float kk8[8];
#pragma unroll
        for (int e = 0; e < 8; ++e) kk8[e] = p.rw_k_k[l * 512 + h * 64 + pq * 8 + e];
        const int g = lane >> 4, kc = lane & 15, vrow = wv * 4 + g;
        float s0 = 0.f, s1 = 0.f, s2 = 0.f, s3 = 0.f;
        v4u pf0, pf1, pfv;
#define SCAN_PREFETCH(ci_) do { const int row_ = scan_chunk_row((ci_), pj, dir, b); const bf16_t* zr_ = Z + (size_t)row_ * ZC; \
            pf0 = *(const v4u*)(zr_ + (roleK ? C_K : C_R) + h * 64 + pq * 8); pf1 = *(const v4u*)(zr_ + (roleK ? C_LW : C_LA) + dir * 64 + pq * 8); \
            if (tid < 128) { const int rowv_ = scan_chunk_row((ci_), vj, dir, b); pfv = *(const v4u*)(Z + (size_t)rowv_ * ZC + C_V + h * 64 + half * 32 + vq * 8); } } while (0)
        SCAN_PREFETCH(0);
        for (int ci = 0; ci < 72; ++ci) {
            float f0[8]; unpack8(pf0, f0);
            if (roleK) {
                float ss = 0.f;
#pragma unroll
                for (int e = 0; e < 8; ++e) { const float t_ = f0[e] * kk8[e]; ss += t_ * t_; }
                ss += swz_xor<1>(ss); ss += swz_xor<2>(ss); ss += swz_xor<4>(ss);
                *(LAS f32x4*)(sKF + pj * 64 + pq * 8) = (f32x4){f0[0], f0[1], f0[2], f0[3]};
                *(LAS f32x4*)(sKF + pj * 64 + pq * 8 + 4) = (f32x4){f0[4], f0[5], f0[6], f0[7]};
                if (pq == 0) sRN[pj] = rsqrtf(fmaxf(ss, 1e-12f));
                float f1[8]; unpack8(pf1, f1);
#pragma unroll
                for (int e = 0; e < 8; ++e) { const float ex = __expf(2.f * f1[e]); f1[e] = 1.f - 2.f / (ex + 1.f); }
                v4u o; o.x = pk2(f1[0], f1[1]); o.y = pk2(f1[2], f1[3]); o.z = pk2(f1[4], f1[5]); o.w = pk2(f1[6], f1[7]);
                *(LAS v4u*)(sLW + pj * 64 + pq * 8) = o;
            } else {
                *(LAS v4u*)(sLA + pj * 64 + pq * 8) = pf1;
            }
            __syncthreads();
            {
                f32x4 accw = {0.f, 0.f, 0.f, 0.f}, acca = {0.f, 0.f, 0.f, 0.f};
#pragma unroll
                for (int ks = 0; ks < 2; ++ks) {
                    const bf16x8_t aw = *(const LAS bf16x8_t*)(sLW + (mb * 16 + fr) * 64 + 8 * fq + 32 * ks);
                    const bf16x8_t aa = *(const LAS bf16x8_t*)(sLA + (mb * 16 + fr) * 64 + 8 * fq + 32 * ks);
                    accw = __builtin_amdgcn_mfma_f32_16x16x32_bf16(aw, Bw[ks], accw, 0, 0, 0);
                    acca = __builtin_amdgcn_mfma_f32_16x16x32_bf16(aa, Ba[ks], acca, 0, 0, 0);
                }
#pragma unroll
                for (int i = 0; i < 4; ++i) {
                    const int j = mb * 16 + fq * 4 + i, c = nb * 16 + fr;
                    const float wl = accw[i] + w0c, al = acca[i] + a0c;
                    const float nx = -wl; const float sp = fmaxf(nx, 0.f) + __logf(1.f + __expf(-fabsf(nx)));
                    const float decay = __expf(-__expf(-sp - 0.5f));
                    const float a = 1.f / (1.f + __expf(-al));
                    const float k = sKF[j * 64 + c]; const float kk = k * kkc * sRN[j];
                    sW[j * 64 + c] = decay; sKK[j * 64 + c] = kk; sB[j * 64 + c] = kk * a; sKD[j * 64 + c] = k * (1.f + (a - 1.f) * kac);
                }
                if (!roleK) { *(LAS f32x4*)(sR + pj * 64 + pq * 8) = (f32x4){f0[0], f0[1], f0[2], f0[3]}; *(LAS f32x4*)(sR + pj * 64 + pq * 8 + 4) = (f32x4){f0[4], f0[5], f0[6], f0[7]}; }
                if (tid < 128) { float fv[8]; unpack8(pfv, fv); *(LAS f32x4*)(sV + vj * 32 + vq * 8) = (f32x4){fv[0], fv[1], fv[2], fv[3]}; *(LAS f32x4*)(sV + vj * 32 + vq * 8 + 4) = (f32x4){fv[4], fv[5], fv[6], fv[7]}; }
                if (ci > 0 && !(last && ci <= 8)) {
                    const int j = tid >> 4, r2 = (tid & 15) * 2; const int row = scan_chunk_row(ci - 1, j, dir, b);
                    *(unsigned*)(Y + ((size_t)dir * LR + row) * 512 + h * 64 + half * 32 + r2) = pk2(sY[r2 * 36 + j], sY[(r2 + 1) * 36 + j]);
                }
            }
            __syncthreads();
            if (ci + 1 < 72) SCAN_PREFETCH(ci + 1);
#define SCAN_LD(j_, W_, KK_, BB_, KD_, RR_, V_) do { W_ = *(const LAS f32x4*)(sW + (j_) * 64 + kc * 4); KK_ = *(const LAS f32x4*)(sKK + (j_) * 64 + kc * 4); BB_ = *(const LAS f32x4*)(sB + (j_) * 64 + kc * 4); \
                KD_ = *(const LAS f32x4*)(sKD + (j_) * 64 + kc * 4); RR_ = *(const LAS f32x4*)(sR + (j_) * 64 + kc * 4); V_ = sV[(j_) * 32 + vrow]; } while (0)
#define SCAN_STEP(W_, KK_, BB_, KD_, RR_, V_, Y_) do { float pd = s0 * KK_[0] + s1 * KK_[1] + s2 * KK_[2] + s3 * KK_[3]; pd = row16_sum(pd); \
                s0 = s0 * W_[0] + (V_ * KD_[0] - pd * BB_[0]); s1 = s1 * W_[1] + (V_ * KD_[1] - pd * BB_[1]); s2 = s2 * W_[2] + (V_ * KD_[2] - pd * BB_[2]); s3 = s3 * W_[3] + (V_ * KD_[3] - pd * BB_[3]); \
                float y_ = s0 * RR_[0] + s1 * RR_[1] + s2 * RR_[2] + s3 * RR_[3]; Y_ = row16_sum(y_); } while (0)
            {
                f32x4 wA, kkA, bbA, kdA, rrA, wB, kkB, bbB, kdB, rrB; float vA, vB;
                SCAN_LD(0, wA, kkA, bbA, kdA, rrA, vA);
#pragma unroll 1
                for (int j = 0; j < 32; j += 4) {
                    f32x4 y4;
                    SCAN_LD(j + 1, wB, kkB, bbB, kdB, rrB, vB);
                    SCAN_STEP(wA, kkA, bbA, kdA, rrA, vA, y4[0]);
                    SCAN_LD(j + 2, wA, kkA, bbA, kdA, rrA, vA);
                    SCAN_STEP(wB, kkB, bbB, kdB, rrB, vB, y4[1]);
                    SCAN_LD(j + 3, wB, kkB, bbB, kdB, rrB, vB);
                    SCAN_STEP(wA, kkA, bbA, kdA, rrA, vA, y4[2]);
                    SCAN_LD((j + 4) & 31, wA, kkA, bbA, kdA, rrA, vA);
                    SCAN_STEP(wB, kkB, bbB, kdB, rrB, vB, y4[3]);
                    *(LAS f32x4*)(sY + vrow * 36 + j) = y4;
                }
            }
#undef SCAN_LD
#undef SCAN_STEP
        }
        __syncthreads();
        {
            const int j = tid >> 4, r2 = (tid & 15) * 2; const int row = scan_chunk_row(71, j, dir, b);
            *(unsigned*)(Y + ((size_t)dir * LR + row) * 512 + h * 64 + half * 32 + r2) = pk2(sY[r2 * 36 + j], sY[(r2 + 1) * 36 + j]);
        }
        __syncthreads();
#undef SCAN_PREFETCH
    }
}

__device__ __forceinline__ void ph_natt(const Params& p, float* sm, int l, int wg, int nwg) {
    const bf16_t* Z = (const bf16_t*)(p.ws + WS_Z);
    bf16_t* YB = (bf16_t*)(p.ws + WS_YB);
    const int lane = otid() & 63, wv = otid() >> 6, nwv = blockDim.x >> 6;
    float* qs = sm + wv * 512;
    float* ps = qs + 64;
    const bool last = (l == 1);
    const int nq = last ? NLAT : LR;
    const float* rpb = p.na_rpb + (size_t)l * 8 * 15 * 31;
    const float kg = p.na_k_g[l * 64 + lane], qg = p.na_q_g[l * 64 + lane];
    for (int task = wg * nwv + wv; task < nq * 8; task += nwg * nwv) {
        const int r = task >> 3, hd = task & 7;
        const bool isl = r < NLAT;
        const int b = isl ? (r >> 11) : ((r - NLAT) >> 8);
        const int t = r & 2047, qi = t >> 6, qj = t & 63;
        const int r0 = min(max(qi - 4, 0), 32 - 8), cs = min(max(qj - 8, 0), 64 - 16);
        const int nkeys = isl ? 384 : 256;
        {
            const float qv = bf2f(Z[(size_t)r * ZC + C_Q + hd * 64 + lane]);
            const float ss = wave_sum(qv * qv);
            qs[lane] = qv * rsqrtf(ss * (1.f / 64.f) + RMS_EPS) * qg * 0.125f * kg;
        }
        float lg[6]; float mx = -INFINITY;
#pragma unroll
        for (int i = 0; i < 6; ++i) {
            const int kidx = lane + 64 * i; lg[i] = -INFINITY;
            if (kidx < nkeys) {
                int krow; float bias = 0.f;
                if (isl && kidx < 128) { const int a = kidx >> 4, cc = kidx & 15; krow = b * SEQ + (r0 + a) * 64 + cs + cc;
                    bias = rpb[(hd * 15 + (r0 + a - qi + 7)) * 31 + (cs + cc - qj + 15)]; }
                else krow = NLAT + b * CTXL + (isl ? kidx - 128 : kidx);
                const uint4* kp = (const uint4*)(Z + (size_t)krow * ZC + C_KB + hd * 64);
                float ss = 0.f, dot = 0.f;
#pragma unroll 2
                for (int u = 0; u < 8; ++u) { const uint4 w = kp[u]; const unsigned ww[4] = {w.x, w.y, w.z, w.w};
                    const float4 qa = *(const float4*)(qs + u * 8), qb = *(const float4*)(qs + u * 8 + 4);
                    const float q[8] = {qa.x, qa.y, qa.z, qa.w, qb.x, qb.y, qb.z, qb.w};
#pragma unroll
                    for (int e = 0; e < 4; ++e) { const float k0 = __uint_as_float(ww[e] << 16), k1 = __uint_as_float(ww[e] & 0xffff0000u);
                        ss += k0 * k0 + k1 * k1; dot += k0 * q[e * 2] + k1 * q[e * 2 + 1]; } }
                lg[i] = dot * rsqrtf(ss * (1.f / 64.f) + RMS_EPS) + bias;
                mx = fmaxf(mx, lg[i]);
            }
        }
        mx = wave_max(mx);
        float sum = 0.f;
#pragma unroll
        for (int i = 0; i < 6; ++i) { const int kidx = lane + 64 * i; if (kidx < nkeys) { lg[i] = __expf(lg[i] - mx); sum += lg[i]; } }
        sum = wave_sum(sum);
        const float inv = 1.f / sum;
#pragma unroll
        for (int i = 0; i < 6; ++i) { const int kidx = lane + 64 * i; if (kidx < nkeys) ps[kidx] = lg[i] * inv; }
        float acc = 0.f;
        for (int kidx = 0; kidx < nkeys; ++kidx) {
            int krow;
            if (isl && kidx < 128) krow = b * SEQ + (r0 + (kidx >> 4)) * 64 + cs + (kidx & 15);
            else krow = NLAT + b * CTXL + (isl ? kidx - 128 : kidx);
            acc += ps[kidx] * bf2f(Z[(size_t)krow * ZC + C_VB + hd * 64 + lane]);
        }
        YB[(size_t)r * 512 + hd * 64 + lane] = f2bf(acc);
    }
}

typedef float f32x16_t __attribute__((ext_vector_type(16)));
#define MFMA32(a_, b_, c_) __builtin_amdgcn_mfma_f32_32x32x16_bf16((a_), (b_), (c_), 0, 0, 0)
#define MFMA16(a_, b_, c_) __builtin_amdgcn_mfma_f32_16x16x32_bf16((a_), (b_), (c_), 0, 0, 0)
__device__ __forceinline__ int scan3_row(int sc, int j, int dir, int b) {
    if (sc < 16) { const int t = sc * 16 + j; return NLAT + b * CTXL + (dir ? (CTXL - 1 - t) : t); }
    const int t = (sc - 16) * 16 + j; return b * SEQ + (dir ? (SEQ - 1 - t) : t);
}
constexpr int S3_KR = 0, S3_KD = 4096, S3_BT = 6144, S3_BD = 8192, S3_ET = 9216, S3_VT = 10240, S3_A = 11264, S3_PC = 12288, S3_SET = 12800;
constexpr int S3_SY = 8 * S3_SET;
constexpr int S3_SYSUB = 32 * 20 * 4;
#define S3_LDS_FENCE() asm volatile("s_waitcnt lgkmcnt(0)" ::: "memory")
__device__ __forceinline__ float frcp(float x) { return __builtin_amdgcn_rcpf(x); }
__device__ __forceinline__ bf16_t f2bf_fast(float x) { const __bf16 b = (__bf16)x; return __builtin_bit_cast(bf16_t, b); }
__device__ __forceinline__ void row_gather4(float x, float& r0, float& r1, float& r2, float& r3) {
    auto a = __builtin_amdgcn_permlane32_swap(__float_as_uint(x), __float_as_uint(x), false, false);
    auto b0 = __builtin_amdgcn_permlane16_swap(a[0], a[0], false, false);
    auto b1 = __builtin_amdgcn_permlane16_swap(a[1], a[1], false, false);
    r0 = __uint_as_float(b0[0]); r1 = __uint_as_float(b0[1]); r2 = __uint_as_float(b1[0]); r3 = __uint_as_float(b1[1]);
}
__device__ __forceinline__ void ph_scan3(const Params& p, unsigned char* ldsb, int l, int wg, int nwg) {
    const int tid = otid(), lane = tid & 63;
    const int wv = __builtin_amdgcn_readfirstlane(tid >> 6);
    LAS unsigned char* L = (LAS unsigned char*)ldsb;
    const bf16_t* Z = (const bf16_t*)(p.ws + WS_Z);
    bf16_t* Y = (bf16_t*)(p.ws + WS_Y2);
    const bool last = (l == 1);
    for (int task = wg; task < 256; task += nwg) {
        const int b = task >> 5, h = (task >> 2) & 7, dir = (task >> 1) & 1, half = task & 1;
        __syncthreads();
        if (wv == 0) {
            const int vcol = lane & 31, hi = lane >> 5;
            f32x16_t st0, st1;
#pragma unroll
            for (int r = 0; r < 16; ++r) { st0[r] = 0.f; st1[r] = 0.f; }
            for (int iter = 0; iter < 38; ++iter) {
                __syncthreads();
                if (iter < 1 || iter > 36) continue;
                const int buf = (iter - 1) & 1;
#pragma unroll 1
                for (int sub = 0; sub < 4; ++sub) {
                    LAS unsigned char* set = L + (buf * 4 + sub) * S3_SET;
                    bf16x8_t sb[4];
                    { v4u w;
                      w.x = pg8::cvt_pk_bf16(st0[0], st0[1]); w.y = pg8::cvt_pk_bf16(st0[2], st0[3]); w.z = pg8::cvt_pk_bf16(st0[4], st0[5]); w.w = pg8::cvt_pk_bf16(st0[6], st0[7]); sb[0] = __builtin_bit_cast(bf16x8_t, w);
                      w.x = pg8::cvt_pk_bf16(st0[8], st0[9]); w.y = pg8::cvt_pk_bf16(st0[10], st0[11]); w.z = pg8::cvt_pk_bf16(st0[12], st0[13]); w.w = pg8::cvt_pk_bf16(st0[14], st0[15]); sb[1] = __builtin_bit_cast(bf16x8_t, w);
                      w.x = pg8::cvt_pk_bf16(st1[0], st1[1]); w.y = pg8::cvt_pk_bf16(st1[2], st1[3]); w.z = pg8::cvt_pk_bf16(st1[4], st1[5]); w.w = pg8::cvt_pk_bf16(st1[6], st1[7]); sb[2] = __builtin_bit_cast(bf16x8_t, w);
                      w.x = pg8::cvt_pk_bf16(st1[8], st1[9]); w.y = pg8::cvt_pk_bf16(st1[10], st1[11]); w.z = pg8::cvt_pk_bf16(st1[12], st1[13]); w.w = pg8::cvt_pk_bf16(st1[14], st1[15]); sb[3] = __builtin_bit_cast(bf16x8_t, w); }
                    f32x16_t acc;
#pragma unroll
                    for (int r = 0; r < 16; ++r) acc[r] = 0.f;
#pragma unroll
                    for (int ks = 0; ks < 4; ++ks) { const bf16x8_t af = *(const LAS bf16x8_t*)(set + S3_KR + vcol * 128 + (ks * 16 + 8 * hi) * 2); acc = MFMA32(af, sb[ks], acc); }
                    const bf16x8_t vtf = *(const LAS bf16x8_t*)(set + S3_VT + vcol * 32 + 8 * hi * 2);
                    { const bf16x8_t bdf = *(const LAS bf16x8_t*)(set + S3_BD + vcol * 32 + 8 * hi * 2); acc = MFMA32(bdf, vtf, acc); }
                    float rhs[16];
#pragma unroll
                    for (int r = 0; r < 8; ++r) { auto rr = __builtin_amdgcn_permlane32_swap(__float_as_uint(acc[r]), __float_as_uint(acc[r]), false, false);
                        const int t0 = (r & 3) + 8 * (r >> 2); rhs[t0] = __uint_as_float(rr[0]); rhs[t0 + 4] = __uint_as_float(rr[1]); }
                    float u[16];
#pragma unroll
                    for (int i = 0; i < 16; ++i) {
                        u[i] = rhs[i];
                        if (i < 15) {
                            const LAS float* ar = (const LAS float*)(set + S3_A) + i * 16;
                            const f32x4 a0 = *(const LAS f32x4*)(ar), a1 = *(const LAS f32x4*)(ar + 4), a2 = *(const LAS f32x4*)(ar + 8), a3 = *(const LAS f32x4*)(ar + 12);
                            const float av[16] = {a0[0], a0[1], a0[2], a0[3], a1[0], a1[1], a1[2], a1[3], a2[0], a2[1], a2[2], a2[3], a3[0], a3[1], a3[2], a3[3]};
#pragma unroll
                            for (int t = i + 1; t < 16; ++t) rhs[t] -= u[i] * av[t];
                        }
                    }
                    bf16x8_t ub;
                    { v4u w; w.x = pg8::cvt_pk_bf16(hi ? u[8] : u[0], hi ? u[9] : u[1]); w.y = pg8::cvt_pk_bf16(hi ? u[10] : u[2], hi ? u[11] : u[3]);
                      w.z = pg8::cvt_pk_bf16(hi ? u[12] : u[4], hi ? u[13] : u[5]); w.w = pg8::cvt_pk_bf16(hi ? u[14] : u[6], hi ? u[15] : u[7]); ub = __builtin_bit_cast(bf16x8_t, w); }
                    { const bf16x8_t etf = *(const LAS bf16x8_t*)(set + S3_ET + vcol * 32 + 8 * hi * 2); acc = MFMA32(etf, ub, acc); }
                    { LAS float* sy = (LAS float*)(L + S3_SY + (buf * 4 + sub) * S3_SYSUB) + vcol * 20;
                      *(LAS f32x4*)(sy + 4 * hi) = (f32x4){acc[8], acc[9], acc[10], acc[11]};
                      *(LAS f32x4*)(sy + 8 + 4 * hi) = (f32x4){acc[12], acc[13], acc[14], acc[15]}; }
                    { const bf16x8_t kd0 = *(const LAS bf16x8_t*)(set + S3_KD + vcol * 32 + 8 * hi * 2), kd1 = *(const LAS bf16x8_t*)(set + S3_KD + (32 + vcol) * 32 + 8 * hi * 2);
                      const bf16x8_t bt0 = *(const LAS bf16x8_t*)(set + S3_BT + vcol * 32 + 8 * hi * 2), bt1 = *(const LAS bf16x8_t*)(set + S3_BT + (32 + vcol) * 32 + 8 * hi * 2);
                      st0 = MFMA32(kd0, vtf, st0); st0 = MFMA32(bt0, ub, st0);
                      st1 = MFMA32(kd1, vtf, st1); st1 = MFMA32(bt1, ub, st1); }
#pragma unroll
                    for (int g = 0; g < 4; ++g) {
                        const f32x4 p0 = *(const LAS f32x4*)((const LAS float*)(set + S3_PC) + 8 * g + 4 * hi), p1 = *(const LAS f32x4*)((const LAS float*)(set + S3_PC) + 32 + 8 * g + 4 * hi);
#pragma unroll
                        for (int e = 0; e < 4; ++e) { st0[4 * g + e] *= p0[e]; st1[4 * g + e] *= p1[e]; }
                    }
                }
            }
        } else if (wv <= 4) {
            const int fr = lane & 15, fq = lane >> 4, pw = wv - 1;
            float w0c[4], a0c[4], kkc[4], kac[4];
#pragma unroll
            for (int nb = 0; nb < 4; ++nb) { const int cch = h * 64 + nb * 16 + fr;
                w0c[nb] = p.rw_w0[(l * 2 + dir) * 512 + cch]; a0c[nb] = p.rw_a0[(l * 2 + dir) * 512 + cch]; kkc[nb] = p.rw_k_k[l * 512 + cch]; kac[nb] = p.rw_k_a[l * 512 + cch]; }
            const bf16_t* lwt = (const bf16_t*)(p.ws + WS_LW_T) + ((size_t)(dir * 512 + h * 64 + fr) * 64 + 8 * fq);
            const bf16_t* lat = (const bf16_t*)(p.ws + WS_LA_T) + ((size_t)(dir * 512 + h * 64 + fr) * 64 + 8 * fq);
            const int pq = lane & 7;
            float kk8[8];
#pragma unroll
            for (int e = 0; e < 8; ++e) kk8[e] = p.rw_k_k[l * 512 + h * 64 + pq * 8 + e];
            const int Pfr = (fr & 3) | ((fr & 4) << 1) | ((fr & 8) >> 1);
            v4u pk_[2], pr_[2], plw_[2], pla_[2], pv_;
#define S3_PREFETCH(sc_) do { _Pragma("unroll") for (int it_ = 0; it_ < 2; ++it_) { const int pp_ = lane + 64 * it_; const bf16_t* zr_ = Z + (size_t)scan3_row((sc_), pp_ >> 3, dir, b) * ZC; \
                pk_[it_] = *(const v4u*)(zr_ + C_K + h * 64 + pq * 8); pr_[it_] = *(const v4u*)(zr_ + C_R + h * 64 + pq * 8); plw_[it_] = *(const v4u*)(zr_ + C_LW + dir * 64 + pq * 8); pla_[it_] = *(const v4u*)(zr_ + C_LA + dir * 64 + pq * 8); } \
                pv_ = *(const v4u*)(Z + (size_t)scan3_row((sc_), lane >> 2, dir, b) * ZC + C_V + h * 64 + half * 32 + (lane & 3) * 8); } while (0)
            S3_PREFETCH(pw);
            for (int iter = 0; iter < 38; ++iter) {
                __syncthreads();
                if (iter >= 36) continue;
                LAS unsigned char* set = L + ((iter & 1) * 4 + pw) * S3_SET;
                LAS bf16_t* RK = (LAS bf16_t*)(set + S3_KR); LAS bf16_t* RR = (LAS bf16_t*)(set + S3_KR + 2048);
                LAS bf16_t* LWt = (LAS bf16_t*)(set + S3_KD); LAS bf16_t* LAt = (LAS bf16_t*)(set + S3_BT);
                LAS float* RN = (LAS float*)(set + S3_PC);
#pragma unroll
                for (int it = 0; it < 2; ++it) { const int pp = lane + 64 * it, j = pp >> 3;
                    float f[8]; unpack8(pk_[it], f); float ss = 0.f;
#pragma unroll
                    for (int e = 0; e < 8; ++e) { const float t_ = f[e] * kk8[e]; ss += t_ * t_; }
                    ss += swz_xor<1>(ss); ss += swz_xor<2>(ss); ss += swz_xor<4>(ss);
                    if (pq == 0) RN[j] = rsqrtf(fmaxf(ss, 1e-12f));
                    *(LAS v4u*)(RK + j * 64 + pq * 8) = pk_[it]; *(LAS v4u*)(RR + j * 64 + pq * 8) = pr_[it]; *(LAS v4u*)(LAt + j * 64 + pq * 8) = pla_[it];
                    float g[8]; unpack8(plw_[it], g);
#pragma unroll
                    for (int e = 0; e < 8; ++e) { const float ex = __expf(2.f * g[e]); g[e] = 1.f - 2.f * frcp(ex + 1.f); }
                    v4u o; o.x = pg8::cvt_pk_bf16(g[0], g[1]); o.y = pg8::cvt_pk_bf16(g[2], g[3]); o.z = pg8::cvt_pk_bf16(g[4], g[5]); o.w = pg8::cvt_pk_bf16(g[6], g[7]);
                    *(LAS v4u*)(LWt + j * 64 + pq * 8) = o; }
                const v4u vkeep = pv_;
                bf16x8_t Bw[4][2], Ba[4][2];
#pragma unroll
                for (int nb = 0; nb < 4; ++nb)
#pragma unroll
                    for (int ks = 0; ks < 2; ++ks) { Bw[nb][ks] = *(const bf16x8_t*)(lwt + (size_t)nb * 16 * 64 + 32 * ks); Ba[nb][ks] = *(const bf16x8_t*)(lat + (size_t)nb * 16 * 64 + 32 * ks); }
                if (iter + 1 < 36) S3_PREFETCH(4 * (iter + 1) + pw);
                S3_LDS_FENCE();
                f32x4 accw[4], acca[4];
#pragma unroll
                for (int nb = 0; nb < 4; ++nb) { accw[nb] = (f32x4){0.f, 0.f, 0.f, 0.f}; acca[nb] = (f32x4){0.f, 0.f, 0.f, 0.f}; }
#pragma unroll
                for (int ks = 0; ks < 2; ++ks) {
                    const bf16x8_t aw = *(const LAS bf16x8_t*)(LWt + fr * 64 + 8 * fq + 32 * ks), aa = *(const LAS bf16x8_t*)(LAt + fr * 64 + 8 * fq + 32 * ks);
#pragma unroll
                    for (int nb = 0; nb < 4; ++nb) { accw[nb] = MFMA16(aw, Bw[nb][ks], accw[nb]); acca[nb] = MFMA16(aa, Ba[nb][ks], acca[nb]); }
                }
                float rawk[4][4], rawr[4][4], rnv[4];
#pragma unroll
                for (int i = 0; i < 4; ++i) { rnv[i] = RN[4 * fq + i];
#pragma unroll
                    for (int nb = 0; nb < 4; ++nb) { rawk[nb][i] = bf2f(RK[(4 * fq + i) * 64 + 16 * nb + fr]); rawr[nb][i] = bf2f(RR[(4 * fq + i) * 64 + 16 * nb + fr]); } }
                S3_LDS_FENCE();
                LAS bf16_t* KR = (LAS bf16_t*)(set + S3_KR); LAS bf16_t* BK = (LAS bf16_t*)(set + S3_BD);
                LAS bf16_t* KD = (LAS bf16_t*)(set + S3_KD); LAS bf16_t* BT = (LAS bf16_t*)(set + S3_BT);
#pragma unroll
                for (int nb = 0; nb < 4; ++nb) {
                    float ev[4], kkv[4], bv[4], kdv[4];
#pragma unroll
                    for (int i = 0; i < 4; ++i) {
                        const float wl = accw[nb][i] + w0c[nb], al = acca[nb][i] + a0c[nb];
                        ev[i] = 0.60653065971f * frcp(1.f + __expf(-wl));
                        const float a = frcp(1.f + __expf(-al));
                        const float k = rawk[nb][i];
                        kkv[i] = k * kkc[nb] * rnv[i]; bv[i] = kkv[i] * a; kdv[i] = k * (1.f + (a - 1.f) * kac[nb]); }
                    const float c0 = ev[0], c1 = c0 + ev[1], c2 = c1 + ev[2], c3 = c2 + ev[3];
                    const float T0 = __int_as_float(__builtin_amdgcn_ds_bpermute(fr * 4, __float_as_int(c3))), T1 = __int_as_float(__builtin_amdgcn_ds_bpermute((fr + 16) * 4, __float_as_int(c3))),
                                T2 = __int_as_float(__builtin_amdgcn_ds_bpermute((fr + 32) * 4, __float_as_int(c3)));
                    const float off = (fq > 0 ? T0 : 0.f) + (fq > 1 ? T1 : 0.f) + (fq > 2 ? T2 : 0.f);
                    const float cs[4] = {off + c0, off + c1, off + c2, off + c3};
                    const int colp = 16 * nb + Pfr, c = 16 * nb + fr;
                    float ktl[4], nbet[4];
#pragma unroll
                    for (int i = 0; i < 4; ++i) { const int t = 4 * fq + i;
                        const float E1 = __expf(cs[i]); const float E2 = frcp(E1); const float E3 = E2 * __expf(ev[i]);
                        const float kap = kkv[i] * E3, bet = bv[i] * E1, kt = kdv[i] * E1, rt = rawr[nb][i] * E2;
                        KR[t * 64 + colp] = f2bf_fast(kap); KR[(16 + t) * 64 + colp] = f2bf_fast(rt);
                        BK[t * 64 + colp] = f2bf_fast(bet); BK[(16 + t) * 64 + colp] = f2bf_fast(kt);
                        ktl[i] = kt; nbet[i] = -bet;
                        if (i == 3 && fq == 3) ((LAS float*)(set + S3_PC))[64 + c] = E2; }
                    v2u wk, wb; wk.x = pg8::cvt_pk_bf16(ktl[0], ktl[1]); wk.y = pg8::cvt_pk_bf16(ktl[2], ktl[3]);
                    wb.x = pg8::cvt_pk_bf16(nbet[0], nbet[1]); wb.y = pg8::cvt_pk_bf16(nbet[2], nbet[3]);
                    *(LAS v2u*)(KD + c * 16 + 4 * fq) = wk; *(LAS v2u*)(BT + c * 16 + 4 * fq) = wb;
                }
                S3_LDS_FENCE();
                f32x16_t G;
#pragma unroll
                for (int r = 0; r < 16; ++r) G[r] = 0.f;
                { const int n = lane & 31, hi = lane >> 5;
#pragma unroll
                  for (int ks = 0; ks < 4; ++ks) { const bf16x8_t af = *(const LAS bf16x8_t*)(BK + n * 64 + ks * 16 + 8 * hi), bf = *(const LAS bf16x8_t*)(KR + n * 64 + ks * 16 + 8 * hi); G = MFMA32(af, bf, G); }
                  S3_LDS_FENCE();
                  const int tt = n & 15; const bool isr = n >= 16;
                  float gm[16];
#pragma unroll
                  for (int r = 0; r < 16; ++r) { const int i = (r & 3) + 8 * ((r >> 2) & 1) + 4 * hi; const bool keep = isr ? (i <= tt) : (i < tt); gm[r] = keep ? G[r] : 0.f; }
                  LAS float* Am = (LAS float*)(set + S3_A);
                  if (!isr) {
#pragma unroll
                      for (int r = 0; r < 8; ++r) { const int i = (r & 3) + 8 * (r >> 2) + 4 * hi; Am[i * 16 + tt] = gm[r]; } }
                  { v2u e0, e1; float ge[8];
#pragma unroll
                    for (int r = 0; r < 8; ++r) ge[r] = isr ? -gm[r] : 0.f;
                    e0.x = pg8::cvt_pk_bf16(ge[0], ge[1]); e0.y = pg8::cvt_pk_bf16(ge[2], ge[3]); e1.x = pg8::cvt_pk_bf16(ge[4], ge[5]); e1.y = pg8::cvt_pk_bf16(ge[6], ge[7]);
                    LAS bf16_t* ET = (LAS bf16_t*)(set + S3_ET); *(LAS v2u*)(ET + n * 16 + 4 * hi) = e0; *(LAS v2u*)(ET + n * 16 + 8 + 4 * hi) = e1; }
                  { v2u d0, d1; d0.x = pg8::cvt_pk_bf16(gm[8], gm[9]); d0.y = pg8::cvt_pk_bf16(gm[10], gm[11]); d1.x = pg8::cvt_pk_bf16(gm[12], gm[13]); d1.y = pg8::cvt_pk_bf16(gm[14], gm[15]);
                    LAS bf16_t* BD = (LAS bf16_t*)(set + S3_BD); *(LAS v2u*)(BD + n * 16 + 4 * hi) = d0; *(LAS v2u*)(BD + n * 16 + 8 + 4 * hi) = d1; } }
                { LAS bf16_t* VTt = (LAS bf16_t*)(set + S3_VT); const int jv = lane >> 2, qv = lane & 3;
#pragma unroll
                  for (int e = 0; e < 4; ++e) { const unsigned w = e == 0 ? vkeep.x : e == 1 ? vkeep.y : e == 2 ? vkeep.z : vkeep.w;
                      VTt[(8 * qv + 2 * e) * 16 + jv] = (bf16_t)(w & 0xffffu); VTt[(8 * qv + 2 * e + 1) * 16 + jv] = (bf16_t)(w >> 16); } }
                { const float pcv = ((LAS float*)(set + S3_PC))[64 + lane]; S3_LDS_FENCE(); ((LAS float*)(set + S3_PC))[lane] = pcv; }
            }
#undef S3_PREFETCH
        } else {
            const int ft = tid - 320;
            for (int iter = 0; iter < 38; ++iter) {
                __syncthreads();
                if (iter < 2) continue;
                const int ch = iter - 2, buf = ch & 1;
                if (last && ch < 4) continue;
                for (int idx = ft; idx < 1024; idx += 192) {
                    const int sub = idx >> 8, j = (idx >> 4) & 15, v2 = (idx & 15) * 2;
                    const LAS float* sy = (const LAS float*)(L + S3_SY + (buf * 4 + sub) * S3_SYSUB);
                    const int row = scan3_row(4 * ch + sub, j, dir, b);
                    *(unsigned*)(Y + ((size_t)dir * LR + row) * 512 + h * 64 + half * 32 + v2) = pk2(sy[v2 * 20 + j], sy[(v2 + 1) * 20 + j]);
                }
            }
        }
    }
    __syncthreads();
}

constexpr int S4_KR = 0, S4_BK = 4096, S4_KD = 8192, S4_BT = 10240, S4_VT = 12288, S4_A = 13312, S4_PC = 14336, S4_SET = 14592;
constexpr int S4_SY = 6 * S4_SET, S4_SYSUB = 32 * 20 * 4;
__device__ __forceinline__ void ph_scan4(const Params& p, unsigned char* ldsb, int l, int wg, int nwg) {
    const int tid = otid(), lane = tid & 63;
    const int wv = __builtin_amdgcn_readfirstlane(tid >> 6);
    LAS unsigned char* L = (LAS unsigned char*)ldsb;
    const bf16_t* Z = (const bf16_t*)(p.ws + WS_Z);
    bf16_t* Y = (bf16_t*)(p.ws + WS_Y2);
    const bool last = (l == 1);
    for (int task = wg; task < 256; task += nwg) {
        const int b = task >> 5, h = (task >> 2) & 7, dir = (task >> 1) & 1, half = task & 1;
        __syncthreads();
        if (wv == 0) {
            const int vcol = lane & 31, hi = lane >> 5;
            const int tt = vcol & 15; const bool isr = vcol >= 16;
            f32x16_t st0, st1;
#pragma unroll
            for (int r = 0; r < 16; ++r) { st0[r] = 0.f; st1[r] = 0.f; }
            for (int iter = 0; iter < 50; ++iter) {
                __syncthreads();
                if (iter < 1 || iter > 48) continue;
                const int buf = (iter - 1) & 1;
#pragma unroll 1
                for (int sub = 0; sub < 3; ++sub) {
                    LAS unsigned char* set = L + (buf * 3 + sub) * S4_SET;
                    bf16x8_t krf[4];
#pragma unroll
                    for (int ks = 0; ks < 4; ++ks) krf[ks] = *(const LAS bf16x8_t*)(set + S4_KR + vcol * 128 + (ks * 16 + 8 * hi) * 2);
                    float gm[16];
                    { f32x16_t G;
#pragma unroll
                      for (int r = 0; r < 16; ++r) G[r] = 0.f;
#pragma unroll
                      for (int ks = 0; ks < 4; ++ks) { const bf16x8_t bkf = *(const LAS bf16x8_t*)(set + S4_BK + vcol * 128 + (ks * 16 + 8 * hi) * 2); G = MFMA32(bkf, krf[ks], G); }
#pragma unroll
                      for (int r = 0; r < 16; ++r) { const int i = (r & 3) + 8 * ((r >> 2) & 1) + 4 * hi; const bool keep = isr ? (i <= tt) : (i < tt); gm[r] = keep ? G[r] : 0.f; } }
                    LAS float* Am = (LAS float*)(set + S4_A);
                    if (!isr) {
#pragma unroll
                        for (int r = 0; r < 8; ++r) { const int i = (r & 3) + 8 * (r >> 2) + 4 * hi; Am[i * 16 + tt] = gm[r]; } }
                    bf16x8_t etf, bdf;
                    { v4u w; float ge[8];
#pragma unroll
                      for (int r = 0; r < 8; ++r) ge[r] = isr ? -gm[r] : 0.f;
                      w.x = pg8::cvt_pk_bf16(ge[0], ge[1]); w.y = pg8::cvt_pk_bf16(ge[2], ge[3]); w.z = pg8::cvt_pk_bf16(ge[4], ge[5]); w.w = pg8::cvt_pk_bf16(ge[6], ge[7]); etf = __builtin_bit_cast(bf16x8_t, w);
                      w.x = pg8::cvt_pk_bf16(gm[8], gm[9]); w.y = pg8::cvt_pk_bf16(gm[10], gm[11]); w.z = pg8::cvt_pk_bf16(gm[12], gm[13]); w.w = pg8::cvt_pk_bf16(gm[14], gm[15]); bdf = __builtin_bit_cast(bf16x8_t, w); }
                    bf16x8_t sb[4];
                    { v4u w;
                      w.x = pg8::cvt_pk_bf16(st0[0], st0[1]); w.y = pg8::cvt_pk_bf16(st0[2], st0[3]); w.z = pg8::cvt_pk_bf16(st0[4], st0[5]); w.w = pg8::cvt_pk_bf16(st0[6], st0[7]); sb[0] = __builtin_bit_cast(bf16x8_t, w);
                      w.x = pg8::cvt_pk_bf16(st0[8], st0[9]); w.y = pg8::cvt_pk_bf16(st0[10], st0[11]); w.z = pg8::cvt_pk_bf16(st0[12], st0[13]); w.w = pg8::cvt_pk_bf16(st0[14], st0[15]); sb[1] = __builtin_bit_cast(bf16x8_t, w);
                      w.x = pg8::cvt_pk_bf16(st1[0], st1[1]); w.y = pg8::cvt_pk_bf16(st1[2], st1[3]); w.z = pg8::cvt_pk_bf16(st1[4], st1[5]); w.w = pg8::cvt_pk_bf16(st1[6], st1[7]); sb[2] = __builtin_bit_cast(bf16x8_t, w);
                      w.x = pg8::cvt_pk_bf16(st1[8], st1[9]); w.y = pg8::cvt_pk_bf16(st1[10], st1[11]); w.z = pg8::cvt_pk_bf16(st1[12], st1[13]); w.w = pg8::cvt_pk_bf16(st1[14], st1[15]); sb[3] = __builtin_bit_cast(bf16x8_t, w); }
                    f32x16_t acc;
#pragma unroll
                    for (int r = 0; r < 16; ++r) acc[r] = 0.f;
#pragma unroll
                    for (int ks = 0; ks < 4; ++ks) acc = MFMA32(krf[ks], sb[ks], acc);
                    bf16x8_t vtf;
                    { const v2u a = *(const LAS v2u*)(set + S4_VT + vcol * 32 + 4 * hi * 2), c = *(const LAS v2u*)(set + S4_VT + vcol * 32 + (8 + 4 * hi) * 2); const v4u w = {a.x, a.y, c.x, c.y}; vtf = __builtin_bit_cast(bf16x8_t, w); }
                    acc = MFMA32(bdf, vtf, acc);
                    float rhs[16];
#pragma unroll
                    for (int r = 0; r < 8; ++r) { auto rr = __builtin_amdgcn_permlane32_swap(__float_as_uint(acc[r]), __float_as_uint(acc[r]), false, false);
                        const int t0 = (r & 3) + 8 * (r >> 2); rhs[t0] = __uint_as_float(rr[0]); rhs[t0 + 4] = __uint_as_float(rr[1]); }
                    S3_LDS_FENCE();
                    float u[16];
#pragma unroll
                    for (int i = 0; i < 16; ++i) {
                        u[i] = rhs[i];
                        if (i < 15) {
                            const LAS float* ar = Am + i * 16;
                            const f32x4 a0 = *(const LAS f32x4*)(ar), a1 = *(const LAS f32x4*)(ar + 4), a2 = *(const LAS f32x4*)(ar + 8), a3 = *(const LAS f32x4*)(ar + 12);
                            const float av[16] = {a0[0], a0[1], a0[2], a0[3], a1[0], a1[1], a1[2], a1[3], a2[0], a2[1], a2[2], a2[3], a3[0], a3[1], a3[2], a3[3]};
#pragma unroll
                            for (int t = i + 1; t < 16; ++t) rhs[t] -= u[i] * av[t];
                        }
                    }
                    bf16x8_t ub;
                    { v4u w; w.x = pg8::cvt_pk_bf16(hi ? u[4] : u[0], hi ? u[5] : u[1]); w.y = pg8::cvt_pk_bf16(hi ? u[6] : u[2], hi ? u[7] : u[3]);
                      w.z = pg8::cvt_pk_bf16(hi ? u[12] : u[8], hi ? u[13] : u[9]); w.w = pg8::cvt_pk_bf16(hi ? u[14] : u[10], hi ? u[15] : u[11]); ub = __builtin_bit_cast(bf16x8_t, w); }
                    acc = MFMA32(etf, ub, acc);
                    { LAS float* sy = (LAS float*)(L + S4_SY + (buf * 3 + sub) * S4_SYSUB) + vcol * 20;
                      *(LAS f32x4*)(sy + 4 * hi) = (f32x4){acc[8], acc[9], acc[10], acc[11]};
                      *(LAS f32x4*)(sy + 8 + 4 * hi) = (f32x4){acc[12], acc[13], acc[14], acc[15]}; }
#define S4_FRAG2(base_, row_) ({ const v2u a_ = *(const LAS v2u*)(set + (base_) + (row_) * 32 + 4 * hi * 2), c_ = *(const LAS v2u*)(set + (base_) + (row_) * 32 + (8 + 4 * hi) * 2); const v4u w_ = {a_.x, a_.y, c_.x, c_.y}; __builtin_bit_cast(bf16x8_t, w_); })
                    { const bf16x8_t kd0 = S4_FRAG2(S4_KD, vcol), kd1 = S4_FRAG2(S4_KD, 32 + vcol), bt0 = S4_FRAG2(S4_BT, vcol), bt1 = S4_FRAG2(S4_BT, 32 + vcol);
                      st0 = MFMA32(kd0, vtf, st0); st0 = MFMA32(bt0, ub, st0);
                      st1 = MFMA32(kd1, vtf, st1); st1 = MFMA32(bt1, ub, st1); }
#undef S4_FRAG2
#pragma unroll
                    for (int g = 0; g < 4; ++g) {
                        const f32x4 p0 = *(const LAS f32x4*)((const LAS float*)(set + S4_PC) + 8 * g + 4 * hi), p1 = *(const LAS f32x4*)((const LAS float*)(set + S4_PC) + 32 + 8 * g + 4 * hi);
#pragma unroll
                        for (int e = 0; e < 4; ++e) { st0[4 * g + e] *= p0[e]; st1[4 * g + e] *= p1[e]; }
                    }
                }
            }
        } else if (wv <= 6) {
            const int fr = lane & 15, fq = lane >> 4, hp = wv - 1, sub = hp >> 1, chh = hp & 1;
            float w0c[2], a0c[2], kac[2], kkc4[4];
            bf16x8_t Bw[2][2], Ba[2][2];
#pragma unroll
            for (int nb = 0; nb < 4; ++nb) kkc4[nb] = p.rw_k_k[l * 512 + h * 64 + nb * 16 + fr];
#pragma unroll
            for (int q = 0; q < 2; ++q) { const int cch = h * 64 + (2 * chh + q) * 16 + fr;
                w0c[q] = p.rw_w0[(l * 2 + dir) * 512 + cch]; a0c[q] = p.rw_a0[(l * 2 + dir) * 512 + cch]; kac[q] = p.rw_k_a[l * 512 + cch];
#pragma unroll
                for (int ks = 0; ks < 2; ++ks) {
                    Bw[q][ks] = *(const bf16x8_t*)((const bf16_t*)(p.ws + WS_LW_T) + ((size_t)(dir * 512 + cch) * 64 + 8 * fq + 32 * ks));
                    Ba[q][ks] = *(const bf16x8_t*)((const bf16_t*)(p.ws + WS_LA_T) + ((size_t)(dir * 512 + cch) * 64 + 8 * fq + 32 * ks)); } }
            const int Pfr = (fr & 3) | ((fr & 4) << 1) | ((fr & 8) >> 1);
            v4u plw[2], pla[2]; bf16_t pk[4][4], pr[2][4];
#define S4_PREFETCH(sc_) do { const bf16_t* za_ = Z + (size_t)scan3_row((sc_), fr, dir, b) * ZC; \
                _Pragma("unroll") for (int ks_ = 0; ks_ < 2; ++ks_) { plw[ks_] = *(const v4u*)(za_ + C_LW + dir * 64 + 8 * fq + 32 * ks_); pla[ks_] = *(const v4u*)(za_ + C_LA + dir * 64 + 8 * fq + 32 * ks_); } \
                _Pragma("unroll") for (int i_ = 0; i_ < 4; ++i_) { const bf16_t* zt_ = Z + (size_t)scan3_row((sc_), 4 * fq + i_, dir, b) * ZC; \
                    _Pragma("unroll") for (int nb_ = 0; nb_ < 4; ++nb_) pk[nb_][i_] = zt_[C_K + h * 64 + nb_ * 16 + fr]; \
                    _Pragma("unroll") for (int q_ = 0; q_ < 2; ++q_) pr[q_][i_] = zt_[C_R + h * 64 + (2 * chh + q_) * 16 + fr]; } } while (0)
            S4_PREFETCH(sub);
            for (int iter = 0; iter < 50; ++iter) {
                __syncthreads();
                if (iter >= 48) continue;
                LAS unsigned char* set = L + ((iter & 1) * 3 + sub) * S4_SET;
                bf16x8_t aw[2], aa[2];
#pragma unroll
                for (int ks = 0; ks < 2; ++ks) { float g[8]; unpack8(plw[ks], g);
#pragma unroll
                    for (int e = 0; e < 8; ++e) { const float ex = __expf(2.f * g[e]); g[e] = 1.f - 2.f * frcp(ex + 1.f); }
                    v4u o; o.x = pg8::cvt_pk_bf16(g[0], g[1]); o.y = pg8::cvt_pk_bf16(g[2], g[3]); o.z = pg8::cvt_pk_bf16(g[4], g[5]); o.w = pg8::cvt_pk_bf16(g[6], g[7]);
                    aw[ks] = __builtin_bit_cast(bf16x8_t, o); aa[ks] = __builtin_bit_cast(bf16x8_t, pla[ks]); }
                float kf[4][4], rf[2][4];
#pragma unroll
                for (int i = 0; i < 4; ++i) {
#pragma unroll
                    for (int nb = 0; nb < 4; ++nb) kf[nb][i] = bf2f(pk[nb][i]);
#pragma unroll
                    for (int q = 0; q < 2; ++q) rf[q][i] = bf2f(pr[q][i]); }
                if (iter + 1 < 48) S4_PREFETCH(3 * (iter + 1) + sub);
                f32x4 accw[2], acca[2];
#pragma unroll
                for (int q = 0; q < 2; ++q) { accw[q] = (f32x4){0.f, 0.f, 0.f, 0.f}; acca[q] = (f32x4){0.f, 0.f, 0.f, 0.f}; }
#pragma unroll
                for (int ks = 0; ks < 2; ++ks)
#pragma unroll
                    for (int q = 0; q < 2; ++q) { accw[q] = MFMA16(aw[ks], Bw[q][ks], accw[q]); acca[q] = MFMA16(aa[ks], Ba[q][ks], acca[q]); }
                float rnv[4];
#pragma unroll
                for (int i = 0; i < 4; ++i) { float ss = 0.f;
#pragma unroll
                    for (int nb = 0; nb < 4; ++nb) { const float t_ = kf[nb][i] * kkc4[nb]; ss += t_ * t_; }
                    rnv[i] = rsqrtf(fmaxf(row16_sum(ss), 1e-12f)); }
                LAS bf16_t* KR = (LAS bf16_t*)(set + S4_KR); LAS bf16_t* BK = (LAS bf16_t*)(set + S4_BK);
                LAS bf16_t* KD = (LAS bf16_t*)(set + S4_KD); LAS bf16_t* BT = (LAS bf16_t*)(set + S4_BT);
#pragma unroll
                for (int q = 0; q < 2; ++q) { const int nb = 2 * chh + q;
                    float ev[4], kkv[4], bv[4], kdv[4];
#pragma unroll
                    for (int i = 0; i < 4; ++i) {
                        const float wl = accw[q][i] + w0c[q], al = acca[q][i] + a0c[q];
                        ev[i] = 0.60653065971f * frcp(1.f + __expf(-wl));
                        const float a = frcp(1.f + __expf(-al));
                        const float k = kf[nb][i];
                        kkv[i] = k * kkc4[nb] * rnv[i]; bv[i] = kkv[i] * a; kdv[i] = k * (1.f + (a - 1.f) * kac[q]); }
                    const float c0 = ev[0], c1 = c0 + ev[1], c2 = c1 + ev[2], c3 = c2 + ev[3];
                    const float T0 = __int_as_float(__builtin_amdgcn_ds_bpermute(fr * 4, __float_as_int(c3))), T1 = __int_as_float(__builtin_amdgcn_ds_bpermute((fr + 16) * 4, __float_as_int(c3))),
                                T2 = __int_as_float(__builtin_amdgcn_ds_bpermute((fr + 32) * 4, __float_as_int(c3)));
                    const float off = (fq > 0 ? T0 : 0.f) + (fq > 1 ? T1 : 0.f) + (fq > 2 ? T2 : 0.f);
                    const float cs[4] = {off + c0, off + c1, off + c2, off + c3};
                    const int colp = 16 * nb + Pfr, c = 16 * nb + fr;
                    float ktl[4], nbet[4];
#pragma unroll
                    for (int i = 0; i < 4; ++i) { const int t = 4 * fq + i;
                        const float E1 = __expf(cs[i]); const float E2 = frcp(E1); const float E3 = E2 * __expf(ev[i]);
                        const float kap = kkv[i] * E3, bet = bv[i] * E1, kt = kdv[i] * E1, rt = rf[q][i] * E2;
                        KR[t * 64 + colp] = f2bf_fast(kap); KR[(16 + t) * 64 + colp] = f2bf_fast(rt);
                        BK[t * 64 + colp] = f2bf_fast(bet); BK[(16 + t) * 64 + colp] = f2bf_fast(kt);
                        ktl[i] = kt; nbet[i] = -bet;
                        if (i == 3 && fq == 3) ((LAS float*)(set + S4_PC))[c] = E2; }
                    v2u wk, wb; wk.x = pg8::cvt_pk_bf16(ktl[0], ktl[1]); wk.y = pg8::cvt_pk_bf16(ktl[2], ktl[3]);
                    wb.x = pg8::cvt_pk_bf16(nbet[0], nbet[1]); wb.y = pg8::cvt_pk_bf16(nbet[2], nbet[3]);
                    *(LAS v2u*)(KD + c * 16 + 4 * fq) = wk; *(LAS v2u*)(BT + c * 16 + 4 * fq) = wb;
                }
            }
#undef S4_PREFETCH
        } else {
            const int jv = lane >> 2, qv = lane & 3;
            v4u pv[3];
#define S4_PREFV(ch_) do { _Pragma("unroll") for (int s_ = 0; s_ < 3; ++s_) pv[s_] = *(const v4u*)(Z + (size_t)scan3_row(3 * (ch_) + s_, jv, dir, b) * ZC + C_V + h * 64 + half * 32 + qv * 8); } while (0)
            S4_PREFV(0);
            for (int iter = 0; iter < 50; ++iter) {
                __syncthreads();
                if (iter < 48) {
#pragma unroll
                    for (int s_ = 0; s_ < 3; ++s_) { LAS bf16_t* VTt = (LAS bf16_t*)(L + ((iter & 1) * 3 + s_) * S4_SET + S4_VT);
#pragma unroll
                        for (int e = 0; e < 4; ++e) { const unsigned w = e == 0 ? pv[s_].x : e == 1 ? pv[s_].y : e == 2 ? pv[s_].z : pv[s_].w;
                            VTt[(8 * qv + 2 * e) * 16 + jv] = (bf16_t)(w & 0xffffu); VTt[(8 * qv + 2 * e + 1) * 16 + jv] = (bf16_t)(w >> 16); } }
                    if (iter + 1 < 48) S4_PREFV(iter + 1);
                }
                if (iter >= 2) {
                    const int ch = iter - 2, buf = ch & 1;
                    for (int idx = lane; idx < 768; idx += 64) {
                        const int s_ = idx >> 8, j = (idx >> 4) & 15, v2 = (idx & 15) * 2; const int sc = 3 * ch + s_;
                        if (last && sc < 16) continue;
                        const LAS float* sy = (const LAS float*)(L + S4_SY + (buf * 3 + s_) * S4_SYSUB);
                        const int row = scan3_row(sc, j, dir, b);
                        *(unsigned*)(Y + ((size_t)dir * LR + row) * 512 + h * 64 + half * 32 + v2) = pk2(sy[v2 * 20 + j], sy[(v2 + 1) * 20 + j]);
                    }
                }
            }
#undef S4_PREFV
        }
    }
    __syncthreads();
}

constexpr int S5_KR = 0, S5_BK = 4608, S5_KD = 9216, S5_BT = 11776, S5_VT = 14336, S5_A = 16896, S5_PC = 18944, S5_SET = 19200;
constexpr int S5_SY = 6 * S5_SET, S5_SYSUB = 32 * 20 * 4;
__device__ __forceinline__ void ph_scan5(const Params& p, unsigned char* ldsb, int l, int wg, int nwg) {
    const int tid = otid(), lane = tid & 63;
    const int wv = __builtin_amdgcn_readfirstlane(tid >> 6);
    LAS unsigned char* L = (LAS unsigned char*)ldsb;
    const bf16_t* Z = (const bf16_t*)(p.ws + WS_Z);
    bf16_t* Y = (bf16_t*)(p.ws + WS_Y2);
    const bool last = (l == 1);
    for (int task = wg; task < 128; task += nwg) {
        const int b = task >> 4, h = (task >> 1) & 7, dir = task & 1;
        __syncthreads();
        if (wv <= 1) {
            const int half = wv;
            const int vcol = lane & 31, hi = lane >> 5;
            const int tt = vcol & 15; const bool isr = vcol >= 16;
            f32x16_t st0, st1;
#pragma unroll
            for (int r = 0; r < 16; ++r) { st0[r] = 0.f; st1[r] = 0.f; }
            for (int iter = 0; iter < 50; ++iter) {
                __syncthreads();
                if (iter < 1 || iter > 48) continue;
                const int buf = (iter - 1) & 1;
#pragma unroll 1
                for (int sub = 0; sub < 3; ++sub) {
                    LAS unsigned char* set = L + (buf * 3 + sub) * S5_SET;
                    bf16x8_t krf[4];
#pragma unroll
                    for (int ks = 0; ks < 4; ++ks) krf[ks] = *(const LAS bf16x8_t*)(set + S5_KR + vcol * 144 + (ks * 16 + 8 * hi) * 2);
                    float gm[16];
                    { f32x16_t G;
#pragma unroll
                      for (int r = 0; r < 16; ++r) G[r] = 0.f;
#pragma unroll
                      for (int ks = 0; ks < 4; ++ks) { const bf16x8_t bkf = *(const LAS bf16x8_t*)(set + S5_BK + vcol * 144 + (ks * 16 + 8 * hi) * 2); G = MFMA32(bkf, krf[ks], G); }
#pragma unroll
                      for (int r = 0; r < 16; ++r) { const int i = (r & 3) + 8 * ((r >> 2) & 1) + 4 * hi; const bool keep = isr ? (i <= tt) : (i < tt); gm[r] = keep ? G[r] : 0.f; } }
                    LAS float* Am = (LAS float*)(set + S5_A + half * 1024);
                    if (!isr) {
#pragma unroll
                        for (int r = 0; r < 8; ++r) { const int i = (r & 3) + 8 * (r >> 2) + 4 * hi; Am[i * 16 + tt] = gm[r]; } }
                    bf16x8_t etf, bdf;
                    { v4u w; float ge[8];
#pragma unroll
                      for (int r = 0; r < 8; ++r) ge[r] = isr ? -gm[r] : 0.f;
                      w.x = pg8::cvt_pk_bf16(ge[0], ge[1]); w.y = pg8::cvt_pk_bf16(ge[2], ge[3]); w.z = pg8::cvt_pk_bf16(ge[4], ge[5]); w.w = pg8::cvt_pk_bf16(ge[6], ge[7]); etf = __builtin_bit_cast(bf16x8_t, w);
                      w.x = pg8::cvt_pk_bf16(gm[8], gm[9]); w.y = pg8::cvt_pk_bf16(gm[10], gm[11]); w.z = pg8::cvt_pk_bf16(gm[12], gm[13]); w.w = pg8::cvt_pk_bf16(gm[14], gm[15]); bdf = __builtin_bit_cast(bf16x8_t, w); }
                    bf16x8_t sb[4];
                    { v4u w;
                      w.x = pg8::cvt_pk_bf16(st0[0], st0[1]); w.y = pg8::cvt_pk_bf16(st0[2], st0[3]); w.z = pg8::cvt_pk_bf16(st0[4], st0[5]); w.w = pg8::cvt_pk_bf16(st0[6], st0[7]); sb[0] = __builtin_bit_cast(bf16x8_t, w);
                      w.x = pg8::cvt_pk_bf16(st0[8], st0[9]); w.y = pg8::cvt_pk_bf16(st0[10], st0[11]); w.z = pg8::cvt_pk_bf16(st0[12], st0[13]); w.w = pg8::cvt_pk_bf16(st0[14], st0[15]); sb[1] = __builtin_bit_cast(bf16x8_t, w);
                      w.x = pg8::cvt_pk_bf16(st1[0], st1[1]); w.y = pg8::cvt_pk_bf16(st1[2], st1[3]); w.z = pg8::cvt_pk_bf16(st1[4], st1[5]); w.w = pg8::cvt_pk_bf16(st1[6], st1[7]); sb[2] = __builtin_bit_cast(bf16x8_t, w);
                      w.x = pg8::cvt_pk_bf16(st1[8], st1[9]); w.y = pg8::cvt_pk_bf16(st1[10], st1[11]); w.z = pg8::cvt_pk_bf16(st1[12], st1[13]); w.w = pg8::cvt_pk_bf16(st1[14], st1[15]); sb[3] = __builtin_bit_cast(bf16x8_t, w); }
                    f32x16_t acc;
#pragma unroll
                    for (int r = 0; r < 16; ++r) acc[r] = 0.f;
#pragma unroll
                    for (int ks = 0; ks < 4; ++ks) acc = MFMA32(krf[ks], sb[ks], acc);
#define S5_FRAG2(base_, row_) ({ const v2u a_ = *(const LAS v2u*)(set + (base_) + (row_) * 40 + 4 * hi * 2), c_ = *(const LAS v2u*)(set + (base_) + (row_) * 40 + (8 + 4 * hi) * 2); const v4u w_ = {a_.x, a_.y, c_.x, c_.y}; __builtin_bit_cast(bf16x8_t, w_); })
                    const bf16x8_t vtf = S5_FRAG2(S5_VT, half * 32 + vcol);
                    acc = MFMA32(bdf, vtf, acc);
                    float rhs[16];
#pragma unroll
                    for (int r = 0; r < 8; ++r) { auto rr = __builtin_amdgcn_permlane32_swap(__float_as_uint(acc[r]), __float_as_uint(acc[r]), false, false);
                        const int t0 = (r & 3) + 8 * (r >> 2); rhs[t0] = __uint_as_float(rr[0]); rhs[t0 + 4] = __uint_as_float(rr[1]); }
                    S3_LDS_FENCE();
                    float u[16];
#pragma unroll
                    for (int i = 0; i < 16; ++i) {
                        u[i] = rhs[i];
                        if (i < 15) {
                            const LAS float* ar = Am + i * 16;
                            const f32x4 a0 = *(const LAS f32x4*)(ar), a1 = *(const LAS f32x4*)(ar + 4), a2 = *(const LAS f32x4*)(ar + 8), a3 = *(const LAS f32x4*)(ar + 12);
                            const float av[16] = {a0[0], a0[1], a0[2], a0[3], a1[0], a1[1], a1[2], a1[3], a2[0], a2[1], a2[2], a2[3], a3[0], a3[1], a3[2], a3[3]};
#pragma unroll
                            for (int t = i + 1; t < 16; ++t) rhs[t] -= u[i] * av[t];
                        }
                    }
                    bf16x8_t ub;
                    { v4u w; w.x = pg8::cvt_pk_bf16(hi ? u[4] : u[0], hi ? u[5] : u[1]); w.y = pg8::cvt_pk_bf16(hi ? u[6] : u[2], hi ? u[7] : u[3]);
                      w.z = pg8::cvt_pk_bf16(hi ? u[12] : u[8], hi ? u[13] : u[9]); w.w = pg8::cvt_pk_bf16(hi ? u[14] : u[10], hi ? u[15] : u[11]); ub = __builtin_bit_cast(bf16x8_t, w); }
                    acc = MFMA32(etf, ub, acc);
                    { LAS float* sy = (LAS float*)(L + S5_SY + ((buf * 3 + sub) * 2 + half) * S5_SYSUB) + vcol * 20;
                      *(LAS f32x4*)(sy + 4 * hi) = (f32x4){acc[8], acc[9], acc[10], acc[11]};
                      *(LAS f32x4*)(sy + 8 + 4 * hi) = (f32x4){acc[12], acc[13], acc[14], acc[15]}; }
                    { const bf16x8_t kd0 = S5_FRAG2(S5_KD, vcol), kd1 = S5_FRAG2(S5_KD, 32 + vcol), bt0 = S5_FRAG2(S5_BT, vcol), bt1 = S5_FRAG2(S5_BT, 32 + vcol);
                      st0 = MFMA32(kd0, vtf, st0); st0 = MFMA32(bt0, ub, st0);
                      st1 = MFMA32(kd1, vtf, st1); st1 = MFMA32(bt1, ub, st1); }
#undef S5_FRAG2
#pragma unroll
                    for (int g = 0; g < 4; ++g) {
                        const f32x4 p0 = *(const LAS f32x4*)((const LAS float*)(set + S5_PC) + 8 * g + 4 * hi), p1 = *(const LAS f32x4*)((const LAS float*)(set + S5_PC) + 32 + 8 * g + 4 * hi);
#pragma unroll
                        for (int e = 0; e < 4; ++e) { st0[4 * g + e] *= p0[e]; st1[4 * g + e] *= p1[e]; }
                    }
                }
            }
        } else {
            const int fr = lane & 15, fq = lane >> 4, hp = wv - 2, sub = hp >> 1, chh = hp & 1;
            float w0c[2], a0c[2], kac[2], kkc4[4];
            bf16x8_t Bw[2][2], Ba[2][2];
#pragma unroll
            for (int nb = 0; nb < 4; ++nb) kkc4[nb] = p.rw_k_k[l * 512 + h * 64 + nb * 16 + fr];
#pragma unroll
            for (int q = 0; q < 2; ++q) { const int cch = h * 64 + (2 * chh + q) * 16 + fr;
                w0c[q] = p.rw_w0[(l * 2 + dir) * 512 + cch]; a0c[q] = p.rw_a0[(l * 2 + dir) * 512 + cch]; kac[q] = p.rw_k_a[l * 512 + cch];
#pragma unroll
                for (int ks = 0; ks < 2; ++ks) {
                    Bw[q][ks] = *(const bf16x8_t*)((const bf16_t*)(p.ws + WS_LW_T) + ((size_t)(dir * 512 + cch) * 64 + 8 * fq + 32 * ks));
                    Ba[q][ks] = *(const bf16x8_t*)((const bf16_t*)(p.ws + WS_LA_T) + ((size_t)(dir * 512 + cch) * 64 + 8 * fq + 32 * ks)); } }
            const int Pfr = (fr & 3) | ((fr & 4) << 1) | ((fr & 8) >> 1);
            const int jv = lane >> 2, qv = lane & 3;
            v4u plw[2], pla[2], pvv, pkf[2], prf;
            bf16x8_t Idm[2];
#pragma unroll
            for (int o_ = 0; o_ < 2; ++o_) { const int jsel = 16 * o_ + fr - 8 * fq; v4u w = {0u, 0u, 0u, 0u};
                if (jsel >= 0 && jsel < 8) { const unsigned one = (jsel & 1) ? 0x3f800000u : 0x00003f80u; if ((jsel >> 1) == 0) w.x = one; else if ((jsel >> 1) == 1) w.y = one; else if ((jsel >> 1) == 2) w.z = one; else w.w = one; }
                Idm[o_] = __builtin_bit_cast(bf16x8_t, w); }
#define S5_PREFETCH(sc_) do { const bf16_t* za_ = Z + (size_t)scan3_row((sc_), fr, dir, b) * ZC; \
                _Pragma("unroll") for (int ks_ = 0; ks_ < 2; ++ks_) { plw[ks_] = *(const v4u*)(za_ + C_LW + dir * 64 + 8 * fq + 32 * ks_); pla[ks_] = *(const v4u*)(za_ + C_LA + dir * 64 + 8 * fq + 32 * ks_); \
                    pkf[ks_] = *(const v4u*)(za_ + C_K + h * 64 + 8 * fq + 32 * ks_); } \
                prf = *(const v4u*)(za_ + C_R + h * 64 + 8 * fq + 32 * chh); \
                pvv = *(const v4u*)(Z + (size_t)scan3_row((sc_), jv, dir, b) * ZC + C_V + h * 64 + chh * 32 + qv * 8); } while (0)
            S5_PREFETCH(sub);
            for (int iter = 0; iter < 50; ++iter) {
                __syncthreads();
                if (iter >= 2) {
                    const int ch = iter - 2, buf = ch & 1, sc = 3 * ch + sub;
                    if (!(last && sc < 16)) {
                        const LAS float* sy = (const LAS float*)(L + S5_SY + ((buf * 3 + sub) * 2 + chh) * S5_SYSUB);
#pragma unroll
                        for (int k4 = 0; k4 < 4; ++k4) { const int idx = lane + 64 * k4, j = idx >> 4, v2 = (idx & 15) * 2;
                            const int row = scan3_row(sc, j, dir, b);
                            *(unsigned*)(Y + ((size_t)dir * LR + row) * 512 + h * 64 + chh * 32 + v2) = pk2(sy[v2 * 20 + j], sy[(v2 + 1) * 20 + j]); }
                    }
                }
                if (iter >= 48) continue;
                LAS unsigned char* set = L + ((iter & 1) * 3 + sub) * S5_SET;
                bf16x8_t aw[2], aa[2];
#pragma unroll
                for (int ks = 0; ks < 2; ++ks) { aw[ks] = __builtin_bit_cast(bf16x8_t, plw[ks]); aa[ks] = __builtin_bit_cast(bf16x8_t, pla[ks]); }
                f32x4 kf[4], rf[2];
                { const f32x4 z4 = {0.f, 0.f, 0.f, 0.f};
#pragma unroll
                  for (int nb = 0; nb < 4; ++nb) kf[nb] = MFMA16(__builtin_bit_cast(bf16x8_t, pkf[nb >> 1]), Idm[nb & 1], z4);
#pragma unroll
                  for (int q = 0; q < 2; ++q) rf[q] = MFMA16(__builtin_bit_cast(bf16x8_t, prf), Idm[q], z4); }
                { LAS bf16_t* VTt = (LAS bf16_t*)(set + S5_VT);
#pragma unroll
                  for (int e = 0; e < 4; ++e) { const unsigned w = e == 0 ? pvv.x : e == 1 ? pvv.y : e == 2 ? pvv.z : pvv.w;
                      VTt[(chh * 32 + 8 * qv + 2 * e) * 20 + jv] = (bf16_t)(w & 0xffffu); VTt[(chh * 32 + 8 * qv + 2 * e + 1) * 20 + jv] = (bf16_t)(w >> 16); } }
                if (iter + 1 < 48) S5_PREFETCH(3 * (iter + 1) + sub);
                f32x4 accw[2], acca[2];
#pragma unroll
                for (int q = 0; q < 2; ++q) { accw[q] = (f32x4){0.f, 0.f, 0.f, 0.f}; acca[q] = (f32x4){0.f, 0.f, 0.f, 0.f}; }
#pragma unroll
                for (int ks = 0; ks < 2; ++ks)
#pragma unroll
                    for (int q = 0; q < 2; ++q) { accw[q] = MFMA16(aw[ks], Bw[q][ks], accw[q]); acca[q] = MFMA16(aa[ks], Ba[q][ks], acca[q]); }
                float rnv[4];
#pragma unroll
                for (int i = 0; i < 4; ++i) { float ss = 0.f;
#pragma unroll
                    for (int nb = 0; nb < 4; ++nb) { const float t_ = kf[nb][i] * kkc4[nb]; ss += t_ * t_; }
                    rnv[i] = rsqrtf(fmaxf(row16_sum(ss), 1e-12f)); }
                LAS bf16_t* KR = (LAS bf16_t*)(set + S5_KR); LAS bf16_t* BK = (LAS bf16_t*)(set + S5_BK);
                LAS bf16_t* KD = (LAS bf16_t*)(set + S5_KD); LAS bf16_t* BT = (LAS bf16_t*)(set + S5_BT);
#pragma unroll
                for (int q = 0; q < 2; ++q) { const int nb = 2 * chh + q;
                    float ev[4], kkv[4], bv[4], kdv[4];
#pragma unroll
                    for (int i = 0; i < 4; ++i) {
                        const float wl = accw[q][i] + w0c[q], al = acca[q][i] + a0c[q];
                        ev[i] = 0.60653065971f * frcp(1.f + __expf(-wl));
                        const float a = frcp(1.f + __expf(-al));
                        const float k = kf[nb][i];
                        kkv[i] = k * kkc4[nb] * rnv[i]; bv[i] = kkv[i] * a; kdv[i] = k * (1.f + (a - 1.f) * kac[q]); }
                    const float c0 = ev[0], c1 = c0 + ev[1], c2 = c1 + ev[2], c3 = c2 + ev[3];
                    const float T0 = __int_as_float(__builtin_amdgcn_ds_bpermute(fr * 4, __float_as_int(c3))), T1 = __int_as_float(__builtin_amdgcn_ds_bpermute((fr + 16) * 4, __float_as_int(c3))),
                                T2 = __int_as_float(__builtin_amdgcn_ds_bpermute((fr + 32) * 4, __float_as_int(c3)));
                    const float off = (fq > 0 ? T0 : 0.f) + (fq > 1 ? T1 : 0.f) + (fq > 2 ? T2 : 0.f);
                    const float cs[4] = {off + c0, off + c1, off + c2, off + c3};
                    const int colp = 16 * nb + Pfr, c = 16 * nb + fr;
                    float ktl[4], nbet[4];
                    float E2p = 0.f;
#pragma unroll
                    for (int i = 0; i < 4; ++i) { const int t = 4 * fq + i;
                        const float E1 = __expf(cs[i]); const float E2 = frcp(E1); const float E3 = (i == 0) ? E2 * __expf(ev[0]) : E2p; E2p = E2;
                        const float kap = kkv[i] * E3, bet = bv[i] * E1, kt = kdv[i] * E1, rt = rf[q][i] * E2;
                        KR[t * 72 + colp] = f2bf_fast(kap); KR[(16 + t) * 72 + colp] = f2bf_fast(rt);
                        BK[t * 72 + colp] = f2bf_fast(bet); BK[(16 + t) * 72 + colp] = f2bf_fast(kt);
                        ktl[i] = kt; nbet[i] = -bet;
                        if (i == 3 && fq == 3) ((LAS float*)(set + S5_PC))[c] = E2; }
                    v2u wk, wb; wk.x = pg8::cvt_pk_bf16(ktl[0], ktl[1]); wk.y = pg8::cvt_pk_bf16(ktl[2], ktl[3]);
                    wb.x = pg8::cvt_pk_bf16(nbet[0], nbet[1]); wb.y = pg8::cvt_pk_bf16(nbet[2], nbet[3]);
                    *(LAS v2u*)(KD + c * 20 + 4 * fq) = wk; *(LAS v2u*)(BT + c * 20 + 4 * fq) = wb;
                }
            }
#undef S5_PREFETCH
        }
    }
    __syncthreads();
}
__device__ __forceinline__ void na_block(const bf16_t* kbase, const bf16x8_t (&qf)[2], bool lat, int dr31, int c0, int jq, int cs, const LAS float* rp,
                                         int fr, int fq, float (&pv)[4], float& lsum) {
    const bf16x8_t k0 = *(const bf16x8_t*)(kbase + (size_t)fr * ZC + 8 * fq), k1 = *(const bf16x8_t*)(kbase + (size_t)fr * ZC + 8 * fq + 32);
    float ss = 0.f;
#pragma unroll
    for (int e = 0; e < 8; ++e) { const float a = bf2f((bf16_t)k0[e]), b = bf2f((bf16_t)k1[e]); ss += a * a + b * b; }
    ss += swz_xor<16>(ss); ss = xor32_add(ss);
    const float rk = rsqrtf(ss * (1.f / 64.f) + RMS_EPS);
    f32x4 st = {0.f, 0.f, 0.f, 0.f};
    st = __builtin_amdgcn_mfma_f32_16x16x32_bf16(k0, qf[0], st, 0, 0, 0);
    st = __builtin_amdgcn_mfma_f32_16x16x32_bf16(k1, qf[1], st, 0, 0, 0);
#pragma unroll
    for (int i = 0; i < 4; ++i) {
        const float rki = __int_as_float(__builtin_amdgcn_ds_bpermute((4 * fq + i) * 4, __float_as_int(rk)));
        float x = st[i] * rki;
        if (lat) { const int c = c0 + 4 * fq + i; const bool valid = (c >= cs) && (c < cs + 16);
            const int di = min(max(c - jq + 15, 0), 30);
            x = valid ? __expf(fminf(x + rp[dr31 + di], 80.f)) : 0.f; }
        else x = __expf(fminf(x, 80.f));
        pv[i] = x; lsum += x;
    }
}
__device__ __forceinline__ void ph_natt2(const Params& p, unsigned char* ldsb, int l, int wg, int nwg) {
    const int tid = otid(), lane = tid & 63, wv = tid >> 6, fr = lane & 15, fq = lane >> 4;
    LAS float* rp = (LAS float*)ldsb + wv * 512;
    const bf16_t* Z = (const bf16_t*)(p.ws + WS_Z); const bf16_t* VT = (const bf16_t*)(p.ws + WS_VT); bf16_t* YB = (bf16_t*)(p.ws + WS_YB);
    const bool last = (l == 1);
    const int nunits = last ? 8192 : 9216;
    float gsc[2][8];
#pragma unroll
    for (int ks = 0; ks < 2; ++ks)
#pragma unroll
        for (int j = 0; j < 8; ++j) { const int d = 8 * fq + j + 32 * ks; gsc[ks][j] = p.na_q_g[l * 64 + d] * p.na_k_g[l * 64 + d] * 0.125f; }
    int cur_h = -1;
    for (int unit = wg * 8 + wv; unit < nunits; unit += nwg * 8) {
        int b, h, i = 0, qb, qrow0; bool isl;
        if (unit < 8192) { b = unit >> 10; h = (unit >> 7) & 7; i = (unit >> 2) & 31; qb = unit & 3; isl = true; qrow0 = b * SEQ + i * 64 + qb * 16; }
        else { const int u2 = unit - 8192; b = u2 >> 7; h = (u2 >> 4) & 7; qb = u2 & 15; isl = false; qrow0 = NLAT + b * CTXL + qb * 16; }
        if (h != cur_h) { for (int idx = lane; idx < 465; idx += 64) rp[idx] = p.na_rpb[(size_t)(l * 8 + h) * 465 + idx]; cur_h = h; }
        bf16x8_t qf[2];
        { const bf16_t* qp = Z + (size_t)(qrow0 + fr) * ZC + C_Q + h * 64 + 8 * fq;
          const bf16x8_t q0 = *(const bf16x8_t*)qp, q1 = *(const bf16x8_t*)(qp + 32);
          float f0[8], f1[8]; float ss = 0.f;
#pragma unroll
          for (int e = 0; e < 8; ++e) { f0[e] = bf2f((bf16_t)q0[e]); f1[e] = bf2f((bf16_t)q1[e]); ss += f0[e] * f0[e] + f1[e] * f1[e]; }
          ss += swz_xor<16>(ss); ss = xor32_add(ss);
          const float rq = rsqrtf(ss * (1.f / 64.f) + RMS_EPS);
#pragma unroll
          for (int e = 0; e < 8; ++e) { qf[0][e] = (short)f2bf(f0[e] * rq * gsc[0][e]); qf[1][e] = (short)f2bf(f1[e] * rq * gsc[1][e]); } }
        f32x4 o[4];
#pragma unroll
        for (int db = 0; db < 4; ++db) o[db] = (f32x4){0.f, 0.f, 0.f, 0.f};
        float lsum = 0.f;
        const bf16_t* vtb = VT + ((size_t)((b * 8 + h) * 64 + fr)) * 2304 + 4 * fq;
        const int jq = qb * 16 + fr, cs = min(max(jq - 8, 0), 48);
        const int r0 = min(max(i - 4, 0), 24);
        const int kb_lo = (qb <= 1) ? 0 : qb - 1, nkb = (qb == 0 || qb == 3) ? 2 : 3;
        const int nlat = isl ? 8 * nkb : 0, ntot = nlat + 16;
        for (int t = 0; t < ntot; t += 2) {
            float pa[4], pb[4]; int tposA, tposB;
            { const int tt = t; const bool lt = tt < nlat; int krow, dr31 = 0, c0 = 0;
              if (lt) { const int a = tt / nkb, kb = kb_lo + tt % nkb; krow = b * SEQ + (r0 + a) * 64 + 16 * kb; tposA = 256 + (r0 + a) * 64 + 16 * kb; dr31 = (r0 + a - i + 7) * 31; c0 = 16 * kb; }
              else { const int cbk = tt - nlat; krow = NLAT + b * CTXL + 16 * cbk; tposA = 16 * cbk; }
              na_block(Z + (size_t)krow * ZC + C_KB + h * 64, qf, lt, dr31, c0, jq, cs, rp, fr, fq, pa, lsum); }
            { const int tt = t + 1; const bool lt = tt < nlat; int krow, dr31 = 0, c0 = 0;
              if (lt) { const int a = tt / nkb, kb = kb_lo + tt % nkb; krow = b * SEQ + (r0 + a) * 64 + 16 * kb; tposB = 256 + (r0 + a) * 64 + 16 * kb; dr31 = (r0 + a - i + 7) * 31; c0 = 16 * kb; }
              else { const int cbk = tt - nlat; krow = NLAT + b * CTXL + 16 * cbk; tposB = 16 * cbk; }
              na_block(Z + (size_t)krow * ZC + C_KB + h * 64, qf, lt, dr31, c0, jq, cs, rp, fr, fq, pb, lsum); }
            bf16x8_t pf;
            pf[0] = (short)f2bf(pa[0]); pf[1] = (short)f2bf(pa[1]); pf[2] = (short)f2bf(pa[2]); pf[3] = (short)f2bf(pa[3]);
            pf[4] = (short)f2bf(pb[0]); pf[5] = (short)f2bf(pb[1]); pf[6] = (short)f2bf(pb[2]); pf[7] = (short)f2bf(pb[3]);
#pragma unroll
            for (int db = 0; db < 4; ++db) {
                typedef short s16x4_t __attribute__((ext_vector_type(4)));
                const s16x4_t va = *(const s16x4_t*)(vtb + (size_t)db * 16 * 2304 + tposA), vb = *(const s16x4_t*)(vtb + (size_t)db * 16 * 2304 + tposB);
                const bf16x8_t vf = {va[0], va[1], va[2], va[3], vb[0], vb[1], vb[2], vb[3]};
                o[db] = __builtin_amdgcn_mfma_f32_16x16x32_bf16(pf, vf, o[db], 0, 0, 0);
            }
        }
        lsum += swz_xor<16>(lsum); lsum = xor32_add(lsum);
        const float linv = 1.f / lsum;
#pragma unroll
        for (int i2 = 0; i2 < 4; ++i2) {
            const float li = __int_as_float(__builtin_amdgcn_ds_bpermute((4 * fq + i2) * 4, __float_as_int(linv)));
            bf16_t* yp = YB + (size_t)(qrow0 + 4 * fq + i2) * 512 + h * 64 + fr;
#pragma unroll
            for (int db = 0; db < 4; ++db) yp[db * 16] = f2bf(o[db][i2] * li);
        }
    }
}

typedef short s16x4_t __attribute__((ext_vector_type(4)));
__device__ __forceinline__ void na_soft(const f32x4 st, const float (&rki)[4], bool lat, int dr31, int c0, int jq, int cs, const LAS float* rp, int fq, float (&pv)[4], float& lsum) {
    if (lat) {
        float bi[4];
#pragma unroll
        for (int i = 0; i < 4; ++i) { const int c = c0 + i; bi[i] = rp[dr31 + min(max(c - jq + 15, 0), 30)]; }
#pragma unroll
        for (int i = 0; i < 4; ++i) { const int c = c0 + i; const bool valid = (c >= cs) && (c < cs + 16);
            const float x = valid ? fminf(st[i] * rki[i] + bi[i], 80.f) : -1e30f;
            const float e = __expf(x); pv[i] = e; lsum += e; }
    } else {
#pragma unroll
        for (int i = 0; i < 4; ++i) { const float e = __expf(fminf(st[i] * rki[i], 80.f)); pv[i] = e; lsum += e; }
    }
}
__device__ __forceinline__ void ph_natt3(const Params& p, unsigned char* ldsb, int l, int wg, int nwg) {
    const int wv = otid() >> 6;
    LAS unsigned char* L = (LAS unsigned char*)ldsb;
    LAS bf16_t* sK = (LAS bf16_t*)(L + 0);
    LAS bf16_t* sVT = (LAS bf16_t*)(L + 36864);
    LAS float* sRK = (LAS float*)(L + 70656);
    LAS float* rp = (LAS float*)(L + 71680);
    LAS float* sG = (LAS float*)(L + 73728);
    const bf16_t* Z = (const bf16_t*)(p.ws + WS_Z); const bf16_t* VT = (const bf16_t*)(p.ws + WS_VT); bf16_t* YB = (bf16_t*)(p.ws + WS_YB);
    const bool last = (l == 1);
    for (int task = wg; task < 256; task += nwg) {
        const int b = task >> 5, h = (task >> 2) & 7, quarter = task & 3;
        const int tid = otid();
        __syncthreads();
#pragma unroll
        for (int it = 0; it < 4; ++it) { const int pc = tid + 512 * it, key = pc >> 3, q = pc & 7;
            const v4u kw = *(const v4u*)(Z + (size_t)(NLAT + b * CTXL + key) * ZC + C_KB + h * 64 + 8 * q);
            *(LAS v4u*)(sK + key * 72 + 8 * q) = kw;
            float f[8]; unpack8(kw, f); float ss = 0.f;
#pragma unroll
            for (int e = 0; e < 8; ++e) ss += f[e] * f[e];
            ss += swz_xor<1>(ss); ss += swz_xor<2>(ss); ss += swz_xor<4>(ss);
            if (q == 0) sRK[key] = rsqrtf(ss * (1.f / 64.f) + RMS_EPS);
            const int d = pc >> 5, q2 = pc & 31;
            *(LAS v4u*)(sVT + d * 264 + 8 * q2) = *(const v4u*)(VT + ((size_t)((b * 8 + h) * 64 + d)) * 2304 + 8 * q2); }
        if (tid < 465) rp[tid] = p.na_rpb[(size_t)(l * 8 + h) * 465 + tid];
        if (tid < 64) sG[tid] = p.na_q_g[l * 64 + tid] * p.na_k_g[l * 64 + tid] * 0.125f;
        __syncthreads();
        const int nun = last ? 32 : 36;
        for (int u = wv; u < nun; u += 8) {
            const int lane2 = otid() & 63, fr = lane2 & 15, fq = lane2 >> 4;
            const bool isl = u < 32;
            const int i = 8 * quarter + (u >> 2), qb = isl ? (u & 3) : (4 * quarter + (u - 32));
            const int qrow0 = isl ? (b * SEQ + i * 64 + qb * 16) : (NLAT + b * CTXL + qb * 16);
            bf16x8_t qf[2];
            { const bf16_t* qp = Z + (size_t)(qrow0 + fr) * ZC + C_Q + h * 64 + 8 * fq;
              const bf16x8_t q0 = *(const bf16x8_t*)qp, q1 = *(const bf16x8_t*)(qp + 32);
              float f0[8], f1[8]; float ss = 0.f;
#pragma unroll
              for (int e = 0; e < 8; ++e) { f0[e] = bf2f((bf16_t)q0[e]); f1[e] = bf2f((bf16_t)q1[e]); ss += f0[e] * f0[e] + f1[e] * f1[e]; }
              ss += swz_xor<16>(ss); ss = xor32_add(ss);
              const float rq = rsqrtf(ss * (1.f / 64.f) + RMS_EPS);
              const f32x4 g00 = *(const LAS f32x4*)(sG + 8 * fq), g01 = *(const LAS f32x4*)(sG + 8 * fq + 4), g10 = *(const LAS f32x4*)(sG + 32 + 8 * fq), g11 = *(const LAS f32x4*)(sG + 36 + 8 * fq);
#pragma unroll
              for (int e = 0; e < 4; ++e) { f0[e] *= rq * g00[e]; f0[4 + e] *= rq * g01[e]; f1[e] *= rq * g10[e]; f1[4 + e] *= rq * g11[e]; }
              v4u w0, w1; w0.x = pg8::cvt_pk_bf16(f0[0], f0[1]); w0.y = pg8::cvt_pk_bf16(f0[2], f0[3]); w0.z = pg8::cvt_pk_bf16(f0[4], f0[5]); w0.w = pg8::cvt_pk_bf16(f0[6], f0[7]);
              w1.x = pg8::cvt_pk_bf16(f1[0], f1[1]); w1.y = pg8::cvt_pk_bf16(f1[2], f1[3]); w1.z = pg8::cvt_pk_bf16(f1[4], f1[5]); w1.w = pg8::cvt_pk_bf16(f1[6], f1[7]);
              qf[0] = __builtin_bit_cast(bf16x8_t, w0); qf[1] = __builtin_bit_cast(bf16x8_t, w1); }
            f32x4 o[4];
#pragma unroll
            for (int db = 0; db < 4; ++db) o[db] = (f32x4){0.f, 0.f, 0.f, 0.f};
            float lsum = 0.f;
            const bf16_t* vtb = VT + ((size_t)((b * 8 + h) * 64 + fr)) * 2304 + 4 * fq;
            const int jq = qb * 16 + fr, cs = min(max(jq - 8, 0), 48);
            const int r0 = min(max(i - 4, 0), 24);
            const int c0 = (qb == 0) ? 0 : (qb == 1) ? 8 : (qb == 2) ? 24 : 32;
            const int krow_in = 8 * (fr >> 2) + (fr & 3);
#define NA_LOAD(a_, KA_, KB_, V_) do { const int tok_ = (r0 + (a_)) * 64 + c0; \
                const bf16_t* kp_ = Z + (size_t)(b * SEQ + tok_ + krow_in) * ZC + C_KB + h * 64 + 8 * fq; KA_[0] = *(const bf16x8_t*)kp_; KA_[1] = *(const bf16x8_t*)(kp_ + 32); \
                KB_[0] = *(const bf16x8_t*)(kp_ + 4 * ZC); KB_[1] = *(const bf16x8_t*)(kp_ + 4 * ZC + 32); \
                _Pragma("unroll") for (int db_ = 0; db_ < 4; ++db_) V_[db_] = *(const bf16x8_t*)(VT + ((size_t)((b * 8 + h) * 64 + 16 * db_ + fr)) * 2304 + 256 + tok_ + 8 * fq); } while (0)
#define NA_SCORE_LAT(a_, K_, cofs_, P_) do { \
                float ss_ = 0.f; _Pragma("unroll") for (int e_ = 0; e_ < 8; ++e_) { const float x_ = bf2f((bf16_t)K_[0][e_]), y_ = bf2f((bf16_t)K_[1][e_]); ss_ += x_ * x_ + y_ * y_; } \
                ss_ += swz_xor<16>(ss_); ss_ = xor32_add(ss_); const float rk_ = rsqrtf(ss_ * (1.f / 64.f) + RMS_EPS); \
                f32x4 st_ = {0.f, 0.f, 0.f, 0.f}; st_ = __builtin_amdgcn_mfma_f32_16x16x32_bf16(K_[0], qf[0], st_, 0, 0, 0); st_ = __builtin_amdgcn_mfma_f32_16x16x32_bf16(K_[1], qf[1], st_, 0, 0, 0); \
                float rki_[4]; _Pragma("unroll") for (int i_ = 0; i_ < 4; ++i_) rki_[i_] = __int_as_float(__builtin_amdgcn_ds_bpermute((4 * fq + i_) * 4, __float_as_int(rk_))); \
                na_soft(st_, rki_, true, (r0 + (a_) - i + 7) * 31, c0 + (cofs_) + 8 * fq, jq, cs, rp, fq, P_, lsum); } while (0)
#define NA_PV(PA_, PB_, V_) do { v4u pw_; pw_.x = pg8::cvt_pk_bf16(PA_[0], PA_[1]); pw_.y = pg8::cvt_pk_bf16(PA_[2], PA_[3]); pw_.z = pg8::cvt_pk_bf16(PB_[0], PB_[1]); pw_.w = pg8::cvt_pk_bf16(PB_[2], PB_[3]); \
                const bf16x8_t pf_ = __builtin_bit_cast(bf16x8_t, pw_); \
                _Pragma("unroll") for (int db_ = 0; db_ < 4; ++db_) o[db_] = __builtin_amdgcn_mfma_f32_16x16x32_bf16(pf_, V_[db_], o[db_], 0, 0, 0); } while (0)
#define NA_CTX_LOAD(sidx_) do { \
                _Pragma("unroll") for (int hb = 0; hb < 2; ++hb) { const int key = 32 * (sidx_) + krow_in + 4 * hb; \
                    ck[hb][0] = *(const LAS bf16x8_t*)(sK + key * 72 + 8 * fq); ck[hb][1] = *(const LAS bf16x8_t*)(sK + key * 72 + 8 * fq + 32); \
                    crk[hb] = *(const LAS f32x4*)(sRK + 32 * (sidx_) + 8 * fq + 4 * hb); } \
                _Pragma("unroll") for (int db = 0; db < 4; ++db) cv[db] = *(const LAS bf16x8_t*)(sVT + (16 * db + fr) * 264 + 32 * (sidx_) + 8 * fq); } while (0)
#define NA_CTX_COMPUTE() do { float pa_[4], pb_[4]; \
                _Pragma("unroll") for (int hb = 0; hb < 2; ++hb) { \
                    f32x4 st = {0.f, 0.f, 0.f, 0.f}; \
                    st = __builtin_amdgcn_mfma_f32_16x16x32_bf16(ck[hb][0], qf[0], st, 0, 0, 0); st = __builtin_amdgcn_mfma_f32_16x16x32_bf16(ck[hb][1], qf[1], st, 0, 0, 0); \
                    const float rki[4] = {crk[hb][0], crk[hb][1], crk[hb][2], crk[hb][3]}; \
                    if (hb == 0) na_soft(st, rki, false, 0, 0, 0, 0, rp, fq, pa_, lsum); else na_soft(st, rki, false, 0, 0, 0, 0, rp, fq, pb_, lsum); } \
                NA_PV(pa_, pb_, cv); } while (0)
            bf16x8_t ck[2][2], cv[4]; f32x4 crk[2];
            if (isl) {
                bf16x8_t kA[2][2], kB[2][2], vv[2][4];
                NA_LOAD(0, kA[0], kB[0], vv[0]);
#pragma unroll 1
                for (int s2 = 0; s2 < 8; s2 += 2) {
#pragma unroll
                    for (int si = 0; si < 2; ++si) { const int sidx = s2 + si;
                        if (sidx + 1 < 8) NA_LOAD(sidx + 1, kA[si ^ 1], kB[si ^ 1], vv[si ^ 1]);
                        NA_CTX_LOAD(sidx);
                        __builtin_amdgcn_sched_barrier(0);
                        float pa[4], pb[4];
                        NA_SCORE_LAT(sidx, kA[si], 0, pa); NA_SCORE_LAT(sidx, kB[si], 4, pb);
                        NA_PV(pa, pb, vv[si]);
                        __builtin_amdgcn_sched_barrier(0);
                        NA_CTX_COMPUTE();
                        __builtin_amdgcn_sched_barrier(0);
                    }
                }
            } else {
#pragma unroll 1
                for (int sidx = 0; sidx < 8; ++sidx) { NA_CTX_LOAD(sidx); __builtin_amdgcn_sched_barrier(0); NA_CTX_COMPUTE(); }
            }
#undef NA_CTX_LOAD
#undef NA_CTX_COMPUTE
#undef NA_LOAD
#undef NA_SCORE_LAT
#undef NA_PV
            lsum += swz_xor<16>(lsum); lsum = xor32_add(lsum);
            const float linv = 1.f / lsum;
#pragma unroll
            for (int i2 = 0; i2 < 4; ++i2) {
                const float li = __int_as_float(__builtin_amdgcn_ds_bpermute((4 * fq + i2) * 4, __float_as_int(linv)));
                bf16_t* yp = YB + (size_t)(qrow0 + 4 * fq + i2) * 512 + h * 64 + fr;
#pragma unroll
                for (int db = 0; db < 4; ++db) yp[db * 16] = f2bf(o[db][i2] * li);
            }
        }
    }
    __syncthreads();
}

__device__ __forceinline__ void ph_convert_moe(const Params& p, unsigned char* ldsb, int l, int wg, int nwg);
__device__ __forceinline__ void ph_scan_natt(const Params& p, unsigned char* ldsb, int l, int wg, int nwg) {
    const int hs_ = nwg >> 1;
    if (nwg < 2) { ph_scan5(p, ldsb, l, 0, 1); __syncthreads(); ph_natt3(p, ldsb, l, 0, 1); }
    else if (wg < hs_) ph_scan5(p, ldsb, l, wg, hs_);
    else { ph_natt3(p, ldsb, l, wg - hs_, nwg - hs_); ph_convert_moe(p, ldsb, l, wg - hs_, nwg - hs_); }
}

__device__ __forceinline__ void ph_rwkvout(const Params& p, float* sm, int l, int wg, int nwg) {
    const bf16_t* Z = (const bf16_t*)(p.ws + WS_Z);
    const bf16_t* Y2 = (const bf16_t*)(p.ws + WS_Y2);
    bf16_t* OA = (bf16_t*)(p.ws + WS_OUTA);
    const int c = otid(); const int nrows = (l == 1) ? NLAT : LR;
    const float lng = p.rw_ln_g[l * 512 + c], lnb = p.rw_ln_b[l * 512 + c], rk = p.rw_r_k[l * 512 + c];
    const float* glb = p.rw_g_lora_b + (size_t)l * 128 * 512 + c;
    for (int r = wg; r < nrows; r += nwg) {
        __syncthreads();
        if (c < 128) sm[c] = sigmoidf_(bf2f(Z[(size_t)r * ZC + C_LG + c]));
        __syncthreads();
        const float yv = bf2f(Y2[(size_t)r * 512 + c]) + bf2f(Y2[((size_t)LR + r) * 512 + c]);
        const float mu = wave_sum(yv) * (1.f / 64.f); const float d = yv - mu; const float var = wave_sum(d * d) * (1.f / 64.f);
        const float yn = d * rsqrtf(var + GN_EPS) * lng + lnb;
        const float rr = bf2f(Z[(size_t)r * ZC + C_R + c]), kk = bf2f(Z[(size_t)r * ZC + C_K + c]), vv = bf2f(Z[(size_t)r * ZC + C_V + c]);
        const float bon = wave_sum(rr * kk * rk) * vv;
        float g = 0.f;
#pragma unroll 4
        for (int j = 0; j < 128; ++j) g += sm[j] * glb[(size_t)j * 512];
        OA[(size_t)r * 512 + c] = f2bf((yn + bon) * g);
    }
}

struct EpiOutA {
    static constexpr bool PERM = true, AFTER_DRAIN = false;
    const bf16_t* PRE; bf16_t* OA;
    __device__ __forceinline__ void operator()(const f32x4 (&acc)[2][2][4][2], const pg8::Unit& u, int wr, int wc, int fr, int fq) const {
        const int row0 = u.pm * 256 + wr * 64 + fr, colb = u.pn * 256 + wc * 32 + 8 * fq;
#pragma unroll
        for (int ai = 0; ai < 2; ++ai)
#pragma unroll
            for (int bj = 0; bj < 2; ++bj) { const int col = colb + bj * 128;
                v4u pw[4];
#pragma unroll
                for (int m = 0; m < 4; ++m) pw[m] = *(const v4u*)(PRE + (size_t)(row0 + ai * 128 + m * 16) * 512 + col);
#pragma unroll
                for (int m = 0; m < 4; ++m) { const int row = row0 + ai * 128 + m * 16;
                    float pr[8]; unpack8(pw[m], pr);
                    const f32x4 v0 = acc[ai][bj][m][0], v1 = acc[ai][bj][m][1];
                    v4u w; w.x = pg8::cvt_pk_bf16(pr[0] * v0[0], pr[1] * v0[1]); w.y = pg8::cvt_pk_bf16(pr[2] * v0[2], pr[3] * v0[3]);
                    w.z = pg8::cvt_pk_bf16(pr[4] * v1[0], pr[5] * v1[1]); w.w = pg8::cvt_pk_bf16(pr[6] * v1[2], pr[7] * v1[3]);
                    *(v4u*)(OA + (size_t)row * 512 + col) = w; } }
    }
};
__device__ __forceinline__ void ph_rwkvout2(const Params& p, unsigned char* ldsb, int l, int wg, int nwg) {
    const int nrows = (l == 1) ? NLAT : LR;
    pg8::StaticOrder S; S.init(nrows, 512, nwg, wg);
    {
        const int tid = otid(), lane = tid & 63, wv = tid >> 6;
        const bf16_t* Z = (const bf16_t*)(p.ws + WS_Z); bf16_t* Y2 = (bf16_t*)(p.ws + WS_Y2);
        pg8::Unit u;
        for (int it = 0; S.next(it, u); ++it) {
            const int c = u.pn * 256 + 4 * lane;
            const f32x4 lng = *(const f32x4*)(p.rw_ln_g + l * 512 + c), lnb = *(const f32x4*)(p.rw_ln_b + l * 512 + c), rkk = *(const f32x4*)(p.rw_r_k + l * 512 + c);
            for (int rr0 = wv; rr0 < 256; rr0 += 32) {
                v2u lyf[4], lyb[4], lr[4], lk[4], lv[4];
#pragma unroll
                for (int q = 0; q < 4; ++q) { const int row = u.pm * 256 + rr0 + 8 * q;
                    lyf[q] = *(const v2u*)(Y2 + (size_t)row * 512 + c); lyb[q] = *(const v2u*)(Y2 + ((size_t)LR + row) * 512 + c);
                    lr[q] = *(const v2u*)(Z + (size_t)row * ZC + C_R + c); lk[q] = *(const v2u*)(Z + (size_t)row * ZC + C_K + c); lv[q] = *(const v2u*)(Z + (size_t)row * ZC + C_V + c); }
#pragma unroll
                for (int q = 0; q < 4; ++q) { const int row = u.pm * 256 + rr0 + 8 * q;
                    float yf[4], yb[4], r4[4], k4[4], v4[4];
                    unpack4(lyf[q], yf); unpack4(lyb[q], yb); unpack4(lr[q], r4); unpack4(lk[q], k4); unpack4(lv[q], v4);
                    float y[4]; float sy = 0.f, sb = 0.f;
#pragma unroll
                    for (int e = 0; e < 4; ++e) { y[e] = yf[e] + yb[e]; sy += y[e]; sb += r4[e] * k4[e] * rkk[e]; }
                    sy = row16_sum(sy); sb = row16_sum(sb);
                    const float mu = sy * (1.f / 64.f); float sq = 0.f;
#pragma unroll
                    for (int e = 0; e < 4; ++e) { y[e] -= mu; sq += y[e] * y[e]; }
                    sq = row16_sum(sq);
                    const float rs = rsqrtf(sq * (1.f / 64.f) + GN_EPS);
                    float o[4];
#pragma unroll
                    for (int e = 0; e < 4; ++e) o[e] = y[e] * rs * lng[e] + lnb[e] + sb * v4[e];
                    v2u w; w.x = pk2(o[0], o[1]); w.y = pk2(o[2], o[3]);
                    *(v2u*)(Y2 + (size_t)row * 512 + c) = w; }
            }
        }
    }
    asm volatile("s_waitcnt vmcnt(0)" ::: "memory");
    __syncthreads();
    pg8::Gemm g{(const bf16_t*)(p.ws + WS_SG), (const bf16_t*)(p.ws + WS_GL_T), nrows, 512, 256};
    EpiOutA E{(const bf16_t*)(p.ws + WS_Y2), (bf16_t*)(p.ws + WS_OUTA)};
    pg8::gemm_phase<EpiOutA, pg8::StaticOrder, true, true>((LAS unsigned char*)ldsb, g, S, E);
}

__device__ __forceinline__ void ph_merge(const Params& p, float* sm, int l, int wg, int nwg) {
    const bf16_t* Z = (const bf16_t*)(p.ws + WS_Z);
    bf16_t* MG = (bf16_t*)(p.ws + WS_MERGED);
    float* TMP = (float*)(p.ws + WS_YS);
    const int nrows = (l == 1) ? NLAT : LR;
    gemm_naive<bf16_t>(sm, wg, nwg, nrows, DM, 512, (const bf16_t*)(p.ws + WS_OUTA), 512, nullptr, 0, p.proj_a + (size_t)l * 512 * DM, DM,
                       [=](int r, int c, float v) { TMP[(size_t)r * DM + c] = sigmoidf_(bf2f(Z[(size_t)r * ZC + C_GA + c])) * v; });
    gemm_naive<bf16_t>(sm, wg, nwg, nrows, DM, 512, (const bf16_t*)(p.ws + WS_YB), 512, nullptr, 0, p.proj_b + (size_t)l * 512 * DM, DM,
                       [=](int r, int c, float v) { MG[(size_t)r * DM + c] = f2bf(TMP[(size_t)r * DM + c] + sigmoidf_(bf2f(Z[(size_t)r * ZC + C_GB + c])) * v); });
}

__device__ __forceinline__ void ph_wout(const Params& p, float* sm, int l, int wg, int nwg) {
    const float* MOD = (const float*)(p.ws + WS_MOD);
    const int nrows = (l == 1) ? NLAT : LR;
    const Params pp = p;
    gemm_naive<bf16_t>(sm, wg, nwg, nrows, DM, DM, (const bf16_t*)(p.ws + WS_MERGED), DM, nullptr, 0, p.w_out + (size_t)l * DM * DM, DM,
                       [=](int r, int c, float v) { const float base = (l == 0 ? in_row(pp, r) : st_row(pp, r))[c];
                           st_row(pp, r)[c] = base + MOD[(l * 9 + mod_row(r)) * 6144 + 2 * DM + c] * v; });
}

__device__ __forceinline__ void ph_route(const Params& p, float* sm, int l, int wg, int nwg) {
    const int lane = otid() & 63, wv = otid() >> 6, nwv = blockDim.x >> 6;
    const float* MOD = (const float*)(p.ws + WS_MOD);
    bf16_t* H2 = (bf16_t*)(p.ws + WS_H2);
    const int nrows = (l == 1) ? NLAT : LR;
    for (int r = wg * nwv + wv; r < nrows; r += nwg * nwv) {
        const float* xr = st_row(p, r);
        float v[16]; float ss = 0.f;
#pragma unroll
        for (int i = 0; i < 16; ++i) { v[i] = xr[lane + 64 * i]; ss += v[i] * v[i]; }
        ss = wave_sum(ss);
        const float rs = rsqrtf(ss * (1.f / DM) + RMS_EPS);
        const float* m = MOD + (l * 9 + mod_row(r)) * 6144;
        float* hs = sm + wv * 1024;
#pragma unroll
        for (int i = 0; i < 16; ++i) { const int d = lane + 64 * i;
            const float h = (v[i] * rs * p.norm2_g[l * DM + d]) * (1.f + m[4 * DM + d]) + m[3 * DM + d];
            H2[(size_t)r * DM + d] = f2bf(h); hs[d] = h; }
        float dsum = 0.f;
        { const int e = lane & 15, part = lane >> 4; const float* rw = p.router_w + (size_t)(part * 256) * 16 + e; const float* hp = hs + part * 256;
#pragma unroll 4
            for (int d = 0; d < 256; ++d) dsum += hp[d] * rw[(size_t)d * 16]; }
        dsum += swz_xor<16>(dsum); dsum = xor32_add(dsum);
        const float myscore = 1.f / (1.f + expf(-dsum));
        float sc[16], sel[16];
#pragma unroll
        for (int e = 0; e < 16; ++e) { sc[e] = rdlane(myscore, e); sel[e] = sc[e] + p.router_bias[e]; }
        int best = 0; float bestv = -INFINITY;
#pragma unroll
        for (int g = 0; g < 4; ++g) { float m1 = -INFINITY, m2 = -INFINITY;
#pragma unroll
            for (int j = 0; j < 4; ++j) { const float s = sel[g * 4 + j]; if (s > m1) { m2 = m1; m1 = s; } else if (s > m2) m2 = s; }
            const float gs = m1 + m2; if (gs > bestv) { bestv = gs; best = g; } }
        int i0 = -1; float v0 = -INFINITY;
#pragma unroll
        for (int e = 0; e < 16; ++e) if ((e >> 2) == best && sel[e] > v0) { v0 = sel[e]; i0 = e; }
        int i1 = -1; float v1 = -INFINITY;
#pragma unroll
        for (int e = 0; e < 16; ++e) if ((e >> 2) == best && e != i0 && sel[e] > v1) { v1 = sel[e]; i1 = e; }
        float s0 = 0.f, s1 = 0.f;
#pragma unroll
        for (int e = 0; e < 16; ++e) { if (e == i0) s0 = sc[e]; if (e == i1) s1 = sc[e]; }
        const float inv = 1.f / (s0 + s1);
        if (lane == 0) {
            ((int*)(p.ws + WS_TOKI))[r] = i0 | (i1 << 8);
            ((float2*)(p.ws + WS_TOKG))[r] = make_float2(s0 * inv, s1 * inv);
        }
    }
}

__device__ __forceinline__ void ph_lists(const Params& p, float* sm, int l, int wg, int nwg) {
    int* cnt = (int*)(p.ws + WS_CTL) + l * 16;
    int* LT = (int*)(p.ws + WS_LTOK); float* LGt = (float*)(p.ws + WS_LGATE);
    const int* TI = (const int*)(p.ws + WS_TOKI); const float2* TG = (const float2*)(p.ws + WS_TOKG);
    const int nrows = (l == 1) ? NLAT : LR;
    const int tid = otid(), lane = tid & 63, wv = tid >> 6;
    int* wcnt = (int*)sm;
    for (int e = wg; e < NE; e += nwg) {
        int base = 0;
        for (int c0 = 0; c0 < nrows; c0 += 512) {
            const int t = c0 + tid;
            int slot = -1; float g = 0.f;
            if (t < nrows) { const int ti = TI[t]; const float2 tg = TG[t];
                if ((ti & 255) == e) { slot = 0; g = tg.x; } else if ((ti >> 8) == e) { slot = 1; g = tg.y; } }
            const unsigned long long bal = __ballot(slot >= 0);
            __syncthreads();
            if (lane == 0) wcnt[wv] = __popcll(bal);
            __syncthreads();
            int woff = 0, tot = 0;
#pragma unroll
            for (int w = 0; w < 8; ++w) { const int c = wcnt[w]; if (w < wv) woff += c; tot += c; }
            if (slot >= 0) { const int pos = base + woff + __popcll(bal & ((1ull << lane) - 1ull));
                LT[e * LR + pos] = t * 2 + slot; LGt[e * LR + pos] = g; }
            base += tot;
        }
        if (tid == 0) cnt[e] = base;
    }
}

__device__ __forceinline__ void ph_convert_moe(const Params& p, unsigned char* ldsb, int l, int wg, int nwg) {
    const int lane = otid() & 63, wv = __builtin_amdgcn_readfirstlane(otid() >> 6);
    LAS float* scr = (LAS float*)((LAS unsigned char*)ldsb + 32768 + wv * 8704);
    const int gw = wg * 8 + wv, NGW = nwg * 8;
    for (int it = gw; it < 16 * 768; it += NGW) {
        const int e = it / 768, r = it % 768, which = r >> 8, q = r & 255;
        if (which < 2) { const int kb = q >> 4, nb = q & 15, n0 = nb * 32;
            const float* W = (which == 0 ? p.moe_w1 : p.moe_w3) + (size_t)(l * NE + e) * DM * DE;
            tr_item(W, DE, kb * 64, n0, (bf16_t*)(p.ws + WS_W13T) + (size_t)e * 1024 * 1024, DM, (n0 >> 7) * 256 + (n0 & 127) + which * 128, scr, lane); }
        else { const int kb = q >> 5, nb = q & 31;
            tr_item(p.moe_w2 + (size_t)(l * NE + e) * DE * DM, DM, kb * 64, nb * 32, (bf16_t*)(p.ws + WS_W2T) + (size_t)e * 1024 * 512, DE, nb * 32, scr, lane); }
    }
}
__device__ __forceinline__ void ph_route2(const Params& p, float* sm, int l, int wg, int nwg) {
    const int tid = otid(), lane = tid & 63, wv = tid >> 6, fr = lane & 15, fq = lane >> 4;
    const float* MOD = (const float*)(p.ws + WS_MOD);
    bf16_t* H2 = (bf16_t*)(p.ws + WS_H2T);
    int* TI = (int*)(p.ws + WS_TOKI); float2* TG = (float2*)(p.ws + WS_TOKG);
    const int nrows = (l == 1) ? NLAT : LR;
    const int per = (nrows + nwg - 1) / nwg, r_beg = wg * per, r_end = min(nrows, r_beg + per);
    float* hs = sm;
    float* part = sm + 16 * 1028;
    int* lcnt = (int*)(part + 8 * 256);
    if (tid < 16) lcnt[tid] = 0;
    float Bw[32];
#pragma unroll
    for (int kk = 0; kk < 32; ++kk) Bw[kk] = p.router_w[(size_t)(128 * wv + 4 * kk + fq) * 16 + fr];
    for (int blk = r_beg; blk < r_end; blk += 16) {
        __syncthreads();
#pragma unroll
        for (int tt = 0; tt < 2; ++tt) { const int tl = wv * 2 + tt, r = blk + tl;
            if (r < r_end) {
                const bf16_t* xr = (const bf16_t*)(p.ws + WS_X1B) + (size_t)r * DM;
                const float* m = MOD + (l * 9 + mod_row(r)) * 6144;
                f32x4 v[4]; float ss = 0.f;
#pragma unroll
                for (int j = 0; j < 4; ++j) { float t4[4]; unpack4(*(const v2u*)(xr + 4 * lane + 256 * j), t4); v[j] = (f32x4){t4[0], t4[1], t4[2], t4[3]}; ss += (v[j][0] * v[j][0] + v[j][1] * v[j][1]) + (v[j][2] * v[j][2] + v[j][3] * v[j][3]); }
                ss = wave_sum(ss);
                const float rs = rsqrtf(ss * (1.f / DM) + RMS_EPS);
#pragma unroll
                for (int j = 0; j < 4; ++j) { const int d = 4 * lane + 256 * j;
                    const f32x4 g = *(const f32x4*)(p.norm2_g + l * DM + d), sh = *(const f32x4*)(m + 3 * DM + d), scl = *(const f32x4*)(m + 4 * DM + d);
                    const f32x4 h = v[j] * rs * g * (scl + 1.f) + sh;
                    v2u w; w.x = pk2(h[0], h[1]); w.y = pk2(h[2], h[3]);
                    *(v2u*)(H2 + (size_t)r * DM + d) = w;
                    *(f32x4*)(hs + tl * 1028 + d) = h; }
            } else {
#pragma unroll
                for (int j = 0; j < 4; ++j) *(f32x4*)(hs + tl * 1028 + 4 * lane + 256 * j) = (f32x4){0.f, 0.f, 0.f, 0.f};
            }
        }
        __syncthreads();
        { f32x4 acc = {0.f, 0.f, 0.f, 0.f};
#pragma unroll
          for (int kk = 0; kk < 32; ++kk) { const float a = hs[fr * 1028 + 128 * wv + 4 * kk + fq]; acc = __builtin_amdgcn_mfma_f32_16x16x4f32(a, Bw[kk], acc, 0, 0, 0); }
#pragma unroll
          for (int i = 0; i < 4; ++i) part[wv * 256 + (4 * fq + i) * 16 + fr] = acc[i]; }
        __syncthreads();
        if (tid < 16 && blk + tid < r_end) {
            const int r = blk + tid;
            float sc[16], sel[16];
#pragma unroll
            for (int e = 0; e < 16; ++e) { float d = 0.f;
#pragma unroll
                for (int w8 = 0; w8 < 8; ++w8) d += part[w8 * 256 + tid * 16 + e];
                sc[e] = 1.f / (1.f + expf(-d)); sel[e] = sc[e] + p.router_bias[e]; }
            int best = 0; float bestv = -INFINITY;
#pragma unroll
            for (int g = 0; g < 4; ++g) { float m1 = -INFINITY, m2 = -INFINITY;
#pragma unroll
                for (int j = 0; j < 4; ++j) { const float s_ = sel[g * 4 + j]; if (s_ > m1) { m2 = m1; m1 = s_; } else if (s_ > m2) m2 = s_; }
                const float gs = m1 + m2; if (gs > bestv) { bestv = gs; best = g; } }
            int i0 = -1; float v0 = -INFINITY;
#pragma unroll
            for (int e = 0; e < 16; ++e) if ((e >> 2) == best && sel[e] > v0) { v0 = sel[e]; i0 = e; }
            int i1 = -1; float v1 = -INFINITY;
#pragma unroll
            for (int e = 0; e < 16; ++e) if ((e >> 2) == best && e != i0 && sel[e] > v1) { v1 = sel[e]; i1 = e; }
            float s0 = 0.f, s1 = 0.f;
#pragma unroll
            for (int e = 0; e < 16; ++e) { if (e == i0) s0 = sc[e]; if (e == i1) s1 = sc[e]; }
            const float inv = 1.f / (s0 + s1);
            TI[r] = i0 | (i1 << 8); TG[r] = make_float2(s0 * inv, s1 * inv); atomicAdd(&lcnt[i0], 1); atomicAdd(&lcnt[i1], 1);
        }
    }
    __syncthreads();
    if (tid < 16) ((int*)(p.ws + WS_CNTWG))[wg * 16 + tid] = lcnt[tid];
}
__device__ __forceinline__ void ph_lists2(const Params& p, float* sm, int l, int wg, int nwg) {
    const int tid = otid(), lane = tid & 63, wv = tid >> 6;
    const int* CW = (const int*)(p.ws + WS_CNTWG);
    const int* TI = (const int*)(p.ws + WS_TOKI); const float2* TG = (const float2*)(p.ws + WS_TOKG);
    int* RD = (int*)(p.ws + WS_ROWDST); float* RG = (float*)(p.ws + WS_ROWGATE);
    const bf16_t* H2 = (const bf16_t*)(p.ws + WS_H2T); bf16_t* H2S = (bf16_t*)(p.ws + WS_H2S);
    const int nrows = (l == 1) ? NLAT : LR;
    const int per = (nrows + nwg - 1) / nwg, r_beg = wg * per, r_end = min(nrows, r_beg + per);
    int* s_tot = (int*)sm;
    int* s_before = s_tot + 16;
    int* s_off = s_tot + 32;
    int* s_ti = s_tot + 64;
    int* s_pos = s_tot + 64 + 128;
    int* s_cw = s_tot + 512;
    for (int i = tid; i < nwg * 16; i += 512) s_cw[i] = CW[i];
    for (int i = tid; i < r_end - r_beg; i += 512) s_ti[i] = TI[r_beg + i];
    __syncthreads();
    if (tid < 256) {
        const int e = tid & 15, part = tid >> 4; int tot = 0, bef = 0;
        for (int w = part; w < nwg; w += 16) { const int c = s_cw[w * 16 + e]; tot += c; if (w < wg) bef += c; }
        s_cw[4096 + tid] = tot; s_cw[4096 + 256 + tid] = bef;
    }
    __syncthreads();
    if (tid < 16) { int tot = 0, bef = 0; for (int q = 0; q < 16; ++q) { tot += s_cw[4096 + q * 16 + tid]; bef += s_cw[4096 + 256 + q * 16 + tid]; } s_tot[tid] = tot; s_before[tid] = bef; }
    __syncthreads();
    if (tid == 0) { int o = 0; for (int e = 0; e < 16; ++e) { s_off[e] = o; o += (s_tot[e] + 255) & ~255; } s_off[16] = o; }
    __syncthreads();
    if (wg == 0) {
        int* OFFS = (int*)(p.ws + WS_OFFS); int* TEXP = (int*)(p.ws + WS_TEXP);
        if (tid < 17) OFFS[tid] = s_off[tid];
        if (tid == 17) OFFS[17] = s_off[16] >> 8;
        if (tid < 160) { int e = 0; for (int k = 1; k < 16; ++k) if (tid * 256 >= s_off[k]) e = k; TEXP[tid] = e; }
    }
    if (wg < 16) { const int beg = s_off[wg] + s_tot[wg], end = s_off[wg + 1]; for (int i = beg + tid; i < end; i += 512) { RD[i] = -1; RG[i] = 0.f; } }
    const int n = r_end - r_beg;
    if (tid < n) { const int ti = s_ti[tid], e0 = ti & 255, e1 = ti >> 8; int k0 = 0, k1 = 0;
        for (int j = 0; j < tid; ++j) { const int tj = s_ti[j]; k0 += ((tj & 255) == e0) + ((tj >> 8) == e0); k1 += ((tj & 255) == e1) + ((tj >> 8) == e1); }
        const int p0 = s_off[e0] + s_before[e0] + k0, p1 = s_off[e1] + s_before[e1] + k1;
        s_pos[2 * tid] = p0; s_pos[2 * tid + 1] = p1;
        const float2 g = TG[r_beg + tid];
        RD[p0] = (r_beg + tid) * 2; RG[p0] = g.x; RD[p1] = (r_beg + tid) * 2 + 1; RG[p1] = g.y; }
    (void)H2; (void)H2S; (void)lane; (void)wv; (void)s_pos;
}
struct MoeOrder : pg8::StaticOrder {
    const int* texp; unsigned stride;
    __device__ __forceinline__ bool next(int i, pg8::Unit& u) const { if (!pg8::StaticOrder::next(i, u)) return false; u.boff = (unsigned)texp[u.pm] * stride; return true; }
};
constexpr int CW_RDY = 8192;
__device__ __forceinline__ void st16_wt(void* ptr, v4u v) { asm volatile("global_store_dwordx4 %0, %1, off sc1\n\ts_nop 1" :: "v"(ptr), "v"(v) : "memory"); }
struct MoeOrderPub : MoeOrder {
    static constexpr bool GATHER = true;
    unsigned* rdy;
    __device__ __forceinline__ void done(const pg8::Unit& u) const {
        asm volatile("s_waitcnt vmcnt(0)" ::: "memory");
        if ((otid() & 63) == 0) (void)__hip_atomic_fetch_add(rdy + 16 * u.pm, 1u, __ATOMIC_RELAXED, __HIP_MEMORY_SCOPE_AGENT);
    }
};
struct MoeOrderSub : pg8::StaticOrder {
    const int* texp; unsigned stride; const unsigned* rdy; int nx, J, x, j, rr, nl, base; bool classed;
    __device__ __forceinline__ void init2(int M, int N, int G_, int c_) {
        init(M, N, G_, c_);
        classed = (G_ % 8) == 0 && G_ >= 8;
        if (classed) { J = G_ / 8; x = c_ % 8; j = c_ / 8; nx = (nwg - x + 7) / 8; if (nx < 0) nx = 0; rr = nx % J; nl = J - rr; base = min(nx, 2 * nl); }
    }
    __device__ __forceinline__ bool next(int i, pg8::Unit& u) const {
        if (!classed) { if (!pg8::StaticOrder::next(i, u)) return false; u.boff = (unsigned)texp[u.pm] * stride; return true; }
        int s;
        if (j >= rr) { const int rank = j - rr; s = (i == 0) ? rank : (i == 1) ? nl + rank : base + j + (i - 2) * J; if (i < 2 && s >= base) return false; }
        else s = base + j + i * J;
        if (s >= nx) return false;
        unit_of(s * 8 + x, u); u.boff = (unsigned)texp[u.pm] * stride; return true;
    }
    __device__ __forceinline__ void a_ready(const pg8::Unit& u) const {
        if (otid() < 64) {
            unsigned sp = 0u;
            while ((unsigned)__builtin_amdgcn_readfirstlane(__hip_atomic_load(rdy + 16 * u.pm, __ATOMIC_RELAXED, __HIP_MEMORY_SCOPE_AGENT)) < 32u) { __builtin_amdgcn_s_sleep(2); if (++sp > (1u << 22)) break; }
            __builtin_amdgcn_fence(__ATOMIC_ACQUIRE, "agent");
            asm volatile("s_waitcnt vmcnt(0)" ::: "memory");
        }
        asm volatile("" ::: "memory"); __builtin_amdgcn_s_barrier(); asm volatile("" ::: "memory");
    }
};
struct EpiHid {
    static constexpr bool PERM = true, AFTER_DRAIN = false;
    bf16_t* HID;
    __device__ __forceinline__ void operator()(const f32x4 (&acc)[2][2][4][2], const pg8::Unit& u, int wr, int wc, int fr, int fq) const {
        const int row0 = u.pm * 256 + wr * 64 + fr, col = u.pn * 128 + wc * 32 + 8 * fq;
#pragma unroll
        for (int ai = 0; ai < 2; ++ai)
#pragma unroll
            for (int m = 0; m < 4; ++m) {
                const f32x4 a0 = acc[ai][0][m][0], a1 = acc[ai][0][m][1], b0 = acc[ai][1][m][0], b1 = acc[ai][1][m][1];
                float o[8];
#pragma unroll
                for (int e = 0; e < 4; ++e) { o[e] = a0[e] * sigmoidf_(a0[e]) * b0[e]; o[4 + e] = a1[e] * sigmoidf_(a1[e]) * b1[e]; }
                v4u w; w.x = pg8::cvt_pk_bf16(o[0], o[1]); w.y = pg8::cvt_pk_bf16(o[2], o[3]); w.z = pg8::cvt_pk_bf16(o[4], o[5]); w.w = pg8::cvt_pk_bf16(o[6], o[7]);
                st16_wt(HID + (size_t)(row0 + ai * 128 + m * 16) * DE + col, w); }
    }
};
struct EpiYs {
    static constexpr bool PERM = true, AFTER_DRAIN = false;
    bf16_t* YS; const int* RD; const float* RG;
    __device__ __forceinline__ void operator()(const f32x4 (&acc)[2][2][4][2], const pg8::Unit& u, int wr, int wc, int fr, int fq) const {
        const int row0 = u.pm * 256 + wr * 64 + fr, colb = u.pn * 256 + wc * 32 + 8 * fq;
        int dsts[2][4]; float gs[2][4];
#pragma unroll
        for (int ai = 0; ai < 2; ++ai)
#pragma unroll
            for (int m = 0; m < 4; ++m) { const int row = row0 + ai * 128 + m * 16; dsts[ai][m] = RD[row]; gs[ai][m] = RG[row]; }
#pragma unroll
        for (int ai = 0; ai < 2; ++ai)
#pragma unroll
            for (int m = 0; m < 4; ++m) { const int dst = dsts[ai][m]; const float g = gs[ai][m];
                if (dst >= 0) {
#pragma unroll
                    for (int bj = 0; bj < 2; ++bj) { const f32x4 v0 = acc[ai][bj][m][0] * g, v1 = acc[ai][bj][m][1] * g;
                        v4u w; w.x = pg8::cvt_pk_bf16(v0[0], v0[1]); w.y = pg8::cvt_pk_bf16(v0[2], v0[3]); w.z = pg8::cvt_pk_bf16(v1[0], v1[1]); w.w = pg8::cvt_pk_bf16(v1[2], v1[3]);
                        *(v4u*)(YS + (size_t)dst * DM + colb + bj * 128) = w; } } }
    }
};
__device__ __forceinline__ void ph_moe1_mfma(const Params& p, unsigned char* ldsb, int l, int wg, int nwg) {
    const int ntiles = ((const int*)(p.ws + WS_OFFS))[17];
    pg8::Gemm g{(const bf16_t*)(p.ws + WS_H2T), (const bf16_t*)(p.ws + WS_W13T), ntiles * 256, 1024, DM};
    MoeOrderPub S; S.init(ntiles * 256, 1024, nwg, wg); S.texp = (const int*)(p.ws + WS_TEXP); S.stride = 1024u * 1024u * 2u; S.rdy = (unsigned*)(p.ws + WS_CTL) + CW_RDY + l * 4096; S.rowsrc = (const int*)(p.ws + WS_ROWDST);
    EpiHid E{(bf16_t*)(p.ws + WS_HID2)};
    pg8::gemm_phase<EpiHid, MoeOrderPub, true, true>((LAS unsigned char*)ldsb, g, S, E);
}
__device__ __forceinline__ void ph_moe2_mfma(const Params& p, unsigned char* ldsb, int l, int wg, int nwg) {
    const int ntiles = ((const int*)(p.ws + WS_OFFS))[17];
    pg8::Gemm g{(const bf16_t*)(p.ws + WS_HID2), (const bf16_t*)(p.ws + WS_W2T), ntiles * 256, 1024, DE};
    MoeOrderSub S; S.init2(ntiles * 256, 1024, nwg, wg); S.texp = (const int*)(p.ws + WS_TEXP); S.stride = 1024u * 512u * 2u; S.rdy = (const unsigned*)(p.ws + WS_CTL) + CW_RDY + l * 4096;
    EpiYs E{(bf16_t*)(p.ws + WS_YS2), (const int*)(p.ws + WS_ROWDST), (const float*)(p.ws + WS_ROWGATE)};
    pg8::gemm_phase<EpiYs, MoeOrderSub, true, true>((LAS unsigned char*)ldsb, g, S, E);
}
__device__ __forceinline__ void ph_combine2(const Params& p, int l, int wg, int nwg) {
    const float* MOD = (const float*)(p.ws + WS_MOD);
    const bf16_t* YS = (const bf16_t*)(p.ws + WS_YS2);
    const int nrows = (l == 1) ? NLAT : LR;
    for (size_t i = (size_t)wg * 512 + otid(); i < (size_t)nrows * DM; i += (size_t)nwg * 512) {
        const int r = (int)(i >> 10), d = (int)(i & 1023);
        float* xp = st_row(p, r) + d;
        *xp = *xp + MOD[(l * 9 + mod_row(r)) * 6144 + 5 * DM + d] * (bf2f(YS[(size_t)(2 * r) * DM + d]) + bf2f(YS[(size_t)(2 * r + 1) * DM + d]));
    }
}

__device__ __forceinline__ void ph_moe1(const Params& p, float* sm, int l, int wg, int nwg) {
    const int* cnt = (const int*)(p.ws + WS_CTL) + l * 16;
    const int* LT = (const int*)(p.ws + WS_LTOK);
    float* T1 = (float*)(p.ws + WS_TMP1); bf16_t* HID = (bf16_t*)(p.ws + WS_HID);
    int off = 0;
    for (int e = 0; e < NE; ++e) {
        const int M = cnt[e];
        float* t1 = T1 + (size_t)off * DE; bf16_t* hid = HID + (size_t)off * DE;
        gemm_naive<bf16_t>(sm, wg, nwg, M, DE, DM, (const bf16_t*)(p.ws + WS_H2), DM, LT + e * LR, 1, p.moe_w1 + ((size_t)(l * NE + e) * DM) * DE, DE,
                           [=](int r, int c, float v) { t1[(size_t)r * DE + c] = v; });
        gemm_naive<bf16_t>(sm, wg, nwg, M, DE, DM, (const bf16_t*)(p.ws + WS_H2), DM, LT + e * LR, 1, p.moe_w3 + ((size_t)(l * NE + e) * DM) * DE, DE,
                           [=](int r, int c, float v) { const float a = t1[(size_t)r * DE + c]; hid[(size_t)r * DE + c] = f2bf(a * sigmoidf_(a) * v); });
        off += (M + 255) & ~255;
    }
}
__device__ __forceinline__ void ph_moe2(const Params& p, float* sm, int l, int wg, int nwg) {
    const int* cnt = (const int*)(p.ws + WS_CTL) + l * 16;
    const int* LT = (const int*)(p.ws + WS_LTOK); const float* LGt = (const float*)(p.ws + WS_LGATE);
    const bf16_t* HID = (const bf16_t*)(p.ws + WS_HID); bf16_t* YS = (bf16_t*)(p.ws + WS_YS);
    int off = 0;
    for (int e = 0; e < NE; ++e) {
        const int M = cnt[e];
        const int* lt = LT + e * LR; const float* lgt = LGt + e * LR;
        gemm_naive<bf16_t>(sm, wg, nwg, M, DM, DE, HID + (size_t)off * DE, DE, nullptr, 0, p.moe_w2 + ((size_t)(l * NE + e) * DE) * DM, DM,
                           [=](int r, int c, float v) { YS[(size_t)lt[r] * DM + c] = f2bf(lgt[r] * v); });
        off += (M + 255) & ~255;
    }
}
__device__ __forceinline__ void ph_combine(const Params& p, int l, int wg, int nwg) {
    const float* MOD = (const float*)(p.ws + WS_MOD);
    const bf16_t* YS = (const bf16_t*)(p.ws + WS_YS);
    const int nrows = (l == 1) ? NLAT : LR;
    for (size_t i = (size_t)wg * blockDim.x + otid(); i < (size_t)nrows * DM; i += (size_t)nwg * blockDim.x) {
        const int r = (int)(i >> 10), d = (int)(i & 1023);
        float* xp = st_row(p, r) + d;
        *xp = *xp + MOD[(l * 9 + mod_row(r)) * 6144 + 5 * DM + d] * (bf2f(YS[(size_t)(2 * r) * DM + d]) + bf2f(YS[(size_t)(2 * r + 1) * DM + d]));
    }
}

#define GAS __attribute__((address_space(1)))
#define XB_TMO      128
#define XB_XCNT(j)  (256  + 64 * (j))
#define XB_XSUB(j)  (1280 + 64 * (j))
#define XB_XGEN(j)  (2304 + 64 * (j))
#define XB_TOP      3328
#define XB_TOPGEN   3392
#define XCD_BAR_WORDS 3456
#define XB_SPIN_CAP (1u << 24)
__device__ __forceinline__ unsigned xb_ld(unsigned* p)              { return __hip_atomic_load(p, __ATOMIC_RELAXED, __HIP_MEMORY_SCOPE_AGENT); }
__device__ __forceinline__ unsigned xb_add(unsigned* p, unsigned v) { return __hip_atomic_fetch_add(p, v, __ATOMIC_RELAXED, __HIP_MEMORY_SCOPE_AGENT); }
__device__ __forceinline__ unsigned xb_xcc_id() { return (unsigned)__builtin_amdgcn_s_getreg((3 << 11) | 20) & 0xFu; }
#define XB_SPIN(cond, bar) do { unsigned _sp = 0; while (cond) { __builtin_amdgcn_s_sleep(1); \
    if ((++_sp & 255u) == 0u) { if (xb_ld(&(bar)[XB_TMO])) break; if (_sp > XB_SPIN_CAP) { atomicAdd(&(bar)[XB_TMO], 1u); break; } } } } while (0)
struct XcdBarrier { unsigned* bar; unsigned x; volatile LAS unsigned* st; };
__device__ __forceinline__ XcdBarrier xcd_barrier_post(unsigned* bar, volatile LAS unsigned* st) {
    XcdBarrier b; b.bar = bar; b.x = xb_xcc_id(); b.st = st;
    if (threadIdx.x == 0) (void)xb_add(&bar[XB_XCNT(b.x)], 1u);
    return b;
}
__device__ __forceinline__ void xcd_barrier_complete(unsigned* bar, unsigned x, unsigned& nloc, unsigned& nx) {
    const unsigned G = gridDim.x * gridDim.y * gridDim.z;
    unsigned sum, cnt, mine, sp = 0u;
    for (;;) {
        sum = 0u; cnt = 0u; mine = 0u;
#pragma unroll
        for (unsigned j = 0; j < 16; ++j) { const unsigned c = xb_ld(&bar[XB_XCNT(j)]); sum += c; cnt += (c > 0u) ? 1u : 0u; mine = (j == x) ? c : mine; }
        if (sum == G) break;
        __builtin_amdgcn_s_sleep(1);
        if ((++sp & 255u) == 0u) { if (xb_ld(&bar[XB_TMO])) break; if (sp > XB_SPIN_CAP) { atomicAdd(&bar[XB_TMO], 1u); break; } }
    }
    nloc = mine > 0u ? mine : 1u; nx = cnt > 0u ? cnt : 1u;
}
__device__ __forceinline__ void xcd_barrier(const XcdBarrier& b) {
    asm volatile("s_waitcnt vmcnt(0)" ::: "memory");
    __syncthreads();
    if (threadIdx.x == 0) {
        unsigned* bar = b.bar;
        __builtin_amdgcn_s_waitcnt(0);
        unsigned nloc = b.st[0], nx = b.st[1];
        if (nloc == 0u) { xcd_barrier_complete(bar, b.x, nloc, nx); b.st[0] = nloc; b.st[1] = nx; }
        const unsigned old = xb_add(&bar[XB_XSUB(b.x)], 1u);
        const unsigned gen = old / nloc;
        if (old + 1u == (gen + 1u) * nloc) {
            __builtin_amdgcn_fence(__ATOMIC_RELEASE, "agent");
            asm volatile("s_waitcnt vmcnt(0)" ::: "memory");
            const unsigned og = xb_add(&bar[XB_TOP], 1u);
            const unsigned tg = og / nx;
            if (og + 1u == (tg + 1u) * nx) xb_add(&bar[XB_TOPGEN], 1u);
            else XB_SPIN(xb_ld(&bar[XB_TOPGEN]) == tg, bar);
            __builtin_amdgcn_fence(__ATOMIC_ACQUIRE, "agent");
            xb_add(&bar[XB_XGEN(b.x)], 1u);
            asm volatile("s_waitcnt vmcnt(0)" ::: "memory");
        } else {
            XB_SPIN(xb_ld(&bar[XB_XGEN(b.x)]) == gen, bar);
            __builtin_amdgcn_fence(__ATOMIC_ACQUIRE, "agent");
            asm volatile("s_waitcnt vmcnt(0)" ::: "memory");
        }
    }
    __syncthreads();
}

__device__ __forceinline__ void xcd_barrier_lean(const XcdBarrier& b) {
    asm volatile("s_waitcnt vmcnt(0)" ::: "memory");
    __syncthreads();
    if (threadIdx.x == 0) {
        unsigned* bar = b.bar;
        __builtin_amdgcn_s_waitcnt(0);
        unsigned nloc = b.st[0], nx = b.st[1];
        const unsigned old = xb_add(&bar[XB_XSUB(b.x)], 1u);
        const unsigned gen = old / nloc;
        if (old + 1u == (gen + 1u) * nloc) {
            __builtin_amdgcn_fence(__ATOMIC_RELEASE, "agent");
            asm volatile("s_waitcnt vmcnt(0)" ::: "memory");
            const unsigned og = xb_add(&bar[XB_TOP], 1u);
            const unsigned tg = og / nx;
            if (og + 1u == (tg + 1u) * nx) xb_add(&bar[XB_TOPGEN], 1u);
            else XB_SPIN(xb_ld(&bar[XB_TOPGEN]) == tg, bar);
            __builtin_amdgcn_fence(__ATOMIC_ACQUIRE, "agent");
            xb_add(&bar[XB_XGEN(b.x)], 1u);
            asm volatile("s_waitcnt vmcnt(0)" ::: "memory");
        } else {
            XB_SPIN(xb_ld(&bar[XB_XGEN(b.x)]) == gen, bar);
            __builtin_amdgcn_fence(__ATOMIC_ACQUIRE, "agent");
            asm volatile("s_waitcnt vmcnt(0)" ::: "memory");
        }
    }
    __syncthreads();
}

constexpr int LDS_BYTES = 147456;
constexpr int MISC_OFF = 147456 - 128;
constexpr int CW_BAR = 4096;

__device__ __forceinline__ int owg(int w) { asm volatile("" : "+s"(w)); return w; }
__device__ __forceinline__ Params load_params() {
    Params r{};
#if defined(__HIP_DEVICE_COMPILE__)
    typedef const __attribute__((address_space(4))) unsigned long long* kq_t;
    kq_t k = (kq_t)__builtin_amdgcn_kernarg_segment_ptr(); asm volatile("" : "+s"(k));
    r.x = (const float*)(const __attribute__((address_space(1))) float*)k[0];
    r.c = (const float*)(const __attribute__((address_space(1))) float*)k[1];
    r.ctx = (const float*)(const __attribute__((address_space(1))) float*)k[2];
    r.c_ctx = (const float*)(const __attribute__((address_space(1))) float*)k[3];
    r.mod_w = (const float*)(const __attribute__((address_space(1))) float*)k[4];
    r.mod_b = (const float*)(const __attribute__((address_space(1))) float*)k[5];
    r.norm1_g = (const float*)(const __attribute__((address_space(1))) float*)k[6];
    r.norm2_g = (const float*)(const __attribute__((address_space(1))) float*)k[7];
    r.w_in = (const float*)(const __attribute__((address_space(1))) float*)k[8];
    r.rw_w0 = (const float*)(const __attribute__((address_space(1))) float*)k[9];
    r.rw_w_lora_b = (const float*)(const __attribute__((address_space(1))) float*)k[10];
    r.rw_a0 = (const float*)(const __attribute__((address_space(1))) float*)k[11];
    r.rw_a_lora_b = (const float*)(const __attribute__((address_space(1))) float*)k[12];
    r.rw_g_lora_b = (const float*)(const __attribute__((address_space(1))) float*)k[13];
    r.rw_k_k = (const float*)(const __attribute__((address_space(1))) float*)k[14];
    r.rw_k_a = (const float*)(const __attribute__((address_space(1))) float*)k[15];
    r.rw_r_k = (const float*)(const __attribute__((address_space(1))) float*)k[16];
    r.rw_ln_g = (const float*)(const __attribute__((address_space(1))) float*)k[17];
    r.rw_ln_b = (const float*)(const __attribute__((address_space(1))) float*)k[18];
    r.na_q_g = (const float*)(const __attribute__((address_space(1))) float*)k[19];
    r.na_k_g = (const float*)(const __attribute__((address_space(1))) float*)k[20];
    r.na_rpb = (const float*)(const __attribute__((address_space(1))) float*)k[21];
    r.proj_a = (const float*)(const __attribute__((address_space(1))) float*)k[22];
    r.proj_b = (const float*)(const __attribute__((address_space(1))) float*)k[23];
    r.w_out = (const float*)(const __attribute__((address_space(1))) float*)k[24];
    r.router_w = (const float*)(const __attribute__((address_space(1))) float*)k[25];
    r.router_bias = (const float*)(const __attribute__((address_space(1))) float*)k[26];
    r.moe_w1 = (const float*)(const __attribute__((address_space(1))) float*)k[27];
    r.moe_w3 = (const float*)(const __attribute__((address_space(1))) float*)k[28];
    r.moe_w2 = (const float*)(const __attribute__((address_space(1))) float*)k[29];
    r.out = (float*)(__attribute__((address_space(1))) float*)k[30]; r.ws = (unsigned char*)(__attribute__((address_space(1))) unsigned char*)k[31];
#endif
    return r;
}
#define PRM(name) const Params name = load_params()
__global__ void __launch_bounds__(512, 2) mega(Params p_unused) {
    extern __shared__ __attribute__((aligned(16))) unsigned char lds[];
    float* sm = (float*)lds;
    volatile LAS unsigned* MISC = (volatile LAS unsigned*)((LAS unsigned char*)lds + MISC_OFF);
    if (threadIdx.x < 32) MISC[threadIdx.x] = 0u;
    __syncthreads();
    { PRM(p); (void)xcd_barrier_post((unsigned*)(p.ws + WS_CTL) + CW_BAR, MISC + 8); }
    const int wg0 = blockIdx.x, nwg = gridDim.x;
#define wg owg(wg0)
#define MKBAR(b_) PRM(pb_); XcdBarrier b_; b_.bar = (unsigned*)(pb_.ws + WS_CTL) + CW_BAR; b_.x = xb_xcc_id(); b_.st = MISC + 8
#define GRID_BAR_FIRST() do { MKBAR(b_); xcd_barrier(b_); } while (0)
#define GRID_BAR() do { MKBAR(b_); xcd_barrier_lean(b_); } while (0)
    { PRM(p); ph_mod2(p, sm, wg, nwg); }
    __syncthreads();
    { PRM(p); ph_convert_dense(p, lds, 0, wg, nwg); } GRID_BAR_FIRST();
    { PRM(p); ph_norm1v(p, wg, nwg); } GRID_BAR();
#define LAYER_BODY(l) do { \
        { PRM(p); ph_win_mfma(p, lds, l, wg, nwg); } GRID_BAR(); \
        { PRM(p); ph_scan_natt(p, lds, l, wg, nwg); } GRID_BAR(); \
        { PRM(p); ph_rwkvout2(p, lds, l, wg, nwg); } GRID_BAR(); \
        { PRM(p); ph_merge_mfma(p, lds, l, wg, nwg); } GRID_BAR(); \
        { PRM(p); ph_wout_mfma(p, lds, l, wg, nwg); } GRID_BAR(); \
        { PRM(p); ph_route2(p, sm, l, wg, nwg); } \
        if (l == 0) { __syncthreads(); PRM(p); ph_convert_dense(p, lds, 1, wg, nwg); } \
        GRID_BAR(); \
        { PRM(p); ph_lists2(p, sm, l, wg, nwg); } GRID_BAR(); \
        { PRM(p); ph_moe1_mfma(p, lds, l, wg, nwg); } \
        { PRM(p); ph_moe2_mfma(p, lds, l, wg, nwg); } GRID_BAR(); \
        { PRM(p); ph_combine_norm(p, l, wg, nwg); } if (l == 0) GRID_BAR(); \
    } while (0)
    LAYER_BODY(0);
    LAYER_BODY(1);
}
#undef wg
__global__ void k_zero(float* o, int n) { int i = blockIdx.x * blockDim.x + threadIdx.x; if (i < n) o[i] = 0.f; }

extern "C" void kernel_launch(void* const* d_in, const int* in_sizes, int n_in, void* d_out, int out_size, void* d_ws, size_t ws_size, hipStream_t stream) {
    static int grid = 0;
    if (grid == 0) {
        int dev = 0, cus = 0, per_cu = 0;
        if (hipGetDevice(&dev) != hipSuccess || hipDeviceGetAttribute(&cus, hipDeviceAttributeMultiprocessorCount, dev) != hipSuccess) { grid = -1; }
        else if (hipFuncSetAttribute((const void*)mega, hipFuncAttributeMaxDynamicSharedMemorySize, LDS_BYTES) != hipSuccess) { grid = -1; }
        else {
            if (hipOccupancyMaxActiveBlocksPerMultiprocessor(&per_cu, (const void*)mega, 512, LDS_BYTES) != hipSuccess || per_cu < 1) { fprintf(stderr, "occupancy query says %d\n", per_cu); }
            (void)hipGetLastError();
            grid = cus;
        }
    }
    if (grid <= 0 || n_in != 30 || ws_size < WS_END || out_size != NLAT * DM) {
        fprintf(stderr, "kernel_launch: unexpected grid %d n_in %d / ws_size %zu / out_size %d\n", grid, n_in, ws_size, out_size);
        hipLaunchKernelGGL(k_zero, dim3((out_size + 255) / 256), dim3(256), 0, stream, (float*)d_out, out_size);
        return;
    }
    Params p{};
    const float** pp = (const float**)&p;
    for (int i = 0; i < 30; ++i) pp[i] = (const float*)d_in[i];
    p.out = (float*)d_out; p.ws = (unsigned char*)d_ws;
    (void)hipMemsetAsync((char*)d_ws + WS_CTL, 0, 65536, stream);
    hipLaunchKernelGGL(mega, dim3(grid), dim3(512), LDS_BYTES, stream, p);
}
```

```cpp
#include <hip/hip_runtime.h>
#include <stdint.h>
#include <cstdio>

typedef unsigned short bf16_t;
__device__ __forceinline__ float bf2f(bf16_t v) { return __uint_as_float(((unsigned)v) << 16); }
__device__ __forceinline__ bf16_t f2bf(float f) { unsigned u = __float_as_uint(f); return (bf16_t)((u + 0x7fffu + ((u >> 16) & 1u)) >> 16); }

typedef unsigned v4u __attribute__((ext_vector_type(4)));
typedef unsigned v2u __attribute__((ext_vector_type(2)));
typedef float f32x4 __attribute__((ext_vector_type(4)));
__device__ __forceinline__ unsigned pk2(float lo, float hi) { return (unsigned)f2bf(lo) | ((unsigned)f2bf(hi) << 16); }
__device__ __forceinline__ void unpack8(const v4u w, float (&f)[8]) {
#pragma unroll
    for (int i = 0; i < 4; ++i) { f[2 * i] = __uint_as_float(w[i] << 16); f[2 * i + 1] = __uint_as_float(w[i] & 0xffff0000u); }
}
__device__ __forceinline__ void unpack4(const v2u w, float (&f)[4]) { f[0] = __uint_as_float(w.x << 16); f[1] = __uint_as_float(w.x & 0xffff0000u); f[2] = __uint_as_float(w.y << 16); f[3] = __uint_as_float(w.y & 0xffff0000u); }
constexpr int DM = 1024, NB = 8, SEQ = 2048, CTXL = 256, GW = 64;
constexpr int NLAT = NB * SEQ, NCTX = NB * CTXL, LR = NLAT + NCTX;
constexpr int ZC = 5504;
constexpr int C_R = 0, C_K = 512, C_V = 1024, C_LW = 1536, C_LA = 1664, C_LG = 1792, C_Q = 1920, C_KB = 2432, C_VB = 2944, C_GA = 3456, C_GB = 4480;
constexpr int NE = 16, DE = 512;
constexpr float RMS_EPS = 1e-6f, GN_EPS = 64e-5f;

constexpr size_t MiB = 1u << 20;
constexpr size_t WS_MOD = 0;
constexpr size_t WS_CTL = 1 * MiB;
constexpr size_t WS_LTOK = 2 * MiB;
constexpr size_t WS_LGATE = 4 * MiB;
constexpr size_t WS_TOKI = 6 * MiB;
constexpr size_t WS_TOKG = 6 * MiB + 512 * 1024;
constexpr size_t WS_CNTWG = 2 * MiB;
constexpr size_t WS_OFFS = 2 * MiB + 64 * 1024;
constexpr size_t WS_TEXP = 2 * MiB + 68 * 1024;
constexpr size_t WS_ROWDST = 3 * MiB;
constexpr size_t WS_ROWGATE = 3 * MiB + 512 * 1024;
constexpr size_t WS_CTXS = 8 * MiB;
constexpr size_t WS_W = 16 * MiB;
constexpr size_t WS_WIN_T = WS_W;
constexpr size_t WS_PA_T = WS_W + 11 * MiB;
constexpr size_t WS_PB_T = WS_W + 12 * MiB;
constexpr size_t WS_WO_T = WS_W + 13 * MiB;
constexpr size_t WS_GL_T = WS_W + 15 * MiB;
constexpr size_t WS_LW_T = WS_W + 15 * MiB + 256 * 1024;
constexpr size_t WS_LA_T = WS_W + 15 * MiB + 384 * 1024;
constexpr size_t WS_Z = 32 * MiB;
constexpr size_t WS_X1B = WS_Z;
constexpr size_t WS_H2 = WS_Z;
constexpr size_t WS_TMP1 = WS_Z + 36 * MiB;
constexpr size_t WS_HID = WS_Z + 116 * MiB;
constexpr size_t WS_H2S = WS_Z;
constexpr size_t WS_HID2 = WS_Z + 80 * MiB;
constexpr size_t WS_YS2 = WS_Z + 120 * MiB;
constexpr size_t WS_B = 226 * MiB;
constexpr size_t WS_W13T = WS_B;
constexpr size_t WS_W2T = WS_B + 32 * MiB;
constexpr size_t WS_H2T = WS_B + 84 * MiB;
constexpr size_t WS_VT = WS_B + 54 * MiB;
constexpr size_t WS_SG = WS_B + 72 * MiB;
constexpr size_t WS_Y2 = WS_B + 90 * MiB;
constexpr size_t WS_H = WS_B;
constexpr size_t WS_SW = WS_B;
constexpr size_t WS_SB = WS_B + 36 * MiB;
constexpr size_t WS_SKD = WS_B + 54 * MiB;
constexpr size_t WS_SKK = WS_B + 72 * MiB;
constexpr size_t WS_Y = WS_B + 90 * MiB;
constexpr size_t WS_YB = WS_B + 126 * MiB;
constexpr size_t WS_OUTA = WS_B + 54 * MiB;
constexpr size_t WS_MERGED = WS_B + 90 * MiB;
constexpr size_t WS_YS = WS_B + 54 * MiB;
constexpr size_t WS_END = WS_B + 144 * MiB;

struct Params {
    const float *x, *c, *ctx, *c_ctx, *mod_w, *mod_b, *norm1_g, *norm2_g, *w_in,
        *rw_w0, *rw_w_lora_b, *rw_a0, *rw_a_lora_b, *rw_g_lora_b, *rw_k_k, *rw_k_a, *rw_r_k, *rw_ln_g, *rw_ln_b,
        *na_q_g, *na_k_g, *na_rpb, *proj_a, *proj_b, *w_out, *router_w, *router_bias, *moe_w1, *moe_w3, *moe_w2;
    float* out; unsigned char* ws;
};

__device__ __forceinline__ int otid() { int t = threadIdx.x; asm volatile("" : "+v"(t)); return t; }
template <int M> __device__ __forceinline__ float swz_xor(float v) { return __int_as_float(__builtin_amdgcn_ds_swizzle(__float_as_int(v), (M << 10) | 0x1f)); }
__device__ __forceinline__ float xor32_add(float v) { auto rr = __builtin_amdgcn_permlane32_swap(__float_as_uint(v), __float_as_uint(v), false, false); return __uint_as_float(rr[0]) + __uint_as_float(rr[1]); }
__device__ __forceinline__ float xor32_max(float v) { auto rr = __builtin_amdgcn_permlane32_swap(__float_as_uint(v), __float_as_uint(v), false, false); return fmaxf(__uint_as_float(rr[0]), __uint_as_float(rr[1])); }
__device__ __forceinline__ float wave_sum(float v) {
    v += swz_xor<1>(v); v += swz_xor<2>(v); v += swz_xor<4>(v); v += swz_xor<8>(v); v += swz_xor<16>(v);
    return xor32_add(v);
}
__device__ __forceinline__ float wave_max(float v) {
    v = fmaxf(v, swz_xor<1>(v)); v = fmaxf(v, swz_xor<2>(v)); v = fmaxf(v, swz_xor<4>(v)); v = fmaxf(v, swz_xor<8>(v)); v = fmaxf(v, swz_xor<16>(v));
    return xor32_max(v);
}
__device__ __forceinline__ float rdlane(float v, int l) { return __int_as_float(__builtin_amdgcn_readlane(__float_as_int(v), l)); }
__device__ __forceinline__ float sigmoidf_(float x) { return __builtin_amdgcn_rcpf(1.f + __expf(-x)); }
__device__ __forceinline__ int mod_row(int r) { return r < NLAT ? (r >> 11) : 8; }
__device__ __forceinline__ const float* in_row(const Params& p, int r) { return r < NLAT ? p.x + (size_t)r * DM : p.ctx + (size_t)(r - NLAT) * DM; }
__device__ __forceinline__ float* st_row(const Params& p, int r) { return r < NLAT ? p.out + (size_t)r * DM : (float*)(p.ws + WS_CTXS) + (size_t)(r - NLAT) * DM; }

__device__ __forceinline__ void ph_mod(const Params& p, float* sm, int wg, int nwg) {
    for (int i = otid(); i < 9 * DM; i += blockDim.x) {
        int j = i >> 10, k = i & 1023; float v = j < 8 ? p.c[j * DM + k] : p.c_ctx[k];
        sm[i] = v * sigmoidf_(v);
    }
    __syncthreads();
    float* MOD = (float*)(p.ws + WS_MOD);
    for (int o = wg * blockDim.x + otid(); o < 2 * 6144; o += nwg * blockDim.x) {
        int l = o / 6144, n = o % 6144;
        float acc[9];
#pragma unroll
        for (int j = 0; j < 9; ++j) acc[j] = 0.f;
        const float* w = p.mod_w + (size_t)l * DM * 6144 + n;
        for (int k = 0; k < DM; ++k) { float wv = w[(size_t)k * 6144];
#pragma unroll
            for (int j = 0; j < 9; ++j) acc[j] += sm[j * DM + k] * wv; }
        float bb = p.mod_b[l * 6144 + n];
#pragma unroll
        for (int j = 0; j < 9; ++j) MOD[(l * 9 + j) * 6144 + n] = acc[j] + bb;
    }
}

__device__ __forceinline__ void ph_mod2(const Params& p, float* sm, int wg, int nwg) {
    const int tid = otid(), lane = tid & 63, wv = tid >> 6;
    float* sc = sm;
    float* red = sm + 9 * 1024;
    for (int i = tid; i < 9 * DM; i += 512) { const int j = i >> 10, k = i & 1023; const float v = j < 8 ? p.c[j * DM + k] : p.c_ctx[k]; sc[i] = v * sigmoidf_(v); }
    __syncthreads();
    float* MOD = (float*)(p.ws + WS_MOD);
    for (int unit = wg; unit < 192; unit += nwg) {
        const int l = unit / 96, n0 = (unit % 96) * 64;
        const float* w = p.mod_w + ((size_t)l * DM + wv * 128) * 6144 + n0 + lane;
        float acc[9];
#pragma unroll
        for (int j = 0; j < 9; ++j) acc[j] = 0.f;
        for (int k0 = 0; k0 < 128; k0 += 16) {
            float wv_[16];
#pragma unroll
            for (int i = 0; i < 16; ++i) wv_[i] = w[(size_t)(k0 + i) * 6144];
#pragma unroll
            for (int i4 = 0; i4 < 4; ++i4)
#pragma unroll
                for (int j = 0; j < 9; ++j) { const float4 s4 = *(const float4*)(sc + j * DM + wv * 128 + k0 + i4 * 4);
                    acc[j] += s4.x * wv_[i4 * 4] + s4.y * wv_[i4 * 4 + 1] + s4.z * wv_[i4 * 4 + 2] + s4.w * wv_[i4 * 4 + 3]; }
        }
        __syncthreads();
#pragma unroll
        for (int j = 0; j < 9; ++j) red[(wv * 9 + j) * 64 + lane] = acc[j];
        __syncthreads();
        for (int o = tid; o < 9 * 64; o += 512) { const int j = o >> 6, cc = o & 63; float sum = p.mod_b[l * 6144 + n0 + cc];
#pragma unroll
            for (int w8 = 0; w8 < 8; ++w8) sum += red[(w8 * 9 + j) * 64 + cc];
            MOD[(l * 9 + j) * 6144 + n0 + cc] = sum; }
    }
}
__device__ __forceinline__ void norm_row_to_h(const f32x4 (&v)[4], const float* g1, const float* m, bf16_t* hrow, int lane) {
    float ss = 0.f;
#pragma unroll
    for (int j = 0; j < 4; ++j) ss += (v[j][0] * v[j][0] + v[j][1] * v[j][1]) + (v[j][2] * v[j][2] + v[j][3] * v[j][3]);
    ss = wave_sum(ss);
    const float rs = rsqrtf(ss * (1.f / DM) + RMS_EPS);
#pragma unroll
    for (int j = 0; j < 4; ++j) { const int d = 4 * lane + 256 * j;
        const f32x4 g = *(const f32x4*)(g1 + d), sh = *(const f32x4*)(m + d), scl = *(const f32x4*)(m + DM + d);
        const f32x4 y = v[j] * rs * g * (scl + 1.f) + sh;
        v2u w; w.x = pk2(y[0], y[1]); w.y = pk2(y[2], y[3]);
        *(v2u*)(hrow + d) = w; }
}
__device__ __forceinline__ void ph_norm1v(const Params& p, int wg, int nwg) {
    const int lane = otid() & 63, wv = otid() >> 6;
    const float* MOD = (const float*)(p.ws + WS_MOD);
    bf16_t* H = (bf16_t*)(p.ws + WS_H);
    for (int r = wg * 8 + wv; r < LR; r += nwg * 8) {
        const float* xr = in_row(p, r);
        f32x4 v[4];
#pragma unroll
        for (int j = 0; j < 4; ++j) v[j] = *(const f32x4*)(xr + 4 * lane + 256 * j);
        norm_row_to_h(v, p.norm1_g, MOD + (0 * 9 + mod_row(r)) * 6144, H + (size_t)r * DM, lane);
    }
}
__device__ __forceinline__ void ph_combine_norm(const Params& p, int l, int wg, int nwg) {
    const int lane = otid() & 63, wv = otid() >> 6;
    const float* MOD = (const float*)(p.ws + WS_MOD);
    const bf16_t* YS = (const bf16_t*)(p.ws + WS_YS2);
    bf16_t* H = (bf16_t*)(p.ws + WS_H);
    const int nrows = (l == 1) ? NLAT : LR;
    for (int r = wg * 8 + wv; r < nrows; r += nwg * 8) {
        float* xr = st_row(p, r);
        bf16_t* xb = (r < NLAT) ? (bf16_t*)p.out + (size_t)r * DM : (bf16_t*)(p.ws + WS_CTXS) + (size_t)(r - NLAT) * DM;
        const float* m = MOD + (l * 9 + mod_row(r)) * 6144;
        f32x4 v[4];
#pragma unroll
        for (int j = 0; j < 4; ++j) { const int d = 4 * lane + 256 * j;
            float a[4], b[4]; unpack4(*(const v2u*)(YS + (size_t)(2 * r) * DM + d), a); unpack4(*(const v2u*)(YS + (size_t)(2 * r + 1) * DM + d), b);
            const f32x4 gt = *(const f32x4*)(m + 5 * DM + d);
            float x4[4]; unpack4(*(const v2u*)((const bf16_t*)(p.ws + WS_X1B) + (size_t)r * DM + d), x4);
            f32x4 x = {x4[0], x4[1], x4[2], x4[3]};
            x[0] += gt[0] * (a[0] + b[0]); x[1] += gt[1] * (a[1] + b[1]); x[2] += gt[2] * (a[2] + b[2]); x[3] += gt[3] * (a[3] + b[3]);
            if (l == 0) { v2u w; w.x = pk2(x[0], x[1]); w.y = pk2(x[2], x[3]); *(v2u*)(xb + d) = w; } else *(f32x4*)(xr + d) = x;
            v[j] = x; }
        if (l == 0) norm_row_to_h(v, p.norm1_g + DM, MOD + (1 * 9 + mod_row(r)) * 6144, H + (size_t)r * DM, lane);
    }
}

__device__ __forceinline__ void ph_norm1(const Params& p, int l, int wg, int nwg) {
    const int lane = otid() & 63, wv = otid() >> 6, nwv = blockDim.x >> 6;
    const float* MOD = (const float*)(p.ws + WS_MOD);
    bf16_t* H = (bf16_t*)(p.ws + WS_H);
    for (int r = wg * nwv + wv; r < LR; r += nwg * nwv) {
        const float* xr = l == 0 ? in_row(p, r) : st_row(p, r);
        float v[16]; float ss = 0.f;
#pragma unroll
        for (int i = 0; i < 16; ++i) { v[i] = xr[lane + 64 * i]; ss += v[i] * v[i]; }
        ss = wave_sum(ss);
        const float rs = rsqrtf(ss * (1.f / DM) + RMS_EPS);
        const float* m = MOD + (l * 9 + mod_row(r)) * 6144;
#pragma unroll
        for (int i = 0; i < 16; ++i) { int d = lane + 64 * i;
            float y = v[i] * rs * p.norm1_g[l * DM + d];
            H[(size_t)r * DM + d] = f2bf(y * (1.f + m[DM + d]) + m[d]); }
    }
}

namespace pg8 {
#define PG8_LAS __attribute__((address_space(3)))
typedef unsigned short bf16_t;
typedef short bf16x8 __attribute__((ext_vector_type(8)));
typedef float f32x4 __attribute__((ext_vector_type(4)));
typedef unsigned u32x4 __attribute__((ext_vector_type(4)));
constexpr int BM = 256, BK = 64, HALF = 128, HTB = HALF * BK * 2  , STAGE_BYTES = 8 * HTB, NXCD = 8, WGM = 8;

__host__ __device__ __forceinline__ int lds_byte(int r, int c) { const int st = (r >> 4) * 2 + (c >> 5), rr = r & 15, cc = c & 31, ob = rr * 64 + cc * 2; return st * 1024 + (ob ^ (((ob >> 9) & 1) << 5)); }
__host__ __device__ __forceinline__ void stage_rc(int b, int& R, int& C) { const int st = b / 1024, sb = b % 1024, swz = sb ^ (((sb >> 9) & 1) << 5); R = (st >> 1) * 16 + swz / 64; C = (st & 1) * 32 + (swz % 64) / 2; }
__host__ __device__ __forceinline__ int perm32(int rho) { const int n = rho >> 4, i = rho & 15; return 8 * (i >> 2) + 4 * n + (i & 3); }

struct Unit { int pm, pn; unsigned boff; };
struct Gemm { const bf16_t* A; const bf16_t* Bt; int M, N, K; };

struct StaticOrder {
    int nM, nN, nwg, G, c;
    __host__ __device__ void init(int M, int N, int G_, int c_) { nM = M / BM; nN = N / BM; nwg = nM * nN; G = G_; c = c_; }
    __host__ __device__ void unit_of(int L, Unit& u) const {
        int wgid = L; { const int q = nwg / NXCD, r = nwg % NXCD, xcd = wgid % NXCD, off = wgid / NXCD; wgid = (xcd < r ? xcd * (q + 1) : r * (q + 1) + (xcd - r) * q) + off; }
        const int nig = WGM * nN, gid = wgid / nig, fm = gid * WGM, gsz = (nM - fm) < WGM ? (nM - fm) : WGM;
        u.pm = fm + ((wgid % nig) % gsz); u.pn = (wgid % nig) / gsz; u.boff = 0u;
    }
    __host__ __device__ bool next(int i, Unit& u) const {
        const long L = (long)i * G + c; if (L >= nwg) return false;
        unit_of((int)L, u); return true;
    }
    __device__ __forceinline__ void a_ready(const Unit&) const {}
    __device__ __forceinline__ void done(const Unit&) const {}
    static constexpr bool GATHER = false;
    const int* rowsrc = nullptr;
    static constexpr bool DUALK = false;
    long dA = 0, dB = 0;
};

typedef float cvt_f32x2_t __attribute__((ext_vector_type(2))); typedef __bf16 cvt_bf16x2_t __attribute__((ext_vector_type(2)));
__device__ __forceinline__ unsigned cvt_pk_bf16(float lo, float hi) { const cvt_f32x2_t v = {lo, hi}; const cvt_bf16x2_t b = __builtin_convertvector(v, cvt_bf16x2_t); return __builtin_bit_cast(unsigned, b); }
template <class Epi, class Sched, bool ALIGN_EPI = false, bool SP2 = false>
__device__ __forceinline__ void gemm_phase(PG8_LAS unsigned char* lds, const Gemm g, const Sched& S, const Epi& E) {
    const int tid = otid(), wid = __builtin_amdgcn_readfirstlane(tid >> 6), lane = tid & 63, wr = wid >> 2, wc = wid & 3, fr = lane & 15, fq = lane >> 4;
    constexpr bool DUALK = Sched::DUALK;
    const int K = g.K, nt = DUALK ? 2 * (K / BK) : K / BK;
    constexpr bool GATH = Sched::GATHER;
    static_assert(!GATH || SP2, "gather needs the SP2 loop");
    unsigned voffA[2], voffB[2];
#pragma unroll
    for (int i = 0; i < 2; ++i) { int R, C; stage_rc(tid * 16 + i * 8192, R, C); const int Rb = Epi::PERM ? ((R & ~31) + perm32(R & 31)) : R;
        voffA[i] = (unsigned)(R * K + C) * 2u; voffB[i] = (unsigned)(Rb * K + C) * 2u; }
    const size_t kstep = (size_t)(BK * 2);
    const size_t hstep = (size_t)HALF * K * 2;
    const size_t tstep = 2 * hstep;
    const unsigned ldsw = (unsigned)wid * 1024u;
    const int aoff = lds_byte(wr * 64 + fr, fq * 8), boff = lds_byte(wc * 32 + fr, fq * 8);
#define PG8_SA(b, h) (((b) * 2 + (h)) * HTB)
#define PG8_SB(b, h) ((4 + (b) * 2 + (h)) * HTB)
#define PG8_STAGE(bufoff, gbase, voff) do { _Pragma("unroll") for (int _i = 0; _i < 2; ++_i) \
        __builtin_amdgcn_global_load_lds((const unsigned*)((const char*)(gbase) + (voff)[_i]), (PG8_LAS unsigned*)(lds + (bufoff) + ldsw + _i * 8192), 16, 0, 0); } while (0)
#define PG8_STAGEG(bufoff, off2, kb) do { _Pragma("unroll") for (int _i = 0; _i < 2; ++_i) \
        __builtin_amdgcn_global_load_lds((const unsigned*)((const char*)g.A + (kb) + (off2)[_i]), (PG8_LAS unsigned*)(lds + (bufoff) + ldsw + _i * 8192), 16, 0, 0); } while (0)
#define PG8_STA(bufoff, pexpr, hh, usenext, kb) do { if constexpr (GATH) { if (usenext) PG8_STAGEG(bufoff, gn[hh], kb); else PG8_STAGEG(bufoff, go[hh], kb); } else { PG8_STAGE(bufoff, pexpr, voffA); } } while (0)
#define PG8_GOFF(dst, pm_) do { if constexpr (GATH) { _Pragma("unroll") for (int h_ = 0; h_ < 2; ++h_) _Pragma("unroll") for (int i_ = 0; i_ < 2; ++i_) { int R_, C_; stage_rc(tid * 16 + i_ * 8192, R_, C_); \
        const int v_ = S.rowsrc[(pm_) * 256 + h_ * 128 + R_]; dst[h_][i_] = (unsigned)((v_ < 0 ? 0 : v_) >> 1) * (unsigned)(K * 2) + (unsigned)(C_ * 2); } } } while (0)
#define PG8_LDA(dst, b, h) do { _Pragma("unroll") for (int m = 0; m < 4; ++m) _Pragma("unroll") for (int k = 0; k < 2; ++k) dst[m][k] = *(const PG8_LAS bf16x8*)(lds + PG8_SA(b, h) + aoff + m * 2048 + k * 1024); } while (0)
#define PG8_LDB(dst, b, h) do { _Pragma("unroll") for (int n = 0; n < 2; ++n) _Pragma("unroll") for (int k = 0; k < 2; ++k) dst[n][k] = *(const PG8_LAS bf16x8*)(lds + PG8_SB(b, h) + boff + n * 2048 + k * 1024); } while (0)
#define PG8_MMA(ai, bj, At, Bt) do { __builtin_amdgcn_s_setprio(1); _Pragma("unroll") for (int m = 0; m < 4; ++m) _Pragma("unroll") for (int n = 0; n < 2; ++n) _Pragma("unroll") for (int k = 0; k < 2; ++k) \
        acc[ai][bj][m][n] = __builtin_amdgcn_mfma_f32_16x16x32_bf16(Bt[n][k], At[m][k], acc[ai][bj][m][n], 0, 0, 0); __builtin_amdgcn_s_setprio(0); } while (0)
#define PG8_WAIT_V(n) asm volatile("s_waitcnt vmcnt(" #n ")" ::: "memory")
#define PG8_WAIT_L(n) asm volatile("s_waitcnt lgkmcnt(" #n ")" ::: "memory")
#define PG8_BAR __builtin_amdgcn_s_barrier()
#define PG8_SCHED __builtin_amdgcn_sched_barrier(0)
    Unit cur, nxt; int ui = 0;
    if (!S.next(0, cur)) return;
    f32x4 acc[2][2][4][2];
#pragma unroll
    for (int a = 0; a < 2; ++a)
#pragma unroll
        for (int b = 0; b < 2; ++b)
#pragma unroll
            for (int m = 0; m < 4; ++m)
#pragma unroll
                for (int n = 0; n < 2; ++n) acc[a][b][m][n] = (f32x4){0.f, 0.f, 0.f, 0.f};
    bf16x8 At[4][2], B0[2][2], B1[2][2];
    const char* cA = (const char*)g.A + (size_t)cur.pm * tstep; const char* cB = (const char*)g.Bt + cur.boff + (size_t)cur.pn * tstep;
    unsigned go[2][2] = {{0u, 0u}, {0u, 0u}}, gn[2][2] = {{0u, 0u}, {0u, 0u}};
    PG8_GOFF(go, cur.pm);
    S.a_ready(cur);
    if constexpr (SP2) {
        PG8_STAGE(PG8_SB(0, 0), cB, voffB); PG8_STAGE(PG8_SB(0, 1), cB + hstep, voffB); PG8_STA(PG8_SA(0, 0), cA, 0, false, (size_t)0); PG8_STA(PG8_SA(0, 1), cA + hstep, 1, false, (size_t)0);
        if (wr == 1) PG8_BAR;
        PG8_WAIT_V(2); PG8_BAR;
        PG8_STAGE(PG8_SB(1, 0), cB + kstep, voffB); PG8_STA(PG8_SA(1, 0), cA + kstep, 0, false, kstep); PG8_STAGE(PG8_SB(1, 1), cB + hstep + kstep, voffB);
        PG8_WAIT_V(6); PG8_BAR;
    } else {
        PG8_STAGE(PG8_SB(0, 0), cB, voffB); PG8_STAGE(PG8_SA(0, 0), cA, voffA); PG8_STAGE(PG8_SB(0, 1), cB + hstep, voffB); PG8_STAGE(PG8_SA(0, 1), cA + hstep, voffA);
        if (wr == 1) PG8_BAR;
        PG8_WAIT_V(4); PG8_BAR;
        PG8_STAGE(PG8_SB(1, 0), cB + kstep, voffB); PG8_STAGE(PG8_SA(1, 0), cA + kstep, voffA); PG8_STAGE(PG8_SB(1, 1), cB + hstep + kstep, voffB);
        PG8_WAIT_V(6); PG8_BAR;
    }
    for (;;) {
        const bool has_next = S.next(ui + 1, nxt);
        if constexpr (GATH) { if (has_next) PG8_GOFF(gn, nxt.pm); else { _Pragma("unroll") for (int h_ = 0; h_ < 2; ++h_) _Pragma("unroll") for (int i_ = 0; i_ < 2; ++i_) gn[h_][i_] = go[h_][i_]; } }
        const char* nA = has_next ? (const char*)g.A + (size_t)nxt.pm * tstep : cA; const char* nB = has_next ? (const char*)g.Bt + nxt.boff + (size_t)nxt.pn * tstep : cB;
        for (int t = 0; t < nt; t += 2) {
            const bool last = (t == nt - 2);
            const long ja1 = (DUALK && t + 1 >= nt / 2) ? S.dA : 0, ja2 = (DUALK && t + 2 >= nt / 2) ? S.dA : 0, ja3 = (DUALK && t + 3 >= nt / 2) ? S.dA : 0, jb2 = (DUALK && t + 2 >= nt / 2) ? S.dB : 0, jb3 = (DUALK && t + 3 >= nt / 2) ? S.dB : 0;
            const char* a1 = cA + (size_t)(t + 1) * kstep + ja1;
            const char* a2 = last ? nA : cA + (size_t)(t + 2) * kstep + ja2; const char* b2 = last ? nB : cB + (size_t)(t + 2) * kstep + jb2;
            const char* a3 = last ? nA + kstep : cA + (size_t)(t + 3) * kstep + ja3; const char* b3 = last ? nB + kstep : cB + (size_t)(t + 3) * kstep + jb3;
            if constexpr (DUALK) { if (t == nt / 2) E.mid(acc, cur, wr, wc, fr, fq); }
            if (last && has_next) S.a_ready(nxt);
            const size_t kb2 = last ? (size_t)0 : (size_t)(t + 2) * kstep;
            if constexpr (SP2) {
            PG8_LDB(B0, 0, 0); PG8_LDB(B1, 0, 1); PG8_SCHED; PG8_LDA(At, 0, 0); PG8_STA(PG8_SA(1, 1), a1 + hstep, 1, false, (size_t)(t + 1) * kstep);
            PG8_WAIT_V(8); PG8_WAIT_L(0); PG8_BAR; PG8_MMA(0, 0, At, B0); PG8_MMA(0, 1, At, B1); PG8_BAR; PG8_SCHED;
            PG8_LDA(At, 0, 1); PG8_STAGE(PG8_SB(0, 0), b2, voffB); PG8_STAGE(PG8_SB(0, 1), b2 + hstep, voffB); PG8_STA(PG8_SA(0, 0), a2, 0, last, kb2);
            PG8_WAIT_V(8); PG8_WAIT_L(0); PG8_BAR; PG8_MMA(1, 0, At, B0); PG8_MMA(1, 1, At, B1); PG8_BAR; PG8_SCHED;
            PG8_LDB(B0, 1, 0); PG8_LDB(B1, 1, 1); PG8_SCHED; PG8_LDA(At, 1, 0); PG8_STA(PG8_SA(0, 1), a2 + hstep, 1, last, kb2);
            PG8_WAIT_V(8); PG8_WAIT_L(0); PG8_BAR; PG8_MMA(0, 0, At, B0); PG8_MMA(0, 1, At, B1); PG8_BAR; PG8_SCHED;
            PG8_LDA(At, 1, 1); PG8_STAGE(PG8_SB(1, 0), b3, voffB); PG8_STAGE(PG8_SB(1, 1), b3 + hstep, voffB); PG8_STA(PG8_SA(1, 0), a3, 0, last, kb2 + kstep);
            PG8_WAIT_V(8); PG8_WAIT_L(0); PG8_BAR; PG8_MMA(1, 0, At, B0); PG8_MMA(1, 1, At, B1); PG8_BAR; PG8_SCHED;
            } else {
            PG8_LDB(B0, 0, 0); PG8_SCHED; PG8_LDA(At, 0, 0); PG8_STAGE(PG8_SA(1, 1), a1 + hstep, voffA);
            PG8_WAIT_L(8); PG8_BAR; PG8_WAIT_L(0); PG8_MMA(0, 0, At, B0); PG8_BAR; PG8_SCHED;
            PG8_LDB(B1, 0, 1); PG8_STAGE(PG8_SB(0, 0), b2, voffB);
            PG8_BAR; PG8_WAIT_L(0); PG8_MMA(0, 1, At, B1); PG8_BAR;
            PG8_LDA(At, 0, 1); PG8_STAGE(PG8_SA(0, 0), a2, voffA);
            PG8_BAR; PG8_WAIT_L(0); PG8_MMA(1, 0, At, B0); PG8_BAR; PG8_SCHED;
            PG8_STAGE(PG8_SB(0, 1), b2 + hstep, voffB);
            PG8_WAIT_V(6); PG8_BAR; PG8_MMA(1, 1, At, B1); PG8_BAR;
            PG8_LDB(B0, 1, 0); PG8_SCHED; PG8_LDA(At, 1, 0); PG8_STAGE(PG8_SA(0, 1), a2 + hstep, voffA);
            PG8_WAIT_L(8); PG8_BAR; PG8_WAIT_L(0); PG8_MMA(0, 0, At, B0); PG8_BAR; PG8_SCHED;
            PG8_LDB(B1, 1, 1); PG8_STAGE(PG8_SB(1, 0), b3, voffB);
            PG8_BAR; PG8_WAIT_L(0); PG8_MMA(0, 1, At, B1); PG8_BAR;
            PG8_LDA(At, 1, 1); PG8_STAGE(PG8_SA(1, 0), a3, voffA);
            PG8_BAR; PG8_WAIT_L(0); PG8_MMA(1, 0, At, B0); PG8_BAR; PG8_SCHED;
            PG8_STAGE(PG8_SB(1, 1), b3 + hstep, voffB);
            PG8_WAIT_V(6); PG8_BAR; PG8_MMA(1, 1, At, B1); PG8_BAR;
            }
        }
        if constexpr (ALIGN_EPI) { if (wr == 0) PG8_BAR; }
        if constexpr (!Epi::AFTER_DRAIN) { E(acc, cur, wr, wc, fr, fq); S.done(cur); }
        if (!has_next) break;
#pragma unroll
        for (int a = 0; a < 2; ++a)
#pragma unroll
            for (int b = 0; b < 2; ++b)
#pragma unroll
                for (int m = 0; m < 4; ++m)
#pragma unroll
                    for (int n = 0; n < 2; ++n) acc[a][b][m][n] = (f32x4){0.f, 0.f, 0.f, 0.f};
        cur = nxt; cA = nA; cB = nB; ++ui;
        if constexpr (GATH) { _Pragma("unroll") for (int h_ = 0; h_ < 2; ++h_) _Pragma("unroll") for (int i_ = 0; i_ < 2; ++i_) go[h_][i_] = gn[h_][i_]; }
        if constexpr (ALIGN_EPI) { if (wr == 1) PG8_BAR; }
    }
    PG8_WAIT_V(0);
    if constexpr (!ALIGN_EPI) { if (wr == 0) PG8_BAR; }
    PG8_BAR;
    if constexpr (Epi::AFTER_DRAIN) { E.fused(acc, cur, wr, wc, fr, fq, lds, wid, lane); S.done(cur); }
#undef PG8_SA
#undef PG8_SB
#undef PG8_STAGE
#undef PG8_STAGEG
#undef PG8_STA
#undef PG8_GOFF
#undef PG8_LDA
#undef PG8_LDB
#undef PG8_MMA
#undef PG8_WAIT_V
#undef PG8_WAIT_L
#undef PG8_BAR
#undef PG8_SCHED
}
}

#define LAS __attribute__((address_space(3)))
__device__ __forceinline__ void tr_item(const float* W, int ldw, int k0, int n0, bf16_t* WT, int ldt, int dst_row0, LAS float* scr, int lane) {
    const int rr = lane >> 3, c4 = (lane & 7) * 4;
    f32x4 v[8];
#pragma unroll
    for (int i = 0; i < 8; ++i) v[i] = *(const f32x4*)(W + (size_t)(k0 + 8 * i + rr) * ldw + n0 + c4);
#pragma unroll
    for (int i = 0; i < 8; ++i) { LAS float* d = scr + (8 * i + rr) * 33 + c4; d[0] = v[i][0]; d[1] = v[i][1]; d[2] = v[i][2]; d[3] = v[i][3]; }
    asm volatile("s_waitcnt lgkmcnt(0)" ::: "memory");
    const int c = lane & 7;
#pragma unroll
    for (int j = 0; j < 4; ++j) { const int n = (lane >> 3) + 8 * j; const LAS float* sp = scr + (8 * c) * 33 + n;
        v4u o; o.x = pk2(sp[0 * 33], sp[1 * 33]); o.y = pk2(sp[2 * 33], sp[3 * 33]); o.z = pk2(sp[4 * 33], sp[5 * 33]); o.w = pk2(sp[6 * 33], sp[7 * 33]);
        *(v4u*)(WT + (size_t)(dst_row0 + n) * ldt + k0 + 8 * c) = o; }
    asm volatile("s_waitcnt lgkmcnt(0)" ::: "memory");
}
__device__ __forceinline__ void ph_convert_dense(const Params& p, unsigned char* ldsb, int l, int wg, int nwg) {
    const int lane = otid() & 63, wv = __builtin_amdgcn_readfirstlane(otid() >> 6);
    LAS float* scr = (LAS float*)((LAS unsigned char*)ldsb + wv * 16384);
    const int gw = wg * 8 + wv, NGW = nwg * 8;
    constexpr int I_WIN = 16 * 172, I_PA = 8 * 32, I_WO = 16 * 32, I_LO = 64, I_GL = 32, NIT = I_WIN + 2 * I_PA + I_WO + I_LO + I_GL;
    for (int it = gw; it < NIT; it += NGW) {
        int r = it;
        if (r < I_WIN) { const int kb = r / 172, nb = r % 172; tr_item(p.w_in + (size_t)l * DM * ZC, ZC, kb * 64, nb * 32, (bf16_t*)(p.ws + WS_WIN_T), DM, nb * 32, scr, lane); continue; } r -= I_WIN;
        if (r < I_PA) { const int kb = r / 32, nb = r % 32; tr_item(p.proj_a + (size_t)l * 512 * DM, DM, kb * 64, nb * 32, (bf16_t*)(p.ws + WS_PA_T), 512, nb * 32, scr, lane); continue; } r -= I_PA;
        if (r < I_PA) { const int kb = r / 32, nb = r % 32; tr_item(p.proj_b + (size_t)l * 512 * DM, DM, kb * 64, nb * 32, (bf16_t*)(p.ws + WS_PB_T), 512, nb * 32, scr, lane); continue; } r -= I_PA;
        if (r < I_WO) { const int kb = r / 32, nb = r % 32; tr_item(p.w_out + (size_t)l * DM * DM, DM, kb * 64, nb * 32, (bf16_t*)(p.ws + WS_WO_T), DM, nb * 32, scr, lane); continue; } r -= I_WO;
        if (r >= I_LO) { r -= I_LO; const int kb = r >> 4, nb = r & 15;
            tr_item(p.rw_g_lora_b + (size_t)l * 128 * 512, 512, kb * 64, nb * 32, (bf16_t*)(p.ws + WS_GL_T), 256, nb * 32, scr, lane); continue; }
        { const int which = r >> 5, dir = (r >> 4) & 1, nb = r & 15;
          const float* W = (which ? p.rw_a_lora_b : p.rw_w_lora_b) + (size_t)((l * 2 + dir) * 64) * 512;
          tr_item(W, 512, 0, nb * 32, (bf16_t*)(p.ws + (which ? WS_LA_T : WS_LW_T)) + (size_t)dir * 512 * 64, 64, nb * 32, scr, lane); }
    }
    for (int i = wg * 512 + otid(); i < 512 * 16; i += nwg * 512) ((v4u*)(p.ws + WS_GL_T))[(i >> 4) * 32 + 16 + (i & 15)] = (v4u){0u, 0u, 0u, 0u};
    for (int i = wg * 512 + otid(); i < 16384; i += nwg * 512) ((v4u*)(p.ws + WS_WIN_T + (size_t)ZC * DM * 2))[i] = (v4u){0u, 0u, 0u, 0u};
}

struct EpiZ {
    static constexpr bool PERM = true, AFTER_DRAIN = false;
    bf16_t* Z; bf16_t* SG; bf16_t* VT;
    __device__ __forceinline__ void operator()(const f32x4 (&acc)[2][2][4][2], const pg8::Unit& u, int wr, int wc, int fr, int fq) const {
        const int row0 = u.pm * 256 + wr * 64 + fr;
        const bool lat = u.pm < 64;
        const int bb = lat ? (u.pm >> 3) : (u.pm - 64);
#pragma unroll
        for (int ai = 0; ai < 2; ++ai)
#pragma unroll
            for (int m = 0; m < 4; ++m) { const int row = row0 + ai * 128 + m * 16;
#pragma unroll
                for (int bj = 0; bj < 2; ++bj) { const int cb = u.pn * 256 + bj * 128; if (cb >= ZC) continue;
                    const int col = cb + wc * 32 + 8 * fq;
                    const f32x4 v0 = acc[ai][bj][m][0], v1 = acc[ai][bj][m][1];
                    float o[8] = {v0[0], v0[1], v0[2], v0[3], v1[0], v1[1], v1[2], v1[3]};
                    if (cb == C_LG) {
#pragma unroll
                        for (int e = 0; e < 8; ++e) o[e] = sigmoidf_(o[e]);
                        v4u w; w.x = pg8::cvt_pk_bf16(o[0], o[1]); w.y = pg8::cvt_pk_bf16(o[2], o[3]); w.z = pg8::cvt_pk_bf16(o[4], o[5]); w.w = pg8::cvt_pk_bf16(o[6], o[7]);
                        *(v4u*)(SG + (size_t)row * 256 + (col - C_LG)) = w;
                        *(v4u*)(SG + (size_t)row * 256 + 128 + (col - C_LG)) = (v4u){0u, 0u, 0u, 0u};
                    } else if (cb >= C_GA) {
                        unsigned q[8];
#pragma unroll
                        for (int e = 0; e < 8; ++e) q[e] = (unsigned)(sigmoidf_(o[e]) * 255.f + 0.5f);
                        v2u w; w.x = q[0] | (q[1] << 8) | (q[2] << 16) | (q[3] << 24); w.y = q[4] | (q[5] << 8) | (q[6] << 16) | (q[7] << 24);
                        const int gbase = (col >= C_GB) ? C_GB : C_GA;
                        *(v2u*)((unsigned char*)Z + ((size_t)row * ZC + gbase) * 2 + (col - gbase)) = w;
                    } else {
                        if (cb == C_LW) {
#pragma unroll
                            for (int e = 0; e < 8; ++e) { const float ex = __expf(2.f * o[e]); o[e] = 1.f - 2.f * __builtin_amdgcn_rcpf(ex + 1.f); } }
                        v4u w; w.x = pg8::cvt_pk_bf16(o[0], o[1]); w.y = pg8::cvt_pk_bf16(o[2], o[3]); w.z = pg8::cvt_pk_bf16(o[4], o[5]); w.w = pg8::cvt_pk_bf16(o[6], o[7]);
                        if (!(cb >= C_VB && cb < C_VB + 512)) *(v4u*)(Z + (size_t)row * ZC + col) = w;
                        if (cb >= C_VB && cb < C_VB + 512) {
                            const int hd = (col - C_VB) >> 6, d0 = (col - C_VB) & 63;
                            const int tpos = lat ? 256 + (row & 2047) : (row & 255);
                            bf16_t* vt = VT + ((size_t)((bb * 8 + hd) * 64 + d0)) * 2304 + tpos;
#pragma unroll
                            for (int e = 0; e < 8; ++e) vt[(size_t)e * 2304] = (bf16_t)((e & 1) ? (((e >> 1) == 0 ? w.x : (e >> 1) == 1 ? w.y : (e >> 1) == 2 ? w.z : w.w) >> 16) : (((e >> 1) == 0 ? w.x : (e >> 1) == 1 ? w.y : (e >> 1) == 2 ? w.z : w.w) & 0xffffu));
                        }
                    } } }
    }
};
struct DualOrder : pg8::StaticOrder { static constexpr bool DUALK = true; };
struct EpiMergeF {
    static constexpr bool PERM = true, AFTER_DRAIN = false;
    const bf16_t* Z; bf16_t* MG;
    __device__ __forceinline__ void mid(f32x4 (&acc)[2][2][4][2], const pg8::Unit& u, int wr, int wc, int fr, int fq) const {
        int row0 = u.pm * 256 + wr * 64 + fr, colb = u.pn * 256 + wc * 32 + 8 * fq;
        asm volatile("" : "+v"(row0), "+v"(colb));
#pragma unroll
        for (int ai = 0; ai < 2; ++ai)
#pragma unroll
            for (int bj = 0; bj < 2; ++bj) {
                v2u qa[4], qb[4];
#pragma unroll
                for (int m = 0; m < 4; ++m) { const int row = row0 + ai * 128 + m * 16, col = colb + bj * 128;
                    qa[m] = *(const v2u*)((const unsigned char*)Z + ((size_t)row * ZC + C_GA) * 2 + col);
                    qb[m] = *(const v2u*)((const unsigned char*)Z + ((size_t)row * ZC + C_GB) * 2 + col); }
#pragma unroll
                for (int m = 0; m < 4; ++m)
#pragma unroll
                    for (int e = 0; e < 4; ++e) {
                        const unsigned b0 = (qb[m].x >> (8 * e)) & 255u, b1 = (qb[m].y >> (8 * e)) & 255u;
                        const float r0 = (float)((qa[m].x >> (8 * e)) & 255u) * __builtin_amdgcn_rcpf((float)(b0 ? b0 : 1u));
                        const float r1 = (float)((qa[m].y >> (8 * e)) & 255u) * __builtin_amdgcn_rcpf((float)(b1 ? b1 : 1u));
                        acc[ai][bj][m][0][e] *= r0; acc[ai][bj][m][1][e] *= r1; }
                __builtin_amdgcn_sched_barrier(0);
            }
    }
    __device__ __forceinline__ void operator()(const f32x4 (&acc)[2][2][4][2], const pg8::Unit& u, int wr, int wc, int fr, int fq) const {
        const int row0 = u.pm * 256 + wr * 64 + fr, colb = u.pn * 256 + wc * 32 + 8 * fq;
#pragma unroll
        for (int ai = 0; ai < 2; ++ai) {
            v2u qb[2][4];
#pragma unroll
            for (int bj = 0; bj < 2; ++bj)
#pragma unroll
                for (int m = 0; m < 4; ++m) { const int row = row0 + ai * 128 + m * 16, col = colb + bj * 128;
                    qb[bj][m] = *(const v2u*)((const unsigned char*)Z + ((size_t)row * ZC + C_GB) * 2 + col); }
#pragma unroll
            for (int bj = 0; bj < 2; ++bj)
#pragma unroll
                for (int m = 0; m < 4; ++m) { const int row = row0 + ai * 128 + m * 16, col = colb + bj * 128;
                    float o[8];
#pragma unroll
                    for (int e = 0; e < 4; ++e) { const unsigned b0 = (qb[bj][m].x >> (8 * e)) & 255u, b1 = (qb[bj][m].y >> (8 * e)) & 255u;
                        o[e] = acc[ai][bj][m][0][e] * ((float)(b0 ? b0 : 1u) * (1.f / 255.f)); o[4 + e] = acc[ai][bj][m][1][e] * ((float)(b1 ? b1 : 1u) * (1.f / 255.f)); }
                    v4u w; w.x = pg8::cvt_pk_bf16(o[0], o[1]); w.y = pg8::cvt_pk_bf16(o[2], o[3]); w.z = pg8::cvt_pk_bf16(o[4], o[5]); w.w = pg8::cvt_pk_bf16(o[6], o[7]);
                    *(v4u*)(MG + (size_t)row * DM + col) = w; } }
    }
};
struct EpiWout {
    static constexpr bool PERM = true, AFTER_DRAIN = false;
    const float* x; const float* ctx; const float* out; const float* ctxs; const float* mod; bf16_t* x1b; int l;
    __device__ __forceinline__ void operator()(const f32x4 (&acc)[2][2][4][2], const pg8::Unit& u, int wr, int wc, int fr, int fq) const {
        const bool lat = u.pm < 64;
        const float* base = lat ? x + (size_t)u.pm * 256 * DM : ctx + (size_t)(u.pm - 64) * 256 * DM;
        const bf16_t* baseb = lat ? (const bf16_t*)out + (size_t)u.pm * 256 * DM : (const bf16_t*)ctxs + (size_t)(u.pm - 64) * 256 * DM;
        bf16_t* dst = x1b + (size_t)u.pm * 256 * DM;
        const float* g = mod + (l * 9 + (lat ? (u.pm >> 3) : 8)) * 6144 + 2 * DM;
        const int r0 = wr * 64 + fr, col0 = u.pn * 256 + wc * 32 + 8 * fq;
        f32x4 gv[2][2];
#pragma unroll
        for (int bj = 0; bj < 2; ++bj)
#pragma unroll
            for (int n = 0; n < 2; ++n) gv[bj][n] = *(const f32x4*)(g + col0 + bj * 128 + n * 4);
#pragma unroll
        for (int ai = 0; ai < 2; ++ai)
#pragma unroll
            for (int mp = 0; mp < 2; ++mp) {
                f32x4 bs[2][2][2];
#pragma unroll
                for (int mm = 0; mm < 2; ++mm) { const size_t off = (size_t)(r0 + ai * 128 + (2 * mp + mm) * 16) * DM + col0;
#pragma unroll
                    for (int bj = 0; bj < 2; ++bj) {
                        if (l == 0) {
#pragma unroll
                            for (int n = 0; n < 2; ++n) bs[mm][bj][n] = *(const f32x4*)(base + off + bj * 128 + n * 4);
                        } else { float f8[8]; unpack8(*(const v4u*)(baseb + off + bj * 128), f8);
                            bs[mm][bj][0] = (f32x4){f8[0], f8[1], f8[2], f8[3]}; bs[mm][bj][1] = (f32x4){f8[4], f8[5], f8[6], f8[7]}; } } }
#pragma unroll
                for (int mm = 0; mm < 2; ++mm) { const int m = 2 * mp + mm; const size_t off = (size_t)(r0 + ai * 128 + m * 16) * DM + col0;
#pragma unroll
                    for (int bj = 0; bj < 2; ++bj) { const f32x4 v0 = bs[mm][bj][0] + gv[bj][0] * acc[ai][bj][m][0], v1 = bs[mm][bj][1] + gv[bj][1] * acc[ai][bj][m][1];
                        v4u w; w.x = pg8::cvt_pk_bf16(v0[0], v0[1]); w.y = pg8::cvt_pk_bf16(v0[2], v0[3]); w.z = pg8::cvt_pk_bf16(v1[0], v1[1]); w.w = pg8::cvt_pk_bf16(v1[2], v1[3]);
                        *(v4u*)(dst + off + bj * 128) = w; } } }
    }
};

template <typename AT> __device__ __forceinline__ float ldA(const AT* p);
template <> __device__ __forceinline__ float ldA<bf16_t>(const bf16_t* p) { return bf2f(*p); }
template <> __device__ __forceinline__ float ldA<float>(const float* p) { return *p; }

template <typename AT, class Epi>
__device__ __forceinline__ void gemm_naive(float* sm, int wg, int nwg, int M, int N, int K, const AT* A, int lda, const int* rowmap, int rowshift,
                           const float* B, int ldb, Epi epi) {
    float* As = sm;
    float* Bs = sm + 16 * 132;
    const int tid = otid(), ty = tid >> 4, tx = tid & 15;
    const int ntm = (M + 127) / 128, ntn = N / 64;
    for (int tile = wg; tile < ntm * ntn; tile += nwg) {
        const int tm = tile / ntn, tn = tile % ntn, m0 = tm * 128, n0 = tn * 64;
        float acc[4][4];
#pragma unroll
        for (int i = 0; i < 4; ++i)
#pragma unroll
            for (int j = 0; j < 4; ++j) acc[i][j] = 0.f;
        const int ar = m0 + (tid >> 2);
        int arow = -1;
        if (ar < M) arow = rowmap ? (rowmap[ar] >> rowshift) : ar;
        const AT* ap = A + (size_t)(arow < 0 ? 0 : arow) * lda + (tid & 3) * 4;
        const int bk = tid >> 4, bn = (tid & 15) * 4;
        for (int k0 = 0; k0 < K; k0 += 16) {
#pragma unroll
            for (int i = 0; i < 4; ++i) As[((tid & 3) * 4 + i) * 132 + (tid >> 2)] = arow >= 0 ? ldA<AT>(ap + k0 + i) : 0.f;
            if (tid < 256) { const float4 b = *(const float4*)(B + (size_t)(k0 + bk) * ldb + n0 + bn); *(float4*)(Bs + bk * 68 + bn) = b; }
            __syncthreads();
#pragma unroll
            for (int kk = 0; kk < 16; ++kk) {
                const float4 a = *(const float4*)(As + kk * 132 + ty * 4), b = *(const float4*)(Bs + kk * 68 + tx * 4);
                const float av[4] = {a.x, a.y, a.z, a.w}, bv[4] = {b.x, b.y, b.z, b.w};
#pragma unroll
                for (int i = 0; i < 4; ++i)
#pragma unroll
                    for (int j = 0; j < 4; ++j) acc[i][j] += av[i] * bv[j];
            }
            __syncthreads();
        }
#pragma unroll
        for (int i = 0; i < 4; ++i) { const int row = m0 + ty * 4 + i; if (row < M) {
#pragma unroll
            for (int j = 0; j < 4; ++j) epi(row, n0 + tx * 4 + j, acc[i][j]); } }
    }
}

__device__ __forceinline__ void ph_win(const Params& p, float* sm, int l, int wg, int nwg) {
    bf16_t* Z = (bf16_t*)(p.ws + WS_Z);
    gemm_naive<bf16_t>(sm, wg, nwg, LR, ZC, DM, (const bf16_t*)(p.ws + WS_H), DM, nullptr, 0, p.w_in + (size_t)l * DM * ZC, ZC,
                       [=](int r, int c, float v) { Z[(size_t)r * ZC + c] = f2bf(v); });
}

__device__ __forceinline__ void ph_convert_moe(const Params& p, unsigned char* ldsb, int l, int wg, int nwg);
struct WinOrderLast : pg8::StaticOrder {
    __device__ __forceinline__ bool next(int i, pg8::Unit& u) const {
        const int L = i * G + c;
        if (L < nwg) { unit_of(L, u); return true; }
        const int e = L - nwg; if (e >= 96) return false;
        const int t = e % 12; u.pm = 64 + e / 12; u.pn = t < 7 ? t : t + 2; u.boff = 0u; return true;
    }
};
__device__ __forceinline__ void ph_win_mfma(const Params& p, unsigned char* ldsb, int l, int wg, int nwg) {
    pg8::Gemm g{(const bf16_t*)(p.ws + WS_H), (const bf16_t*)(p.ws + WS_WIN_T), LR, 5632, DM};
    EpiZ E{(bf16_t*)(p.ws + WS_Z), (bf16_t*)(p.ws + WS_SG), (bf16_t*)(p.ws + WS_VT)};
    if (l == 1) {
        WinOrderLast S; S.init(NLAT, 5632, nwg, wg);
        pg8::gemm_phase<EpiZ, WinOrderLast, true, true>((LAS unsigned char*)ldsb, g, S, E);
    } else {
        pg8::StaticOrder S; S.init(LR, 5632, nwg, wg);
        pg8::gemm_phase<EpiZ, pg8::StaticOrder, true, true>((LAS unsigned char*)ldsb, g, S, E);
    }
    const int ntail = (72 * 22) % nwg;
    (void)ntail;
}
__device__ __forceinline__ void ph_merge_mfma(const Params& p, unsigned char* ldsb, int l, int wg, int nwg) {
    const int nrows = (l == 1) ? NLAT : LR;
    pg8::Gemm g{(const bf16_t*)(p.ws + WS_OUTA), (const bf16_t*)(p.ws + WS_PA_T), nrows, DM, 512};
    DualOrder S; S.init(nrows, DM, nwg, wg);
    S.dA = (long)WS_YB - (long)WS_OUTA - 8 * 128; S.dB = (long)WS_PB_T - (long)WS_PA_T - 8 * 128;
    EpiMergeF E{(const bf16_t*)(p.ws + WS_Z), (bf16_t*)(p.ws + WS_MERGED)};
    pg8::gemm_phase<EpiMergeF, DualOrder, true, true>((LAS unsigned char*)ldsb, g, S, E);
}
__device__ __forceinline__ void ph_wout_mfma(const Params& p, unsigned char* ldsb, int l, int wg, int nwg) {
    const int nrows = (l == 1) ? NLAT : LR;
    pg8::Gemm g{(const bf16_t*)(p.ws + WS_MERGED), (const bf16_t*)(p.ws + WS_WO_T), nrows, DM, DM};
    pg8::StaticOrder S; S.init(nrows, DM, nwg, wg);
    EpiWout E{p.x, p.ctx, p.out, (const float*)(p.ws + WS_CTXS), (const float*)(p.ws + WS_MOD), (bf16_t*)(p.ws + WS_X1B), l};
    pg8::gemm_phase<EpiWout, pg8::StaticOrder, true, true>((LAS unsigned char*)ldsb, g, S, E);
}

__device__ __forceinline__ void ph_prep(const Params& p, float* sm, int l, int dir, int wg, int nwg) {
    const bf16_t* Z = (const bf16_t*)(p.ws + WS_Z);
    float* SW = (float*)(p.ws + WS_SW); bf16_t* SB = (bf16_t*)(p.ws + WS_SB); bf16_t* SKD = (bf16_t*)(p.ws + WS_SKD); bf16_t* SKK = (bf16_t*)(p.ws + WS_SKK);
    const int c = otid();
    const float* wlb = p.rw_w_lora_b + ((size_t)(l * 2 + dir) * 64) * 512 + c;
    const float* alb = p.rw_a_lora_b + ((size_t)(l * 2 + dir) * 64) * 512 + c;
    const float w0 = p.rw_w0[(l * 2 + dir) * 512 + c], a0 = p.rw_a0[(l * 2 + dir) * 512 + c];
    const float kkc = p.rw_k_k[l * 512 + c], kac = p.rw_k_a[l * 512 + c];
    for (int r = wg; r < LR; r += nwg) {
        __syncthreads();
        if (c < 64) sm[c] = tanhf(bf2f(Z[(size_t)r * ZC + C_LW + dir * 64 + c]));
        else if (c < 128) sm[c] = bf2f(Z[(size_t)r * ZC + C_LA + dir * 64 + (c - 64)]);
        __syncthreads();
        float wl = w0, al = a0;
#pragma unroll 4
        for (int j = 0; j < 64; ++j) { wl += sm[j] * wlb[(size_t)j * 512]; al += sm[64 + j] * alb[(size_t)j * 512]; }
        const float nx = -wl; const float sp = fmaxf(nx, 0.f) + log1pf(expf(-fabsf(nx)));
        const float decay = expf(-expf(-sp - 0.5f));
        const float a = sigmoidf_(al);
        const float k = bf2f(Z[(size_t)r * ZC + C_K + c]);
        const float kv = k * kkc;
        const float n2 = wave_sum(kv * kv);
        const float kk = kv * rsqrtf(fmaxf(n2, 1e-12f));
        SW[(size_t)r * 512 + c] = decay;
        SB[(size_t)r * 512 + c] = f2bf(kk * a);
        SKD[(size_t)r * 512 + c] = f2bf(k * (1.f + (a - 1.f) * kac));
        SKK[(size_t)r * 512 + c] = f2bf(kk);
    }
}

__device__ __forceinline__ int scan_row(int step, int dir, int b) {
    if (step < CTXL) { int t = dir ? (CTXL - 1 - step) : step; return NLAT + b * CTXL + t; }
    int tt = step - CTXL; int t = dir ? (SEQ - 1 - tt) : tt; return b * SEQ + t;
}
__device__ __forceinline__ void ph_scan(const Params& p, float* sm, int l, int dir, int wg, int nwg) {
    const bf16_t* Z = (const bf16_t*)(p.ws + WS_Z);
    const float* SW = (const float*)(p.ws + WS_SW); const bf16_t* SB = (const bf16_t*)(p.ws + WS_SB); const bf16_t* SKD = (const bf16_t*)(p.ws + WS_SKD); const bf16_t* SKK = (const bf16_t*)(p.ws + WS_SKK);
    float* Y = (float*)(p.ws + WS_Y);
    const int lane = otid() & 63, wv = otid() >> 6, nwv = blockDim.x >> 6;
    const bool last = (l == 1);
    for (int task = wg * nwv + wv; task < 512; task += nwg * nwv) {
        const int b = task >> 6, hd = (task >> 3) & 7, v0 = (task & 7) * 8;
        float s[8];
#pragma unroll
        for (int j = 0; j < 8; ++j) s[j] = 0.f;
        int row = scan_row(0, dir, b);
        float cw = SW[(size_t)row * 512 + hd * 64 + lane], ckk = bf2f(SKK[(size_t)row * 512 + hd * 64 + lane]), cb = bf2f(SB[(size_t)row * 512 + hd * 64 + lane]),
              ckd = bf2f(SKD[(size_t)row * 512 + hd * 64 + lane]), cr = bf2f(Z[(size_t)row * ZC + C_R + hd * 64 + lane]), cv = bf2f(Z[(size_t)row * ZC + C_V + hd * 64 + lane]);
        for (int step = 0; step < CTXL + SEQ; ++step) {
            const int nrow = scan_row(step + 1 < CTXL + SEQ ? step + 1 : step, dir, b);
            const float nw = SW[(size_t)nrow * 512 + hd * 64 + lane], nkk = bf2f(SKK[(size_t)nrow * 512 + hd * 64 + lane]), nb = bf2f(SB[(size_t)nrow * 512 + hd * 64 + lane]),
                        nkd = bf2f(SKD[(size_t)nrow * 512 + hd * 64 + lane]), nr = bf2f(Z[(size_t)nrow * ZC + C_R + hd * 64 + lane]), nv = bf2f(Z[(size_t)nrow * ZC + C_V + hd * 64 + lane]);
            float ysel = 0.f;
#pragma unroll
            for (int j = 0; j < 8; ++j) {
                const float skk = wave_sum(s[j] * ckk);
                const float vj = rdlane(cv, __builtin_amdgcn_readfirstlane(v0 + j));
                s[j] = s[j] * cw - skk * cb + vj * ckd;
                const float y = wave_sum(s[j] * cr);
                if (lane == j) ysel = y;
            }
            const bool isctx = step < CTXL;
            if (!(isctx && last) && lane < 8) {
                float* yp = Y + (size_t)row * 512 + hd * 64 + v0 + lane;
                if (dir == 0) *yp = ysel; else *yp += ysel;
            }
            row = nrow; cw = nw; ckk = nkk; cb = nb; ckd = nkd; cr = nr; cv = nv;
        }
    }
}

typedef short bf16x8_t __attribute__((ext_vector_type(8)));
template <int CTRL> __device__ __forceinline__ float dpp_f(float v) { return __int_as_float(__builtin_amdgcn_update_dpp(0, __float_as_int(v), CTRL, 0xf, 0xf, false)); }
__device__ __forceinline__ float row16_sum(float x) {
    x += dpp_f<0xB1>(x);
    x += dpp_f<0x4E>(x);
    x += dpp_f<0x124>(x);
    x += dpp_f<0x128>(x);
    return x;
}
__device__ __forceinline__ int scan_chunk_row(int ci, int j, int dir, int b) {
    if (ci < 8) { const int t = ci * 32 + j; return NLAT + b * CTXL + (dir ? (CTXL - 1 - t) : t); }
    const int t = (ci - 8) * 32 + j; return b * SEQ + (dir ? (SEQ - 1 - t) : t);
}
__device__ __forceinline__ void ph_scan2(const Params& p, unsigned char* ldsb, int l, int wg, int nwg) {
    const int tid = otid(), lane = tid & 63, wv = tid >> 6;
    LAS unsigned char* L = (LAS unsigned char*)ldsb;
    LAS float* sW = (LAS float*)(L + 0);
    LAS float* sKK = (LAS float*)(L + 8192);
    LAS float* sB = (LAS float*)(L + 16384);
    LAS float* sKD = (LAS float*)(L + 24576);
    LAS float* sR = (LAS float*)(L + 32768);
    LAS float* sV = (LAS float*)(L + 40960);
    LAS float* sY = (LAS float*)(L + 45056);
    LAS float* sKF = (LAS float*)(L + 49664);
    LAS float* sRN = (LAS float*)(L + 57856);
    LAS bf16_t* sLW = (LAS bf16_t*)(L + 58112);
    LAS bf16_t* sLA = (LAS bf16_t*)(L + 62208);
    const bf16_t* Z = (const bf16_t*)(p.ws + WS_Z);
    bf16_t* Y = (bf16_t*)(p.ws + WS_Y2);
    const bool last = (l == 1);
    for (int task = wg; task < 256; task += nwg) {
        const int b = task >> 5, h = (task >> 2) & 7, dir = (task >> 1) & 1, half = task & 1;
        const int mb = wv >> 2, nb = wv & 3, fr = lane & 15, fq = lane >> 4;
        const int cch = h * 64 + nb * 16 + fr;
        const float w0c = p.rw_w0[(l * 2 + dir) * 512 + cch], a0c = p.rw_a0[(l * 2 + dir) * 512 + cch];
        const float kkc = p.rw_k_k[l * 512 + cch], kac = p.rw_k_a[l * 512 + cch];
        bf16x8_t Bw[2], Ba[2];
#pragma unroll
        for (int ks = 0; ks < 2; ++ks) {
            Bw[ks] = *(const bf16x8_t*)((const bf16_t*)(p.ws + WS_LW_T) + ((size_t)(dir * 512 + cch) * 64 + 8 * fq + 32 * ks));
            Ba[ks] = *(const bf16x8_t*)((const bf16_t*)(p.ws + WS_LA_T) + ((size_t)(dir * 512 + cch) * 64 + 8 * fq + 32 * ks));
        }
        const int pj = (tid & 255) >> 3, pq = tid & 7;
        const bool roleK = tid < 256;
        const int vj = tid >> 2, vq = tid & 3;
        float kk8[8];
#pragma unroll
        for (int e = 0; e < 8; ++e) kk8[e] = p.rw_k_k[l * 512 + h * 64 + pq * 8 + e];
        const int g = lane >> 4, kc = lane & 15, vrow = wv * 4 + g;
        float s0 = 0.f, s1 = 0.f, s2 = 0.f, s3 = 0.f;
        v4u pf0, pf1, pfv;
#define SCAN_PREFETCH(ci_) do { const int row_ = scan_chunk_row((ci_), pj, dir, b); const bf16_t* zr_ = Z + (size_t)row_ * ZC; \
            pf0 = *(const v4u*)(zr_ + (roleK ? C_K : C_R) + h * 64 + pq * 8); pf1 = *(const v4u*)(zr_ + (roleK ? C_LW : C_LA) + dir * 64 + pq * 8); \
            if (tid < 128) { const int rowv_ = scan_chunk_row((ci_), vj, dir, b); pfv = *(const v4u*)(Z + (size_t)rowv_ * ZC + C_V + h * 64 + half * 32 + vq * 8); } } while (0)
        SCAN_PREFETCH(0);
        for (int ci = 0; ci < 72; ++ci) {
            float f0[8]; unpack8(pf0, f0);
            if (roleK) {
                float ss = 0.f;
#pragma unroll
                for (int e = 0; e < 8; ++e) { const float t_ = f0[e] * kk8[e]; ss += t_ * t_; }
                ss += swz_xor<1>(ss); ss += swz_xor<2>(ss); ss += swz_xor<4>(ss);
                *(LAS f32x4*)(sKF + pj * 64 + pq * 8) = (f32x4){f0[0], f0[1], f0[2], f0[3]};
                *(LAS f32x4*)(sKF + pj * 64 + pq * 8 + 4) = (f32x4){f0[4], f0[5], f0[6], f0[7]};
                if (pq == 0) sRN[pj] = rsqrtf(fmaxf(ss, 1e-12f));
                float f1[8]; unpack8(pf1, f1);
#pragma unroll
                for (int e = 0; e < 8; ++e) { const float ex = __expf(2.f * f1[e]); f1[e] = 1.f - 2.f / (ex + 1.f); }
                v4u o; o.x = pk2(f1[0], f1[1]); o.y = pk2(f1[2], f1[3]); o.z = pk2(f1[4], f1[5]); o.w = pk2(f1[6], f1[7]);
                *(LAS v4u*)(sLW + pj * 64 + pq * 8) = o;
            } else {
                *(LAS v4u*)(sLA + pj * 64 + pq * 8) = pf1;
            }
            __syncthreads();
            {
                f32x4 accw = {0.f, 0.f, 0.f, 0.f}, acca = {0.f, 0.f, 0.f, 0.f};
#pragma unroll
                for (int ks = 0; ks < 2; ++ks) {
                    const bf16x8_t aw = *(const LAS bf16x8_t*)(sLW + (mb * 16 + fr) * 64 + 8 * fq + 32 * ks);
                    const bf16x8_t aa = *(const LAS bf16x8_t*)(sLA + (mb * 16 + fr) * 64 + 8 * fq + 32 * ks);
                    accw = __builtin_amdgcn_mfma_f32_16x16x32_bf16(aw, Bw[ks], accw, 0, 0, 0);
                    acca = __builtin_amdgcn_mfma_f32_16x16x32_bf16(aa, Ba[ks], acca, 0, 0, 0);
                }
#pragma unroll
                for (int i = 0; i < 4; ++i) {
                    const int j = mb * 16 + fq * 4 + i, c = nb * 16 + fr;
                    const float wl = accw[i] + w0c, al = acca[i] + a0c;
                    const float nx = -wl; const float sp = fmaxf(nx, 0.f) + __logf(1.f + __expf(-fabsf(nx)));
                    const float decay = __expf(-__expf(-sp - 0.5f));
                    const float a = 1.f / (1.f + __expf(-al));
                    const float k = sKF[j * 64 + c]; const float kk = k * kkc * sRN[j];
                    sW[j * 64 + c] = decay; sKK[j * 64 + c] = kk; sB[j * 64 + c] = kk * a; sKD[j * 64 + c] = k * (1.f + (a - 1.f) * kac);
                }
                if (!roleK) { *(LAS f32x4*)(sR + pj * 64 + pq * 8) = (f32x4){f0[0], f0[1], f0[2], f0[3]}; *(LAS f32x4*)(sR + pj * 64 + pq * 8 + 4) = (f32x4){f0[4], f0[5], f0[6], f0[7]}; }
                if (tid < 128) { float fv[8]; unpack8(pfv, fv); *(LAS f32x4*)(sV + vj * 32 + vq * 8) = (f32x4){fv[0], fv[1], fv[2], fv[3]}; *(LAS f32x4*)(sV + vj * 32 + vq * 8 + 4) = (f32x4){fv[4], fv[5], fv[6], fv[7]}; }
                if (ci > 0 && !(last && ci <= 8)) {
                    const int j = tid >> 4, r2 = (tid & 15) * 2; const int row = scan_chunk_row(ci - 1, j, dir, b);
                    *(unsigned*)(Y + ((size_t)dir * LR + row) * 512 + h * 64 + half * 32 + r2) = pk2(sY[r2 * 36 + j], sY[(r2 + 1) * 36 + j]);
                }
            }
            __syncthreads();
            if (ci + 1 < 72) SCAN_PREFETCH(ci + 1);
#define SCAN_LD(j_, W_, KK_, BB_, KD_, RR_, V_) do { W_ = *(const LAS f32x4*)(sW + (j_) * 64 + kc * 4); KK_ = *(const LAS f32x4*)(sKK + (j_) * 64 + kc * 4); BB_ = *(const LAS f32x4*)(sB + (j_) * 64 + kc * 4); \
                KD_ = *(const LAS f32x4*)(sKD + (j_) * 64 + kc * 4); RR_ = *(const LAS f32x4*)(sR + (j_) * 64 + kc * 4); V_ = sV[(j_) * 32 + vrow]; } while (0)
#define SCAN_STEP(W_, KK_, BB_, KD_, RR_, V_, Y_) do { float pd = s0 * KK_[0] + s1 * KK_[1] + s2 * KK_[2] + s3 * KK_[3]; pd = row16_sum(pd); \
                s0 = s0 * W_[0] + (V_ * KD_[0] - pd * BB_[0]); s1 = s1 * W_[1] + (V_ * KD_[1] - pd * BB_[1]); s2 = s2 * W_[2] + (V_ * KD_[2] - pd * BB_[2]); s3 = s3 * W_[3] + (V_ * KD_[3] - pd * BB_[3]); \
                float y_ = s0 * RR_[0] + s1 * RR_[1] + s2 * RR_[2] + s3 * RR_[3]; Y_ = row16_sum(y_); } while (0)
            {
                f32x4 wA, kkA, bbA, kdA, rrA, wB, kkB, bbB, kdB, rrB; float vA, vB;
                SCAN_LD(0, wA, kkA, bbA, kdA, rrA, vA);
#pragma unroll 1
                for (int j = 0; j < 32; j += 4) {
                    f32x4 y4;
                    SCAN_LD(j + 1, wB, kkB, bbB, kdB, rrB, vB);
                    SCAN_STEP(wA, kkA, bbA, kdA, rrA, vA, y4[0]);
                    SCAN_LD(j + 2, wA, kkA, bbA, kdA, rrA, vA);
                    SCAN_STEP(wB, kkB, bbB, kdB, rrB, vB, y4[1]);
                    SCAN_LD(j + 3, wB, kkB, bbB, kdB, rrB, vB);
                    SCAN_STEP(wA, kkA, bbA, kdA, rrA, vA, y4[2]);
                    SCAN_LD((j + 4) & 31, wA, kkA, bbA, kdA, rrA, vA);
                    SCAN_STEP(wB, kkB, bbB, kdB, rrB, vB, y4[3]);
                    *(LAS f32x4*)(sY + vrow * 36 + j) = y4;
                }
            }
#undef SCAN_LD
#undef SCAN_STEP
        }
        __syncthreads();
        {
            const int j = tid >> 4, r2 = (tid & 15) * 2; const int row = scan_chunk_row(71, j, dir, b);
            *(unsigned*)(Y + ((size_t)dir * LR + row) * 512 + h * 64 + half * 32 + r2) = pk2(sY[r2 * 36 + j], sY[(r2 + 1) * 36 + j]);
        }
        __syncthreads();
#undef SCAN_PREFETCH
    }
}

__device__ __forceinline__ void ph_natt(const Params& p, float* sm, int l, int wg, int nwg) {
    const bf16_t* Z = (const bf16_t*)(p.ws + WS_Z);
    bf16_t* YB = (bf16_t*)(p.ws + WS_YB);
    const int lane = otid() & 63, wv = otid() >> 6, nwv = blockDim.x >> 6;
    float* qs = sm + wv * 512;
    float* ps = qs + 64;
    const bool last = (l == 1);
    const int nq = last ? NLAT : LR;
    const float* rpb = p.na_rpb + (size_t)l * 8 * 15 * 31;
    const float kg = p.na_k_g[l * 64 + lane], qg = p.na_q_g[l * 64 + lane];
    for (int task = wg * nwv + wv; task < nq * 8; task += nwg * nwv) {
        const int r = task >> 3, hd = task & 7;
        const bool isl = r < NLAT;
        const int b = isl ? (r >> 11) : ((r - NLAT) >> 8);
        const int t = r & 2047, qi = t >> 6, qj = t & 63;
        const int r0 = min(max(qi - 4, 0), 32 - 8), cs = min(max(qj - 8, 0), 64 - 16);
        const int nkeys = isl ? 384 : 256;
        {
            const float qv = bf2f(Z[(size_t)r * ZC + C_Q + hd * 64 + lane]);
            const float ss = wave_sum(qv * qv);
            qs[lane] = qv * rsqrtf(ss * (1.f / 64.f) + RMS_EPS) * qg * 0.125f * kg;
        }
        float lg[6]; float mx = -INFINITY;
#pragma unroll
        for (int i = 0; i < 6; ++i) {
            const int kidx = lane + 64 * i; lg[i] = -INFINITY;
            if (kidx < nkeys) {
                int krow; float bias = 0.f;
                if (isl && kidx < 128) { const int a = kidx >> 4, cc = kidx & 15; krow = b * SEQ + (r0 + a) * 64 + cs + cc;
                    bias = rpb[(hd * 15 + (r0 + a - qi + 7)) * 31 + (cs + cc - qj + 15)]; }
                else krow = NLAT + b * CTXL + (isl ? kidx - 128 : kidx);
                const uint4* kp = (const uint4*)(Z + (size_t)krow * ZC + C_KB + hd * 64);
                float ss = 0.f, dot = 0.f;
#pragma unroll 2
                for (int u = 0; u < 8; ++u) { const uint4 w = kp[u]; const unsigned ww[4] = {w.x, w.y, w.z, w.w};
                    const float4 qa = *(const float4*)(qs + u * 8), qb = *(const float4*)(qs + u * 8 + 4);
                    const float q[8] = {qa.x, qa.y, qa.z, qa.w, qb.x, qb.y, qb.z, qb.w};
#pragma unroll
                    for (int e = 0; e < 4; ++e) { const float k0 = __uint_as_float(ww[e] << 16), k1 = __uint_as_float(ww[e] & 0xffff0000u);
                        ss += k0 * k0 + k1 * k1; dot += k0 * q[e * 2] + k1 * q[e * 2 + 1]; } }
                lg[i] = dot * rsqrtf(ss * (1.f / 64.f) + RMS_EPS) + bias;
                mx = fmaxf(mx, lg[i]);
            }
        }
        mx = wave_max(mx);
        float sum = 0.f;
#pragma unroll
        for (int i = 0; i < 6; ++i) { const int kidx = lane + 64 * i; if (kidx < nkeys) { lg[i] = __expf(lg[i] - mx); sum += lg[i]; } }
        sum = wave_sum(sum);
        const float inv = 1.f / sum;
#pragma unroll
        for (int i = 0; i < 6; ++i) { const int kidx = lane + 64 * i; if (kidx < nkeys) ps[kidx] = lg[i] * inv; }
        float acc = 0.f;
        for (int kidx = 0; kidx < nkeys; ++kidx) {
            int krow;
            if (isl && kidx < 128) krow = b * SEQ + (r0 + (kidx >> 4)) * 64 + cs + (kidx & 15);
            else krow = NLAT + b * CTXL + (isl ? kidx - 128 : kidx);
            acc += ps[kidx] * bf2f(Z[(size_t)krow * ZC + C_VB + hd * 64 + lane]);
        }
        YB[(size_t)r * 512 + hd * 64 + lane] = f2bf(acc);
    }
}

typedef float f32x16_t __attribute__((ext_vector_type(16)));
#define MFMA32(a_, b_, c_) __builtin_amdgcn_mfma_f32_32x32x16_bf16((a_), (b_), (c_), 0, 0, 0)
#define MFMA16(a_, b_, c_) __builtin_amdgcn_mfma_f32_16x16x32_bf16((a_), (b_), (c_), 0, 0, 0)
__device__ __forceinline__ int scan3_row(int sc, int j, int dir, int b) {
    if (sc < 16) { const int t = sc * 16 + j; return NLAT + b * CTXL + (dir ? (CTXL - 1 - t) : t); }
    const int t = (sc - 16) * 16 + j; return b * SEQ + (dir ? (SEQ - 1 - t) : t);
}
constexpr int S3_KR = 0, S3_KD = 4096, S3_BT = 6144, S3_BD = 8192, S3_ET = 9216, S3_VT = 10240, S3_A = 11264, S3_PC = 12288, S3_SET = 12800;
constexpr int S3_SY = 8 * S3_SET;
constexpr int S3_SYSUB = 32 * 20 * 4;
#define S3_LDS_FENCE() asm volatile("s_waitcnt lgkmcnt(0)" ::: "memory")
__device__ __forceinline__ float frcp(float x) { return __builtin_amdgcn_rcpf(x); }
__device__ __forceinline__ bf16_t f2bf_fast(float x) { const __bf16 b = (__bf16)x; return __builtin_bit_cast(bf16_t, b); }
__device__ __forceinline__ void row_gather4(float x, float& r0, float& r1, float& r2, float& r3) {
    auto a = __builtin_amdgcn_permlane32_swap(__float_as_uint(x), __float_as_uint(x), false, false);
    auto b0 = __builtin_amdgcn_permlane16_swap(a[0], a[0], false, false);
    auto b1 = __builtin_amdgcn_permlane16_swap(a[1], a[1], false, false);
    r0 = __uint_as_float(b0[0]); r1 = __uint_as_float(b0[1]); r2 = __uint_as_float(b1[0]); r3 = __uint_as_float(b1[1]);
}
__device__ __forceinline__ void ph_scan3(const Params& p, unsigned char* ldsb, int l, int wg, int nwg) {
    const int tid = otid(), lane = tid & 63;
    const int wv = __builtin_amdgcn_readfirstlane(tid >> 6);
    LAS unsigned char* L = (LAS unsigned char*)ldsb;
    const bf16_t* Z = (const bf16_t*)(p.ws + WS_Z);
    bf16_t* Y = (bf16_t*)(p.ws + WS_Y2);
    const bool last = (l == 1);
    for (int task = wg; task < 256; task += nwg) {
        const int b = task >> 5, h = (task >> 2) & 7, dir = (task >> 1) & 1, half = task & 1;
        __syncthreads();
        if (wv == 0) {
            const int vcol = lane & 31, hi = lane >> 5;
            f32x16_t st0, st1;
#pragma unroll
            for (int r = 0; r < 16; ++r) { st0[r] = 0.f; st1[r] = 0.f; }
            for (int iter = 0; iter < 38; ++iter) {
                __syncthreads();
                if (iter < 1 || iter > 36) continue;
                const int buf = (iter - 1) & 1;
#pragma unroll 1
                for (int sub = 0; sub < 4; ++sub) {
                    LAS unsigned char* set = L + (buf * 4 + sub) * S3_SET;
                    bf16x8_t sb[4];
                    { v4u w;
                      w.x = pg8::cvt_pk_bf16(st0[0], st0[1]); w.y = pg8::cvt_pk_bf16(st0[2], st0[3]); w.z = pg8::cvt_pk_bf16(st0[4], st0[5]); w.w = pg8::cvt_pk_bf16(st0[6], st0[7]); sb[0] = __builtin_bit_cast(bf16x8_t, w);
                      w.x = pg8::cvt_pk_bf16(st0[8], st0[9]); w.y = pg8::cvt_pk_bf16(st0[10], st0[11]); w.z = pg8::cvt_pk_bf16(st0[12], st0[13]); w.w = pg8::cvt_pk_bf16(st0[14], st0[15]); sb[1] = __builtin_bit_cast(bf16x8_t, w);
                      w.x = pg8::cvt_pk_bf16(st1[0], st1[1]); w.y = pg8::cvt_pk_bf16(st1[2], st1[3]); w.z = pg8::cvt_pk_bf16(st1[4], st1[5]); w.w = pg8::cvt_pk_bf16(st1[6], st1[7]); sb[2] = __builtin_bit_cast(bf16x8_t, w);
                      w.x = pg8::cvt_pk_bf16(st1[8], st1[9]); w.y = pg8::cvt_pk_bf16(st1[10], st1[11]); w.z = pg8::cvt_pk_bf16(st1[12], st1[13]); w.w = pg8::cvt_pk_bf16(st1[14], st1[15]); sb[3] = __builtin_bit_cast(bf16x8_t, w); }
                    f32x16_t acc;
#pragma unroll
                    for (int r = 0; r < 16; ++r) acc[r] = 0.f;
#pragma unroll
                    for (int ks = 0; ks < 4; ++ks) { const bf16x8_t af = *(const LAS bf16x8_t*)(set + S3_KR + vcol * 128 + (ks * 16 + 8 * hi) * 2); acc = MFMA32(af, sb[ks], acc); }
                    const bf16x8_t vtf = *(const LAS bf16x8_t*)(set + S3_VT + vcol * 32 + 8 * hi * 2);
                    { const bf16x8_t bdf = *(const LAS bf16x8_t*)(set + S3_BD + vcol * 32 + 8 * hi * 2); acc = MFMA32(bdf, vtf, acc); }
                    float rhs[16];
#pragma unroll
                    for (int r = 0; r < 8; ++r) { auto rr = __builtin_amdgcn_permlane32_swap(__float_as_uint(acc[r]), __float_as_uint(acc[r]), false, false);
                        const int t0 = (r & 3) + 8 * (r >> 2); rhs[t0] = __uint_as_float(rr[0]); rhs[t0 + 4] = __uint_as_float(rr[1]); }
                    float u[16];
#pragma unroll
                    for (int i = 0; i < 16; ++i) {
                        u[i] = rhs[i];
                        if (i < 15) {
                            const LAS float* ar = (const LAS float*)(set + S3_A) + i * 16;
                            const f32x4 a0 = *(const LAS f32x4*)(ar), a1 = *(const LAS f32x4*)(ar + 4), a2 = *(const LAS f32x4*)(ar + 8), a3 = *(const LAS f32x4*)(ar + 12);
                            const float av[16] = {a0[0], a0[1], a0[2], a0[3], a1[0], a1[1], a1[2], a1[3], a2[0], a2[1], a2[2], a2[3], a3[0], a3[1], a3[2], a3[3]};
#pragma unroll
                            for (int t = i + 1; t < 16; ++t) rhs[t] -= u[i] * av[t];
                        }
                    }
                    bf16x8_t ub;
                    { v4u w; w.x = pg8::cvt_pk_bf16(hi ? u[8] : u[0], hi ? u[9] : u[1]); w.y = pg8::cvt_pk_bf16(hi ? u[10] : u[2], hi ? u[11] : u[3]);
                      w.z = pg8::cvt_pk_bf16(hi ? u[12] : u[4], hi ? u[13] : u[5]); w.w = pg8::cvt_pk_bf16(hi ? u[14] : u[6], hi ? u[15] : u[7]); ub = __builtin_bit_cast(bf16x8_t, w); }
                    { const bf16x8_t etf = *(const LAS bf16x8_t*)(set + S3_ET + vcol * 32 + 8 * hi * 2); acc = MFMA32(etf, ub, acc); }
                    { LAS float* sy = (LAS float*)(L + S3_SY + (buf * 4 + sub) * S3_SYSUB) + vcol * 20;
                      *(LAS f32x4*)(sy + 4 * hi) = (f32x4){acc[8], acc[9], acc[10], acc[11]};
                      *(LAS f32x4*)(sy + 8 + 4 * hi) = (f32x4){acc[12], acc[13], acc[14], acc[15]}; }
                    { const bf16x8_t kd0 = *(const LAS bf16x8_t*)(set + S3_KD + vcol * 32 + 8 * hi * 2), kd1 = *(const LAS bf16x8_t*)(set + S3_KD + (32 + vcol) * 32 + 8 * hi * 2);
                      const bf16x8_t bt0 = *(const LAS bf16x8_t*)(set + S3_BT + vcol * 32 + 8 * hi * 2), bt1 = *(const LAS bf16x8_t*)(set + S3_BT + (32 + vcol) * 32 + 8 * hi * 2);
                      st0 = MFMA32(kd0, vtf, st0); st0 = MFMA32(bt0, ub, st0);
                      st1 = MFMA32(kd1, vtf, st1); st1 = MFMA32(bt1, ub, st1); }
#pragma unroll
                    for (int g = 0; g < 4; ++g) {
                        const f32x4 p0 = *(const LAS f32x4*)((const LAS float*)(set + S3_PC) + 8 * g + 4 * hi), p1 = *(const LAS f32x4*)((const LAS float*)(set + S3_PC) + 32 + 8 * g + 4 * hi);
#pragma unroll
                        for (int e = 0; e < 4; ++e) { st0[4 * g + e] *= p0[e]; st1[4 * g + e] *= p1[e]; }
                    }
                }
            }
        } else if (wv <= 4) {
            const int fr = lane & 15, fq = lane >> 4, pw = wv - 1;
            float w0c[4], a0c[4], kkc[4], kac[4];
#pragma unroll
            for (int nb = 0; nb < 4; ++nb) { const int cch = h * 64 + nb * 16 + fr;
                w0c[nb] = p.rw_w0[(l * 2 + dir) * 512 + cch]; a0c[nb] = p.rw_a0[(l * 2 + dir) * 512 + cch]; kkc[nb] = p.rw_k_k[l * 512 + cch]; kac[nb] = p.rw_k_a[l * 512 + cch]; }
            const bf16_t* lwt = (const bf16_t*)(p.ws + WS_LW_T) + ((size_t)(dir * 512 + h * 64 + fr) * 64 + 8 * fq);
            const bf16_t* lat = (const bf16_t*)(p.ws + WS_LA_T) + ((size_t)(dir * 512 + h * 64 + fr) * 64 + 8 * fq);
            const int pq = lane & 7;
            float kk8[8];
#pragma unroll
            for (int e = 0; e < 8; ++e) kk8[e] = p.rw_k_k[l * 512 + h * 64 + pq * 8 + e];
            const int Pfr = (fr & 3) | ((fr & 4) << 1) | ((fr & 8) >> 1);
            v4u pk_[2], pr_[2], plw_[2], pla_[2], pv_;
#define S3_PREFETCH(sc_) do { _Pragma("unroll") for (int it_ = 0; it_ < 2; ++it_) { const int pp_ = lane + 64 * it_; const bf16_t* zr_ = Z + (size_t)scan3_row((sc_), pp_ >> 3, dir, b) * ZC; \
                pk_[it_] = *(const v4u*)(zr_ + C_K + h * 64 + pq * 8); pr_[it_] = *(const v4u*)(zr_ + C_R + h * 64 + pq * 8); plw_[it_] = *(const v4u*)(zr_ + C_LW + dir * 64 + pq * 8); pla_[it_] = *(const v4u*)(zr_ + C_LA + dir * 64 + pq * 8); } \
                pv_ = *(const v4u*)(Z + (size_t)scan3_row((sc_), lane >> 2, dir, b) * ZC + C_V + h * 64 + half * 32 + (lane & 3) * 8); } while (0)
            S3_PREFETCH(pw);
            for (int iter = 0; iter < 38; ++iter) {
                __syncthreads();
                if (iter >= 36) continue;
                LAS unsigned char* set = L + ((iter & 1) * 4 + pw) * S3_SET;
                LAS bf16_t* RK = (LAS bf16_t*)(set + S3_KR); LAS bf16_t* RR = (LAS bf16_t*)(set + S3_KR + 2048);
                LAS bf16_t* LWt = (LAS bf16_t*)(set + S3_KD); LAS bf16_t* LAt = (LAS bf16_t*)(set + S3_BT);
                LAS float* RN = (LAS float*)(set + S3_PC);
#pragma unroll
                for (int it = 0; it < 2; ++it) { const int pp = lane + 64 * it, j = pp >> 3;
                    float f[8]; unpack8(pk_[it], f); float ss = 0.f;
#pragma unroll
                    for (int e = 0; e < 8; ++e) { const float t_ = f[e] * kk8[e]; ss += t_ * t_; }
                    ss += swz_xor<1>(ss); ss += swz_xor<2>(ss); ss += swz_xor<4>(ss);
                    if (pq == 0) RN[j] = rsqrtf(fmaxf(ss, 1e-12f));
                    *(LAS v4u*)(RK + j * 64 + pq * 8) = pk_[it]; *(LAS v4u*)(RR + j * 64 + pq * 8) = pr_[it]; *(LAS v4u*)(LAt + j * 64 + pq * 8) = pla_[it];
                    float g[8]; unpack8(plw_[it], g);
#pragma unroll
                    for (int e = 0; e < 8; ++e) { const float ex = __expf(2.f * g[e]); g[e] = 1.f - 2.f * frcp(ex + 1.f); }
                    v4u o; o.x = pg8::cvt_pk_bf16(g[0], g[1]); o.y = pg8::cvt_pk_bf16(g[2], g[3]); o.z = pg8::cvt_pk_bf16(g[4], g[5]); o.w = pg8::cvt_pk_bf16(g[6], g[7]);
                    *(LAS v4u*)(LWt + j * 64 + pq * 8) = o; }
                const v4u vkeep = pv_;
                bf16x8_t Bw[4][2], Ba[4][2];
#pragma unroll
                for (int nb = 0; nb < 4; ++nb)
#pragma unroll
                    for (int ks = 0; ks < 2; ++ks) { Bw[nb][ks] = *(const bf16x8_t*)(lwt + (size_t)nb * 16 * 64 + 32 * ks); Ba[nb][ks] = *(const bf16x8_t*)(lat + (size_t)nb * 16 * 64 + 32 * ks); }
                if (iter + 1 < 36) S3_PREFETCH(4 * (iter + 1) + pw);
                S3_LDS_FENCE();
                f32x4 accw[4], acca[4];
#pragma unroll
                for (int nb = 0; nb < 4; ++nb) { accw[nb] = (f32x4){0.f, 0.f, 0.f, 0.f}; acca[nb] = (f32x4){0.f, 0.f, 0.f, 0.f}; }
#pragma unroll
                for (int ks = 0; ks < 2; ++ks) {
                    const bf16x8_t aw = *(const LAS bf16x8_t*)(LWt + fr * 64 + 8 * fq + 32 * ks), aa = *(const LAS bf16x8_t*)(LAt + fr * 64 + 8 * fq + 32 * ks);
#pragma unroll
                    for (int nb = 0; nb < 4; ++nb) { accw[nb] = MFMA16(aw, Bw[nb][ks], accw[nb]); acca[nb] = MFMA16(aa, Ba[nb][ks], acca[nb]); }
                }
                float rawk[4][4], rawr[4][4], rnv[4];
#pragma unroll
                for (int i = 0; i < 4; ++i) { rnv[i] = RN[4 * fq + i];
#pragma unroll
                    for (int nb = 0; nb < 4; ++nb) { rawk[nb][i] = bf2f(RK[(4 * fq + i) * 64 + 16 * nb + fr]); rawr[nb][i] = bf2f(RR[(4 * fq + i) * 64 + 16 * nb + fr]); } }
                S3_LDS_FENCE();
                LAS bf16_t* KR = (LAS bf16_t*)(set + S3_KR); LAS bf16_t* BK = (LAS bf16_t*)(set + S3_BD);
                LAS bf16_t* KD = (LAS bf16_t*)(set + S3_KD); LAS bf16_t* BT = (LAS bf16_t*)(set + S3_BT);
#pragma unroll
                for (int nb = 0; nb < 4; ++nb) {
                    float ev[4], kkv[4], bv[4], kdv[4];
#pragma unroll
                    for (int i = 0; i < 4; ++i) {
                        const float wl = accw[nb][i] + w0c[nb], al = acca[nb][i] + a0c[nb];
                        ev[i] = 0.60653065971f * frcp(1.f + __expf(-wl));
                        const float a = frcp(1.f + __expf(-al));
                        const float k = rawk[nb][i];
                        kkv[i] = k * kkc[nb] * rnv[i]; bv[i] = kkv[i] * a; kdv[i] = k * (1.f + (a - 1.f) * kac[nb]); }
                    const float c0 = ev[0], c1 = c0 + ev[1], c2 = c1 + ev[2], c3 = c2 + ev[3];
                    const float T0 = __int_as_float(__builtin_amdgcn_ds_bpermute(fr * 4, __float_as_int(c3))), T1 = __int_as_float(__builtin_amdgcn_ds_bpermute((fr + 16) * 4, __float_as_int(c3))),
                                T2 = __int_as_float(__builtin_amdgcn_ds_bpermute((fr + 32) * 4, __float_as_int(c3)));
                    const float off = (fq > 0 ? T0 : 0.f) + (fq > 1 ? T1 : 0.f) + (fq > 2 ? T2 : 0.f);
                    const float cs[4] = {off + c0, off + c1, off + c2, off + c3};
                    const int colp = 16 * nb + Pfr, c = 16 * nb + fr;
                    float ktl[4], nbet[4];
#pragma unroll
                    for (int i = 0; i < 4; ++i) { const int t = 4 * fq + i;
                        const float E1 = __expf(cs[i]); const float E2 = frcp(E1); const float E3 = E2 * __expf(ev[i]);
                        const float kap = kkv[i] * E3, bet = bv[i] * E1, kt = kdv[i] * E1, rt = rawr[nb][i] * E2;
                        KR[t * 64 + colp] = f2bf_fast(kap); KR[(16 + t) * 64 + colp] = f2bf_fast(rt);
                        BK[t * 64 + colp] = f2bf_fast(bet); BK[(16 + t) * 64 + colp] = f2bf_fast(kt);
                        ktl[i] = kt; nbet[i] = -bet;
                        if (i == 3 && fq == 3) ((LAS float*)(set + S3_PC))[64 + c] = E2; }
                    v2u wk, wb; wk.x = pg8::cvt_pk_bf16(ktl[0], ktl[1]); wk.y = pg8::cvt_pk_bf16(ktl[2], ktl[3]);
                    wb.x = pg8::cvt_pk_bf16(nbet[0], nbet[1]); wb.y = pg8::cvt_pk_bf16(nbet[2], nbet[3]);
                    *(LAS v2u*)(KD + c * 16 + 4 * fq) = wk; *(LAS v2u*)(BT + c * 16 + 4 * fq) = wb;
                }
                S3_LDS_FENCE();
                f32x16_t G;
#pragma unroll
                for (int r = 0; r < 16; ++r) G[r] = 0.f;
                { const int n = lane & 31, hi = lane >> 5;
#pragma unroll
                  for (int ks = 0; ks < 4; ++ks) { const bf16x8_t af = *(const LAS bf16x8_t*)(BK + n * 64 + ks * 16 + 8 * hi), bf = *(const LAS bf16x8_t*)(KR + n * 64 + ks * 16 + 8 * hi); G = MFMA32(af, bf, G); }
                  S3_LDS_FENCE();
                  const int tt = n & 15; const bool isr = n >= 16;
                  float gm[16];
#pragma unroll
                  for (int r = 0; r < 16; ++r) { const int i = (r & 3) + 8 * ((r >> 2) & 1) + 4 * hi; const bool keep = isr ? (i <= tt) : (i < tt); gm[r] = keep ? G[r] : 0.f; }
                  LAS float* Am = (LAS float*)(set + S3_A);
                  if (!isr) {
#pragma unroll
                      for (int r = 0; r < 8; ++r) { const int i = (r & 3) + 8 * (r >> 2) + 4 * hi; Am[i * 16 + tt] = gm[r]; } }
                  { v2u e0, e1; float ge[8];
#pragma unroll
                    for (int r = 0; r < 8; ++r) ge[r] = isr ? -gm[r] : 0.f;
                    e0.x = pg8::cvt_pk_bf16(ge[0], ge[1]); e0.y = pg8::cvt_pk_bf16(ge[2], ge[3]); e1.x = pg8::cvt_pk_bf16(ge[4], ge[5]); e1.y = pg8::cvt_pk_bf16(ge[6], ge[7]);
                    LAS bf16_t* ET = (LAS bf16_t*)(set + S3_ET); *(LAS v2u*)(ET + n * 16 + 4 * hi) = e0; *(LAS v2u*)(ET + n * 16 + 8 + 4 * hi) = e1; }
                  { v2u d0, d1; d0.x = pg8::cvt_pk_bf16(gm[8], gm[9]); d0.y = pg8::cvt_pk_bf16(gm[10], gm[11]); d1.x = pg8::cvt_pk_bf16(gm[12], gm[13]); d1.y = pg8::cvt_pk_bf16(gm[14], gm[15]);
                    LAS bf16_t* BD = (LAS bf16_t*)(set + S3_BD); *(LAS v2u*)(BD + n * 16 + 4 * hi) = d0; *(LAS v2u*)(BD + n * 16 + 8 + 4 * hi) = d1; } }
                { LAS bf16_t* VTt = (LAS bf16_t*)(set + S3_VT); const int jv = lane >> 2, qv = lane & 3;
#pragma unroll
                  for (int e = 0; e < 4; ++e) { const unsigned w = e == 0 ? vkeep.x : e == 1 ? vkeep.y : e == 2 ? vkeep.z : vkeep.w;
                      VTt[(8 * qv + 2 * e) * 16 + jv] = (bf16_t)(w & 0xffffu); VTt[(8 * qv + 2 * e + 1) * 16 + jv] = (bf16_t)(w >> 16); } }
                { const float pcv = ((LAS float*)(set + S3_PC))[64 + lane]; S3_LDS_FENCE(); ((LAS float*)(set + S3_PC))[lane] = pcv; }
            }
#undef S3_PREFETCH
        } else {
            const int ft = tid - 320;
            for (int iter = 0; iter < 38; ++iter) {
                __syncthreads();
                if (iter < 2) continue;
                const int ch = iter - 2, buf = ch & 1;
                if (last && ch < 4) continue;
                for (int idx = ft; idx < 1024; idx += 192) {
                    const int sub = idx >> 8, j = (idx >> 4) & 15, v2 = (idx & 15) * 2;
                    const LAS float* sy = (const LAS float*)(L + S3_SY + (buf * 4 + sub) * S3_SYSUB);
                    const int row = scan3_row(4 * ch + sub, j, dir, b);
                    *(unsigned*)(Y + ((size_t)dir * LR + row) * 512 + h * 64 + half * 32 + v2) = pk2(sy[v2 * 20 + j], sy[(v2 + 1) * 20 + j]);
                }
            }
        }
    }
    __syncthreads();
}

constexpr int S4_KR = 0, S4_BK = 4096, S4_KD = 8192, S4_BT = 10240, S4_VT = 12288, S4_A = 13312, S4_PC = 14336, S4_SET = 14592;
constexpr int S4_SY = 6 * S4_SET, S4_SYSUB = 32 * 20 * 4;
__device__ __forceinline__ void ph_scan4(const Params& p, unsigned char* ldsb, int l, int wg, int nwg) {
    const int tid = otid(), lane = tid & 63;
    const int wv = __builtin_amdgcn_readfirstlane(tid >> 6);
    LAS unsigned char* L = (LAS unsigned char*)ldsb;
    const bf16_t* Z = (const bf16_t*)(p.ws + WS_Z);
    bf16_t* Y = (bf16_t*)(p.ws + WS_Y2);
    const bool last = (l == 1);
    for (int task = wg; task < 256; task += nwg) {
        const int b = task >> 5, h = (task >> 2) & 7, dir = (task >> 1) & 1, half = task & 1;
        __syncthreads();
        if (wv == 0) {
            const int vcol = lane & 31, hi = lane >> 5;
            const int tt = vcol & 15; const bool isr = vcol >= 16;
            f32x16_t st0, st1;
#pragma unroll
            for (int r = 0; r < 16; ++r) { st0[r] = 0.f; st1[r] = 0.f; }
            for (int iter = 0; iter < 50; ++iter) {
                __syncthreads();
                if (iter < 1 || iter > 48) continue;
                const int buf = (iter - 1) & 1;
#pragma unroll 1
                for (int sub = 0; sub < 3; ++sub) {
                    LAS unsigned char* set = L + (buf * 3 + sub) * S4_SET;
                    bf16x8_t krf[4];
#pragma unroll
                    for (int ks = 0; ks < 4; ++ks) krf[ks] = *(const LAS bf16x8_t*)(set + S4_KR + vcol * 128 + (ks * 16 + 8 * hi) * 2);
                    float gm[16];
                    { f32x16_t G;
#pragma unroll
                      for (int r = 0; r < 16; ++r) G[r] = 0.f;
#pragma unroll
                      for (int ks = 0; ks < 4; ++ks) { const bf16x8_t bkf = *(const LAS bf16x8_t*)(set + S4_BK + vcol * 128 + (ks * 16 + 8 * hi) * 2); G = MFMA32(bkf, krf[ks], G); }
#pragma unroll
                      for (int r = 0; r < 16; ++r) { const int i = (r & 3) + 8 * ((r >> 2) & 1) + 4 * hi; const bool keep = isr ? (i <= tt) : (i < tt); gm[r] = keep ? G[r] : 0.f; } }
                    LAS float* Am = (LAS float*)(set + S4_A);
                    if (!isr) {
#pragma unroll
                        for (int r = 0; r < 8; ++r) { const int i = (r & 3) + 8 * (r >> 2) + 4 * hi; Am[i * 16 + tt] = gm[r]; } }
                    bf16x8_t etf, bdf;
                    { v4u w; float ge[8];
#pragma unroll
                      for (int r = 0; r < 8; ++r) ge[r] = isr ? -gm[r] : 0.f;
                      w.x = pg8::cvt_pk_bf16(ge[0], ge[1]); w.y = pg8::cvt_pk_bf16(ge[2], ge[3]); w.z = pg8::cvt_pk_bf16(ge[4], ge[5]); w.w = pg8::cvt_pk_bf16(ge[6], ge[7]); etf = __builtin_bit_cast(bf16x8_t, w);
                      w.x = pg8::cvt_pk_bf16(gm[8], gm[9]); w.y = pg8::cvt_pk_bf16(gm[10], gm[11]); w.z = pg8::cvt_pk_bf16(gm[12], gm[13]); w.w = pg8::cvt_pk_bf16(gm[14], gm[15]); bdf = __builtin_bit_cast(bf16x8_t, w); }
                    bf16x8_t sb[4];
                    { v4u w;
                      w.x = pg8::cvt_pk_bf16(st0[0], st0[1]); w.y = pg8::cvt_pk_bf16(st0[2], st0[3]); w.z = pg8::cvt_pk_bf16(st0[4], st0[5]); w.w = pg8::cvt_pk_bf16(st0[6], st0[7]); sb[0] = __builtin_bit_cast(bf16x8_t, w);
                      w.x = pg8::cvt_pk_bf16(st0[8], st0[9]); w.y = pg8::cvt_pk_bf16(st0[10], st0[11]); w.z = pg8::cvt_pk_bf16(st0[12], st0[13]); w.w = pg8::cvt_pk_bf16(st0[14], st0[15]); sb[1] = __builtin_bit_cast(bf16x8_t, w);
                      w.x = pg8::cvt_pk_bf16(st1[0], st1[1]); w.y = pg8::cvt_pk_bf16(st1[2], st1[3]); w.z = pg8::cvt_pk_bf16(st1[4], st1[5]); w.w = pg8::cvt_pk_bf16(st1[6], st1[7]); sb[2] = __builtin_bit_cast(bf16x8_t, w);
                      w.x = pg8::cvt_pk_bf16(st1[8], st1[9]); w.y = pg8::cvt_pk_bf16(st1[10], st1[11]); w.z = pg8::cvt_pk_bf16(st1[12], st1[13]); w.w = pg8::cvt_pk_bf16(st1[14], st1[15]); sb[3] = __builtin_bit_cast(bf16x8_t, w); }
                    f32x16_t acc;
#pragma unroll
                    for (int r = 0; r < 16; ++r) acc[r] = 0.f;
#pragma unroll
                    for (int ks = 0; ks < 4; ++ks) acc = MFMA32(krf[ks], sb[ks], acc);
                    bf16x8_t vtf;
                    { const v2u a = *(const LAS v2u*)(set + S4_VT + vcol * 32 + 4 * hi * 2), c = *(const LAS v2u*)(set + S4_VT + vcol * 32 + (8 + 4 * hi) * 2); const v4u w = {a.x, a.y, c.x, c.y}; vtf = __builtin_bit_cast(bf16x8_t, w); }
                    acc = MFMA32(bdf, vtf, acc);
                    float rhs[16];
#pragma unroll
                    for (int r = 0; r < 8; ++r) { auto rr = __builtin_amdgcn_permlane32_swap(__float_as_uint(acc[r]), __float_as_uint(acc[r]), false, false);
                        const int t0 = (r & 3) + 8 * (r >> 2); rhs[t0] = __uint_as_float(rr[0]); rhs[t0 + 4] = __uint_as_float(rr[1]); }
                    S3_LDS_FENCE();
                    float u[16];
#pragma unroll
                    for (int i = 0; i < 16; ++i) {
                        u[i] = rhs[i];
                        if (i < 15) {
                            const LAS float* ar = Am + i * 16;
                            const f32x4 a0 = *(const LAS f32x4*)(ar), a1 = *(const LAS f32x4*)(ar + 4), a2 = *(const LAS f32x4*)(ar + 8), a3 = *(const LAS f32x4*)(ar + 12);
                            const float av[16] = {a0[0], a0[1], a0[2], a0[3], a1[0], a1[1], a1[2], a1[3], a2[0], a2[1], a2[2], a2[3], a3[0], a3[1], a3[2], a3[3]};
#pragma unroll
                            for (int t = i + 1; t < 16; ++t) rhs[t] -= u[i] * av[t];
                        }
                    }
                    bf16x8_t ub;
                    { v4u w; w.x = pg8::cvt_pk_bf16(hi ? u[4] : u[0], hi ? u[5] : u[1]); w.y = pg8::cvt_pk_bf16(hi ? u[6] : u[2], hi ? u[7] : u[3]);
                      w.z = pg8::cvt_pk_bf16(hi ? u[12] : u[8], hi ? u[13] : u[9]); w.w = pg8::cvt_pk_bf16(hi ? u[14] : u[10], hi ? u[15] : u[11]); ub = __builtin_bit_cast(bf16x8_t, w); }
                    acc = MFMA32(etf, ub, acc);
                    { LAS float* sy = (LAS float*)(L + S4_SY + (buf * 3 + sub) * S4_SYSUB) + vcol * 20;
                      *(LAS f32x4*)(sy + 4 * hi) = (f32x4){acc[8], acc[9], acc[10], acc[11]};
                      *(LAS f32x4*)(sy + 8 + 4 * hi) = (f32x4){acc[12], acc[13], acc[14], acc[15]}; }
#define S4_FRAG2(base_, row_) ({ const v2u a_ = *(const LAS v2u*)(set + (base_) + (row_) * 32 + 4 * hi * 2), c_ = *(const LAS v2u*)(set + (base_) + (row_) * 32 + (8 + 4 * hi) * 2); const v4u w_ = {a_.x, a_.y, c_.x, c_.y}; __builtin_bit_cast(bf16x8_t, w_); })
                    { const bf16x8_t kd0 = S4_FRAG2(S4_KD, vcol), kd1 = S4_FRAG2(S4_KD, 32 + vcol), bt0 = S4_FRAG2(S4_BT, vcol), bt1 = S4_FRAG2(S4_BT, 32 + vcol);
                      st0 = MFMA32(kd0, vtf, st0); st0 = MFMA32(bt0, ub, st0);
                      st1 = MFMA32(kd1, vtf, st1); st1 = MFMA32(bt1, ub, st1); }
#undef S4_FRAG2
#pragma unroll
                    for (int g = 0; g < 4; ++g) {
                        const f32x4 p0 = *(const LAS f32x4*)((const LAS float*)(set + S4_PC) + 8 * g + 4 * hi), p1 = *(const LAS f32x4*)((const LAS float*)(set + S4_PC) + 32 + 8 * g + 4 * hi);
#pragma unroll
                        for (int e = 0; e < 4; ++e) { st0[4 * g + e] *= p0[e]; st1[4 * g + e] *= p1[e]; }
                    }
                }
            }
        } else if (wv <= 6) {
            const int fr = lane & 15, fq = lane >> 4, hp = wv - 1, sub = hp >> 1, chh = hp & 1;
            float w0c[2], a0c[2], kac[2], kkc4[4];
            bf16x8_t Bw[2][2], Ba[2][2];
#pragma unroll
            for (int nb = 0; nb < 4; ++nb) kkc4[nb] = p.rw_k_k[l * 512 + h * 64 + nb * 16 + fr];
#pragma unroll
            for (int q = 0; q < 2; ++q) { const int cch = h * 64 + (2 * chh + q) * 16 + fr;
                w0c[q] = p.rw_w0[(l * 2 + dir) * 512 + cch]; a0c[q] = p.rw_a0[(l * 2 + dir) * 512 + cch]; kac[q] = p.rw_k_a[l * 512 + cch];
#pragma unroll
                for (int ks = 0; ks < 2; ++ks) {
                    Bw[q][ks] = *(const bf16x8_t*)((const bf16_t*)(p.ws + WS_LW_T) + ((size_t)(dir * 512 + cch) * 64 + 8 * fq + 32 * ks));
                    Ba[q][ks] = *(const bf16x8_t*)((const bf16_t*)(p.ws + WS_LA_T) + ((size_t)(dir * 512 + cch) * 64 + 8 * fq + 32 * ks)); } }
            const int Pfr = (fr & 3) | ((fr & 4) << 1) | ((fr & 8) >> 1);
            v4u plw[2], pla[2]; bf16_t pk[4][4], pr[2][4];
#define S4_PREFETCH(sc_) do { const bf16_t* za_ = Z + (size_t)scan3_row((sc_), fr, dir, b) * ZC; \
                _Pragma("unroll") for (int ks_ = 0; ks_ < 2; ++ks_) { plw[ks_] = *(const v4u*)(za_ + C_LW + dir * 64 + 8 * fq + 32 * ks_); pla[ks_] = *(const v4u*)(za_ + C_LA + dir * 64 + 8 * fq + 32 * ks_); } \
                _Pragma("unroll") for (int i_ = 0; i_ < 4; ++i_) { const bf16_t* zt_ = Z + (size_t)scan3_row((sc_), 4 * fq + i_, dir, b) * ZC; \
                    _Pragma("unroll") for (int nb_ = 0; nb_ < 4; ++nb_) pk[nb_][i_] = zt_[C_K + h * 64 + nb_ * 16 + fr]; \
                    _Pragma("unroll") for (int q_ = 0; q_ < 2; ++q_) pr[q_][i_] = zt_[C_R + h * 64 + (2 * chh + q_) * 16 + fr]; } } while (0)
            S4_PREFETCH(sub);
            for (int iter = 0; iter < 50; ++iter) {
                __syncthreads();
                if (iter >= 48) continue;
                LAS unsigned char* set = L + ((iter & 1) * 3 + sub) * S4_SET;
                bf16x8_t aw[2], aa[2];
#pragma unroll
                for (int ks = 0; ks < 2; ++ks) { float g[8]; unpack8(plw[ks], g);
#pragma unroll
                    for (int e = 0; e < 8; ++e) { const float ex = __expf(2.f * g[e]); g[e] = 1.f - 2.f * frcp(ex + 1.f); }
                    v4u o; o.x = pg8::cvt_pk_bf16(g[0], g[1]); o.y = pg8::cvt_pk_bf16(g[2], g[3]); o.z = pg8::cvt_pk_bf16(g[4], g[5]); o.w = pg8::cvt_pk_bf16(g[6], g[7]);
                    aw[ks] = __builtin_bit_cast(bf16x8_t, o); aa[ks] = __builtin_bit_cast(bf16x8_t, pla[ks]); }
                float kf[4][4], rf[2][4];
#pragma unroll
                for (int i = 0; i < 4; ++i) {
#pragma unroll
                    for (int nb = 0; nb < 4; ++nb) kf[nb][i] = bf2f(pk[nb][i]);
#pragma unroll
                    for (int q = 0; q < 2; ++q) rf[q][i] = bf2f(pr[q][i]); }
                if (iter + 1 < 48) S4_PREFETCH(3 * (iter + 1) + sub);
                f32x4 accw[2], acca[2];
#pragma unroll
                for (int q = 0; q < 2; ++q) { accw[q] = (f32x4){0.f, 0.f, 0.f, 0.f}; acca[q] = (f32x4){0.f, 0.f, 0.f, 0.f}; }
#pragma unroll
                for (int ks = 0; ks < 2; ++ks)
#pragma unroll
                    for (int q = 0; q < 2; ++q) { accw[q] = MFMA16(aw[ks], Bw[q][ks], accw[q]); acca[q] = MFMA16(aa[ks], Ba[q][ks], acca[q]); }
                float rnv[4];
#pragma unroll
                for (int i = 0; i < 4; ++i) { float ss = 0.f;
#pragma unroll
                    for (int nb = 0; nb < 4; ++nb) { const float t_ = kf[nb][i] * kkc4[nb]; ss += t_ * t_; }
                    rnv[i] = rsqrtf(fmaxf(row16_sum(ss), 1e-12f)); }
                LAS bf16_t* KR = (LAS bf16_t*)(set + S4_KR); LAS bf16_t* BK = (LAS bf16_t*)(set + S4_BK);
                LAS bf16_t* KD = (LAS bf16_t*)(set + S4_KD); LAS bf16_t* BT = (LAS bf16_t*)(set + S4_BT);
#pragma unroll
                for (int q = 0; q < 2; ++q) { const int nb = 2 * chh + q;
                    float ev[4], kkv[4], bv[4], kdv[4];
#pragma unroll
                    for (int i = 0; i < 4; ++i) {
                        const float wl = accw[q][i] + w0c[q], al = acca[q][i] + a0c[q];
                        ev[i] = 0.60653065971f * frcp(1.f + __expf(-wl));
                        const float a = frcp(1.f + __expf(-al));
                        const float k = kf[nb][i];
                        kkv[i] = k * kkc4[nb] * rnv[i]; bv[i] = kkv[i] * a; kdv[i] = k * (1.f + (a - 1.f) * kac[q]); }
                    const float c0 = ev[0], c1 = c0 + ev[1], c2 = c1 + ev[2], c3 = c2 + ev[3];
                    const float T0 = __int_as_float(__builtin_amdgcn_ds_bpermute(fr * 4, __float_as_int(c3))), T1 = __int_as_float(__builtin_amdgcn_ds_bpermute((fr + 16) * 4, __float_as_int(c3))),
                                T2 = __int_as_float(__builtin_amdgcn_ds_bpermute((fr + 32) * 4, __float_as_int(c3)));
                    const float off = (fq > 0 ? T0 : 0.f) + (fq > 1 ? T1 : 0.f) + (fq > 2 ? T2 : 0.f);
                    const float cs[4] = {off + c0, off + c1, off + c2, off + c3};
                    const int colp = 16 * nb + Pfr, c = 16 * nb + fr;
                    float ktl[4], nbet[4];
#pragma unroll
                    for (int i = 0; i < 4; ++i) { const int t = 4 * fq + i;
                        const float E1 = __expf(cs[i]); const float E2 = frcp(E1); const float E3 = E2 * __expf(ev[i]);
                        const float kap = kkv[i] * E3, bet = bv[i] * E1, kt = kdv[i] * E1, rt = rf[q][i] * E2;
                        KR[t * 64 + colp] = f2bf_fast(kap); KR[(16 + t) * 64 + colp] = f2bf_fast(rt);
                        BK[t * 64 + colp] = f2bf_fast(bet); BK[(16 + t) * 64 + colp] = f2bf_fast(kt);
                        ktl[i] = kt; nbet[i] = -bet;
                        if (i == 3 && fq == 3) ((LAS float*)(set + S4_PC))[c] = E2; }
                    v2u wk, wb; wk.x = pg8::cvt_pk_bf16(ktl[0], ktl[1]); wk.y = pg8::cvt_pk_bf16(ktl[2], ktl[3]);
                    wb.x = pg8::cvt_pk_bf16(nbet[0], nbet[1]); wb.y = pg8::cvt_pk_bf16(nbet[2], nbet[3]);
                    *(LAS v2u*)(KD + c * 16 + 4 * fq) = wk; *(LAS v2u*)(BT + c * 16 + 4 * fq) = wb;
                }
            }
#undef S4_PREFETCH
        } else {
            const int jv = lane >> 2, qv = lane & 3;
            v4u pv[3];
#define S4_PREFV(ch_) do { _Pragma("unroll") for (int s_ = 0; s_ < 3; ++s_) pv[s_] = *(const v4u*)(Z + (size_t)scan3_row(3 * (ch_) + s_, jv, dir, b) * ZC + C_V + h * 64 + half * 32 + qv * 8); } while (0)
            S4_PREFV(0);
            for (int iter = 0; iter < 50; ++iter) {
                __syncthreads();
                if (iter < 48) {
#pragma unroll
                    for (int s_ = 0; s_ < 3; ++s_) { LAS bf16_t* VTt = (LAS bf16_t*)(L + ((iter & 1) * 3 + s_) * S4_SET + S4_VT);
#pragma unroll
                        for (int e = 0; e < 4; ++e) { const unsigned w = e == 0 ? pv[s_].x : e == 1 ? pv[s_].y : e == 2 ? pv[s_].z : pv[s_].w;
                            VTt[(8 * qv + 2 * e) * 16 + jv] = (bf16_t)(w & 0xffffu); VTt[(8 * qv + 2 * e + 1) * 16 + jv] = (bf16_t)(w >> 16); } }
                    if (iter + 1 < 48) S4_PREFV(iter + 1);
                }
                if (iter >= 2) {
                    const int ch = iter - 2, buf = ch & 1;
                    for (int idx = lane; idx < 768; idx += 64) {
                        const int s_ = idx >> 8, j = (idx >> 4) & 15, v2 = (idx & 15) * 2; const int sc = 3 * ch + s_;
                        if (last && sc < 16) continue;
                        const LAS float* sy = (const LAS float*)(L + S4_SY + (buf * 3 + s_) * S4_SYSUB);
                        const int row = scan3_row(sc, j, dir, b);
                        *(unsigned*)(Y + ((size_t)dir * LR + row) * 512 + h * 64 + half * 32 + v2) = pk2(sy[v2 * 20 + j], sy[(v2 + 1) * 20 + j]);
                    }
                }
            }
#undef S4_PREFV
        }
    }
    __syncthreads();
}

constexpr int S5_KR = 0, S5_BK = 4608, S5_KD = 9216, S5_BT = 11776, S5_VT = 14336, S5_A = 16896, S5_PC = 18944, S5_SET = 19200;
constexpr int S5_SY = 6 * S5_SET, S5_SYSUB = 32 * 20 * 4;
__device__ __forceinline__ void ph_scan5(const Params& p, unsigned char* ldsb, int l, int wg, int nwg) {
    const int tid = otid(), lane = tid & 63;
    const int wv = __builtin_amdgcn_readfirstlane(tid >> 6);
    LAS unsigned char* L = (LAS unsigned char*)ldsb;
    const bf16_t* Z = (const bf16_t*)(p.ws + WS_Z);
    bf16_t* Y = (bf16_t*)(p.ws + WS_Y2);
    const bool last = (l == 1);
    for (int task = wg; task < 128; task += nwg) {
        const int b = task >> 4, h = (task >> 1) & 7, dir = task & 1;
        __syncthreads();
        if (wv <= 1) {
            const int half = wv;
            const int lane_c = otid() & 63;
            const int vcol = lane_c & 31, hi = lane_c >> 5;
            const int tt = vcol & 15; const bool isr = vcol >= 16;
            f32x16_t st0, st1;
#pragma unroll
            for (int r = 0; r < 16; ++r) { st0[r] = 0.f; st1[r] = 0.f; }
            for (int iter = 0; iter < 50; ++iter) {
                __syncthreads();
                if (iter < 1 || iter > 48) continue;
                const int buf = (iter - 1) & 1;
                bf16x8_t etf3[3], bdf3[3];
                int tto = tt; asm volatile("" : "+v"(tto));
#pragma unroll
                for (int sub = 0; sub < 3; ++sub) {
                    LAS unsigned char* set = L + (buf * 3 + sub) * S5_SET;
                    float gm[16];
                    { f32x16_t G;
#pragma unroll
                      for (int r = 0; r < 16; ++r) G[r] = 0.f;
#pragma unroll
                      for (int ks = 0; ks < 4; ++ks) { const bf16x8_t kq = *(const LAS bf16x8_t*)(set + S5_KR + vcol * 144 + (ks * 16 + 8 * hi) * 2), bkf = *(const LAS bf16x8_t*)(set + S5_BK + vcol * 144 + (ks * 16 + 8 * hi) * 2); G = MFMA32(bkf, kq, G); }
#pragma unroll
                      for (int r = 0; r < 16; ++r) { const int i = (r & 3) + 8 * ((r >> 2) & 1) + 4 * hi; const bool keep = isr ? (i <= tto) : (i < tto); gm[r] = keep ? G[r] : 0.f; } }
                    LAS float* Am = (LAS float*)(set + S5_A + half * 1024);
                    if (!isr) {
#pragma unroll
                        for (int r = 0; r < 8; ++r) { const int i = (r & 3) + 8 * (r >> 2) + 4 * hi; Am[i * 16 + tt] = gm[r]; } }
                    { v4u w; float ge[8];
#pragma unroll
                      for (int r = 0; r < 8; ++r) ge[r] = isr ? -gm[r] : 0.f;
                      w.x = pg8::cvt_pk_bf16(ge[0], ge[1]); w.y = pg8::cvt_pk_bf16(ge[2], ge[3]); w.z = pg8::cvt_pk_bf16(ge[4], ge[5]); w.w = pg8::cvt_pk_bf16(ge[6], ge[7]); etf3[sub] = __builtin_bit_cast(bf16x8_t, w);
                      w.x = pg8::cvt_pk_bf16(gm[8], gm[9]); w.y = pg8::cvt_pk_bf16(gm[10], gm[11]); w.z = pg8::cvt_pk_bf16(gm[12], gm[13]); w.w = pg8::cvt_pk_bf16(gm[14], gm[15]); bdf3[sub] = __builtin_bit_cast(bf16x8_t, w); }
                }
                S3_LDS_FENCE();
#pragma unroll 1
                for (int sub = 0; sub < 3; ++sub) {
                    LAS unsigned char* set = L + (buf * 3 + sub) * S5_SET;
                    bf16x8_t krf[4];
#pragma unroll
                    for (int ks = 0; ks < 4; ++ks) krf[ks] = *(const LAS bf16x8_t*)(set + S5_KR + vcol * 144 + (ks * 16 + 8 * hi) * 2);
                    LAS float* Am = (LAS float*)(set + S5_A + half * 1024);
                    const bf16x8_t etf = sub == 0 ? etf3[0] : sub == 1 ? etf3[1] : etf3[2], bdf = sub == 0 ? bdf3[0] : sub == 1 ? bdf3[1] : bdf3[2];
                    bf16x8_t sb[4];
                    { v4u w;
                      w.x = pg8::cvt_pk_bf16(st0[0], st0[1]); w.y = pg8::cvt_pk_bf16(st0[2], st0[3]); w.z = pg8::cvt_pk_bf16(st0[4], st0[5]); w.w = pg8::cvt_pk_bf16(st0[6], st0[7]); sb[0] = __builtin_bit_cast(bf16x8_t, w);
                      w.x = pg8::cvt_pk_bf16(st0[8], st0[9]); w.y = pg8::cvt_pk_bf16(st0[10], st0[11]); w.z = pg8::cvt_pk_bf16(st0[12], st0[13]); w.w = pg8::cvt_pk_bf16(st0[14], st0[15]); sb[1] = __builtin_bit_cast(bf16x8_t, w);
                      w.x = pg8::cvt_pk_bf16(st1[0], st1[1]); w.y = pg8::cvt_pk_bf16(st1[2], st1[3]); w.z = pg8::cvt_pk_bf16(st1[4], st1[5]); w.w = pg8::cvt_pk_bf16(st1[6], st1[7]); sb[2] = __builtin_bit_cast(bf16x8_t, w);
                      w.x = pg8::cvt_pk_bf16(st1[8], st1[9]); w.y = pg8::cvt_pk_bf16(st1[10], st1[11]); w.z = pg8::cvt_pk_bf16(st1[12], st1[13]); w.w = pg8::cvt_pk_bf16(st1[14], st1[15]); sb[3] = __builtin_bit_cast(bf16x8_t, w); }
                    f32x16_t acc;
#pragma unroll
                    for (int r = 0; r < 16; ++r) acc[r] = 0.f;
#pragma unroll
                    for (int ks = 0; ks < 4; ++ks) acc = MFMA32(krf[ks], sb[ks], acc);
#define S5_FRAG2(base_, row_) ({ const v2u a_ = *(const LAS v2u*)(set + (base_) + (row_) * 40 + 4 * hi * 2), c_ = *(const LAS v2u*)(set + (base_) + (row_) * 40 + (8 + 4 * hi) * 2); const v4u w_ = {a_.x, a_.y, c_.x, c_.y}; __builtin_bit_cast(bf16x8_t, w_); })
                    const bf16x8_t vtf = S5_FRAG2(S5_VT, half * 32 + vcol);
                    acc = MFMA32(bdf, vtf, acc);
                    float rhs[16];
#pragma unroll
                    for (int r = 0; r < 8; ++r) { auto rr = __builtin_amdgcn_permlane32_swap(__float_as_uint(acc[r]), __float_as_uint(acc[r]), false, false);
                        const int t0 = (r & 3) + 8 * (r >> 2); rhs[t0] = __uint_as_float(rr[0]); rhs[t0 + 4] = __uint_as_float(rr[1]); }
                    S3_LDS_FENCE();
                    float u[16];
#pragma unroll
                    for (int i = 0; i < 16; ++i) {
                        u[i] = rhs[i];
                        if (i < 15) {
                            const LAS float* ar = Am + i * 16;
                            const f32x4 a0 = *(const LAS f32x4*)(ar), a1 = *(const LAS f32x4*)(ar + 4), a2 = *(const LAS f32x4*)(ar + 8), a3 = *(const LAS f32x4*)(ar + 12);
                            const float av[16] = {a0[0], a0[1], a0[2], a0[3], a1[0], a1[1], a1[2], a1[3], a2[0], a2[1], a2[2], a2[3], a3[0], a3[1], a3[2], a3[3]};
#pragma unroll
                            for (int t = i + 1; t < 16; ++t) rhs[t] -= u[i] * av[t];
                        }
                    }
                    bf16x8_t ub;
                    { v4u w; w.x = pg8::cvt_pk_bf16(hi ? u[4] : u[0], hi ? u[5] : u[1]); w.y = pg8::cvt_pk_bf16(hi ? u[6] : u[2], hi ? u[7] : u[3]);
                      w.z = pg8::cvt_pk_bf16(hi ? u[12] : u[8], hi ? u[13] : u[9]); w.w = pg8::cvt_pk_bf16(hi ? u[14] : u[10], hi ? u[15] : u[11]); ub = __builtin_bit_cast(bf16x8_t, w); }
                    acc = MFMA32(etf, ub, acc);
                    { LAS float* sy = (LAS float*)(L + S5_SY + ((buf * 3 + sub) * 2 + half) * S5_SYSUB) + vcol * 20;
                      *(LAS f32x4*)(sy + 4 * hi) = (f32x4){acc[8], acc[9], acc[10], acc[11]};
                      *(LAS f32x4*)(sy + 8 + 4 * hi) = (f32x4){acc[12], acc[13], acc[14], acc[15]}; }
                    { const bf16x8_t kd0 = S5_FRAG2(S5_KD, vcol), kd1 = S5_FRAG2(S5_KD, 32 + vcol), bt0 = S5_FRAG2(S5_BT, vcol), bt1 = S5_FRAG2(S5_BT, 32 + vcol);
                      st0 = MFMA32(kd0, vtf, st0); st0 = MFMA32(bt0, ub, st0);
                      st1 = MFMA32(kd1, vtf, st1); st1 = MFMA32(bt1, ub, st1); }
#undef S5_FRAG2
#pragma unroll
                    for (int g = 0; g < 4; ++g) {
                        const f32x4 p0 = *(const LAS f32x4*)((const LAS float*)(set + S5_PC) + 8 * g + 4 * hi), p1 = *(const LAS f32x4*)((const LAS float*)(set + S5_PC) + 32 + 8 * g + 4 * hi);
#pragma unroll
                        for (int e = 0; e < 4; ++e) { st0[4 * g + e] *= p0[e]; st1[4 * g + e] *= p1[e]; }
                    }
                }
            }
        } else {
            const int lane = otid() & 63;
            const int fr = lane & 15, fq = lane >> 4, hp = wv - 2, sub = hp >> 1, chh = hp & 1;
            float w0c[2], a0c[2], kac[2], kkc4[4];
            bf16x8_t Bw[2][2], Ba[2][2];
#pragma unroll
            for (int nb = 0; nb < 4; ++nb) kkc4[nb] = p.rw_k_k[l * 512 + h * 64 + nb * 16 + fr];
#pragma unroll
            for (int q = 0; q < 2; ++q) { const int cch = h * 64 + (2 * chh + q) * 16 + fr;
                w0c[q] = p.rw_w0[(l * 2 + dir) * 512 + cch]; a0c[q] = p.rw_a0[(l * 2 + dir) * 512 + cch]; kac[q] = p.rw_k_a[l * 512 + cch];
#pragma unroll
                for (int ks = 0; ks < 2; ++ks) {
                    Bw[q][ks] = *(const bf16x8_t*)((const bf16_t*)(p.ws + WS_LW_T) + ((size_t)(dir * 512 + cch) * 64 + 8 * fq + 32 * ks));
                    Ba[q][ks] = *(const bf16x8_t*)((const bf16_t*)(p.ws + WS_LA_T) + ((size_t)(dir * 512 + cch) * 64 + 8 * fq + 32 * ks)); } }
            const int Pfr = (fr & 3) | ((fr & 4) << 1) | ((fr & 8) >> 1);
            const int jv = lane >> 2, qv = lane & 3;
            v4u plw[2], pla[2], pvv, pkf[2], prf;
            bf16x8_t Idm[2];
#pragma unroll
            for (int o_ = 0; o_ < 2; ++o_) { const int jsel = 16 * o_ + fr - 8 * fq; v4u w = {0u, 0u, 0u, 0u};
                if (jsel >= 0 && jsel < 8) { const unsigned one = (jsel & 1) ? 0x3f800000u : 0x00003f80u; if ((jsel >> 1) == 0) w.x = one; else if ((jsel >> 1) == 1) w.y = one; else if ((jsel >> 1) == 2) w.z = one; else w.w = one; }
                Idm[o_] = __builtin_bit_cast(bf16x8_t, w); }
#define S5_PREFETCH(sc_) do { const bf16_t* za_ = Z + (size_t)scan3_row((sc_), fr, dir, b) * ZC; \
                _Pragma("unroll") for (int ks_ = 0; ks_ < 2; ++ks_) { plw[ks_] = *(const v4u*)(za_ + C_LW + dir * 64 + 8 * fq + 32 * ks_); pla[ks_] = *(const v4u*)(za_ + C_LA + dir * 64 + 8 * fq + 32 * ks_); \
                    pkf[ks_] = *(const v4u*)(za_ + C_K + h * 64 + 8 * fq + 32 * ks_); } \
                prf = *(const v4u*)(za_ + C_R + h * 64 + 8 * fq + 32 * chh); \
                pvv = *(const v4u*)(Z + (size_t)scan3_row((sc_), jv, dir, b) * ZC + C_V + h * 64 + chh * 32 + qv * 8); } while (0)
            S5_PREFETCH(sub);
            for (int iter = 0; iter < 50; ++iter) {
                __syncthreads();
                if (iter >= 2) {
                    const int ch = iter - 2, buf = ch & 1, sc = 3 * ch + sub;
                    if (!(last && sc < 16)) {
                        const LAS float* sy = (const LAS float*)(L + S5_SY + ((buf * 3 + sub) * 2 + chh) * S5_SYSUB);
#pragma unroll
                        for (int k4 = 0; k4 < 4; ++k4) { const int idx = lane + 64 * k4, j = idx >> 4, v2 = (idx & 15) * 2;
                            const int row = scan3_row(sc, j, dir, b);
                            *(unsigned*)(Y + ((size_t)dir * LR + row) * 512 + h * 64 + chh * 32 + v2) = pk2(sy[v2 * 20 + j], sy[(v2 + 1) * 20 + j]); }
                    }
                }
                if (iter >= 48) continue;
                LAS unsigned char* set = L + ((iter & 1) * 3 + sub) * S5_SET;
                bf16x8_t aw[2], aa[2];
#pragma unroll
                for (int ks = 0; ks < 2; ++ks) { aw[ks] = __builtin_bit_cast(bf16x8_t, plw[ks]); aa[ks] = __builtin_bit_cast(bf16x8_t, pla[ks]); }
                f32x4 kf[4], rf[2];
                { const f32x4 z4 = {0.f, 0.f, 0.f, 0.f};
#pragma unroll
                  for (int nb = 0; nb < 4; ++nb) kf[nb] = MFMA16(__builtin_bit_cast(bf16x8_t, pkf[nb >> 1]), Idm[nb & 1], z4);
#pragma unroll
                  for (int q = 0; q < 2; ++q) rf[q] = MFMA16(__builtin_bit_cast(bf16x8_t, prf), Idm[q], z4); }
                { LAS bf16_t* VTt = (LAS bf16_t*)(set + S5_VT);
#pragma unroll
                  for (int e = 0; e < 4; ++e) { const unsigned w = e == 0 ? pvv.x : e == 1 ? pvv.y : e == 2 ? pvv.z : pvv.w;
                      VTt[(chh * 32 + 8 * qv + 2 * e) * 20 + jv] = (bf16_t)(w & 0xffffu); VTt[(chh * 32 + 8 * qv + 2 * e + 1) * 20 + jv] = (bf16_t)(w >> 16); } }
                if (iter + 1 < 48) S5_PREFETCH(3 * (iter + 1) + sub);
                f32x4 accw[2], acca[2];
#pragma unroll
                for (int q = 0; q < 2; ++q) { accw[q] = (f32x4){0.f, 0.f, 0.f, 0.f}; acca[q] = (f32x4){0.f, 0.f, 0.f, 0.f}; }
#pragma unroll
                for (int ks = 0; ks < 2; ++ks)
#pragma unroll
                    for (int q = 0; q < 2; ++q) { accw[q] = MFMA16(aw[ks], Bw[q][ks], accw[q]); acca[q] = MFMA16(aa[ks], Ba[q][ks], acca[q]); }
                float rnv[4];
#pragma unroll
                for (int i = 0; i < 4; ++i) { float ss = 0.f;
#pragma unroll
                    for (int nb = 0; nb < 4; ++nb) { const float t_ = kf[nb][i] * kkc4[nb]; ss += t_ * t_; }
                    rnv[i] = rsqrtf(fmaxf(row16_sum(ss), 1e-12f)); }
                LAS bf16_t* KR = (LAS bf16_t*)(set + S5_KR); LAS bf16_t* BK = (LAS bf16_t*)(set + S5_BK);
                LAS bf16_t* KD = (LAS bf16_t*)(set + S5_KD); LAS bf16_t* BT = (LAS bf16_t*)(set + S5_BT);
#pragma unroll
                for (int q = 0; q < 2; ++q) { const int nb = 2 * chh + q;
                    float ev[4], kkv[4], bv[4], kdv[4];
#pragma unroll
                    for (int i = 0; i < 4; ++i) {
                        const float wl = accw[q][i] + w0c[q], al = acca[q][i] + a0c[q];
                        ev[i] = 0.60653065971f * frcp(1.f + __expf(-wl));
                        const float a = frcp(1.f + __expf(-al));
                        const float k = kf[nb][i];
                        kkv[i] = k * kkc4[nb] * rnv[i]; bv[i] = kkv[i] * a; kdv[i] = k * (1.f + (a - 1.f) * kac[q]); }
                    const float c0 = ev[0], c1 = c0 + ev[1], c2 = c1 + ev[2], c3 = c2 + ev[3];
                    const float T0 = __int_as_float(__builtin_amdgcn_ds_bpermute(fr * 4, __float_as_int(c3))), T1 = __int_as_float(__builtin_amdgcn_ds_bpermute((fr + 16) * 4, __float_as_int(c3))),
                                T2 = __int_as_float(__builtin_amdgcn_ds_bpermute((fr + 32) * 4, __float_as_int(c3)));
                    const float off = (fq > 0 ? T0 : 0.f) + (fq > 1 ? T1 : 0.f) + (fq > 2 ? T2 : 0.f);
                    const float cs[4] = {off + c0, off + c1, off + c2, off + c3};
                    const int colp = 16 * nb + Pfr, c = 16 * nb + fr;
                    float ktl[4], nbet[4];
                    float E2p = 0.f;
#pragma unroll
                    for (int i = 0; i < 4; ++i) { const int t = 4 * fq + i;
                        const float E1 = __expf(cs[i]); const float E2 = frcp(E1); const float E3 = (i == 0) ? E2 * __expf(ev[0]) : E2p; E2p = E2;
                        const float kap = kkv[i] * E3, bet = bv[i] * E1, kt = kdv[i] * E1, rt = rf[q][i] * E2;
                        KR[t * 72 + colp] = f2bf_fast(kap); KR[(16 + t) * 72 + colp] = f2bf_fast(rt);
                        BK[t * 72 + colp] = f2bf_fast(bet); BK[(16 + t) * 72 + colp] = f2bf_fast(kt);
                        ktl[i] = kt; nbet[i] = -bet;
                        if (i == 3 && fq == 3) ((LAS float*)(set + S5_PC))[c] = E2; }
                    v2u wk, wb; wk.x = pg8::cvt_pk_bf16(ktl[0], ktl[1]); wk.y = pg8::cvt_pk_bf16(ktl[2], ktl[3]);
                    wb.x = pg8::cvt_pk_bf16(nbet[0], nbet[1]); wb.y = pg8::cvt_pk_bf16(nbet[2], nbet[3]);
                    *(LAS v2u*)(KD + c * 20 + 4 * fq) = wk; *(LAS v2u*)(BT + c * 20 + 4 * fq) = wb;
                }
            }
#undef S5_PREFETCH
        }
    }
    __syncthreads();
}
__device__ __forceinline__ void na_block(const bf16_t* kbase, const bf16x8_t (&qf)[2], bool lat, int dr31, int c0, int jq, int cs, const LAS float* rp,
                                         int fr, int fq, float (&pv)[4], float& lsum) {
    const bf16x8_t k0 = *(const bf16x8_t*)(kbase + (size_t)fr * ZC + 8 * fq), k1 = *(const bf16x8_t*)(kbase + (size_t)fr * ZC + 8 * fq + 32);
    float ss = 0.f;
#pragma unroll
    for (int e = 0; e < 8; ++e) { const float a = bf2f((bf16_t)k0[e]), b = bf2f((bf16_t)k1[e]); ss += a * a + b * b; }
    ss += swz_xor<16>(ss); ss = xor32_add(ss);
    const float rk = rsqrtf(ss * (1.f / 64.f) + RMS_EPS);
    f32x4 st = {0.f, 0.f, 0.f, 0.f};
    st = __builtin_amdgcn_mfma_f32_16x16x32_bf16(k0, qf[0], st, 0, 0, 0);
    st = __builtin_amdgcn_mfma_f32_16x16x32_bf16(k1, qf[1], st, 0, 0, 0);
#pragma unroll
    for (int i = 0; i < 4; ++i) {
        const float rki = __int_as_float(__builtin_amdgcn_ds_bpermute((4 * fq + i) * 4, __float_as_int(rk)));
        float x = st[i] * rki;
        if (lat) { const int c = c0 + 4 * fq + i; const bool valid = (c >= cs) && (c < cs + 16);
            const int di = min(max(c - jq + 15, 0), 30);
            x = valid ? __expf(fminf(x + rp[dr31 + di], 80.f)) : 0.f; }
        else x = __expf(fminf(x, 80.f));
        pv[i] = x; lsum += x;
    }
}
__device__ __forceinline__ void ph_natt2(const Params& p, unsigned char* ldsb, int l, int wg, int nwg) {
    const int tid = otid(), lane = tid & 63, wv = tid >> 6, fr = lane & 15, fq = lane >> 4;
    LAS float* rp = (LAS float*)ldsb + wv * 512;
    const bf16_t* Z = (const bf16_t*)(p.ws + WS_Z); const bf16_t* VT = (const bf16_t*)(p.ws + WS_VT); bf16_t* YB = (bf16_t*)(p.ws + WS_YB);
    const bool last = (l == 1);
    const int nunits = last ? 8192 : 9216;
    float gsc[2][8];
#pragma unroll
    for (int ks = 0; ks < 2; ++ks)
#pragma unroll
        for (int j = 0; j < 8; ++j) { const int d = 8 * fq + j + 32 * ks; gsc[ks][j] = p.na_q_g[l * 64 + d] * p.na_k_g[l * 64 + d] * 0.125f; }
    int cur_h = -1;
    for (int unit = wg * 8 + wv; unit < nunits; unit += nwg * 8) {
        int b, h, i = 0, qb, qrow0; bool isl;
        if (unit < 8192) { b = unit >> 10; h = (unit >> 7) & 7; i = (unit >> 2) & 31; qb = unit & 3; isl = true; qrow0 = b * SEQ + i * 64 + qb * 16; }
        else { const int u2 = unit - 8192; b = u2 >> 7; h = (u2 >> 4) & 7; qb = u2 & 15; isl = false; qrow0 = NLAT + b * CTXL + qb * 16; }
        if (h != cur_h) { for (int idx = lane; idx < 465; idx += 64) rp[idx] = p.na_rpb[(size_t)(l * 8 + h) * 465 + idx]; cur_h = h; }
        bf16x8_t qf[2];
        { const bf16_t* qp = Z + (size_t)(qrow0 + fr) * ZC + C_Q + h * 64 + 8 * fq;
          const bf16x8_t q0 = *(const bf16x8_t*)qp, q1 = *(const bf16x8_t*)(qp + 32);
          float f0[8], f1[8]; float ss = 0.f;
#pragma unroll
          for (int e = 0; e < 8; ++e) { f0[e] = bf2f((bf16_t)q0[e]); f1[e] = bf2f((bf16_t)q1[e]); ss += f0[e] * f0[e] + f1[e] * f1[e]; }
          ss += swz_xor<16>(ss); ss = xor32_add(ss);
          const float rq = rsqrtf(ss * (1.f / 64.f) + RMS_EPS);
#pragma unroll
          for (int e = 0; e < 8; ++e) { qf[0][e] = (short)f2bf(f0[e] * rq * gsc[0][e]); qf[1][e] = (short)f2bf(f1[e] * rq * gsc[1][e]); } }
        f32x4 o[4];
#pragma unroll
        for (int db = 0; db < 4; ++db) o[db] = (f32x4){0.f, 0.f, 0.f, 0.f};
        float lsum = 0.f;
        const bf16_t* vtb = VT + ((size_t)((b * 8 + h) * 64 + fr)) * 2304 + 4 * fq;
        const int jq = qb * 16 + fr, cs = min(max(jq - 8, 0), 48);
        const int r0 = min(max(i - 4, 0), 24);
        const int kb_lo = (qb <= 1) ? 0 : qb - 1, nkb = (qb == 0 || qb == 3) ? 2 : 3;
        const int nlat = isl ? 8 * nkb : 0, ntot = nlat + 16;
        for (int t = 0; t < ntot; t += 2) {
            float pa[4], pb[4]; int tposA, tposB;
            { const int tt = t; const bool lt = tt < nlat; int krow, dr31 = 0, c0 = 0;
              if (lt) { const int a = tt / nkb, kb = kb_lo + tt % nkb; krow = b * SEQ + (r0 + a) * 64 + 16 * kb; tposA = 256 + (r0 + a) * 64 + 16 * kb; dr31 = (r0 + a - i + 7) * 31; c0 = 16 * kb; }
              else { const int cbk = tt - nlat; krow = NLAT + b * CTXL + 16 * cbk; tposA = 16 * cbk; }
              na_block(Z + (size_t)krow * ZC + C_KB + h * 64, qf, lt, dr31, c0, jq, cs, rp, fr, fq, pa, lsum); }
            { const int tt = t + 1; const bool lt = tt < nlat; int krow, dr31 = 0, c0 = 0;
              if (lt) { const int a = tt / nkb, kb = kb_lo + tt % nkb; krow = b * SEQ + (r0 + a) * 64 + 16 * kb; tposB = 256 + (r0 + a) * 64 + 16 * kb; dr31 = (r0 + a - i + 7) * 31; c0 = 16 * kb; }
              else { const int cbk = tt - nlat; krow = NLAT + b * CTXL + 16 * cbk; tposB = 16 * cbk; }
              na_block(Z + (size_t)krow * ZC + C_KB + h * 64, qf, lt, dr31, c0, jq, cs, rp, fr, fq, pb, lsum); }
            bf16x8_t pf;
            pf[0] = (short)f2bf(pa[0]); pf[1] = (short)f2bf(pa[1]); pf[2] = (short)f2bf(pa[2]); pf[3] = (short)f2bf(pa[3]);
            pf[4] = (short)f2bf(pb[0]); pf[5] = (short)f2bf(pb[1]); pf[6] = (short)f2bf(pb[2]); pf[7] = (short)f2bf(pb[3]);
#pragma unroll
            for (int db = 0; db < 4; ++db) {
                typedef short s16x4_t __attribute__((ext_vector_type(4)));
                const s16x4_t va = *(const s16x4_t*)(vtb + (size_t)db * 16 * 2304 + tposA), vb = *(const s16x4_t*)(vtb + (size_t)db * 16 * 2304 + tposB);
                const bf16x8_t vf = {va[0], va[1], va[2], va[3], vb[0], vb[1], vb[2], vb[3]};
                o[db] = __builtin_amdgcn_mfma_f32_16x16x32_bf16(pf, vf, o[db], 0, 0, 0);
            }
        }
        lsum += swz_xor<16>(lsum); lsum = xor32_add(lsum);
        const float linv = 1.f / lsum;
#pragma unroll
        for (int i2 = 0; i2 < 4; ++i2) {
            const float li = __int_as_float(__builtin_amdgcn_ds_bpermute((4 * fq + i2) * 4, __float_as_int(linv)));
            bf16_t* yp = YB + (size_t)(qrow0 + 4 * fq + i2) * 512 + h * 64 + fr;
#pragma unroll
            for (int db = 0; db < 4; ++db) yp[db * 16] = f2bf(o[db][i2] * li);
        }
    }
}

typedef short s16x4_t __attribute__((ext_vector_type(4)));
__device__ __forceinline__ void na_soft(const f32x4 st, const float (&rki)[4], bool lat, int dr31, int c0, int jq, int cs, const LAS float* rp, int fq, float (&pv)[4], float& lsum) {
    if (lat) {
        float bi[4];
#pragma unroll
        for (int i = 0; i < 4; ++i) { const int c = c0 + i; bi[i] = rp[dr31 + min(max(c - jq + 15, 0), 30)]; }
#pragma unroll
        for (int i = 0; i < 4; ++i) { const int c = c0 + i; const bool valid = (c >= cs) && (c < cs + 16);
            const float x = valid ? fminf(st[i] * rki[i] + bi[i], 80.f) : -1e30f;
            const float e = __expf(x); pv[i] = e; lsum += e; }
    } else {
#pragma unroll
        for (int i = 0; i < 4; ++i) { const float e = __expf(fminf(st[i] * rki[i], 80.f)); pv[i] = e; lsum += e; }
    }
}
__device__ __forceinline__ void ph_natt3(const Params& p, unsigned char* ldsb, int l, int wg, int nwg) {
    const int wv = otid() >> 6;
    LAS unsigned char* L = (LAS unsigned char*)ldsb;
    LAS bf16_t* sK = (LAS bf16_t*)(L + 0);
    LAS bf16_t* sVT = (LAS bf16_t*)(L + 36864);
    LAS float* sRK = (LAS float*)(L + 70656);
    LAS float* rp = (LAS float*)(L + 71680);
    LAS float* sG = (LAS float*)(L + 73728);
    const bf16_t* Z = (const bf16_t*)(p.ws + WS_Z); const bf16_t* VT = (const bf16_t*)(p.ws + WS_VT); bf16_t* YB = (bf16_t*)(p.ws + WS_YB);
    const bool last = (l == 1);
    for (int task = wg; task < 256; task += nwg) {
        const int b = task >> 5, h = (task >> 2) & 7, quarter = task & 3;
        const int tid = otid();
        __syncthreads();
#pragma unroll
        for (int it = 0; it < 4; ++it) { const int pc = tid + 512 * it, key = pc >> 3, q = pc & 7;
            const v4u kw = *(const v4u*)(Z + (size_t)(NLAT + b * CTXL + key) * ZC + C_KB + h * 64 + 8 * q);
            *(LAS v4u*)(sK + key * 72 + 8 * q) = kw;
            float f[8]; unpack8(kw, f); float ss = 0.f;
#pragma unroll
            for (int e = 0; e < 8; ++e) ss += f[e] * f[e];
            ss += swz_xor<1>(ss); ss += swz_xor<2>(ss); ss += swz_xor<4>(ss);
            if (q == 0) sRK[key] = rsqrtf(ss * (1.f / 64.f) + RMS_EPS);
            const int d = pc >> 5, q2 = pc & 31;
            *(LAS v4u*)(sVT + d * 264 + 8 * q2) = *(const v4u*)(VT + ((size_t)((b * 8 + h) * 64 + d)) * 2304 + 8 * q2); }
        if (tid < 465) rp[tid] = p.na_rpb[(size_t)(l * 8 + h) * 465 + tid];
        if (tid < 64) sG[tid] = p.na_q_g[l * 64 + tid] * p.na_k_g[l * 64 + tid] * 0.125f;
        __syncthreads();
        const int nun = last ? 32 : 36;
        for (int u = wv; u < nun; u += 8) {
            const int lane2 = otid() & 63, fr = lane2 & 15, fq = lane2 >> 4;
            const bool isl = u < 32;
            const int i = 8 * quarter + (u >> 2), qb = isl ? (u & 3) : (4 * quarter + (u - 32));
            const int qrow0 = isl ? (b * SEQ + i * 64 + qb * 16) : (NLAT + b * CTXL + qb * 16);
            bf16x8_t qf[2];
            { const bf16_t* qp = Z + (size_t)(qrow0 + fr) * ZC + C_Q + h * 64 + 8 * fq;
              const bf16x8_t q0 = *(const bf16x8_t*)qp, q1 = *(const bf16x8_t*)(qp + 32);
              float f0[8], f1[8]; float ss = 0.f;
#pragma unroll
              for (int e = 0; e < 8; ++e) { f0[e] = bf2f((bf16_t)q0[e]); f1[e] = bf2f((bf16_t)q1[e]); ss += f0[e] * f0[e] + f1[e] * f1[e]; }
              ss += swz_xor<16>(ss); ss = xor32_add(ss);
              const float rq = rsqrtf(ss * (1.f / 64.f) + RMS_EPS);
              const f32x4 g00 = *(const LAS f32x4*)(sG + 8 * fq), g01 = *(const LAS f32x4*)(sG + 8 * fq + 4), g10 = *(const LAS f32x4*)(sG + 32 + 8 * fq), g11 = *(const LAS f32x4*)(sG + 36 + 8 * fq);
#pragma unroll
              for (int e = 0; e < 4; ++e) { f0[e] *= rq * g00[e]; f0[4 + e] *= rq * g01[e]; f1[e] *= rq * g10[e]; f1[4 + e] *= rq * g11[e]; }
              v4u w0, w1; w0.x = pg8::cvt_pk_bf16(f0[0], f0[1]); w0.y = pg8::cvt_pk_bf16(f0[2], f0[3]); w0.z = pg8::cvt_pk_bf16(f0[4], f0[5]); w0.w = pg8::cvt_pk_bf16(f0[6], f0[7]);
              w1.x = pg8::cvt_pk_bf16(f1[0], f1[1]); w1.y = pg8::cvt_pk_bf16(f1[2], f1[3]); w1.z = pg8::cvt_pk_bf16(f1[4], f1[5]); w1.w = pg8::cvt_pk_bf16(f1[6], f1[7]);
              qf[0] = __builtin_bit_cast(bf16x8_t, w0); qf[1] = __builtin_bit_cast(bf16x8_t, w1); }
            f32x4 o[4];
#pragma unroll
            for (int db = 0; db < 4; ++db) o[db] = (f32x4){0.f, 0.f, 0.f, 0.f};
            float lsum = 0.f;
            const bf16_t* vtb = VT + ((size_t)((b * 8 + h) * 64 + fr)) * 2304 + 4 * fq;
            const int jq = qb * 16 + fr, cs = min(max(jq - 8, 0), 48);
            const int r0 = min(max(i - 4, 0), 24);
            const int c0 = (qb == 0) ? 0 : (qb == 1) ? 8 : (qb == 2) ? 24 : 32;
            const int krow_in = 8 * (fr >> 2) + (fr & 3);
#define NA_LOAD(a_, KA_, KB_, V_) do { const int tok_ = (r0 + (a_)) * 64 + c0; \
                const bf16_t* kp_ = Z + (size_t)(b * SEQ + tok_ + krow_in) * ZC + C_KB + h * 64 + 8 * fq; KA_[0] = *(const bf16x8_t*)kp_; KA_[1] = *(const bf16x8_t*)(kp_ + 32); \
                KB_[0] = *(const bf16x8_t*)(kp_ + 4 * ZC); KB_[1] = *(const bf16x8_t*)(kp_ + 4 * ZC + 32); \
                _Pragma("unroll") for (int db_ = 0; db_ < 4; ++db_) V_[db_] = *(const bf16x8_t*)(VT + ((size_t)((b * 8 + h) * 64 + 16 * db_ + fr)) * 2304 + 256 + tok_ + 8 * fq); } while (0)
#define NA_SCORE_LAT(a_, K_, cofs_, P_) do { \
                float ss_ = 0.f; _Pragma("unroll") for (int e_ = 0; e_ < 8; ++e_) { const float x_ = bf2f((bf16_t)K_[0][e_]), y_ = bf2f((bf16_t)K_[1][e_]); ss_ += x_ * x_ + y_ * y_; } \
                ss_ += swz_xor<16>(ss_); ss_ = xor32_add(ss_); const float rk_ = rsqrtf(ss_ * (1.f / 64.f) + RMS_EPS); \
                f32x4 st_ = {0.f, 0.f, 0.f, 0.f}; st_ = __builtin_amdgcn_mfma_f32_16x16x32_bf16(K_[0], qf[0], st_, 0, 0, 0); st_ = __builtin_amdgcn_mfma_f32_16x16x32_bf16(K_[1], qf[1], st_, 0, 0, 0); \
                float rki_[4]; _Pragma("unroll") for (int i_ = 0; i_ < 4; ++i_) rki_[i_] = __int_as_float(__builtin_amdgcn_ds_bpermute((4 * fq + i_) * 4, __float_as_int(rk_))); \
                na_soft(st_, rki_, true, (r0 + (a_) - i + 7) * 31, c0 + (cofs_) + 8 * fq, jq, cs, rp, fq, P_, lsum); } while (0)
#define NA_PV(PA_, PB_, V_) do { v4u pw_; pw_.x = pg8::cvt_pk_bf16(PA_[0], PA_[1]); pw_.y = pg8::cvt_pk_bf16(PA_[2], PA_[3]); pw_.z = pg8::cvt_pk_bf16(PB_[0], PB_[1]); pw_.w = pg8::cvt_pk_bf16(PB_[2], PB_[3]); \
                const bf16x8_t pf_ = __builtin_bit_cast(bf16x8_t, pw_); \
                _Pragma("unroll") for (int db_ = 0; db_ < 4; ++db_) o[db_] = __builtin_amdgcn_mfma_f32_16x16x32_bf16(pf_, V_[db_], o[db_], 0, 0, 0); } while (0)
#define NA_CTX_LOAD(sidx_) do { \
                _Pragma("unroll") for (int hb = 0; hb < 2; ++hb) { const int key = 32 * (sidx_) + krow_in + 4 * hb; \
                    ck[hb][0] = *(const LAS bf16x8_t*)(sK + key * 72 + 8 * fq); ck[hb][1] = *(const LAS bf16x8_t*)(sK + key * 72 + 8 * fq + 32); \
                    crk[hb] = *(const LAS f32x4*)(sRK + 32 * (sidx_) + 8 * fq + 4 * hb); } \
                _Pragma("unroll") for (int db = 0; db < 4; ++db) cv[db] = *(const LAS bf16x8_t*)(sVT + (16 * db + fr) * 264 + 32 * (sidx_) + 8 * fq); } while (0)
#define NA_CTX_COMPUTE() do { float pa_[4], pb_[4]; \
                _Pragma("unroll") for (int hb = 0; hb < 2; ++hb) { \
                    f32x4 st = {0.f, 0.f, 0.f, 0.f}; \
                    st = __builtin_amdgcn_mfma_f32_16x16x32_bf16(ck[hb][0], qf[0], st, 0, 0, 0); st = __builtin_amdgcn_mfma_f32_16x16x32_bf16(ck[hb][1], qf[1], st, 0, 0, 0); \
                    const float rki[4] = {crk[hb][0], crk[hb][1], crk[hb][2], crk[hb][3]}; \
                    if (hb == 0) na_soft(st, rki, false, 0, 0, 0, 0, rp, fq, pa_, lsum); else na_soft(st, rki, false, 0, 0, 0, 0, rp, fq, pb_, lsum); } \
                NA_PV(pa_, pb_, cv); } while (0)
            bf16x8_t ck[2][2], cv[4]; f32x4 crk[2];
            if (isl) {
                bf16x8_t kA[2][2], kB[2][2], vv[2][4];
                NA_LOAD(0, kA[0], kB[0], vv[0]);
#pragma unroll 1
                for (int s2 = 0; s2 < 8; s2 += 2) {
#pragma unroll
                    for (int si = 0; si < 2; ++si) { const int sidx = s2 + si;
                        if (sidx + 1 < 8) NA_LOAD(sidx + 1, kA[si ^ 1], kB[si ^ 1], vv[si ^ 1]);
                        NA_CTX_LOAD(sidx);
                        __builtin_amdgcn_sched_barrier(0);
                        float pa[4], pb[4];
                        NA_SCORE_LAT(sidx, kA[si], 0, pa); NA_SCORE_LAT(sidx, kB[si], 4, pb);
                        NA_PV(pa, pb, vv[si]);
                        __builtin_amdgcn_sched_barrier(0);
                        NA_CTX_COMPUTE();
                        __builtin_amdgcn_sched_barrier(0);
                    }
                }
            } else {
#pragma unroll 1
                for (int sidx = 0; sidx < 8; ++sidx) { NA_CTX_LOAD(sidx); __builtin_amdgcn_sched_barrier(0); NA_CTX_COMPUTE(); }
            }
#undef NA_CTX_LOAD
#undef NA_CTX_COMPUTE
#undef NA_LOAD
#undef NA_SCORE_LAT
#undef NA_PV
            lsum += swz_xor<16>(lsum); lsum = xor32_add(lsum);
            const float linv = 1.f / lsum;
#pragma unroll
            for (int i2 = 0; i2 < 4; ++i2) {
                const float li = __int_as_float(__builtin_amdgcn_ds_bpermute((4 * fq + i2) * 4, __float_as_int(linv)));
                bf16_t* yp = YB + (size_t)(qrow0 + 4 * fq + i2) * 512 + h * 64 + fr;
#pragma unroll
                for (int db = 0; db < 4; ++db) yp[db * 16] = f2bf(o[db][i2] * li);
            }
        }
    }
    __syncthreads();
}

__device__ __forceinline__ void ph_convert_moe(const Params& p, unsigned char* ldsb, int l, int wg, int nwg);
__device__ __forceinline__ void ph_scan_natt(const Params& p, unsigned char* ldsb, int l, int wg, int nwg) {
    const int hs_ = nwg >> 1;
    if (nwg < 2) { ph_scan5(p, ldsb, l, 0, 1); __syncthreads(); ph_natt3(p, ldsb, l, 0, 1); }
    else if (wg < hs_) ph_scan5(p, ldsb, l, wg, hs_);
    else { ph_natt3(p, ldsb, l, wg - hs_, nwg - hs_); ph_convert_moe(p, ldsb, l, wg - hs_, nwg - hs_); }
}

__device__ __forceinline__ void ph_rwkvout(const Params& p, float* sm, int l, int wg, int nwg) {
    const bf16_t* Z = (const bf16_t*)(p.ws + WS_Z);
    const bf16_t* Y2 = (const bf16_t*)(p.ws + WS_Y2);
    bf16_t* OA = (bf16_t*)(p.ws + WS_OUTA);
    const int c = otid(); const int nrows = (l == 1) ? NLAT : LR;
    const float lng = p.rw_ln_g[l * 512 + c], lnb = p.rw_ln_b[l * 512 + c], rk = p.rw_r_k[l * 512 + c];
    const float* glb = p.rw_g_lora_b + (size_t)l * 128 * 512 + c;
    for (int r = wg; r < nrows; r += nwg) {
        __syncthreads();
        if (c < 128) sm[c] = sigmoidf_(bf2f(Z[(size_t)r * ZC + C_LG + c]));
        __syncthreads();
        const float yv = bf2f(Y2[(size_t)r * 512 + c]) + bf2f(Y2[((size_t)LR + r) * 512 + c]);
        const float mu = wave_sum(yv) * (1.f / 64.f); const float d = yv - mu; const float var = wave_sum(d * d) * (1.f / 64.f);
        const float yn = d * rsqrtf(var + GN_EPS) * lng + lnb;
        const float rr = bf2f(Z[(size_t)r * ZC + C_R + c]), kk = bf2f(Z[(size_t)r * ZC + C_K + c]), vv = bf2f(Z[(size_t)r * ZC + C_V + c]);
        const float bon = wave_sum(rr * kk * rk) * vv;
        float g = 0.f;
#pragma unroll 4
        for (int j = 0; j < 128; ++j) g += sm[j] * glb[(size_t)j * 512];
        OA[(size_t)r * 512 + c] = f2bf((yn + bon) * g);
    }
}

struct EpiOutA {
    static constexpr bool PERM = true, AFTER_DRAIN = false;
    const bf16_t* PRE; bf16_t* OA;
    __device__ __forceinline__ void operator()(const f32x4 (&acc)[2][2][4][2], const pg8::Unit& u, int wr, int wc, int fr, int fq) const {
        const int row0 = u.pm * 256 + wr * 64 + fr, colb = u.pn * 256 + wc * 32 + 8 * fq;
#pragma unroll
        for (int ai = 0; ai < 2; ++ai)
#pragma unroll
            for (int bj = 0; bj < 2; ++bj) { const int col = colb + bj * 128;
                v4u pw[4];
#pragma unroll
                for (int m = 0; m < 4; ++m) pw[m] = *(const v4u*)(PRE + (size_t)(row0 + ai * 128 + m * 16) * 512 + col);
#pragma unroll
                for (int m = 0; m < 4; ++m) { const int row = row0 + ai * 128 + m * 16;
                    float pr[8]; unpack8(pw[m], pr);
                    const f32x4 v0 = acc[ai][bj][m][0], v1 = acc[ai][bj][m][1];
                    v4u w; w.x = pg8::cvt_pk_bf16(pr[0] * v0[0], pr[1] * v0[1]); w.y = pg8::cvt_pk_bf16(pr[2] * v0[2], pr[3] * v0[3]);
                    w.z = pg8::cvt_pk_bf16(pr[4] * v1[0], pr[5] * v1[1]); w.w = pg8::cvt_pk_bf16(pr[6] * v1[2], pr[7] * v1[3]);
                    *(v4u*)(OA + (size_t)row * 512 + col) = w; } }
    }
};
__device__ __forceinline__ void ph_rwkvout2(const Params& p, unsigned char* ldsb, int l, int wg, int nwg) {
    const int nrows = (l == 1) ? NLAT : LR;
    pg8::StaticOrder S; S.init(nrows, 512, nwg, wg);
    {
        const int tid = otid(), lane = tid & 63, wv = tid >> 6;
        const bf16_t* Z = (const bf16_t*)(p.ws + WS_Z); bf16_t* Y2 = (bf16_t*)(p.ws + WS_Y2);
        pg8::Unit u;
        for (int it = 0; S.next(it, u); ++it) {
            const int c = u.pn * 256 + 4 * lane;
            const f32x4 lng = *(const f32x4*)(p.rw_ln_g + l * 512 + c), lnb = *(const f32x4*)(p.rw_ln_b + l * 512 + c), rkk = *(const f32x4*)(p.rw_r_k + l * 512 + c);
            for (int rr0 = wv; rr0 < 256; rr0 += 32) {
                v2u lyf[4], lyb[4], lr[4], lk[4], lv[4];
#pragma unroll
                for (int q = 0; q < 4; ++q) { const int row = u.pm * 256 + rr0 + 8 * q;
                    lyf[q] = *(const v2u*)(Y2 + (size_t)row * 512 + c); lyb[q] = *(const v2u*)(Y2 + ((size_t)LR + row) * 512 + c);
                    lr[q] = *(const v2u*)(Z + (size_t)row * ZC + C_R + c); lk[q] = *(const v2u*)(Z + (size_t)row * ZC + C_K + c); lv[q] = *(const v2u*)(Z + (size_t)row * ZC + C_V + c); }
#pragma unroll
                for (int q = 0; q < 4; ++q) { const int row = u.pm * 256 + rr0 + 8 * q;
                    float yf[4], yb[4], r4[4], k4[4], v4[4];
                    unpack4(lyf[q], yf); unpack4(lyb[q], yb); unpack4(lr[q], r4); unpack4(lk[q], k4); unpack4(lv[q], v4);
                    float y[4]; float sy = 0.f, sb = 0.f;
#pragma unroll
                    for (int e = 0; e < 4; ++e) { y[e] = yf[e] + yb[e]; sy += y[e]; sb += r4[e] * k4[e] * rkk[e]; }
                    sy = row16_sum(sy); sb = row16_sum(sb);
                    const float mu = sy * (1.f / 64.f); float sq = 0.f;
#pragma unroll
                    for (int e = 0; e < 4; ++e) { y[e] -= mu; sq += y[e] * y[e]; }
                    sq = row16_sum(sq);
                    const float rs = rsqrtf(sq * (1.f / 64.f) + GN_EPS);
                    float o[4];
#pragma unroll
                    for (int e = 0; e < 4; ++e) o[e] = y[e] * rs * lng[e] + lnb[e] + sb * v4[e];
                    v2u w; w.x = pk2(o[0], o[1]); w.y = pk2(o[2], o[3]);
                    *(v2u*)(Y2 + (size_t)row * 512 + c) = w; }
            }
        }
    }
    asm volatile("s_waitcnt vmcnt(0)" ::: "memory");
    __syncthreads();
    pg8::Gemm g{(const bf16_t*)(p.ws + WS_SG), (const bf16_t*)(p.ws + WS_GL_T), nrows, 512, 256};
    EpiOutA E{(const bf16_t*)(p.ws + WS_Y2), (bf16_t*)(p.ws + WS_OUTA)};
    pg8::gemm_phase<EpiOutA, pg8::StaticOrder, true, true>((LAS unsigned char*)ldsb, g, S, E);
}

__device__ __forceinline__ void ph_merge(const Params& p, float* sm, int l, int wg, int nwg) {
    const bf16_t* Z = (const bf16_t*)(p.ws + WS_Z);
    bf16_t* MG = (bf16_t*)(p.ws + WS_MERGED);
    float* TMP = (float*)(p.ws + WS_YS);
    const int nrows = (l == 1) ? NLAT : LR;
    gemm_naive<bf16_t>(sm, wg, nwg, nrows, DM, 512, (const bf16_t*)(p.ws + WS_OUTA), 512, nullptr, 0, p.proj_a + (size_t)l * 512 * DM, DM,
                       [=](int r, int c, float v) { TMP[(size_t)r * DM + c] = sigmoidf_(bf2f(Z[(size_t)r * ZC + C_GA + c])) * v; });
    gemm_naive<bf16_t>(sm, wg, nwg, nrows, DM, 512, (const bf16_t*)(p.ws + WS_YB), 512, nullptr, 0, p.proj_b + (size_t)l * 512 * DM, DM,
                       [=](int r, int c, float v) { MG[(size_t)r * DM + c] = f2bf(TMP[(size_t)r * DM + c] + sigmoidf_(bf2f(Z[(size_t)r * ZC + C_GB + c])) * v); });
}

__device__ __forceinline__ void ph_wout(const Params& p, float* sm, int l, int wg, int nwg) {
    const float* MOD = (const float*)(p.ws + WS_MOD);
    const int nrows = (l == 1) ? NLAT : LR;
    const Params pp = p;
    gemm_naive<bf16_t>(sm, wg, nwg, nrows, DM, DM, (const bf16_t*)(p.ws + WS_MERGED), DM, nullptr, 0, p.w_out + (size_t)l * DM * DM, DM,
                       [=](int r, int c, float v) { const float base = (l == 0 ? in_row(pp, r) : st_row(pp, r))[c];
                           st_row(pp, r)[c] = base + MOD[(l * 9 + mod_row(r)) * 6144 + 2 * DM + c] * v; });
}

__device__ __forceinline__ void ph_route(const Params& p, float* sm, int l, int wg, int nwg) {
    const int lane = otid() & 63, wv = otid() >> 6, nwv = blockDim.x >> 6;
    const float* MOD = (const float*)(p.ws + WS_MOD);
    bf16_t* H2 = (bf16_t*)(p.ws + WS_H2);
    const int nrows = (l == 1) ? NLAT : LR;
    for (int r = wg * nwv + wv; r < nrows; r += nwg * nwv) {
        const float* xr = st_row(p, r);
        float v[16]; float ss = 0.f;
#pragma unroll
        for (int i = 0; i < 16; ++i) { v[i] = xr[lane + 64 * i]; ss += v[i] * v[i]; }
        ss = wave_sum(ss);
        const float rs = rsqrtf(ss * (1.f / DM) + RMS_EPS);
        const float* m = MOD + (l * 9 + mod_row(r)) * 6144;
        float* hs = sm + wv * 1024;
#pragma unroll
        for (int i = 0; i < 16; ++i) { const int d = lane + 64 * i;
            const float h = (v[i] * rs * p.norm2_g[l * DM + d]) * (1.f + m[4 * DM + d]) + m[3 * DM + d];
            H2[(size_t)r * DM + d] = f2bf(h); hs[d] = h; }
        float dsum = 0.f;
        { const int e = lane & 15, part = lane >> 4; const float* rw = p.router_w + (size_t)(part * 256) * 16 + e; const float* hp = hs + part * 256;
#pragma unroll 4
            for (int d = 0; d < 256; ++d) dsum += hp[d] * rw[(size_t)d * 16]; }
        dsum += swz_xor<16>(dsum); dsum = xor32_add(dsum);
        const float myscore = 1.f / (1.f + expf(-dsum));
        float sc[16], sel[16];
#pragma unroll
        for (int e = 0; e < 16; ++e) { sc[e] = rdlane(myscore, e); sel[e] = sc[e] + p.router_bias[e]; }
        int best = 0; float bestv = -INFINITY;
#pragma unroll
        for (int g = 0; g < 4; ++g) { float m1 = -INFINITY, m2 = -INFINITY;
#pragma unroll
            for (int j = 0; j < 4; ++j) { const float s = sel[g * 4 + j]; if (s > m1) { m2 = m1; m1 = s; } else if (s > m2) m2 = s; }
            const float gs = m1 + m2; if (gs > bestv) { bestv = gs; best = g; } }
        int i0 = -1; float v0 = -INFINITY;
#pragma unroll
        for (int e = 0; e < 16; ++e) if ((e >> 2) == best && sel[e] > v0) { v0 = sel[e]; i0 = e; }
        int i1 = -1; float v1 = -INFINITY;
#pragma unroll
        for (int e = 0; e < 16; ++e) if ((e >> 2) == best && e != i0 && sel[e] > v1) { v1 = sel[e]; i1 = e; }
        float s0 = 0.f, s1 = 0.f;
#pragma unroll
        for (int e = 0; e < 16; ++e) { if (e == i0) s0 = sc[e]; if (e == i1) s1 = sc[e]; }
        const float inv = 1.f / (s0 + s1);
        if (lane == 0) {
            ((int*)(p.ws + WS_TOKI))[r] = i0 | (i1 << 8);
            ((float2*)(p.ws + WS_TOKG))[r] = make_float2(s0 * inv, s1 * inv);
        }
    }
}

__device__ __forceinline__ void ph_lists(const Params& p, float* sm, int l, int wg, int nwg) {
    int* cnt = (int*)(p.ws + WS_CTL) + l * 16;
    int* LT = (int*)(p.ws + WS_LTOK); float* LGt = (float*)(p.ws + WS_LGATE);
    const int* TI = (const int*)(p.ws + WS_TOKI); const float2* TG = (const float2*)(p.ws + WS_TOKG);
    const int nrows = (l == 1) ? NLAT : LR;
    const int tid = otid(), lane = tid & 63, wv = tid >> 6;
    int* wcnt = (int*)sm;
    for (int e = wg; e < NE; e += nwg) {
        int base = 0;
        for (int c0 = 0; c0 < nrows; c0 += 512) {
            const int t = c0 + tid;
            int slot = -1; float g = 0.f;
            if (t < nrows) { const int ti = TI[t]; const float2 tg = TG[t];
                if ((ti & 255) == e) { slot = 0; g = tg.x; } else if ((ti >> 8) == e) { slot = 1; g = tg.y; } }
            const unsigned long long bal = __ballot(slot >= 0);
            __syncthreads();
            if (lane == 0) wcnt[wv] = __popcll(bal);
            __syncthreads();
            int woff = 0, tot = 0;
#pragma unroll
            for (int w = 0; w < 8; ++w) { const int c = wcnt[w]; if (w < wv) woff += c; tot += c; }
            if (slot >= 0) { const int pos = base + woff + __popcll(bal & ((1ull << lane) - 1ull));
                LT[e * LR + pos] = t * 2 + slot; LGt[e * LR + pos] = g; }
            base += tot;
        }
        if (tid == 0) cnt[e] = base;
    }
}

__device__ __forceinline__ void ph_convert_moe(const Params& p, unsigned char* ldsb, int l, int wg, int nwg) {
    const int lane = otid() & 63, wv = __builtin_amdgcn_readfirstlane(otid() >> 6);
    LAS float* scr = (LAS float*)((LAS unsigned char*)ldsb + 32768 + wv * 8704);
    const int gw = wg * 8 + wv, NGW = nwg * 8;
    for (int it = gw; it < 16 * 768; it += NGW) {
        const int e = it / 768, r = it % 768, which = r >> 8, q = r & 255;
        if (which < 2) { const int kb = q >> 4, nb = q & 15, n0 = nb * 32;
            const float* W = (which == 0 ? p.moe_w1 : p.moe_w3) + (size_t)(l * NE + e) * DM * DE;
            tr_item(W, DE, kb * 64, n0, (bf16_t*)(p.ws + WS_W13T) + (size_t)e * 1024 * 1024, DM, (n0 >> 7) * 256 + (n0 & 127) + which * 128, scr, lane); }
        else { const int kb = q >> 5, nb = q & 31;
            tr_item(p.moe_w2 + (size_t)(l * NE + e) * DE * DM, DM, kb * 64, nb * 32, (bf16_t*)(p.ws + WS_W2T) + (size_t)e * 1024 * 512, DE, nb * 32, scr, lane); }
    }
}
__device__ __forceinline__ void ph_route2(const Params& p, float* sm, int l, int wg, int nwg) {
    const int tid = otid(), lane = tid & 63, wv = tid >> 6, fr = lane & 15, fq = lane >> 4;
    const float* MOD = (const float*)(p.ws + WS_MOD);
    bf16_t* H2 = (bf16_t*)(p.ws + WS_H2T);
    int* TI = (int*)(p.ws + WS_TOKI); float2* TG = (float2*)(p.ws + WS_TOKG);
    const int nrows = (l == 1) ? NLAT : LR;
    const int per = (nrows + nwg - 1) / nwg, r_beg = wg * per, r_end = min(nrows, r_beg + per);
    float* hs = sm;
    float* part = sm + 16 * 1028;
    int* lcnt = (int*)(part + 8 * 256);
    if (tid < 16) lcnt[tid] = 0;
    float Bw[32];
#pragma unroll
    for (int kk = 0; kk < 32; ++kk) Bw[kk] = p.router_w[(size_t)(128 * wv + 4 * kk + fq) * 16 + fr];
    for (int blk = r_beg; blk < r_end; blk += 16) {
        __syncthreads();
#pragma unroll
        for (int tt = 0; tt < 2; ++tt) { const int tl = wv * 2 + tt, r = blk + tl;
            if (r < r_end) {
                const bf16_t* xr = (const bf16_t*)(p.ws + WS_X1B) + (size_t)r * DM;
                const float* m = MOD + (l * 9 + mod_row(r)) * 6144;
                f32x4 v[4]; float ss = 0.f;
#pragma unroll
                for (int j = 0; j < 4; ++j) { float t4[4]; unpack4(*(const v2u*)(xr + 4 * lane + 256 * j), t4); v[j] = (f32x4){t4[0], t4[1], t4[2], t4[3]}; ss += (v[j][0] * v[j][0] + v[j][1] * v[j][1]) + (v[j][2] * v[j][2] + v[j][3] * v[j][3]); }
                ss = wave_sum(ss);
                const float rs = rsqrtf(ss * (1.f / DM) + RMS_EPS);
#pragma unroll
                for (int j = 0; j < 4; ++j) { const int d = 4 * lane + 256 * j;
                    const f32x4 g = *(const f32x4*)(p.norm2_g + l * DM + d), sh = *(const f32x4*)(m + 3 * DM + d), scl = *(const f32x4*)(m + 4 * DM + d);
                    const f32x4 h = v[j] * rs * g * (scl + 1.f) + sh;
                    v2u w; w.x = pk2(h[0], h[1]); w.y = pk2(h[2], h[3]);
                    *(v2u*)(H2 + (size_t)r * DM + d) = w;
                    *(f32x4*)(hs + tl * 1028 + d) = h; }
            } else {
#pragma unroll
                for (int j = 0; j < 4; ++j) *(f32x4*)(hs + tl * 1028 + 4 * lane + 256 * j) = (f32x4){0.f, 0.f, 0.f, 0.f};
            }
        }
        __syncthreads();
        { f32x4 acc = {0.f, 0.f, 0.f, 0.f};
#pragma unroll
          for (int kk = 0; kk < 32; ++kk) { const float a = hs[fr * 1028 + 128 * wv + 4 * kk + fq]; acc = __builtin_amdgcn_mfma_f32_16x16x4f32(a, Bw[kk], acc, 0, 0, 0); }
#pragma unroll
          for (int i = 0; i < 4; ++i) part[wv * 256 + (4 * fq + i) * 16 + fr] = acc[i]; }
        __syncthreads();
        if (tid < 16 && blk + tid < r_end) {
            const int r = blk + tid;
            float sc[16], sel[16];
#pragma unroll
            for (int e = 0; e < 16; ++e) { float d = 0.f;
#pragma unroll
                for (int w8 = 0; w8 < 8; ++w8) d += part[w8 * 256 + tid * 16 + e];
                sc[e] = 1.f / (1.f + expf(-d)); sel[e] = sc[e] + p.router_bias[e]; }
            int best = 0; float bestv = -INFINITY;
#pragma unroll
            for (int g = 0; g < 4; ++g) { float m1 = -INFINITY, m2 = -INFINITY;
#pragma unroll
                for (int j = 0; j < 4; ++j) { const float s_ = sel[g * 4 + j]; if (s_ > m1) { m2 = m1; m1 = s_; } else if (s_ > m2) m2 = s_; }
                const float gs = m1 + m2; if (gs > bestv) { bestv = gs; best = g; } }
            int i0 = -1; float v0 = -INFINITY;
#pragma unroll
            for (int e = 0; e < 16; ++e) if ((e >> 2) == best && sel[e] > v0) { v0 = sel[e]; i0 = e; }
            int i1 = -1; float v1 = -INFINITY;
#pragma unroll
            for (int e = 0; e < 16; ++e) if ((e >> 2) == best && e != i0 && sel[e] > v1) { v1 = sel[e]; i1 = e; }
            float s0 = 0.f, s1 = 0.f;
#pragma unroll
            for (int e = 0; e < 16; ++e) { if (e == i0) s0 = sc[e]; if (e == i1) s1 = sc[e]; }
            const float inv = 1.f / (s0 + s1);
            TI[r] = i0 | (i1 << 8); TG[r] = make_float2(s0 * inv, s1 * inv); atomicAdd(&lcnt[i0], 1); atomicAdd(&lcnt[i1], 1);
        }
    }
    __syncthreads();
    if (tid < 16) ((int*)(p.ws + WS_CNTWG))[wg * 16 + tid] = lcnt[tid];
}
__device__ __forceinline__ void ph_lists2(const Params& p, float* sm, int l, int wg, int nwg) {
    const int tid = otid(), lane = tid & 63, wv = tid >> 6;
    const int* CW = (const int*)(p.ws + WS_CNTWG);
    const int* TI = (const int*)(p.ws + WS_TOKI); const float2* TG = (const float2*)(p.ws + WS_TOKG);
    int* RD = (int*)(p.ws + WS_ROWDST); float* RG = (float*)(p.ws + WS_ROWGATE);
    const bf16_t* H2 = (const bf16_t*)(p.ws + WS_H2T); bf16_t* H2S = (bf16_t*)(p.ws + WS_H2S);
    const int nrows = (l == 1) ? NLAT : LR;
    const int per = (nrows + nwg - 1) / nwg, r_beg = wg * per, r_end = min(nrows, r_beg + per);
    int* s_tot = (int*)sm;
    int* s_before = s_tot + 16;
    int* s_off = s_tot + 32;
    int* s_ti = s_tot + 64;
    int* s_pos = s_tot + 64 + 128;
    int* s_cw = s_tot + 512;
    for (int i = tid; i < nwg * 16; i += 512) s_cw[i] = CW[i];
    for (int i = tid; i < r_end - r_beg; i += 512) s_ti[i] = TI[r_beg + i];
    __syncthreads();
    if (tid < 256) {
        const int e = tid & 15, part = tid >> 4; int tot = 0, bef = 0;
        for (int w = part; w < nwg; w += 16) { const int c = s_cw[w * 16 + e]; tot += c; if (w < wg) bef += c; }
        s_cw[4096 + tid] = tot; s_cw[4096 + 256 + tid] = bef;
    }
    __syncthreads();
    if (tid < 16) { int tot = 0, bef = 0; for (int q = 0; q < 16; ++q) { tot += s_cw[4096 + q * 16 + tid]; bef += s_cw[4096 + 256 + q * 16 + tid]; } s_tot[tid] = tot; s_before[tid] = bef; }
    __syncthreads();
    if (tid == 0) { int o = 0; for (int e = 0; e < 16; ++e) { s_off[e] = o; o += (s_tot[e] + 255) & ~255; } s_off[16] = o; }
    __syncthreads();
    if (wg == 0) {
        int* OFFS = (int*)(p.ws + WS_OFFS); int* TEXP = (int*)(p.ws + WS_TEXP);
        if (tid < 17) OFFS[tid] = s_off[tid];
        if (tid == 17) OFFS[17] = s_off[16] >> 8;
        if (tid < 160) { int e = 0; for (int k = 1; k < 16; ++k) if (tid * 256 >= s_off[k]) e = k; TEXP[tid] = e; }
    }
    if (wg < 16) { const int beg = s_off[wg] + s_tot[wg], end = s_off[wg + 1]; for (int i = beg + tid; i < end; i += 512) { RD[i] = -1; RG[i] = 0.f; } }
    const int n = r_end - r_beg;
    if (tid < n) { const int ti = s_ti[tid], e0 = ti & 255, e1 = ti >> 8; int k0 = 0, k1 = 0;
        for (int j = 0; j < tid; ++j) { const int tj = s_ti[j]; k0 += ((tj & 255) == e0) + ((tj >> 8) == e0); k1 += ((tj & 255) == e1) + ((tj >> 8) == e1); }
        const int p0 = s_off[e0] + s_before[e0] + k0, p1 = s_off[e1] + s_before[e1] + k1;
        s_pos[2 * tid] = p0; s_pos[2 * tid + 1] = p1;
        const float2 g = TG[r_beg + tid];
        RD[p0] = (r_beg + tid) * 2; RG[p0] = g.x; RD[p1] = (r_beg + tid) * 2 + 1; RG[p1] = g.y; }
    (void)H2; (void)H2S; (void)lane; (void)wv; (void)s_pos;
}
struct MoeOrder : pg8::StaticOrder {
    const int* texp; unsigned stride;
    __device__ __forceinline__ bool next(int i, pg8::Unit& u) const { if (!pg8::StaticOrder::next(i, u)) return false; u.boff = (unsigned)texp[u.pm] * stride; return true; }
};
constexpr int CW_RDY = 8192;
__device__ __forceinline__ void st16_wt(void* ptr, v4u v) { asm volatile("global_store_dwordx4 %0, %1, off sc1\n\ts_nop 1" :: "v"(ptr), "v"(v) : "memory"); }
struct MoeOrderPub : MoeOrder {
    static constexpr bool GATHER = true;
    unsigned* rdy;
    __device__ __forceinline__ void done(const pg8::Unit& u) const {
        asm volatile("s_waitcnt vmcnt(0)" ::: "memory");
        if ((otid() & 63) == 0) (void)__hip_atomic_fetch_add(rdy + 16 * u.pm, 1u, __ATOMIC_RELAXED, __HIP_MEMORY_SCOPE_AGENT);
    }
};
struct MoeOrderSub : pg8::StaticOrder {
    const int* texp; unsigned stride; const unsigned* rdy; int nx, J, x, j, rr, nl, base; bool classed;
    __device__ __forceinline__ void init2(int M, int N, int G_, int c_) {
        init(M, N, G_, c_);
        classed = (G_ % 8) == 0 && G_ >= 8;
        if (classed) { J = G_ / 8; x = c_ % 8; j = c_ / 8; nx = (nwg - x + 7) / 8; if (nx < 0) nx = 0; rr = nx % J; nl = J - rr; base = min(nx, 2 * nl); }
    }
    __device__ __forceinline__ bool next(int i, pg8::Unit& u) const {
        if (!classed) { if (!pg8::StaticOrder::next(i, u)) return false; u.boff = (unsigned)texp[u.pm] * stride; return true; }
        int s;
        if (j >= rr) { const int rank = j - rr; s = (i == 0) ? rank : (i == 1) ? nl + rank : base + j + (i - 2) * J; if (i < 2 && s >= base) return false; }
        else s = base + j + i * J;
        if (s >= nx) return false;
        unit_of(s * 8 + x, u); u.boff = (unsigned)texp[u.pm] * stride; return true;
    }
    __device__ __forceinline__ void a_ready(const pg8::Unit& u) const {
        if (otid() < 64) {
            unsigned sp = 0u;
            while ((unsigned)__builtin_amdgcn_readfirstlane(__hip_atomic_load(rdy + 16 * u.pm, __ATOMIC_RELAXED, __HIP_MEMORY_SCOPE_AGENT)) < 32u) { __builtin_amdgcn_s_sleep(2); if (++sp > (1u << 22)) break; }
            __builtin_amdgcn_fence(__ATOMIC_ACQUIRE, "agent");
            asm volatile("s_waitcnt vmcnt(0)" ::: "memory");
        }
        asm volatile("" ::: "memory"); __builtin_amdgcn_s_barrier(); asm volatile("" ::: "memory");
    }
};
struct EpiHid {
    static constexpr bool PERM = true, AFTER_DRAIN = false;
    bf16_t* HID;
    __device__ __forceinline__ void operator()(const f32x4 (&acc)[2][2][4][2], const pg8::Unit& u, int wr, int wc, int fr, int fq) const {
        const int row0 = u.pm * 256 + wr * 64 + fr, col = u.pn * 128 + wc * 32 + 8 * fq;
#pragma unroll
        for (int ai = 0; ai < 2; ++ai)
#pragma unroll
            for (int m = 0; m < 4; ++m) {
                const f32x4 a0 = acc[ai][0][m][0], a1 = acc[ai][0][m][1], b0 = acc[ai][1][m][0], b1 = acc[ai][1][m][1];
                float o[8];
#pragma unroll
                for (int e = 0; e < 4; ++e) { o[e] = a0[e] * sigmoidf_(a0[e]) * b0[e]; o[4 + e] = a1[e] * sigmoidf_(a1[e]) * b1[e]; }
                v4u w; w.x = pg8::cvt_pk_bf16(o[0], o[1]); w.y = pg8::cvt_pk_bf16(o[2], o[3]); w.z = pg8::cvt_pk_bf16(o[4], o[5]); w.w = pg8::cvt_pk_bf16(o[6], o[7]);
                st16_wt(HID + (size_t)(row0 + ai * 128 + m * 16) * DE + col, w); }
    }
};
struct EpiYs {
    static constexpr bool PERM = true, AFTER_DRAIN = false;
    bf16_t* YS; const int* RD; const float* RG;
    __device__ __forceinline__ void operator()(const f32x4 (&acc)[2][2][4][2], const pg8::Unit& u, int wr, int wc, int fr, int fq) const {
        const int row0 = u.pm * 256 + wr * 64 + fr, colb = u.pn * 256 + wc * 32 + 8 * fq;
        int dsts[2][4]; float gs[2][4];
#pragma unroll
        for (int ai = 0; ai < 2; ++ai)
#pragma unroll
            for (int m = 0; m < 4; ++m) { const int row = row0 + ai * 128 + m * 16; dsts[ai][m] = RD[row]; gs[ai][m] = RG[row]; }
#pragma unroll
        for (int ai = 0; ai < 2; ++ai)
#pragma unroll
            for (int m = 0; m < 4; ++m) { const int dst = dsts[ai][m]; const float g = gs[ai][m];
                if (dst >= 0) {
#pragma unroll
                    for (int bj = 0; bj < 2; ++bj) { const f32x4 v0 = acc[ai][bj][m][0] * g, v1 = acc[ai][bj][m][1] * g;
                        v4u w; w.x = pg8::cvt_pk_bf16(v0[0], v0[1]); w.y = pg8::cvt_pk_bf16(v0[2], v0[3]); w.z = pg8::cvt_pk_bf16(v1[0], v1[1]); w.w = pg8::cvt_pk_bf16(v1[2], v1[3]);
                        *(v4u*)(YS + (size_t)dst * DM + colb + bj * 128) = w; } } }
    }
};
__device__ __forceinline__ void ph_moe1_mfma(const Params& p, unsigned char* ldsb, int l, int wg, int nwg) {
    const int ntiles = ((const int*)(p.ws + WS_OFFS))[17];
    pg8::Gemm g{(const bf16_t*)(p.ws + WS_H2T), (const bf16_t*)(p.ws + WS_W13T), ntiles * 256, 1024, DM};
    MoeOrderPub S; S.init(ntiles * 256, 1024, nwg, wg); S.texp = (const int*)(p.ws + WS_TEXP); S.stride = 1024u * 1024u * 2u; S.rdy = (unsigned*)(p.ws + WS_CTL) + CW_RDY + l * 4096; S.rowsrc = (const int*)(p.ws + WS_ROWDST);
    EpiHid E{(bf16_t*)(p.ws + WS_HID2)};
    pg8::gemm_phase<EpiHid, MoeOrderPub, true, true>((LAS unsigned char*)ldsb, g, S, E);
}
__device__ __forceinline__ void ph_moe2_mfma(const Params& p, unsigned char* ldsb, int l, int wg, int nwg) {
    const int ntiles = ((const int*)(p.ws + WS_OFFS))[17];
    pg8::Gemm g{(const bf16_t*)(p.ws + WS_HID2), (const bf16_t*)(p.ws + WS_W2T), ntiles * 256, 1024, DE};
    MoeOrderSub S; S.init2(ntiles * 256, 1024, nwg, wg); S.texp = (const int*)(p.ws + WS_TEXP); S.stride = 1024u * 512u * 2u; S.rdy = (const unsigned*)(p.ws + WS_CTL) + CW_RDY + l * 4096;
    EpiYs E{(bf16_t*)(p.ws + WS_YS2), (const int*)(p.ws + WS_ROWDST), (const float*)(p.ws + WS_ROWGATE)};
    pg8::gemm_phase<EpiYs, MoeOrderSub, true, true>((LAS unsigned char*)ldsb, g, S, E);
}
__device__ __forceinline__ void ph_combine2(const Params& p, int l, int wg, int nwg) {
    const float* MOD = (const float*)(p.ws + WS_MOD);
    const bf16_t* YS = (const bf16_t*)(p.ws + WS_YS2);
    const int nrows = (l == 1) ? NLAT : LR;
    for (size_t i = (size_t)wg * 512 + otid(); i < (size_t)nrows * DM; i += (size_t)nwg * 512) {
        const int r = (int)(i >> 10), d = (int)(i & 1023);
        float* xp = st_row(p, r) + d;
        *xp = *xp + MOD[(l * 9 + mod_row(r)) * 6144 + 5 * DM + d] * (bf2f(YS[(size_t)(2 * r) * DM + d]) + bf2f(YS[(size_t)(2 * r + 1) * DM + d]));
    }
}

__device__ __forceinline__ void ph_moe1(const Params& p, float* sm, int l, int wg, int nwg) {
    const int* cnt = (const int*)(p.ws + WS_CTL) + l * 16;
    const int* LT = (const int*)(p.ws + WS_LTOK);
    float* T1 = (float*)(p.ws + WS_TMP1); bf16_t* HID = (bf16_t*)(p.ws + WS_HID);
    int off = 0;
    for (int e = 0; e < NE; ++e) {
        const int M = cnt[e];
        float* t1 = T1 + (size_t)off * DE; bf16_t* hid = HID + (size_t)off * DE;
        gemm_naive<bf16_t>(sm, wg, nwg, M, DE, DM, (const bf16_t*)(p.ws + WS_H2), DM, LT + e * LR, 1, p.moe_w1 + ((size_t)(l * NE + e) * DM) * DE, DE,
                           [=](int r, int c, float v) { t1[(size_t)r * DE + c] = v; });
        gemm_naive<bf16_t>(sm, wg, nwg, M, DE, DM, (const bf16_t*)(p.ws + WS_H2), DM, LT + e * LR, 1, p.moe_w3 + ((size_t)(l * NE + e) * DM) * DE, DE,
                           [=](int r, int c, float v) { const float a = t1[(size_t)r * DE + c]; hid[(size_t)r * DE + c] = f2bf(a * sigmoidf_(a) * v); });
        off += (M + 255) & ~255;
    }
}
__device__ __forceinline__ void ph_moe2(const Params& p, float* sm, int l, int wg, int nwg) {
    const int* cnt = (const int*)(p.ws + WS_CTL) + l * 16;
    const int* LT = (const int*)(p.ws + WS_LTOK); const float* LGt = (const float*)(p.ws + WS_LGATE);
    const bf16_t* HID = (const bf16_t*)(p.ws + WS_HID); bf16_t* YS = (bf16_t*)(p.ws + WS_YS);
    int off = 0;
    for (int e = 0; e < NE; ++e) {
        const int M = cnt[e];
        const int* lt = LT + e * LR; const float* lgt = LGt + e * LR;
        gemm_naive<bf16_t>(sm, wg, nwg, M, DM, DE, HID + (size_t)off * DE, DE, nullptr, 0, p.moe_w2 + ((size_t)(l * NE + e) * DE) * DM, DM,
                           [=](int r, int c, float v) { YS[(size_t)lt[r] * DM + c] = f2bf(lgt[r] * v); });
        off += (M + 255) & ~255;
    }
}
__device__ __forceinline__ void ph_combine(const Params& p, int l, int wg, int nwg) {
    const float* MOD = (const float*)(p.ws + WS_MOD);
    const bf16_t* YS = (const bf16_t*)(p.ws + WS_YS);
    const int nrows = (l == 1) ? NLAT : LR;
    for (size_t i = (size_t)wg * blockDim.x + otid(); i < (size_t)nrows * DM; i += (size_t)nwg * blockDim.x) {
        const int r = (int)(i >> 10), d = (int)(i & 1023);
        float* xp = st_row(p, r) + d;
        *xp = *xp + MOD[(l * 9 + mod_row(r)) * 6144 + 5 * DM + d] * (bf2f(YS[(size_t)(2 * r) * DM + d]) + bf2f(YS[(size_t)(2 * r + 1) * DM + d]));
    }
}

#define GAS __attribute__((address_space(1)))
#define XB_TMO      128
#define XB_XCNT(j)  (256  + 64 * (j))
#define XB_XSUB(j)  (1280 + 64 * (j))
#define XB_XGEN(j)  (2304 + 64 * (j))
#define XB_TOP      3328
#define XB_TOPGEN   3392
#define XCD_BAR_WORDS 3456
#define XB_SPIN_CAP (1u << 24)
__device__ __forceinline__ unsigned xb_ld(unsigned* p)              { return __hip_atomic_load(p, __ATOMIC_RELAXED, __HIP_MEMORY_SCOPE_AGENT); }
__device__ __forceinline__ unsigned xb_add(unsigned* p, unsigned v) { return __hip_atomic_fetch_add(p, v, __ATOMIC_RELAXED, __HIP_MEMORY_SCOPE_AGENT); }
__device__ __forceinline__ unsigned xb_xcc_id() { return (unsigned)__builtin_amdgcn_s_getreg((3 << 11) | 20) & 0xFu; }
#define XB_SPIN(cond, bar) do { unsigned _sp = 0; while (cond) { __builtin_amdgcn_s_sleep(1); \
    if ((++_sp & 255u) == 0u) { if (xb_ld(&(bar)[XB_TMO])) break; if (_sp > XB_SPIN_CAP) { atomicAdd(&(bar)[XB_TMO], 1u); break; } } } } while (0)
struct XcdBarrier { unsigned* bar; unsigned x; volatile LAS unsigned* st; };
__device__ __forceinline__ XcdBarrier xcd_barrier_post(unsigned* bar, volatile LAS unsigned* st) {
    XcdBarrier b; b.bar = bar; b.x = xb_xcc_id(); b.st = st;
    if (threadIdx.x == 0) (void)xb_add(&bar[XB_XCNT(b.x)], 1u);
    return b;
}
__device__ __forceinline__ void xcd_barrier_complete(unsigned* bar, unsigned x, unsigned& nloc, unsigned& nx) {
    const unsigned G = gridDim.x * gridDim.y * gridDim.z;
    unsigned sum, cnt, mine, sp = 0u;
    for (;;) {
        sum = 0u; cnt = 0u; mine = 0u;
#pragma unroll
        for (unsigned j = 0; j < 16; ++j) { const unsigned c = xb_ld(&bar[XB_XCNT(j)]); sum += c; cnt += (c > 0u) ? 1u : 0u; mine = (j == x) ? c : mine; }
        if (sum == G) break;
        __builtin_amdgcn_s_sleep(1);
        if ((++sp & 255u) == 0u) { if (xb_ld(&bar[XB_TMO])) break; if (sp > XB_SPIN_CAP) { atomicAdd(&bar[XB_TMO], 1u); break; } }
    }
    nloc = mine > 0u ? mine : 1u; nx = cnt > 0u ? cnt : 1u;
}
__device__ __forceinline__ void xcd_barrier(const XcdBarrier& b) {
    asm volatile("s_waitcnt vmcnt(0)" ::: "memory");
    __syncthreads();
    if (threadIdx.x == 0) {
        unsigned* bar = b.bar;
        __builtin_amdgcn_s_waitcnt(0);
        unsigned nloc = b.st[0], nx = b.st[1];
        if (nloc == 0u) { xcd_barrier_complete(bar, b.x, nloc, nx); b.st[0] = nloc; b.st[1] = nx; }
        const unsigned old = xb_add(&bar[XB_XSUB(b.x)], 1u);
        const unsigned gen = old / nloc;
        if (old + 1u == (gen + 1u) * nloc) {
            __builtin_amdgcn_fence(__ATOMIC_RELEASE, "agent");
            asm volatile("s_waitcnt vmcnt(0)" ::: "memory");
            const unsigned og = xb_add(&bar[XB_TOP], 1u);
            const unsigned tg = og / nx;
            if (og + 1u == (tg + 1u) * nx) xb_add(&bar[XB_TOPGEN], 1u);
            else XB_SPIN(xb_ld(&bar[XB_TOPGEN]) == tg, bar);
            __builtin_amdgcn_fence(__ATOMIC_ACQUIRE, "agent");
            xb_add(&bar[XB_XGEN(b.x)], 1u);
            asm volatile("s_waitcnt vmcnt(0)" ::: "memory");
        } else {
            XB_SPIN(xb_ld(&bar[XB_XGEN(b.x)]) == gen, bar);
            __builtin_amdgcn_fence(__ATOMIC_ACQUIRE, "agent");
            asm volatile("s_waitcnt vmcnt(0)" ::: "memory");
        }
    }
    __syncthreads();
}

__device__ __forceinline__ void xcd_barrier_lean(const XcdBarrier& b) {
    asm volatile("s_waitcnt vmcnt(0)" ::: "memory");
    __syncthreads();
    if (threadIdx.x == 0) {
        unsigned* bar = b.bar;
        __builtin_amdgcn_s_waitcnt(0);
        unsigned nloc = b.st[0], nx = b.st[1];
        const unsigned old = xb_add(&bar[XB_XSUB(b.x)], 1u);
        const unsigned gen = old / nloc;
        if (old + 1u == (gen + 1u) * nloc) {
            __builtin_amdgcn_fence(__ATOMIC_RELEASE, "agent");
            asm volatile("s_waitcnt vmcnt(0)" ::: "memory");
            const unsigned og = xb_add(&bar[XB_TOP], 1u);
            const unsigned tg = og / nx;
            if (og + 1u == (tg + 1u) * nx) xb_add(&bar[XB_TOPGEN], 1u);
            else XB_SPIN(xb_ld(&bar[XB_TOPGEN]) == tg, bar);
            __builtin_amdgcn_fence(__ATOMIC_ACQUIRE, "agent");
            xb_add(&bar[XB_XGEN(b.x)], 1u);
            asm volatile("s_waitcnt vmcnt(0)" ::: "memory");
        } else {
            XB_SPIN(xb_ld(&bar[XB_XGEN(b.x)]) == gen, bar);
            __builtin_amdgcn_fence(__ATOMIC_ACQUIRE, "agent");
            asm volatile("s_waitcnt vmcnt(0)" ::: "memory");
        }
    }
    __syncthreads();
}

constexpr int LDS_BYTES = 147456;
constexpr int MISC_OFF = 147456 - 128;
constexpr int CW_BAR = 4096;

__device__ __forceinline__ int owg(int w) { asm volatile("" : "+s"(w)); return w; }
__device__ __forceinline__ Params load_params() {
    Params r{};
#if defined(__HIP_DEVICE_COMPILE__)
    typedef const __attribute__((address_space(4))) unsigned long long* kq_t;
    kq_t k = (kq_t)__builtin_amdgcn_kernarg_segment_ptr(); asm volatile("" : "+s"(k));
    r.x = (const float*)(const __attribute__((address_space(1))) float*)k[0];
    r.c = (const float*)(const __attribute__((address_space(1))) float*)k[1];
    r.ctx = (const float*)(const __attribute__((address_space(1))) float*)k[2];
    r.c_ctx = (const float*)(const __attribute__((address_space(1))) float*)k[3];
    r.mod_w = (const float*)(const __attribute__((address_space(1))) float*)k[4];
    r.mod_b = (const float*)(const __attribute__((address_space(1))) float*)k[5];
    r.norm1_g = (const float*)(const __attribute__((address_space(1))) float*)k[6];
    r.norm2_g = (const float*)(const __attribute__((address_space(1))) float*)k[7];
    r.w_in = (const float*)(const __attribute__((address_space(1))) float*)k[8];
    r.rw_w0 = (const float*)(const __attribute__((address_space(1))) float*)k[9];
    r.rw_w_lora_b = (const float*)(const __attribute__((address_space(1))) float*)k[10];
    r.rw_a0 = (const float*)(const __attribute__((address_space(1))) float*)k[11];
    r.rw_a_lora_b = (const float*)(const __attribute__((address_space(1))) float*)k[12];
    r.rw_g_lora_b = (const float*)(const __attribute__((address_space(1))) float*)k[13];
    r.rw_k_k = (const float*)(const __attribute__((address_space(1))) float*)k[14];
    r.rw_k_a = (const float*)(const __attribute__((address_space(1))) float*)k[15];
    r.rw_r_k = (const float*)(const __attribute__((address_space(1))) float*)k[16];
    r.rw_ln_g = (const float*)(const __attribute__((address_space(1))) float*)k[17];
    r.rw_ln_b = (const float*)(const __attribute__((address_space(1))) float*)k[18];
    r.na_q_g = (const float*)(const __attribute__((address_space(1))) float*)k[19];
    r.na_k_g = (const float*)(const __attribute__((address_space(1))) float*)k[20];
    r.na_rpb = (const float*)(const __attribute__((address_space(1))) float*)k[21];
    r.proj_a = (const float*)(const __attribute__((address_space(1))) float*)k[22];
    r.proj_b = (const float*)(const __attribute__((address_space(1))) float*)k[23];
    r.w_out = (const float*)(const __attribute__((address_space(1))) float*)k[24];
    r.router_w = (const float*)(const __attribute__((address_space(1))) float*)k[25];
    r.router_bias = (const float*)(const __attribute__((address_space(1))) float*)k[26];
    r.moe_w1 = (const float*)(const __attribute__((address_space(1))) float*)k[27];
    r.moe_w3 = (const float*)(const __attribute__((address_space(1))) float*)k[28];
    r.moe_w2 = (const float*)(const __attribute__((address_space(1))) float*)k[29];
    r.out = (float*)(__attribute__((address_space(1))) float*)k[30]; r.ws = (unsigned char*)(__attribute__((address_space(1))) unsigned char*)k[31];
#endif
    return r;
}
#define PRM(name) const Params name = load_params()
__global__ void __launch_bounds__(512, 2) mega(Params p_unused) {
    extern __shared__ __attribute__((aligned(16))) unsigned char lds[];
    float* sm = (float*)lds;
    volatile LAS unsigned* MISC = (volatile LAS unsigned*)((LAS unsigned char*)lds + MISC_OFF);
    if (threadIdx.x < 32) MISC[threadIdx.x] = 0u;
    __syncthreads();
    { PRM(p); (void)xcd_barrier_post((unsigned*)(p.ws + WS_CTL) + CW_BAR, MISC + 8); }
    const int wg0 = blockIdx.x, nwg = gridDim.x;
#define wg owg(wg0)
#define MKBAR(b_) PRM(pb_); XcdBarrier b_; b_.bar = (unsigned*)(pb_.ws + WS_CTL) + CW_BAR; b_.x = xb_xcc_id(); b_.st = MISC + 8
#define GRID_BAR_FIRST() do { MKBAR(b_); xcd_barrier(b_); } while (0)
#define GRID_BAR() do { MKBAR(b_); xcd_barrier_lean(b_); } while (0)
    { PRM(p); ph_mod2(p, sm, wg, nwg); }
    __syncthreads();
    { PRM(p); ph_convert_dense(p, lds, 0, wg, nwg); } GRID_BAR_FIRST();
    { PRM(p); ph_norm1v(p, wg, nwg); } GRID_BAR();
#define LAYER_BODY(l) do { \
        { PRM(p); ph_win_mfma(p, lds, l, wg, nwg); } GRID_BAR(); \
        { PRM(p); ph_scan_natt(p, lds, l, wg, nwg); } GRID_BAR(); \
        { PRM(p); ph_rwkvout2(p, lds, l, wg, nwg); } GRID_BAR(); \
        { PRM(p); ph_merge_mfma(p, lds, l, wg, nwg); } GRID_BAR(); \
        { PRM(p); ph_wout_mfma(p, lds, l, wg, nwg); } GRID_BAR(); \
        { PRM(p); ph_route2(p, sm, l, wg, nwg); } \
        if (l == 0) { __syncthreads(); PRM(p); ph_convert_dense(p, lds, 1, wg, nwg); } \
        GRID_BAR(); \
        { PRM(p); ph_lists2(p, sm, l, wg, nwg); } GRID_BAR(); \
        { PRM(p); ph_moe1_mfma(p, lds, l, wg, nwg); } \
        { PRM(p); ph_moe2_mfma(p, lds, l, wg, nwg); } GRID_BAR(); \
        { PRM(p); ph_combine_norm(p, l, wg, nwg); } if (l == 0) GRID_BAR(); \
    } while (0)
    LAYER_BODY(0);
    LAYER_BODY(1);
}
#undef wg
__global__ void k_zero(float* o, int n) { int i = blockIdx.x * blockDim.x + threadIdx.x; if (i < n) o[i] = 0.f; }

extern "C" void kernel_launch(void* const* d_in, const int* in_sizes, int n_in, void* d_out, int out_size, void* d_ws, size_t ws_size, hipStream_t stream) {
    static int grid = 0;
    if (grid == 0) {
        int dev = 0, cus = 0, per_cu = 0;
        if (hipGetDevice(&dev) != hipSuccess || hipDeviceGetAttribute(&cus, hipDeviceAttributeMultiprocessorCount, dev) != hipSuccess) { grid = -1; }
        else if (hipFuncSetAttribute((const void*)mega, hipFuncAttributeMaxDynamicSharedMemorySize, LDS_BYTES) != hipSuccess) { grid = -1; }
        else {
            if (hipOccupancyMaxActiveBlocksPerMultiprocessor(&per_cu, (const void*)mega, 512, LDS_BYTES) != hipSuccess || per_cu < 1) { fprintf(stderr, "occupancy query says %d\n", per_cu); }
            (void)hipGetLastError();
            grid = cus;
        }
    }
    if (grid <= 0 || n_in != 30 || ws_size < WS_END || out_size != NLAT * DM) {
        fprintf(stderr, "kernel_launch: unexpected grid %d n_in %d / ws_size %zu / out_size %d\n", grid, n_in, ws_size, out_size);
        hipLaunchKernelGGL(k_zero, dim3((out_size + 255) / 256), dim3(256), 0, stream, (float*)d_out, out_size);
        return;
    }
    Params p{};
    const float** pp = (const float**)&p;
    for (int i = 0; i < 30; ++i) pp[i] = (const float*)d_in[i];
    p.out = (float*)d_out; p.ws = (unsigned char*)d_ws;
    (void)hipMemsetAsync((char*)d_ws + WS_CTL, 0, 65536, stream);
    hipLaunchKernelGGL(mega, dim3(grid), dim3(512), LDS_BYTES, stream, p);
}
```

```cpp
#include <hip/hip_runtime.h>
#include <stdint.h>
#include <cstdio>

typedef unsigned short bf16_t;
__device__ __forceinline__ float bf2f(bf16_t v) { return __uint_as_float(((unsigned)v) << 16); }
__device__ __forceinline__ bf16_t f2bf(float f) { unsigned u = __float_as_uint(f); return (bf16_t)((u + 0x7fffu + ((u >> 16) & 1u)) >> 16); }

typedef unsigned v4u __attribute__((ext_vector_type(4)));
typedef unsigned v2u __attribute__((ext_vector_type(2)));
typedef float f32x4 __attribute__((ext_vector_type(4)));
__device__ __forceinline__ unsigned pk2(float lo, float hi) { return (unsigned)f2bf(lo) | ((unsigned)f2bf(hi) << 16); }
__device__ __forceinline__ void unpack8(const v4u w, float (&f)[8]) {
#pragma unroll
    for (int i = 0; i < 4; ++i) { f[2 * i] = __uint_as_float(w[i] << 16); f[2 * i + 1] = __uint_as_float(w[i] & 0xffff0000u); }
}
__device__ __forceinline__ void unpack4(const v2u w, float (&f)[4]) { f[0] = __uint_as_float(w.x << 16); f[1] = __uint_as_float(w.x & 0xffff0000u); f[2] = __uint_as_float(w.y << 16); f[3] = __uint_as_float(w.y & 0xffff0000u); }
constexpr int DM = 1024, NB = 8, SEQ = 2048, CTXL = 256, GW = 64;
constexpr int NLAT = NB * SEQ, NCTX = NB * CTXL, LR = NLAT + NCTX;
constexpr int ZC = 5504;
constexpr int C_R = 0, C_K = 512, C_V = 1024, C_LW = 1536, C_LA = 1664, C_LG = 1792, C_Q = 1920, C_KB = 2432, C_VB = 2944, C_GA = 3456, C_GB = 4480;
constexpr int NE = 16, DE = 512;
constexpr float RMS_EPS = 1e-6f, GN_EPS = 64e-5f;

constexpr size_t MiB = 1u << 20;
constexpr size_t WS_MOD = 0;
constexpr size_t WS_CTL = 1 * MiB;
constexpr size_t WS_LTOK = 2 * MiB;
constexpr size_t WS_LGATE = 4 * MiB;
constexpr size_t WS_TOKI = 6 * MiB;
constexpr size_t WS_TOKG = 6 * MiB + 512 * 1024;
constexpr size_t WS_CNTWG = 2 * MiB;
constexpr size_t WS_OFFS = 2 * MiB + 64 * 1024;
constexpr size_t WS_TEXP = 2 * MiB + 68 * 1024;
constexpr size_t WS_ROWDST = 3 * MiB;
constexpr size_t WS_ROWGATE = 3 * MiB + 512 * 1024;
constexpr size_t WS_CTXS = 8 * MiB;
constexpr size_t WS_W = 16 * MiB;
constexpr size_t WS_WIN_T = WS_W;
constexpr size_t WS_PA_T = WS_W + 11 * MiB;
constexpr size_t WS_PB_T = WS_W + 12 * MiB;
constexpr size_t WS_WO_T = WS_W + 13 * MiB;
constexpr size_t WS_GL_T = WS_W + 15 * MiB;
constexpr size_t WS_LW_T = WS_W + 15 * MiB + 256 * 1024;
constexpr size_t WS_LA_T = WS_W + 15 * MiB + 384 * 1024;
constexpr size_t WS_Z = 32 * MiB;
constexpr size_t WS_X1B = WS_Z;
constexpr size_t WS_H2 = WS_Z;
constexpr size_t WS_TMP1 = WS_Z + 36 * MiB;
constexpr size_t WS_HID = WS_Z + 116 * MiB;
constexpr size_t WS_H2S = WS_Z;
constexpr size_t WS_HID2 = WS_Z + 80 * MiB;
constexpr size_t WS_YS2 = WS_Z + 120 * MiB;
constexpr size_t WS_B = 226 * MiB;
constexpr size_t WS_W13T = WS_B;
constexpr size_t WS_W2T = WS_B + 32 * MiB;
constexpr size_t WS_H2T = WS_B + 84 * MiB;
constexpr size_t WS_VT = WS_B + 54 * MiB;
constexpr size_t WS_SG = WS_B + 72 * MiB;
constexpr size_t WS_Y2 = WS_B + 90 * MiB;
constexpr size_t WS_H = WS_B;
constexpr size_t WS_SW = WS_B;
constexpr size_t WS_SB = WS_B + 36 * MiB;
constexpr size_t WS_SKD = WS_B + 54 * MiB;
constexpr size_t WS_SKK = WS_B + 72 * MiB;
constexpr size_t WS_Y = WS_B + 90 * MiB;
constexpr size_t WS_YB = WS_B + 126 * MiB;
constexpr size_t WS_OUTA = WS_B + 54 * MiB;
constexpr size_t WS_MERGED = WS_B + 90 * MiB;
constexpr size_t WS_YS = WS_B + 54 * MiB;
constexpr size_t WS_END = WS_B + 144 * MiB;

struct Params {
    const float *x, *c, *ctx, *c_ctx, *mod_w, *mod_b, *norm1_g, *norm2_g, *w_in,
        *rw_w0, *rw_w_lora_b, *rw_a0, *rw_a_lora_b, *rw_g_lora_b, *rw_k_k, *rw_k_a, *rw_r_k, *rw_ln_g, *rw_ln_b,
        *na_q_g, *na_k_g, *na_rpb, *proj_a, *proj_b, *w_out, *router_w, *router_bias, *moe_w1, *moe_w3, *moe_w2;
    float* out; unsigned char* ws;
};

__device__ __forceinline__ int otid() { int t = threadIdx.x; asm volatile("" : "+v"(t)); return t; }
template <int M> __device__ __forceinline__ float swz_xor(float v) { return __int_as_float(__builtin_amdgcn_ds_swizzle(__float_as_int(v), (M << 10) | 0x1f)); }
__device__ __forceinline__ float xor32_add(float v) { auto rr = __builtin_amdgcn_permlane32_swap(__float_as_uint(v), __float_as_uint(v), false, false); return __uint_as_float(rr[0]) + __uint_as_float(rr[1]); }
__device__ __forceinline__ float xor32_max(float v) { auto rr = __builtin_amdgcn_permlane32_swap(__float_as_uint(v), __float_as_uint(v), false, false); return fmaxf(__uint_as_float(rr[0]), __uint_as_float(rr[1])); }
__device__ __forceinline__ float wave_sum(float v) {
    v += swz_xor<1>(v); v += swz_xor<2>(v); v += swz_xor<4>(v); v += swz_xor<8>(v); v += swz_xor<16>(v);
    return xor32_add(v);
}
__device__ __forceinline__ float wave_max(float v) {
    v = fmaxf(v, swz_xor<1>(v)); v = fmaxf(v, swz_xor<2>(v)); v = fmaxf(v, swz_xor<4>(v)); v = fmaxf(v, swz_xor<8>(v)); v = fmaxf(v, swz_xor<16>(v));
    return xor32_max(v);
}
__device__ __forceinline__ float rdlane(float v, int l) { return __int_as_float(__builtin_amdgcn_readlane(__float_as_int(v), l)); }
__device__ __forceinline__ float sigmoidf_(float x) { return __builtin_amdgcn_rcpf(1.f + __expf(-x)); }
__device__ __forceinline__ int mod_row(int r) { return r < NLAT ? (r >> 11) : 8; }
__device__ __forceinline__ const float* in_row(const Params& p, int r) { return r < NLAT ? p.x + (size_t)r * DM : p.ctx + (size_t)(r - NLAT) * DM; }
__device__ __forceinline__ float* st_row(const Params& p, int r) { return r < NLAT ? p.out + (size_t)r * DM : (float*)(p.ws + WS_CTXS) + (size_t)(r - NLAT) * DM; }

__device__ __forceinline__ void ph_mod(const Params& p, float* sm, int wg, int nwg) {
    for (int i = otid(); i < 9 * DM; i += blockDim.x) {
        int j = i >> 10, k = i & 1023; float v = j < 8 ? p.c[j * DM + k] : p.c_ctx[k];
        sm[i] = v * sigmoidf_(v);
    }
    __syncthreads();
    float* MOD = (float*)(p.ws + WS_MOD);
    for (int o = wg * blockDim.x + otid(); o < 2 * 6144; o += nwg * blockDim.x) {
        int l = o / 6144, n = o % 6144;
        float acc[9];
#pragma unroll
        for (int j = 0; j < 9; ++j) acc[j] = 0.f;
        const float* w = p.mod_w + (size_t)l * DM * 6144 + n;
        for (int k = 0; k < DM; ++k) { float wv = w[(size_t)k * 6144];
#pragma unroll
            for (int j = 0; j < 9; ++j) acc[j] += sm[j * DM + k] * wv; }
        float bb = p.mod_b[l * 6144 + n];
#pragma unroll
        for (int j = 0; j < 9; ++j) MOD[(l * 9 + j) * 6144 + n] = acc[j] + bb;
    }
}

__device__ __forceinline__ void ph_mod2(const Params& p, float* sm, int wg, int nwg) {
    const int tid = otid(), lane = tid & 63, wv = tid >> 6;
    float* sc = sm;
    float* red = sm + 9 * 1024;
    for (int i = tid; i < 9 * DM; i += 512) { const int j = i >> 10, k = i & 1023; const float v = j < 8 ? p.c[j * DM + k] : p.c_ctx[k]; sc[i] = v * sigmoidf_(v); }
    __syncthreads();
    float* MOD = (float*)(p.ws + WS_MOD);
    for (int unit = wg; unit < 192; unit += nwg) {
        const int l = unit / 96, n0 = (unit % 96) * 64;
        const float* w = p.mod_w + ((size_t)l * DM + wv * 128) * 6144 + n0 + lane;
        float acc[9];
#pragma unroll
        for (int j = 0; j < 9; ++j) acc[j] = 0.f;
        for (int k0 = 0; k0 < 128; k0 += 16) {
            float wv_[16];
#pragma unroll
            for (int i = 0; i < 16; ++i) wv_[i] = w[(size_t)(k0 + i) * 6144];
#pragma unroll
            for (int i4 = 0; i4 < 4; ++i4)
#pragma unroll
                for (int j = 0; j < 9; ++j) { const float4 s4 = *(const float4*)(sc + j * DM + wv * 128 + k0 + i4 * 4);
                    acc[j] += s4.x * wv_[i4 * 4] + s4.y * wv_[i4 * 4 + 1] + s4.z * wv_[i4 * 4 + 2] + s4.w * wv_[i4 * 4 + 3]; }
        }
        __syncthreads();
#pragma unroll
        for (int j = 0; j < 9; ++j) red[(wv * 9 + j) * 64 + lane] = acc[j];
        __syncthreads();
        for (int o = tid; o < 9 * 64; o += 512) { const int j = o >> 6, cc = o & 63; float sum = p.mod_b[l * 6144 + n0 + cc];
#pragma unroll
            for (int w8 = 0; w8 < 8; ++w8) sum += red[(w8 * 9 + j) * 64 + cc];
            MOD[(l * 9 + j) * 6144 + n0 + cc] = sum; }
    }
}
__device__ __forceinline__ void norm_row_to_h(const f32x4 (&v)[4], const float* g1, const float* m, bf16_t* hrow, int lane) {
    float ss = 0.f;
#pragma unroll
    for (int j = 0; j < 4; ++j) ss += (v[j][0] * v[j][0] + v[j][1] * v[j][1]) + (v[j][2] * v[j][2] + v[j][3] * v[j][3]);
    ss = wave_sum(ss);
    const float rs = rsqrtf(ss * (1.f / DM) + RMS_EPS);
#pragma unroll
    for (int j = 0; j < 4; ++j) { const int d = 4 * lane + 256 * j;
        const f32x4 g = *(const f32x4*)(g1 + d), sh = *(const f32x4*)(m + d), scl = *(const f32x4*)(m + DM + d);
        const f32x4 y = v[j] * rs * g * (scl + 1.f) + sh;
        v2u w; w.x = pk2(y[0], y[1]); w.y = pk2(y[2], y[3]);
        *(v2u*)(hrow + d) = w; }
}
__device__ __forceinline__ void ph_norm1v(const Params& p, int wg, int nwg) {
    const int lane = otid() & 63, wv = otid() >> 6;
    const float* MOD = (const float*)(p.ws + WS_MOD);
    bf16_t* H = (bf16_t*)(p.ws + WS_H);
    for (int r = wg * 8 + wv; r < LR; r += nwg * 8) {
        const float* xr = in_row(p, r);
        f32x4 v[4];
#pragma unroll
        for (int j = 0; j < 4; ++j) v[j] = *(const f32x4*)(xr + 4 * lane + 256 * j);
        norm_row_to_h(v, p.norm1_g, MOD + (0 * 9 + mod_row(r)) * 6144, H + (size_t)r * DM, lane);
    }
}
__device__ __forceinline__ void ph_combine_norm(const Params& p, int l, int wg, int nwg) {
    const int lane = otid() & 63, wv = otid() >> 6;
    const float* MOD = (const float*)(p.ws + WS_MOD);
    const bf16_t* YS = (const bf16_t*)(p.ws + WS_YS2);
    bf16_t* H = (bf16_t*)(p.ws + WS_H);
    const int nrows = (l == 1) ? NLAT : LR;
    for (int r = wg * 8 + wv; r < nrows; r += nwg * 8) {
        float* xr = st_row(p, r);
        bf16_t* xb = (r < NLAT) ? (bf16_t*)p.out + (size_t)r * DM : (bf16_t*)(p.ws + WS_CTXS) + (size_t)(r - NLAT) * DM;
        const float* m = MOD + (l * 9 + mod_row(r)) * 6144;
        f32x4 v[4];
#pragma unroll
        for (int j = 0; j < 4; ++j) { const int d = 4 * lane + 256 * j;
            float a[4], b[4]; unpack4(*(const v2u*)(YS + (size_t)(2 * r) * DM + d), a); unpack4(*(const v2u*)(YS + (size_t)(2 * r + 1) * DM + d), b);
            const f32x4 gt = *(const f32x4*)(m + 5 * DM + d);
            float x4[4]; unpack4(*(const v2u*)((const bf16_t*)(p.ws + WS_X1B) + (size_t)r * DM + d), x4);
            f32x4 x = {x4[0], x4[1], x4[2], x4[3]};
            x[0] += gt[0] * (a[0] + b[0]); x[1] += gt[1] * (a[1] + b[1]); x[2] += gt[2] * (a[2] + b[2]); x[3] += gt[3] * (a[3] + b[3]);
            if (l == 0) { v2u w; w.x = pk2(x[0], x[1]); w.y = pk2(x[2], x[3]); *(v2u*)(xb + d) = w; } else *(f32x4*)(xr + d) = x;
            v[j] = x; }
        if (l == 0) norm_row_to_h(v, p.norm1_g + DM, MOD + (1 * 9 + mod_row(r)) * 6144, H + (size_t)r * DM, lane);
    }
}

__device__ __forceinline__ void ph_norm1(const Params& p, int l, int wg, int nwg) {
    const int lane = otid() & 63, wv = otid() >> 6, nwv = blockDim.x >> 6;
    const float* MOD = (const float*)(p.ws + WS_MOD);
    bf16_t* H = (bf16_t*)(p.ws + WS_H);
    for (int r = wg * nwv + wv; r < LR; r += nwg * nwv) {
        const float* xr = l == 0 ? in_row(p, r) : st_row(p, r);
        float v[16]; float ss = 0.f;
#pragma unroll
        for (int i = 0; i < 16; ++i) { v[i] = xr[lane + 64 * i]; ss += v[i] * v[i]; }
        ss = wave_sum(ss);
        const float rs = rsqrtf(ss * (1.f / DM) + RMS_EPS);
        const float* m = MOD + (l * 9 + mod_row(r)) * 6144;
#pragma unroll
        for (int i = 0; i < 16; ++i) { int d = lane + 64 * i;
            float y = v[i] * rs * p.norm1_g[l * DM + d];
            H[(size_t)r * DM + d] = f2bf(y * (1.f + m[DM + d]) + m[d]); }
    }
}

namespace pg8 {
#define PG8_LAS __attribute__((address_space(3)))
typedef unsigned short bf16_t;
typedef short bf16x8 __attribute__((ext_vector_type(8)));
typedef float f32x4 __attribute__((ext_vector_type(4)));
typedef unsigned u32x4 __attribute__((ext_vector_type(4)));
constexpr int BM = 256, BK = 64, HALF = 128, HTB = HALF * BK * 2  , STAGE_BYTES = 8 * HTB, NXCD = 8, WGM = 8;

__host__ __device__ __forceinline__ int lds_byte(int r, int c) { const int st = (r >> 4) * 2 + (c >> 5), rr = r & 15, cc = c & 31, ob = rr * 64 + cc * 2; return st * 1024 + (ob ^ (((ob >> 9) & 1) << 5)); }
__host__ __device__ __forceinline__ void stage_rc(int b, int& R, int& C) { const int st = b / 1024, sb = b % 1024, swz = sb ^ (((sb >> 9) & 1) << 5); R = (st >> 1) * 16 + swz / 64; C = (st & 1) * 32 + (swz % 64) / 2; }
__host__ __device__ __forceinline__ int perm32(int rho) { const int n = rho >> 4, i = rho & 15; return 8 * (i >> 2) + 4 * n + (i & 3); }

struct Unit { int pm, pn; unsigned boff; };
struct Gemm { const bf16_t* A; const bf16_t* Bt; int M, N, K; };

struct StaticOrder {
    int nM, nN, nwg, G, c;
    __host__ __device__ void init(int M, int N, int G_, int c_) { nM = M / BM; nN = N / BM; nwg = nM * nN; G = G_; c = c_; }
    __host__ __device__ void unit_of(int L, Unit& u) const {
        int wgid = L; { const int q = nwg / NXCD, r = nwg % NXCD, xcd = wgid % NXCD, off = wgid / NXCD; wgid = (xcd < r ? xcd * (q + 1) : r * (q + 1) + (xcd - r) * q) + off; }
        const int nig = WGM * nN, gid = wgid / nig, fm = gid * WGM, gsz = (nM - fm) < WGM ? (nM - fm) : WGM;
        u.pm = fm + ((wgid % nig) % gsz); u.pn = (wgid % nig) / gsz; u.boff = 0u;
    }
    __host__ __device__ bool next(int i, Unit& u) const {
        const long L = (long)i * G + c; if (L >= nwg) return false;
        unit_of((int)L, u); return true;
    }
    __device__ __forceinline__ void a_ready(const Unit&) const {}
    __device__ __forceinline__ void done(const Unit&) const {}
    static constexpr bool GATHER = false;
    const int* rowsrc = nullptr;
    static constexpr bool DUALK = false;
    long dA = 0, dB = 0;
};

typedef float cvt_f32x2_t __attribute__((ext_vector_type(2))); typedef __bf16 cvt_bf16x2_t __attribute__((ext_vector_type(2)));
__device__ __forceinline__ unsigned cvt_pk_bf16(float lo, float hi) { const cvt_f32x2_t v = {lo, hi}; const cvt_bf16x2_t b = __builtin_convertvector(v, cvt_bf16x2_t); return __builtin_bit_cast(unsigned, b); }
template <class Epi, class Sched, bool ALIGN_EPI = false, bool SP2 = false>
__device__ __forceinline__ void gemm_phase(PG8_LAS unsigned char* lds, const Gemm g, const Sched& S, const Epi& E) {
    const int tid = otid(), wid = __builtin_amdgcn_readfirstlane(tid >> 6), lane = tid & 63, wr = wid >> 2, wc = wid & 3, fr = lane & 15, fq = lane >> 4;
    constexpr bool DUALK = Sched::DUALK;
    const int K = g.K, nt = DUALK ? 2 * (K / BK) : K / BK;
    constexpr bool GATH = Sched::GATHER;
    static_assert(!GATH || SP2, "gather needs the SP2 loop");
    unsigned voffA[2], voffB[2];
#pragma unroll
    for (int i = 0; i < 2; ++i) { int R, C; stage_rc(tid * 16 + i * 8192, R, C); const int Rb = Epi::PERM ? ((R & ~31) + perm32(R & 31)) : R;
        voffA[i] = (unsigned)(R * K + C) * 2u; voffB[i] = (unsigned)(Rb * K + C) * 2u; }
    const size_t kstep = (size_t)(BK * 2);
    const size_t hstep = (size_t)HALF * K * 2;
    const size_t tstep = 2 * hstep;
    const unsigned ldsw = (unsigned)wid * 1024u;
    const int aoff = lds_byte(wr * 64 + fr, fq * 8), boff = lds_byte(wc * 32 + fr, fq * 8);
#define PG8_SA(b, h) (((b) * 2 + (h)) * HTB)
#define PG8_SB(b, h) ((4 + (b) * 2 + (h)) * HTB)
#define PG8_STAGE(bufoff, gbase, voff) do { _Pragma("unroll") for (int _i = 0; _i < 2; ++_i) \
        __builtin_amdgcn_global_load_lds((const unsigned*)((const char*)(gbase) + (voff)[_i]), (PG8_LAS unsigned*)(lds + (bufoff) + ldsw + _i * 8192), 16, 0, 0); } while (0)
#define PG8_STAGEG(bufoff, off2, kb) do { _Pragma("unroll") for (int _i = 0; _i < 2; ++_i) \
        __builtin_amdgcn_global_load_lds((const unsigned*)((const char*)g.A + (kb) + (off2)[_i]), (PG8_LAS unsigned*)(lds + (bufoff) + ldsw + _i * 8192), 16, 0, 0); } while (0)
#define PG8_STA(bufoff, pexpr, hh, usenext, kb) do { if constexpr (GATH) { if (usenext) PG8_STAGEG(bufoff, gn[hh], kb); else PG8_STAGEG(bufoff, go[hh], kb); } else { PG8_STAGE(bufoff, pexpr, voffA); } } while (0)
#define PG8_GOFF(dst, pm_) do { if constexpr (GATH) { _Pragma("unroll") for (int h_ = 0; h_ < 2; ++h_) _Pragma("unroll") for (int i_ = 0; i_ < 2; ++i_) { int R_, C_; stage_rc(tid * 16 + i_ * 8192, R_, C_); \
        const int v_ = S.rowsrc[(pm_) * 256 + h_ * 128 + R_]; dst[h_][i_] = (unsigned)((v_ < 0 ? 0 : v_) >> 1) * (unsigned)(K * 2) + (unsigned)(C_ * 2); } } } while (0)
#define PG8_LDA(dst, b, h) do { _Pragma("unroll") for (int m = 0; m < 4; ++m) _Pragma("unroll") for (int k = 0; k < 2; ++k) dst[m][k] = *(const PG8_LAS bf16x8*)(lds + PG8_SA(b, h) + aoff + m * 2048 + k * 1024); } while (0)
#define PG8_LDB(dst, b, h) do { _Pragma("unroll") for (int n = 0; n < 2; ++n) _Pragma("unroll") for (int k = 0; k < 2; ++k) dst[n][k] = *(const PG8_LAS bf16x8*)(lds + PG8_SB(b, h) + boff + n * 2048 + k * 1024); } while (0)
#define PG8_MMA(ai, bj, At, Bt) do { __builtin_amdgcn_s_setprio(1); _Pragma("unroll") for (int m = 0; m < 4; ++m) _Pragma("unroll") for (int n = 0; n < 2; ++n) _Pragma("unroll") for (int k = 0; k < 2; ++k) \
        acc[ai][bj][m][n] = __builtin_amdgcn_mfma_f32_16x16x32_bf16(Bt[n][k], At[m][k], acc[ai][bj][m][n], 0, 0, 0); __builtin_amdgcn_s_setprio(0); } while (0)
#define PG8_WAIT_V(n) asm volatile("s_waitcnt vmcnt(" #n ")" ::: "memory")
#define PG8_WAIT_L(n) asm volatile("s_waitcnt lgkmcnt(" #n ")" ::: "memory")
#define PG8_BAR __builtin_amdgcn_s_barrier()
#define PG8_SCHED __builtin_amdgcn_sched_barrier(0)
    Unit cur, nxt; int ui = 0;
    if (!S.next(0, cur)) return;
    f32x4 acc[2][2][4][2];
#pragma unroll
    for (int a = 0; a < 2; ++a)
#pragma unroll
        for (int b = 0; b < 2; ++b)
#pragma unroll
            for (int m = 0; m < 4; ++m)
#pragma unroll
                for (int n = 0; n < 2; ++n) acc[a][b][m][n] = (f32x4){0.f, 0.f, 0.f, 0.f};
    bf16x8 At[4][2], B0[2][2], B1[2][2];
    const char* cA = (const char*)g.A + (size_t)cur.pm * tstep; const char* cB = (const char*)g.Bt + cur.boff + (size_t)cur.pn * tstep;
    unsigned go[2][2] = {{0u, 0u}, {0u, 0u}}, gn[2][2] = {{0u, 0u}, {0u, 0u}};
    PG8_GOFF(go, cur.pm);
    S.a_ready(cur);
    if constexpr (SP2) {
        PG8_STAGE(PG8_SB(0, 0), cB, voffB); PG8_STAGE(PG8_SB(0, 1), cB + hstep, voffB); PG8_STA(PG8_SA(0, 0), cA, 0, false, (size_t)0); PG8_STA(PG8_SA(0, 1), cA + hstep, 1, false, (size_t)0);
        if (wr == 1) PG8_BAR;
        PG8_WAIT_V(2); PG8_BAR;
        PG8_STAGE(PG8_SB(1, 0), cB + kstep, voffB); PG8_STA(PG8_SA(1, 0), cA + kstep, 0, false, kstep); PG8_STAGE(PG8_SB(1, 1), cB + hstep + kstep, voffB);
        PG8_WAIT_V(6); PG8_BAR;
    } else {
        PG8_STAGE(PG8_SB(0, 0), cB, voffB); PG8_STAGE(PG8_SA(0, 0), cA, voffA); PG8_STAGE(PG8_SB(0, 1), cB + hstep, voffB); PG8_STAGE(PG8_SA(0, 1), cA + hstep, voffA);
        if (wr == 1) PG8_BAR;
        PG8_WAIT_V(4); PG8_BAR;
        PG8_STAGE(PG8_SB(1, 0), cB + kstep, voffB); PG8_STAGE(PG8_SA(1, 0), cA + kstep, voffA); PG8_STAGE(PG8_SB(1, 1), cB + hstep + kstep, voffB);
        PG8_WAIT_V(6); PG8_BAR;
    }
    for (;;) {
        const bool has_next = S.next(ui + 1, nxt);
        if constexpr (GATH) { if (has_next) PG8_GOFF(gn, nxt.pm); else { _Pragma("unroll") for (int h_ = 0; h_ < 2; ++h_) _Pragma("unroll") for (int i_ = 0; i_ < 2; ++i_) gn[h_][i_] = go[h_][i_]; } }
        const char* nA = has_next ? (const char*)g.A + (size_t)nxt.pm * tstep : cA; const char* nB = has_next ? (const char*)g.Bt + nxt.boff + (size_t)nxt.pn * tstep : cB;
        for (int t = 0; t < nt; t += 2) {
            const bool last = (t == nt - 2);
            const long ja1 = (DUALK && t + 1 >= nt / 2) ? S.dA : 0, ja2 = (DUALK && t + 2 >= nt / 2) ? S.dA : 0, ja3 = (DUALK && t + 3 >= nt / 2) ? S.dA : 0, jb2 = (DUALK && t + 2 >= nt / 2) ? S.dB : 0, jb3 = (DUALK && t + 3 >= nt / 2) ? S.dB : 0;
            const char* a1 = cA + (size_t)(t + 1) * kstep + ja1;
            const char* a2 = last ? nA : cA + (size_t)(t + 2) * kstep + ja2; const char* b2 = last ? nB : cB + (size_t)(t + 2) * kstep + jb2;
            const char* a3 = last ? nA + kstep : cA + (size_t)(t + 3) * kstep + ja3; const char* b3 = last ? nB + kstep : cB + (size_t)(t + 3) * kstep + jb3;
            if constexpr (DUALK) { if (t == nt / 2) E.mid(acc, cur, wr, wc, fr, fq); }
            if (last && has_next) S.a_ready(nxt);
            const size_t kb2 = last ? (size_t)0 : (size_t)(t + 2) * kstep;
            if constexpr (SP2) {
            PG8_LDB(B0, 0, 0); PG8_LDB(B1, 0, 1); PG8_SCHED; PG8_LDA(At, 0, 0); PG8_STA(PG8_SA(1, 1), a1 + hstep, 1, false, (size_t)(t + 1) * kstep);
            PG8_WAIT_V(8); PG8_WAIT_L(0); PG8_BAR; PG8_MMA(0, 0, At, B0); PG8_MMA(0, 1, At, B1); PG8_BAR; PG8_SCHED;
            PG8_LDA(At, 0, 1); PG8_STAGE(PG8_SB(0, 0), b2, voffB); PG8_STAGE(PG8_SB(0, 1), b2 + hstep, voffB); PG8_STA(PG8_SA(0, 0), a2, 0, last, kb2);
            PG8_WAIT_V(8); PG8_WAIT_L(0); PG8_BAR; PG8_MMA(1, 0, At, B0); PG8_MMA(1, 1, At, B1); PG8_BAR; PG8_SCHED;
            PG8_LDB(B0, 1, 0); PG8_LDB(B1, 1, 1); PG8_SCHED; PG8_LDA(At, 1, 0); PG8_STA(PG8_SA(0, 1), a2 + hstep, 1, last, kb2);
            PG8_WAIT_V(8); PG8_WAIT_L(0); PG8_BAR; PG8_MMA(0, 0, At, B0); PG8_MMA(0, 1, At, B1); PG8_BAR; PG8_SCHED;
            PG8_LDA(At, 1, 1); PG8_STAGE(PG8_SB(1, 0), b3, voffB); PG8_STAGE(PG8_SB(1, 1), b3 + hstep, voffB); PG8_STA(PG8_SA(1, 0), a3, 0, last, kb2 + kstep);
            PG8_WAIT_V(8); PG8_WAIT_L(0); PG8_BAR; PG8_MMA(1, 0, At, B0); PG8_MMA(1, 1, At, B1); PG8_BAR; PG8_SCHED;
            } else {
            PG8_LDB(B0, 0, 0); PG8_SCHED; PG8_LDA(At, 0, 0); PG8_STAGE(PG8_SA(1, 1), a1 + hstep, voffA);
            PG8_WAIT_L(8); PG8_BAR; PG8_WAIT_L(0); PG8_MMA(0, 0, At, B0); PG8_BAR; PG8_SCHED;
            PG8_LDB(B1, 0, 1); PG8_STAGE(PG8_SB(0, 0), b2, voffB);
            PG8_BAR; PG8_WAIT_L(0); PG8_MMA(0, 1, At, B1); PG8_BAR;
            PG8_LDA(At, 0, 1); PG8_STAGE(PG8_SA(0, 0), a2, voffA);
            PG8_BAR; PG8_WAIT_L(0); PG8_MMA(1, 0, At, B0); PG8_BAR; PG8_SCHED;
            PG8_STAGE(PG8_SB(0, 1), b2 + hstep, voffB);
            PG8_WAIT_V(6); PG8_BAR; PG8_MMA(1, 1, At, B1); PG8_BAR;
            PG8_LDB(B0, 1, 0); PG8_SCHED; PG8_LDA(At, 1, 0); PG8_STAGE(PG8_SA(0, 1), a2 + hstep, voffA);
            PG8_WAIT_L(8); PG8_BAR; PG8_WAIT_L(0); PG8_MMA(0, 0, At, B0); PG8_BAR; PG8_SCHED;
            PG8_LDB(B1, 1, 1); PG8_STAGE(PG8_SB(1, 0), b3, voffB);
            PG8_BAR; PG8_WAIT_L(0); PG8_MMA(0, 1, At, B1); PG8_BAR;
            PG8_LDA(At, 1, 1); PG8_STAGE(PG8_SA(1, 0), a3, voffA);
            PG8_BAR; PG8_WAIT_L(0); PG8_MMA(1, 0, At, B0); PG8_BAR; PG8_SCHED;
            PG8_STAGE(PG8_SB(1, 1), b3 + hstep, voffB);
            PG8_WAIT_V(6); PG8_BAR; PG8_MMA(1, 1, At, B1); PG8_BAR;
            }
        }
        if constexpr (ALIGN_EPI) { if (wr == 0) PG8_BAR; }
        if constexpr (!Epi::AFTER_DRAIN) { E(acc, cur, wr, wc, fr, fq); S.done(cur); }
        if (!has_next) break;
#pragma unroll
        for (int a = 0; a < 2; ++a)
#pragma unroll
            for (int b = 0; b < 2; ++b)
#pragma unroll
                for (int m = 0; m < 4; ++m)
#pragma unroll
                    for (int n = 0; n < 2; ++n) acc[a][b][m][n] = (f32x4){0.f, 0.f, 0.f, 0.f};
        cur = nxt; cA = nA; cB = nB; ++ui;
        if constexpr (GATH) { _Pragma("unroll") for (int h_ = 0; h_ < 2; ++h_) _Pragma("unroll") for (int i_ = 0; i_ < 2; ++i_) go[h_][i_] = gn[h_][i_]; }
        if constexpr (ALIGN_EPI) { if (wr == 1) PG8_BAR; }
    }
    PG8_WAIT_V(0);
    if constexpr (!ALIGN_EPI) { if (wr == 0) PG8_BAR; }
    PG8_BAR;
    if constexpr (Epi::AFTER_DRAIN) { E.fused(acc, cur, wr, wc, fr, fq, lds, wid, lane); S.done(cur); }
#undef PG8_SA
#undef PG8_SB
#undef PG8_STAGE
#undef PG8_STAGEG
#undef PG8_STA
#undef PG8_GOFF
#undef PG8_LDA
#undef PG8_LDB
#undef PG8_MMA
#undef PG8_WAIT_V
#undef PG8_WAIT_L
#undef PG8_BAR
#undef PG8_SCHED
}
}

#define LAS __attribute__((address_space(3)))
__device__ __forceinline__ void tr_item(const float* W, int ldw, int k0, int n0, bf16_t* WT, int ldt, int dst_row0, LAS float* scr, int lane) {
    const int rr = lane >> 3, c4 = (lane & 7) * 4;
    f32x4 v[8];
#pragma unroll
    for (int i = 0; i < 8; ++i) v[i] = *(const f32x4*)(W + (size_t)(k0 + 8 * i + rr) * ldw + n0 + c4);
#pragma unroll
    for (int i = 0; i < 8; ++i) { LAS float* d = scr + (8 * i + rr) * 33 + c4; d[0] = v[i][0]; d[1] = v[i][1]; d[2] = v[i][2]; d[3] = v[i][3]; }
    asm volatile("s_waitcnt lgkmcnt(0)" ::: "memory");
    const int c = lane & 7;
#pragma unroll
    for (int j = 0; j < 4; ++j) { const int n = (lane >> 3) + 8 * j; const LAS float* sp = scr + (8 * c) * 33 + n;
        v4u o; o.x = pk2(sp[0 * 33], sp[1 * 33]); o.y = pk2(sp[2 * 33], sp[3 * 33]); o.z = pk2(sp[4 * 33], sp[5 * 33]); o.w = pk2(sp[6 * 33], sp[7 * 33]);
        *(v4u*)(WT + (size_t)(dst_row0 + n) * ldt + k0 + 8 * c) = o; }
    asm volatile("s_waitcnt lgkmcnt(0)" ::: "memory");
}
__device__ __forceinline__ void ph_convert_dense(const Params& p, unsigned char* ldsb, int l, int wg, int nwg) {
    const int lane = otid() & 63, wv = __builtin_amdgcn_readfirstlane(otid() >> 6);
    LAS float* scr = (LAS float*)((LAS unsigned char*)ldsb + wv * 16384);
    const int gw = wg * 8 + wv, NGW = nwg * 8;
    constexpr int I_WIN = 16 * 172, I_PA = 8 * 32, I_WO = 16 * 32, I_LO = 64, I_GL = 32, NIT = I_WIN + 2 * I_PA + I_WO + I_LO + I_GL;
    for (int it = gw; it < NIT; it += NGW) {
        int r = it;
        if (r < I_WIN) { const int kb = r / 172, nb = r % 172; tr_item(p.w_in + (size_t)l * DM * ZC, ZC, kb * 64, nb * 32, (bf16_t*)(p.ws + WS_WIN_T), DM, nb * 32, scr, lane); continue; } r -= I_WIN;
        if (r < I_PA) { const int kb = r / 32, nb = r % 32; tr_item(p.proj_a + (size_t)l * 512 * DM, DM, kb * 64, nb * 32, (bf16_t*)(p.ws + WS_PA_T), 512, nb * 32, scr, lane); continue; } r -= I_PA;
        if (r < I_PA) { const int kb = r / 32, nb = r % 32; tr_item(p.proj_b + (size_t)l * 512 * DM, DM, kb * 64, nb * 32, (bf16_t*)(p.ws + WS_PB_T), 512, nb * 32, scr, lane); continue; } r -= I_PA;
        if (r < I_WO) { const int kb = r / 32, nb = r % 32; tr_item(p.w_out + (size_t)l * DM * DM, DM, kb * 64, nb * 32, (bf16_t*)(p.ws + WS_WO_T), DM, nb * 32, scr, lane); continue; } r -= I_WO;
        if (r >= I_LO) { r -= I_LO; const int kb = r >> 4, nb = r & 15;
            tr_item(p.rw_g_lora_b + (size_t)l * 128 * 512, 512, kb * 64, nb * 32, (bf16_t*)(p.ws + WS_GL_T), 256, nb * 32, scr, lane); continue; }
        { const int which = r >> 5, dir = (r >> 4) & 1, nb = r & 15;
          const float* W = (which ? p.rw_a_lora_b : p.rw_w_lora_b) + (size_t)((l * 2 + dir) * 64) * 512;
          tr_item(W, 512, 0, nb * 32, (bf16_t*)(p.ws + (which ? WS_LA_T : WS_LW_T)) + (size_t)dir * 512 * 64, 64, nb * 32, scr, lane); }
    }
    for (int i = wg * 512 + otid(); i < 512 * 16; i += nwg * 512) ((v4u*)(p.ws + WS_GL_T))[(i >> 4) * 32 + 16 + (i & 15)] = (v4u){0u, 0u, 0u, 0u};
    for (int i = wg * 512 + otid(); i < 16384; i += nwg * 512) ((v4u*)(p.ws + WS_WIN_T + (size_t)ZC * DM * 2))[i] = (v4u){0u, 0u, 0u, 0u};
}

struct EpiZ {
    static constexpr bool PERM = true, AFTER_DRAIN = false;
    bf16_t* Z; bf16_t* SG; bf16_t* VT;
    __device__ __forceinline__ void operator()(const f32x4 (&acc)[2][2][4][2], const pg8::Unit& u, int wr, int wc, int fr, int fq) const {
        const int row0 = u.pm * 256 + wr * 64 + fr;
        const bool lat = u.pm < 64;
        const int bb = lat ? (u.pm >> 3) : (u.pm - 64);
#pragma unroll
        for (int ai = 0; ai < 2; ++ai)
#pragma unroll
            for (int m = 0; m < 4; ++m) { const int row = row0 + ai * 128 + m * 16;
#pragma unroll
                for (int bj = 0; bj < 2; ++bj) { const int cb = u.pn * 256 + bj * 128; if (cb >= ZC) continue;
                    const int col = cb + wc * 32 + 8 * fq;
                    const f32x4 v0 = acc[ai][bj][m][0], v1 = acc[ai][bj][m][1];
                    float o[8] = {v0[0], v0[1], v0[2], v0[3], v1[0], v1[1], v1[2], v1[3]};
                    if (cb == C_LG) {
#pragma unroll
                        for (int e = 0; e < 8; ++e) o[e] = sigmoidf_(o[e]);
                        v4u w; w.x = pg8::cvt_pk_bf16(o[0], o[1]); w.y = pg8::cvt_pk_bf16(o[2], o[3]); w.z = pg8::cvt_pk_bf16(o[4], o[5]); w.w = pg8::cvt_pk_bf16(o[6], o[7]);
                        *(v4u*)(SG + (size_t)row * 256 + (col - C_LG)) = w;
                        *(v4u*)(SG + (size_t)row * 256 + 128 + (col - C_LG)) = (v4u){0u, 0u, 0u, 0u};
                    } else if (cb >= C_GA) {
                        unsigned q[8];
#pragma unroll
                        for (int e = 0; e < 8; ++e) q[e] = (unsigned)(sigmoidf_(o[e]) * 255.f + 0.5f);
                        v2u w; w.x = q[0] | (q[1] << 8) | (q[2] << 16) | (q[3] << 24); w.y = q[4] | (q[5] << 8) | (q[6] << 16) | (q[7] << 24);
                        const int gbase = (col >= C_GB) ? C_GB : C_GA;
                        *(v2u*)((unsigned char*)Z + ((size_t)row * ZC + gbase) * 2 + (col - gbase)) = w;
                    } else {
                        if (cb == C_LW) {
#pragma unroll
                            for (int e = 0; e < 8; ++e) { const float ex = __expf(2.f * o[e]); o[e] = 1.f - 2.f * __builtin_amdgcn_rcpf(ex + 1.f); } }
                        v4u w; w.x = pg8::cvt_pk_bf16(o[0], o[1]); w.y = pg8::cvt_pk_bf16(o[2], o[3]); w.z = pg8::cvt_pk_bf16(o[4], o[5]); w.w = pg8::cvt_pk_bf16(o[6], o[7]);
                        if (!(cb >= C_VB && cb < C_VB + 512)) *(v4u*)(Z + (size_t)row * ZC + col) = w;
                        if (cb >= C_VB && cb < C_VB + 512) {
                            const int hd = (col - C_VB) >> 6, d0 = (col - C_VB) & 63;
                            const int tpos = lat ? 256 + (row & 2047) : (row & 255);
                            bf16_t* vt = VT + ((size_t)((bb * 8 + hd) * 64 + d0)) * 2304 + tpos;
#pragma unroll
                            for (int e = 0; e < 8; ++e) vt[(size_t)e * 2304] = (bf16_t)((e & 1) ? (((e >> 1) == 0 ? w.x : (e >> 1) == 1 ? w.y : (e >> 1) == 2 ? w.z : w.w) >> 16) : (((e >> 1) == 0 ? w.x : (e >> 1) == 1 ? w.y : (e >> 1) == 2 ? w.z : w.w) & 0xffffu));
                        }
                    } } }
    }
};
struct DualOrder : pg8::StaticOrder { static constexpr bool DUALK = true; };
struct EpiMergeF {
    static constexpr bool PERM = true, AFTER_DRAIN = false;
    const bf16_t* Z; bf16_t* MG;
    __device__ __forceinline__ void mid(f32x4 (&acc)[2][2][4][2], const pg8::Unit& u, int wr, int wc, int fr, int fq) const {
        int row0 = u.pm * 256 + wr * 64 + fr, colb = u.pn * 256 + wc * 32 + 8 * fq;
        asm volatile("" : "+v"(row0), "+v"(colb));
#pragma unroll
        for (int ai = 0; ai < 2; ++ai)
#pragma unroll
            for (int bj = 0; bj < 2; ++bj) {
                v2u qa[4], qb[4];
#pragma unroll
                for (int m = 0; m < 4; ++m) { const int row = row0 + ai * 128 + m * 16, col = colb + bj * 128;
                    qa[m] = *(const v2u*)((const unsigned char*)Z + ((size_t)row * ZC + C_GA) * 2 + col);
                    qb[m] = *(const v2u*)((const unsigned char*)Z + ((size_t)row * ZC + C_GB) * 2 + col); }
#pragma unroll
                for (int m = 0; m < 4; ++m)
#pragma unroll
                    for (int e = 0; e < 4; ++e) {
                        const unsigned b0 = (qb[m].x >> (8 * e)) & 255u, b1 = (qb[m].y >> (8 * e)) & 255u;
                        const float r0 = (float)((qa[m].x >> (8 * e)) & 255u) * __builtin_amdgcn_rcpf((float)(b0 ? b0 : 1u));
                        const float r1 = (float)((qa[m].y >> (8 * e)) & 255u) * __builtin_amdgcn_rcpf((float)(b1 ? b1 : 1u));
                        acc[ai][bj][m][0][e] *= r0; acc[ai][bj][m][1][e] *= r1; }
                __builtin_amdgcn_sched_barrier(0);
            }
    }
    __device__ __forceinline__ void operator()(const f32x4 (&acc)[2][2][4][2], const pg8::Unit& u, int wr, int wc, int fr, int fq) const {
        const int row0 = u.pm * 256 + wr * 64 + fr, colb = u.pn * 256 + wc * 32 + 8 * fq;
#pragma unroll
        for (int ai = 0; ai < 2; ++ai) {
            v2u qb[2][4];
#pragma unroll
            for (int bj = 0; bj < 2; ++bj)
#pragma unroll
                for (int m = 0; m < 4; ++m) { const int row = row0 + ai * 128 + m * 16, col = colb + bj * 128;
                    qb[bj][m] = *(const v2u*)((const unsigned char*)Z + ((size_t)row * ZC + C_GB) * 2 + col); }
#pragma unroll
            for (int bj = 0; bj < 2; ++bj)
#pragma unroll
                for (int m = 0; m < 4; ++m) { const int row = row0 + ai * 128 + m * 16, col = colb + bj * 128;
                    float o[8];
#pragma unroll
                    for (int e = 0; e < 4; ++e) { const unsigned b0 = (qb[bj][m].x >> (8 * e)) & 255u, b1 = (qb[bj][m].y >> (8 * e)) & 255u;
                        o[e] = acc[ai][bj][m][0][e] * ((float)(b0 ? b0 : 1u) * (1.f / 255.f)); o[4 + e] = acc[ai][bj][m][1][e] * ((float)(b1 ? b1 : 1u) * (1.f / 255.f)); }
                    v4u w; w.x = pg8::cvt_pk_bf16(o[0], o[1]); w.y = pg8::cvt_pk_bf16(o[2], o[3]); w.z = pg8::cvt_pk_bf16(o[4], o[5]); w.w = pg8::cvt_pk_bf16(o[6], o[7]);
                    *(v4u*)(MG + (size_t)row * DM + col) = w; } }
    }
};
struct EpiWout {
    static constexpr bool PERM = true, AFTER_DRAIN = false;
    const float* x; const float* ctx; const float* out; const float* ctxs; const float* mod; bf16_t* x1b; int l;
    __device__ __forceinline__ void operator()(const f32x4 (&acc)[2][2][4][2], const pg8::Unit& u, int wr, int wc, int fr, int fq) const {
        const bool lat = u.pm < 64;
        const float* base = lat ? x + (size_t)u.pm * 256 * DM : ctx + (size_t)(u.pm - 64) * 256 * DM;
        const bf16_t* baseb = lat ? (const bf16_t*)out + (size_t)u.pm * 256 * DM : (const bf16_t*)ctxs + (size_t)(u.pm - 64) * 256 * DM;
        bf16_t* dst = x1b + (size_t)u.pm * 256 * DM;
        const float* g = mod + (l * 9 + (lat ? (u.pm >> 3) : 8)) * 6144 + 2 * DM;
        const int r0 = wr * 64 + fr, col0 = u.pn * 256 + wc * 32 + 8 * fq;
        f32x4 gv[2][2];
#pragma unroll
        for (int bj = 0; bj < 2; ++bj)
#pragma unroll
            for (int n = 0; n < 2; ++n) gv[bj][n] = *(const f32x4*)(g + col0 + bj * 128 + n * 4);
#pragma unroll
        for (int ai = 0; ai < 2; ++ai)
#pragma unroll
            for (int mp = 0; mp < 2; ++mp) {
                f32x4 bs[2][2][2];
#pragma unroll
                for (int mm = 0; mm < 2; ++mm) { const size_t off = (size_t)(r0 + ai * 128 + (2 * mp + mm) * 16) * DM + col0;
#pragma unroll
                    for (int bj = 0; bj < 2; ++bj) {
                        if (l == 0) {
#pragma unroll
                            for (int n = 0; n < 2; ++n) bs[mm][bj][n] = *(const f32x4*)(base + off + bj * 128 + n * 4);
                        } else { float f8[8]; unpack8(*(const v4u*)(baseb + off + bj * 128), f8);
                            bs[mm][bj][0] = (f32x4){f8[0], f8[1], f8[2], f8[3]}; bs[mm][bj][1] = (f32x4){f8[4], f8[5], f8[6], f8[7]}; } } }
#pragma unroll
                for (int mm = 0; mm < 2; ++mm) { const int m = 2 * mp + mm; const size_t off = (size_t)(r0 + ai * 128 + m * 16) * DM + col0;
#pragma unroll
                    for (int bj = 0; bj < 2; ++bj) { const f32x4 v0 = bs[mm][bj][0] + gv[bj][0] * acc[ai][bj][m][0], v1 = bs[mm][bj][1] + gv[bj][1] * acc[ai][bj][m][1];
                        v4u w; w.x = pg8::cvt_pk_bf16(v0[0], v0[1]); w.y = pg8::cvt_pk_bf16(v0[2], v0[3]); w.z = pg8::cvt_pk_bf16(v1[0], v1[1]); w.w = pg8::cvt_pk_bf16(v1[2], v1[3]);
                        *(v4u*)(dst + off + bj * 128) = w; } } }
    }
};

template <typename AT> __device__ __forceinline__ float ldA(const AT* p);
template <> __device__ __forceinline__ float ldA<bf16_t>(const bf16_t* p) { return bf2f(*p); }
template <> __device__ __forceinline__ float ldA<float>(const float* p) { return *p; }

template <typename AT, class Epi>
__device__ __forceinline__ void gemm_naive(float* sm, int wg, int nwg, int M, int N, int K, const AT* A, int lda, const int* rowmap, int rowshift,
                           const float* B, int ldb, Epi epi) {
    float* As = sm;
    float* Bs = sm + 16 * 132;
    const int tid = otid(), ty = tid >> 4, tx = tid & 15;
    const int ntm = (M + 127) / 128, ntn = N / 64;
    for (int tile = wg; tile < ntm * ntn; tile += nwg) {
        const int tm = tile / ntn, tn = tile % ntn, m0 = tm * 128, n0 = tn * 64;
        float acc[4][4];
#pragma unroll
        for (int i = 0; i < 4; ++i)
#pragma unroll
            for (int j = 0; j < 4; ++j) acc[i][j] = 0.f;
        const int ar = m0 + (tid >> 2);
        int arow = -1;
        if (ar < M) arow = rowmap ? (rowmap[ar] >> rowshift) : ar;
        const AT* ap = A + (size_t)(arow < 0 ? 0 : arow) * lda + (tid & 3) * 4;
        const int bk = tid >> 4, bn = (tid & 15) * 4;
        for (int k0 = 0; k0 < K; k0 += 16) {
#pragma unroll
            for (int i = 0; i < 4; ++i) As[((tid & 3) * 4 + i) * 132 + (tid >> 2)] = arow >= 0 ? ldA<AT>(ap + k0 + i) : 0.f;
            if (tid < 256) { const float4 b = *(const float4*)(B + (size_t)(k0 + bk) * ldb + n0 + bn); *(float4*)(Bs + bk * 68 + bn) = b; }
            __syncthreads();
#pragma unroll
            for (int kk = 0; kk < 16; ++kk) {
                const float4 a = *(const float4*)(As + kk * 132 + ty * 4), b = *(const float4*)(Bs + kk * 68 + tx * 4);
                const float av[4] = {a.x, a.y, a.z, a.w}, bv[4] = {b.x, b.y, b.z, b.w};
#pragma unroll
                for (int i = 0; i < 4; ++i)
#pragma unroll
                    for (int j = 0; j < 4; ++j) acc[i][j] += av[i] * bv[j];
            }
            __syncthreads();
        }
#pragma unroll
        for (int i = 0; i < 4; ++i) { const int row = m0 + ty * 4 + i; if (row < M) {
#pragma unroll
            for (int j = 0; j < 4; ++j) epi(row, n0 + tx * 4 + j, acc[i][j]); } }
    }
}

__device__ __forceinline__ void ph_win(const Params& p, float* sm, int l, int wg, int nwg) {
    bf16_t* Z = (bf16_t*)(p.ws + WS_Z);
    gemm_naive<bf16_t>(sm, wg, nwg, LR, ZC, DM, (const bf16_t*)(p.ws + WS_H), DM, nullptr, 0, p.w_in + (size_t)l * DM * ZC, ZC,
                       [=](int r, int c, float v) { Z[(size_t)r * ZC + c] = f2bf(v); });
}

__device__ __forceinline__ void ph_convert_moe(const Params& p, unsigned char* ldsb, int l, int wg, int nwg);
struct WinOrderLast : pg8::StaticOrder {
    __device__ __forceinline__ bool next(int i, pg8::Unit& u) const {
        const int L = i * G + c;
        if (L < nwg) { unit_of(L, u); return true; }
        const int e = L - nwg; if (e >= 96) return false;
        const int t = e % 12; u.pm = 64 + e / 12; u.pn = t < 7 ? t : t + 2; u.boff = 0u; return true;
    }
};
__device__ __forceinline__ void ph_win_mfma(const Params& p, unsigned char* ldsb, int l, int wg, int nwg) {
    pg8::Gemm g{(const bf16_t*)(p.ws + WS_H), (const bf16_t*)(p.ws + WS_WIN_T), LR, 5632, DM};
    EpiZ E{(bf16_t*)(p.ws + WS_Z), (bf16_t*)(p.ws + WS_SG), (bf16_t*)(p.ws + WS_VT)};
    if (l == 1) {
        WinOrderLast S; S.init(NLAT, 5632, nwg, wg);
        pg8::gemm_phase<EpiZ, WinOrderLast, true, true>((LAS unsigned char*)ldsb, g, S, E);
    } else {
        pg8::StaticOrder S; S.init(LR, 5632, nwg, wg);
        pg8::gemm_phase<EpiZ, pg8::StaticOrder, true, true>((LAS unsigned char*)ldsb, g, S, E);
    }
    const int ntail = (72 * 22) % nwg;
    (void)ntail;
}
__device__ __forceinline__ void ph_merge_mfma(const Params& p, unsigned char* ldsb, int l, int wg, int nwg) {
    const int nrows = (l == 1) ? NLAT : LR;
    pg8::Gemm g{(const bf16_t*)(p.ws + WS_OUTA), (const bf16_t*)(p.ws + WS_PA_T), nrows, DM, 512};
    DualOrder S; S.init(nrows, DM, nwg, wg);
    S.dA = (long)WS_YB - (long)WS_OUTA - 8 * 128; S.dB = (long)WS_PB_T - (long)WS_PA_T - 8 * 128;
    EpiMergeF E{(const bf16_t*)(p.ws + WS_Z), (bf16_t*)(p.ws + WS_MERGED)};
    pg8::gemm_phase<EpiMergeF, DualOrder, true, true>((LAS unsigned char*)ldsb, g, S, E);
}
__device__ __forceinline__ void ph_wout_mfma(const Params& p, unsigned char* ldsb, int l, int wg, int nwg) {
    const int nrows = (l == 1) ? NLAT : LR;
    pg8::Gemm g{(const bf16_t*)(p.ws + WS_MERGED), (const bf16_t*)(p.ws + WS_WO_T), nrows, DM, DM};
    pg8::StaticOrder S; S.init(nrows, DM, nwg, wg);
    EpiWout E{p.x, p.ctx, p.out, (const float*)(p.ws + WS_CTXS), (const float*)(p.ws + WS_MOD), (bf16_t*)(p.ws + WS_X1B), l};
    pg8::gemm_phase<EpiWout, pg8::StaticOrder, true, true>((LAS unsigned char*)ldsb, g, S, E);
}

__device__ __forceinline__ void ph_prep(const Params& p, float* sm, int l, int dir, int wg, int nwg) {
    const bf16_t* Z = (const bf16_t*)(p.ws + WS_Z);
    float* SW = (float*)(p.ws + WS_SW); bf16_t* SB = (bf16_t*)(p.ws + WS_SB); bf16_t* SKD = (bf16_t*)(p.ws + WS_SKD); bf16_t* SKK = (bf16_t*)(p.ws + WS_SKK);
    const int c = otid();
    const float* wlb = p.rw_w_lora_b + ((size_t)(l * 2 + dir) * 64) * 512 + c;
    const float* alb = p.rw_a_lora_b + ((size_t)(l * 2 + dir) * 64) * 512 + c;
    const float w0 = p.rw_w0[(l * 2 + dir) * 512 + c], a0 = p.rw_a0[(l * 2 + dir) * 512 + c];
    const float kkc = p.rw_k_k[l * 512 + c], kac = p.rw_k_a[l * 512 + c];
    for (int r = wg; r < LR; r += nwg) {
        __syncthreads();
        if (c < 64) sm[c] = tanhf(bf2f(Z[(size_t)r * ZC + C_LW + dir * 64 + c]));
        else if (c < 128) sm[c] = bf2f(Z[(size_t)r * ZC + C_LA + dir * 64 + (c - 64)]);
        __syncthreads();
        float wl = w0, al = a0;
#pragma unroll 4
        for (int j = 0; j < 64; ++j) { wl += sm[j] * wlb[(size_t)j * 512]; al += sm[64 + j] * alb[(size_t)j * 512]; }
        const float nx = -wl; const float sp = fmaxf(nx, 0.f) + log1pf(expf(-fabsf(nx)));
        const float decay = expf(-expf(-sp - 0.5f));
        const float a = sigmoidf_(al);
        const float k = bf2f(Z[(size_t)r * ZC + C_K + c]);
        const float kv = k * kkc;
        const float n2 = wave_sum(kv * kv);
        const float kk = kv * rsqrtf(fmaxf(n2, 1e-12f));
        SW[(size_t)r * 512 + c] = decay;
        SB[(size_t)r * 512 + c] = f2bf(kk * a);
        SKD[(size_t)r * 512 + c] = f2bf(k * (1.f + (a - 1.f) * kac));
        SKK[(size_t)r * 512 + c] = f2bf(kk);
    }
}

__device__ __forceinline__ int scan_row(int step, int dir, int b) {
    if (step < CTXL) { int t = dir ? (CTXL - 1 - step) : step; return NLAT + b * CTXL + t; }
    int tt = step - CTXL; int t = dir ? (SEQ - 1 - tt) : tt; return b * SEQ + t;
}
__device__ __forceinline__ void ph_scan(const Params& p, float* sm, int l, int dir, int wg, int nwg) {
    const bf16_t* Z = (const bf16_t*)(p.ws + WS_Z);
    const float* SW = (const float*)(p.ws + WS_SW); const bf16_t* SB = (const bf16_t*)(p.ws + WS_SB); const bf16_t* SKD = (const bf16_t*)(p.ws + WS_SKD); const bf16_t* SKK = (const bf16_t*)(p.ws + WS_SKK);
    float* Y = (float*)(p.ws + WS_Y);
    const int lane = otid() & 63, wv = otid() >> 6, nwv = blockDim.x >> 6;
    const bool last = (l == 1);
    for (int task = wg * nwv + wv; task < 512; task += nwg * nwv) {
        const int b = task >> 6, hd = (task >> 3) & 7, v0 = (task & 7) * 8;
        float s[8];
#pragma unroll
        for (int j = 0; j < 8; ++j) s[j] = 0.f;
        int row = scan_row(0, dir, b);
        float cw = SW[(size_t)row * 512 + hd * 64 + lane], ckk = bf2f(SKK[(size_t)row * 512 + hd * 64 + lane]), cb = bf2f(SB[(size_t)row * 512 + hd * 64 + lane]),
              ckd = bf2f(SKD[(size_t)row * 512 + hd * 64 + lane]), cr = bf2f(Z[(size_t)row * ZC + C_R + hd * 64 + lane]), cv = bf2f(Z[(size_t)row * ZC + C_V + hd * 64 + lane]);
        for (int step = 0; step < CTXL + SEQ; ++step) {
            const int nrow = scan_row(step + 1 < CTXL + SEQ ? step + 1 : step, dir, b);
            const float nw = SW[(size_t)nrow * 512 + hd * 64 + lane], nkk = bf2f(SKK[(size_t)nrow * 512 + hd * 64 + lane]), nb = bf2f(SB[(size_t)nrow * 512 + hd * 64 + lane]),
                        nkd = bf2f(SKD[(size_t)nrow * 512 + hd * 64 + lane]), nr = bf2f(Z[(size_t)nrow * ZC + C_R + hd * 64 + lane]), nv = bf2f(Z[(size_t)nrow * ZC + C_V + hd * 64 + lane]);
            float ysel = 0.f;
#pragma unroll
            for (int j = 0; j < 8; ++j) {
                const float skk = wave_sum(s[j] * ckk);
                const float vj = rdlane(cv, __builtin_amdgcn_readfirstlane(v0 + j));
                s[j] = s[j] * cw - skk * cb + vj * ckd;
                const float y = wave_sum(s[j] * cr);
                if (lane == j) ysel = y;
            }
            const bool isctx = step < CTXL;
            if (!(isctx && last) && lane < 8) {
                float* yp = Y + (size_t)row * 512 + hd * 64 + v0 + lane;
                if (dir == 0) *yp = ysel; else *yp += ysel;
            }
            row = nrow; cw = nw; ckk = nkk; cb = nb; ckd = nkd; cr = nr; cv = nv;
        }
    }
}

typedef short bf16x8_t __attribute__((ext_vector_type(8)));
template <int CTRL> __device__ __forceinline__ float dpp_f(float v) { return __int_as_float(__builtin_amdgcn_update_dpp(0, __float_as_int(v), CTRL, 0xf, 0xf, false)); }
__device__ __forceinline__ float row16_sum(float x) {
    x += dpp_f<0xB1>(x);
    x += dpp_f<0x4E>(x);
    x += dpp_f<0x124>(x);
    x += dpp_f<0x128>(x);
    return x;
}
__device__ __forceinline__ int scan_chunk_row(int ci, int j, int dir, int b) {
    if (ci < 8) { const int t = ci * 32 + j; return NLAT + b * CTXL + (dir ? (CTXL - 1 - t) : t); }
    const int t = (ci - 8) * 32 + j; return b * SEQ + (dir ? (SEQ - 1 - t) : t);
}
__device__ __forceinline__ void ph_scan2(const Params& p, unsigned char* ldsb, int l, int wg, int nwg) {
    const int tid = otid(), lane = tid & 63, wv = tid >> 6;
    LAS unsigned char* L = (LAS unsigned char*)ldsb;
    LAS float* sW = (LAS float*)(L + 0);
    LAS float* sKK = (LAS float*)(L + 8192);
    LAS float* sB = (LAS float*)(L + 16384);
    LAS float* sKD = (LAS float*)(L + 24576);
    LAS float* sR = (LAS float*)(L + 32768);
    LAS float* sV = (LAS float*)(L + 40960);
    LAS float* sY = (LAS float*)(L + 45056);
    LAS float* sKF = (LAS float*)(L + 49664);
    LAS float* sRN = (LAS float*)(L + 57856);
    LAS bf16_t* sLW = (LAS bf16_t*)(L + 58112);
    LAS bf16_t* sLA = (LAS bf16_t*)(L + 62208);
    const bf16_t* Z = (const bf16_t*)(p.ws + WS_Z);
    bf16_t* Y = (bf16_t*)(p.ws + WS_Y2);
    const bool last = (l == 1);
    for (int task = wg; task < 256; task += nwg) {
        const int b = task >> 5, h = (task >> 2) & 7, dir = (task >> 1) & 1, half = task & 1;
        const int mb = wv >> 2, nb = wv & 3, fr = lane & 15, fq = lane >> 4;
        const int cch = h * 64 + nb * 16 + fr;
        const float w0c = p.rw_w0[(l * 2 + dir) * 512 + cch], a0c = p.rw_a0[(l * 2 + dir) * 512 + cch];
        const float kkc = p.rw_k_k[l * 512 + cch], kac = p.rw_k_a[l * 512 + cch];
        bf16x8_t Bw[2], Ba[2];
#pragma unroll
        for (int ks = 0; ks < 2; ++ks) {
            Bw[ks] = *(const bf16x8_t*)((const bf16_t*)(p.ws + WS_LW_T) + ((size_t)(dir * 512 + cch) * 64 + 8 * fq + 32 * ks));
            Ba[ks] = *(const bf16x8_t*)((const bf16_t*)(p.ws + WS_LA_T) + ((size_t)(dir * 512 + cch) * 64 + 8 * fq + 32 * ks));
        }
        const int pj = (tid & 255) >> 3, pq = tid & 7;
        const bool roleK = tid < 256;
        const int vj = tid >> 2, vq = tid & 3;
        float kk8[8];
#pragma unroll
        for (int e = 0; e < 8; ++e) kk8[e] = p.rw_k_k[l * 512 + h * 64 + pq * 8 + e];
        const int g = lane >> 4, kc = lane & 15, vrow = wv * 4 + g;
        float s0 = 0.f, s1 = 0.f, s2 = 0.f, s3 = 0.f;
        v4u pf0, pf1, pfv;
#define SCAN_PREFETCH(ci_) do { const int row_ = scan_chunk_row((ci_), pj, dir, b); const bf16_t* zr_ = Z + (size_t)row_ * ZC; \
            pf0 = *(const v4u*)(zr_ + (roleK ? C_K : C_R) + h * 64 + pq * 8); pf1 = *(const v4u*)(zr_ + (roleK ? C_LW : C_LA) + dir * 64 + pq * 8); \
            if (tid < 128) { const int rowv_ = scan_chunk_row((ci_), vj, dir, b); pfv = *(const v4u*)(Z + (size_t)rowv_ * ZC + C_V + h * 64 + half * 32 + vq * 8); } } while (0)
        SCAN_PREFETCH(0);
        for (int ci = 0; ci < 72; ++ci) {
            float f0[8]; unpack8(pf0, f0);
            if (roleK) {
                float ss = 0.f;
#pragma unroll
                for (int e = 0; e < 8; ++e) { const float t_ = f0[e] * kk8[e]; ss += t_ * t_; }
                ss += swz_xor<1>(ss); ss += swz_xor<2>(ss); ss += swz_xor<4>(ss);
                *(LAS f32x4*)(sKF + pj * 64 + pq * 8) = (f32x4){f0[0], f0[1], f0[2], f0[3]};
                *(LAS f32x4*)(sKF + pj * 64 + pq * 8 + 4) = (f32x4){f0[4], f0[5], f0[6], f0[7]};
                if (pq == 0) sRN[pj] = rsqrtf(fmaxf(ss, 1e-12f));
                float f1[8]; unpack8(pf1, f1);
#pragma unroll
                for (int e = 0; e < 8; ++e) { const float ex = __expf(2.f * f1[e]); f1[e] = 1.f - 2.f / (ex + 1.f); }
                v4u o; o.x = pk2(f1[0], f1[1]); o.y = pk2(f1[2], f1[3]); o.z = pk2(f1[4], f1[5]); o.w = pk2(f1[6], f1[7]);
                *(LAS v4u*)(sLW + pj * 64 + pq * 8) = o;
            } else {
                *(LAS v4u*)(sLA + pj * 64 + pq * 8) = pf1;
            }
            __syncthreads();
            {
                f32x4 accw = {0.f, 0.f, 0.f, 0.f}, acca = {0.f, 0.f, 0.f, 0.f};
#pragma unroll
                for (int ks = 0; ks < 2; ++ks) {
                    const bf16x8_t aw = *(const LAS bf16x8_t*)(sLW + (mb * 16 + fr) * 64 + 8 * fq + 32 * ks);
                    const bf16x8_t aa = *(const LAS bf16x8_t*)(sLA + (mb * 16 + fr) * 64 + 8 * fq + 32 * ks);
                    accw = __builtin_amdgcn_mfma_f32_16x16x32_bf16(aw, Bw[ks], accw, 0, 0, 0);
                    acca = __builtin_amdgcn_mfma_f32_16x16x32_bf16(aa, Ba[ks], acca, 0, 0, 0);
                }
#pragma unroll
                for (int i = 0; i < 4; ++i) {
                    const int j = mb * 16 + fq * 4 + i, c = nb * 16 + fr;
                    const float wl = accw[i] + w0c, al = acca[i] + a0c;
                    const float nx = -wl; const float sp = fmaxf(nx, 0.f) + __logf(1.f + __expf(-fabsf(nx)));
                    const float decay = __expf(-__expf(-sp - 0.5f));
                    const float a = 1.f / (1.f + __expf(-al));
                    const float k = sKF[j * 64 + c]; const float kk = k * kkc * sRN[j];
                    sW[j * 64 + c] = decay; sKK[j * 64 + c] = kk; sB[j * 64 + c] = kk * a; sKD[j * 64 + c] = k * (1.f + (a - 1.f) * kac);
                }
                if (!roleK) { *(LAS f32x4*)(sR + pj * 64 + pq * 8) = (f32x4){f0[0], f0[1], f0[2], f0[3]}; *(LAS f32x4*)(sR + pj * 64 + pq * 8 + 4) = (f32x4){f0[4], f0[5], f0[6], f0[7]}; }
                if (tid < 128) { float fv[8]; unpack8(pfv, fv); *(LAS f32x4*)(sV + vj * 32 + vq * 8) = (f32x4){fv[0], fv[1], fv[2], fv[3]}; *(LAS f32x4*)(sV + vj * 32 + vq * 8 + 4) = (f32x4){fv[4], fv[5], fv[6], fv[7]}; }
                if (ci > 0 && !(last && ci <= 8)) {
                    const int j = tid >> 4, r2 = (tid & 15) * 2; const int row = scan_chunk_row(ci - 1, j, dir, b);
                    *(unsigned*)(Y + ((size_t)dir * LR + row) * 512 + h * 64 + half * 32 + r2) = pk2(sY[r2 * 36 + j], sY[(r2 + 1) * 36 + j]);
                }
            }
            __syncthreads();
            if (ci + 1 < 72) SCAN_PREFETCH(ci + 1);
#define SCAN_LD(j_, W_, KK_, BB_, KD_, RR_, V_) do { W_ = *(const LAS f32x4*)(sW + (j_) * 64 + kc * 4); KK_ = *(const LAS f32x4*)(sKK + (j_) * 64 + kc * 4); BB_ = *(const LAS f32x4*)(sB + (j_) * 64 + kc * 4); \
                KD_ = *(const LAS f32x4*)(sKD + (j_) * 64 + kc * 4); RR_ = *(const LAS f32x4*)(sR + (j_) * 64 + kc * 4); V_ = sV[(j_) * 32 + vrow]; } while (0)
#define SCAN_STEP(W_, KK_, BB_, KD_, RR_, V_, Y_) do { float pd = s0 * KK_[0] + s1 * KK_[1] + s2 * KK_[2] + s3 * KK_[3]; pd = row16_sum(pd); \
                s0 = s0 * W_[0] + (V_ * KD_[0] - pd * BB_[0]); s1 = s1 * W_[1] + (V_ * KD_[1] - pd * BB_[1]); s2 = s2 * W_[2] + (V_ * KD_[2] - pd * BB_[2]); s3 = s3 * W_[3] + (V_ * KD_[3] - pd * BB_[3]); \
                float y_ = s0 * RR_[0] + s1 * RR_[1] + s2 * RR_[2] + s3 * RR_[3]; Y_ = row16_sum(y_); } while (0)
            {
                f32x4 wA, kkA, bbA, kdA, rrA, wB, kkB, bbB, kdB, rrB; float vA, vB;
                SCAN_LD(0, wA, kkA, bbA, kdA, rrA, vA);
#pragma unroll 1
                for (int j = 0; j < 32; j += 4) {
                    f32x4 y4;
                    SCAN_LD(j + 1, wB, kkB, bbB, kdB, rrB, vB);
                    SCAN_STEP(wA, kkA, bbA, kdA, rrA, vA, y4[0]);
                    SCAN_LD(j + 2, wA, kkA, bbA, kdA, rrA, vA);
                    SCAN_STEP(wB, kkB, bbB, kdB, rrB, vB, y4[1]);
                    SCAN_LD(j + 3, wB, kkB, bbB, kdB, rrB, vB);
                    SCAN_STEP(wA, kkA, bbA, kdA, rrA, vA, y4[2]);
                    SCAN_LD((j + 4) & 31, wA, kkA, bbA, kdA, rrA, vA);
                    SCAN_STEP(wB, kkB, bbB, kdB, rrB, vB, y4[3]);
                    *(LAS f32x4*)(sY + vrow * 36 + j) = y4;
                }
            }
#undef SCAN_LD
#undef SCAN_STEP
        }
        __syncthreads();
        {
            const int j = tid >> 4, r2 = (tid & 15) * 2; const int row = scan_chunk_row(71, j, dir, b);
            *(unsigned*)(Y + ((size_t)dir * LR + row) * 512 + h * 64 + half * 32 + r2) = pk2(sY[r2 * 36 + j], sY[(r2 + 1) * 36 + j]);
        }
        __syncthreads();
#undef SCAN_PREFETCH
    }
}

__device__ __forceinline__ void ph_natt(const Params& p, float* sm, int l, int wg, int nwg) {
    const bf16_t* Z = (const bf16_t*)(p.ws + WS_Z);
    bf16_t* YB = (bf16_t*)(p.ws + WS_YB);
    const int lane = otid() & 63, wv = otid() >> 6, nwv = blockDim.x >> 6;
    float* qs = sm + wv * 512;
    float* ps = qs + 64;
    const bool last = (l == 1);
    const int nq = last ? NLAT : LR;
    const float* rpb = p.na_rpb + (size_t)l * 8 * 15 * 31;
    const float kg = p.na_k_g[l * 64 + lane], qg = p.na_q_g[l * 64 + lane];
    for (int task = wg * nwv + wv; task < nq * 8; task += nwg * nwv) {
        const int r = task >> 3, hd = task & 7;
        const bool isl = r < NLAT;
        const int b = isl ? (r >> 11) : ((r - NLAT) >> 8);
        const int t = r & 2047, qi = t >> 6, qj = t & 63;
        const int r0 = min(max(qi - 4, 0), 32 - 8), cs = min(max(qj - 8, 0), 64 - 16);
        const int nkeys = isl ? 384 : 256;
        {
            const float qv = bf2f(Z[(size_t)r * ZC + C_Q + hd * 64 + lane]);
            const float ss = wave_sum(qv * qv);
            qs[lane] = qv * rsqrtf(ss * (1.f / 64.f) + RMS_EPS) * qg * 0.125f * kg;
        }
        float lg[6]; float mx = -INFINITY;
#pragma unroll
        for (int i = 0; i < 6; ++i) {
            const int kidx = lane + 64 * i; lg[i] = -INFINITY;
            if (kidx < nkeys) {
                int krow; float bias = 0.f;
                if (isl && kidx < 128) { const int a = kidx >> 4, cc = kidx & 15; krow = b * SEQ + (r0 + a) * 64 + cs + cc;
                    bias = rpb[(hd * 15 + (r0 + a - qi + 7)) * 31 + (cs + cc - qj + 15)]; }
                else krow = NLAT + b * CTXL + (isl ? kidx - 128 : kidx);
                const uint4* kp = (const uint4*)(Z + (size_t)krow * ZC + C_KB + hd * 64);
                float ss = 0.f, dot = 0.f;
#pragma unroll 2
                for (int u = 0; u < 8; ++u) { const uint4 w = kp[u]; const unsigned ww[4] = {w.x, w.y, w.z, w.w};
                    const float4 qa = *(const float4*)(qs + u * 8), qb = *(const float4*)(qs + u * 8 + 4);
                    const float q[8] = {qa.x, qa.y, qa.z, qa.w, qb.x, qb.y, qb.z, qb.w};
#pragma unroll
                    for (int e = 0; e < 4; ++e) { const float k0 = __uint_as_float(ww[e] << 16), k1 = __uint_as_float(ww[e] & 0xffff0000u);
                        ss += k0 * k0 + k1 * k1; dot += k0 * q[e * 2] + k1 * q[e * 2 + 1]; } }
                lg[i] = dot * rsqrtf(ss * (1.f / 64.f) + RMS_EPS) + bias;
                mx = fmaxf(mx, lg[i]);
            }
        }
        mx = wave_max(mx);
        float sum = 0.f;
#pragma unroll
        for (int i = 0; i < 6; ++i) { const int kidx = lane + 64 * i; if (kidx < nkeys) { lg[i] = __expf(lg[i] - mx); sum += lg[i]; } }
        sum = wave_sum(sum);
        const float inv = 1.f / sum;
#pragma unroll
        for (int i = 0; i < 6; ++i) { const int kidx = lane + 64 * i; if (kidx < nkeys) ps[kidx] = lg[i] * inv; }
        float acc = 0.f;
        for (int kidx = 0; kidx < nkeys; ++kidx) {
            int krow;
            if (isl && kidx < 128) krow = b * SEQ + (r0 + (kidx >> 4)) * 64 + cs + (kidx & 15);
            else krow = NLAT + b * CTXL + (isl ? kidx - 128 : kidx);
            acc += ps[kidx] * bf2f(Z[(size_t)krow * ZC + C_VB + hd * 64 + lane]);
        }
        YB[(size_t)r * 512 + hd * 64 + lane] = f2bf(acc);
    }
}

typedef float f32x16_t __attribute__((ext_vector_type(16)));
#define MFMA32(a_, b_, c_) __builtin_amdgcn_mfma_f32_32x32x16_bf16((a_), (b_), (c_), 0, 0, 0)
#define MFMA16(a_, b_, c_) __builtin_amdgcn_mfma_f32_16x16x32_bf16((a_), (b_), (c_), 0, 0, 0)
__device__ __forceinline__ int scan3_row(int sc, int j, int dir, int b) {
    if (sc < 16) { const int t = sc * 16 + j; return NLAT + b * CTXL + (dir ? (CTXL - 1 - t) : t); }
    const int t = (sc - 16) * 16 + j; return b * SEQ + (dir ? (SEQ - 1 - t) : t);
}
constexpr int S3_KR = 0, S3_KD = 4096, S3_BT = 6144, S3_BD = 8192, S3_ET = 9216, S3_VT = 10240, S3_A = 11264, S3_PC = 12288, S3_SET = 12800;
constexpr int S3_SY = 8 * S3_SET;
constexpr int S3_SYSUB = 32 * 20 * 4;
#define S3_LDS_FENCE() asm volatile("s_waitcnt lgkmcnt(0)" ::: "memory")
__device__ __forceinline__ float frcp(float x) { return __builtin_amdgcn_rcpf(x); }
__device__ __forceinline__ bf16_t f2bf_fast(float x) { const __bf16 b = (__bf16)x; return __builtin_bit_cast(bf16_t, b); }
__device__ __forceinline__ void row_gather4(float x, float& r0, float& r1, float& r2, float& r3) {
    auto a = __builtin_amdgcn_permlane32_swap(__float_as_uint(x), __float_as_uint(x), false, false);
    auto b0 = __builtin_amdgcn_permlane16_swap(a[0], a[0], false, false);
    auto b1 = __builtin_amdgcn_permlane16_swap(a[1], a[1], false, false);
    r0 = __uint_as_float(b0[0]); r1 = __uint_as_float(b0[1]); r2 = __uint_as_float(b1[0]); r3 = __uint_as_float(b1[1]);
}
__device__ __forceinline__ void ph_scan3(const Params& p, unsigned char* ldsb, int l, int wg, int nwg) {
    const int tid = otid(), lane = tid & 63;
    const int wv = __builtin_amdgcn_readfirstlane(tid >> 6);
    LAS unsigned char* L = (LAS unsigned char*)ldsb;
    const bf16_t* Z = (const bf16_t*)(p.ws + WS_Z);
    bf16_t* Y = (bf16_t*)(p.ws + WS_Y2);
    const bool last = (l == 1);
    for (int task = wg; task < 256; task += nwg) {
        const int b = task >> 5, h = (task >> 2) & 7, dir = (task >> 1) & 1, half = task & 1;
        __syncthreads();
        if (wv == 0) {
            const int vcol = lane & 31, hi = lane >> 5;
            f32x16_t st0, st1;
#pragma unroll
            for (int r = 0; r < 16; ++r) { st0[r] = 0.f; st1[r] = 0.f; }
            for (int iter = 0; iter < 38; ++iter) {
                __syncthreads();
                if (iter < 1 || iter > 36) continue;
                const int buf = (iter - 1) & 1;
#pragma unroll 1
                for (int sub = 0; sub < 4; ++sub) {
                    LAS unsigned char* set = L + (buf * 4 + sub) * S3_SET;
                    bf16x8_t sb[4];
                    { v4u w;
                      w.x = pg8::cvt_pk_bf16(st0[0], st0[1]); w.y = pg8::cvt_pk_bf16(st0[2], st0[3]); w.z = pg8::cvt_pk_bf16(st0[4], st0[5]); w.w = pg8::cvt_pk_bf16(st0[6], st0[7]); sb[0] = __builtin_bit_cast(bf16x8_t, w);
                      w.x = pg8::cvt_pk_bf16(st0[8], st0[9]); w.y = pg8::cvt_pk_bf16(st0[10], st0[11]); w.z = pg8::cvt_pk_bf16(st0[12], st0[13]); w.w = pg8::cvt_pk_bf16(st0[14], st0[15]); sb[1] = __builtin_bit_cast(bf16x8_t, w);
                      w.x = pg8::cvt_pk_bf16(st1[0], st1[1]); w.y = pg8::cvt_pk_bf16(st1[2], st1[3]); w.z = pg8::cvt_pk_bf16(st1[4], st1[5]); w.w = pg8::cvt_pk_bf16(st1[6], st1[7]); sb[2] = __builtin_bit_cast(bf16x8_t, w);
                      w.x = pg8::cvt_pk_bf16(st1[8], st1[9]); w.y = pg8::cvt_pk_bf16(st1[10], st1[11]); w.z = pg8::cvt_pk_bf16(st1[12], st1[13]); w.w = pg8::cvt_pk_bf16(st1[14], st1[15]); sb[3] = __builtin_bit_cast(bf16x8_t, w); }
                    f32x16_t acc;
#pragma unroll
                    for (int r = 0; r < 16; ++r) acc[r] = 0.f;
#pragma unroll
                    for (int ks = 0; ks < 4; ++ks) { const bf16x8_t af = *(const LAS bf16x8_t*)(set + S3_KR + vcol * 128 + (ks * 16 + 8 * hi) * 2); acc = MFMA32(af, sb[ks], acc); }
                    const bf16x8_t vtf = *(const LAS bf16x8_t*)(set + S3_VT + vcol * 32 + 8 * hi * 2);
                    { const bf16x8_t bdf = *(const LAS bf16x8_t*)(set + S3_BD + vcol * 32 + 8 * hi * 2); acc = MFMA32(bdf, vtf, acc); }
                    float rhs[16];
#pragma unroll
                    for (int r = 0; r < 8; ++r) { auto rr = __builtin_amdgcn_permlane32_swap(__float_as_uint(acc[r]), __float_as_uint(acc[r]), false, false);
                        const int t0 = (r & 3) + 8 * (r >> 2); rhs[t0] = __uint_as_float(rr[0]); rhs[t0 + 4] = __uint_as_float(rr[1]); }
                    float u[16];
#pragma unroll
                    for (int i = 0; i < 16; ++i) {
                        u[i] = rhs[i];
                        if (i < 15) {
                            const LAS float* ar = (const LAS float*)(set + S3_A) + i * 16;
                            const f32x4 a0 = *(const LAS f32x4*)(ar), a1 = *(const LAS f32x4*)(ar + 4), a2 = *(const LAS f32x4*)(ar + 8), a3 = *(const LAS f32x4*)(ar + 12);
                            const float av[16] = {a0[0], a0[1], a0[2], a0[3], a1[0], a1[1], a1[2], a1[3], a2[0], a2[1], a2[2], a2[3], a3[0], a3[1], a3[2], a3[3]};
#pragma unroll
                            for (int t = i + 1; t < 16; ++t) rhs[t] -= u[i] * av[t];
                        }
                    }
                    bf16x8_t ub;
                    { v4u w; w.x = pg8::cvt_pk_bf16(hi ? u[8] : u[0], hi ? u[9] : u[1]); w.y = pg8::cvt_pk_bf16(hi ? u[10] : u[2], hi ? u[11] : u[3]);
                      w.z = pg8::cvt_pk_bf16(hi ? u[12] : u[4], hi ? u[13] : u[5]); w.w = pg8::cvt_pk_bf16(hi ? u[14] : u[6], hi ? u[15] : u[7]); ub = __builtin_bit_cast(bf16x8_t, w); }
                    { const bf16x8_t etf = *(const LAS bf16x8_t*)(set + S3_ET + vcol * 32 + 8 * hi * 2); acc = MFMA32(etf, ub, acc); }
                    { LAS float* sy = (LAS float*)(L + S3_SY + (buf * 4 + sub) * S3_SYSUB) + vcol * 20;
                      *(LAS f32x4*)(sy + 4 * hi) = (f32x4){acc[8], acc[9], acc[10], acc[11]};
                      *(LAS f32x4*)(sy + 8 + 4 * hi) = (f32x4){acc[12], acc[13], acc[14], acc[15]}; }
                    { const bf16x8_t kd0 = *(const LAS bf16x8_t*)(set + S3_KD + vcol * 32 + 8 * hi * 2), kd1 = *(const LAS bf16x8_t*)(set + S3_KD + (32 + vcol) * 32 + 8 * hi * 2);
                      const bf16x8_t bt0 = *(const LAS bf16x8_t*)(set + S3_BT + vcol * 32 + 8 * hi * 2), bt1 = *(const LAS bf16x8_t*)(set + S3_BT + (32 + vcol) * 32 + 8 * hi * 2);
                      st0 = MFMA32(kd0, vtf, st0); st0 = MFMA32(bt0, ub, st0);
                      st1 = MFMA32(kd1, vtf, st1); st1 = MFMA32(bt1, ub, st1); }
#pragma unroll
                    for (int g = 0; g < 4; ++g) {
                        const f32x4 p0 = *(const LAS f32x4*)((const LAS float*)(set + S3_PC) + 8 * g + 4 * hi), p1 = *(const LAS f32x4*)((const LAS float*)(set + S3_PC) + 32 + 8 * g + 4 * hi);
#pragma unroll
                        for (int e = 0; e < 4; ++e) { st0[4 * g + e] *= p0[e]; st1[4 * g + e] *= p1[e]; }
                    }
                }
            }
        } else if (wv <= 4) {
            const int fr = lane & 15, fq = lane >> 4, pw = wv - 1;
            float w0c[4], a0c[4], kkc[4], kac[4];
#pragma unroll
            for (int nb = 0; nb < 4; ++nb) { const int cch = h * 64 + nb * 16 + fr;
                w0c[nb] = p.rw_w0[(l * 2 + dir) * 512 + cch]; a0c[nb] = p.rw_a0[(l * 2 + dir) * 512 + cch]; kkc[nb] = p.rw_k_k[l * 512 + cch]; kac[nb] = p.rw_k_a[l * 512 + cch]; }
            const bf16_t* lwt = (const bf16_t*)(p.ws + WS_LW_T) + ((size_t)(dir * 512 + h * 64 + fr) * 64 + 8 * fq);
            const bf16_t* lat = (const bf16_t*)(p.ws + WS_LA_T) + ((size_t)(dir * 512 + h * 64 + fr) * 64 + 8 * fq);
            const int pq = lane & 7;
            float kk8[8];
#pragma unroll
            for (int e = 0; e < 8; ++e) kk8[e] = p.rw_k_k[l * 512 + h * 64 + pq * 8 + e];
            const int Pfr = (fr & 3) | ((fr & 4) << 1) | ((fr & 8) >> 1);
            v4u pk_[2], pr_[2], plw_[2], pla_[2], pv_;
#define S3_PREFETCH(sc_) do { _Pragma("unroll") for (int it_ = 0; it_ < 2; ++it_) { const int pp_ = lane + 64 * it_; const bf16_t* zr_ = Z + (size_t)scan3_row((sc_), pp_ >> 3, dir, b) * ZC; \
                pk_[it_] = *(const v4u*)(zr_ + C_K + h * 64 + pq * 8); pr_[it_] = *(const v4u*)(zr_ + C_R + h * 64 + pq * 8); plw_[it_] = *(const v4u*)(zr_ + C_LW + dir * 64 + pq * 8); pla_[it_] = *(const v4u*)(zr_ + C_LA + dir * 64 + pq * 8); } \
                pv_ = *(const v4u*)(Z + (size_t)scan3_row((sc_), lane >> 2, dir, b) * ZC + C_V + h * 64 + half * 32 + (lane & 3) * 8); } while (0)
            S3_PREFETCH(pw);
            for (int iter = 0; iter < 38; ++iter) {
                __syncthreads();
                if (iter >= 36) continue;
                LAS unsigned char* set = L + ((iter & 1) * 4 + pw) * S3_SET;
                LAS bf16_t* RK = (LAS bf16_t*)(set + S3_KR); LAS bf16_t* RR = (LAS bf16_t*)(set + S3_KR + 2048);
                LAS bf16_t* LWt = (LAS bf16_t*)(set + S3_KD); LAS bf16_t* LAt = (LAS bf16_t*)(set + S3_BT);
                LAS float* RN = (LAS float*)(set + S3_PC);
#pragma unroll
                for (int it = 0; it < 2; ++it) { const int pp = lane + 64 * it, j = pp >> 3;
                    float f[8]; unpack8(pk_[it], f); float ss = 0.f;
#pragma unroll
                    for (int e = 0; e < 8; ++e) { const float t_ = f[e] * kk8[e]; ss += t_ * t_; }
                    ss += swz_xor<1>(ss); ss += swz_xor<2>(ss); ss += swz_xor<4>(ss);
                    if (pq == 0) RN[j] = rsqrtf(fmaxf(ss, 1e-12f));
                    *(LAS v4u*)(RK + j * 64 + pq * 8) = pk_[it]; *(LAS v4u*)(RR + j * 64 + pq * 8) = pr_[it]; *(LAS v4u*)(LAt + j * 64 + pq * 8) = pla_[it];
                    float g[8]; unpack8(plw_[it], g);
#pragma unroll
                    for (int e = 0; e < 8; ++e) { const float ex = __expf(2.f * g[e]); g[e] = 1.f - 2.f * frcp(ex + 1.f); }
                    v4u o; o.x = pg8::cvt_pk_bf16(g[0], g[1]); o.y = pg8::cvt_pk_bf16(g[2], g[3]); o.z = pg8::cvt_pk_bf16(g[4], g[5]); o.w = pg8::cvt_pk_bf16(g[6], g[7]);
                    *(LAS v4u*)(LWt + j * 64 + pq * 8) = o; }
                const v4u vkeep = pv_;
                bf16x8_t Bw[4][2], Ba[4][2];
#pragma unroll
                for (int nb = 0; nb < 4; ++nb)
#pragma unroll
                    for (int ks = 0; ks < 2; ++ks) { Bw[nb][ks] = *(const bf16x8_t*)(lwt + (size_t)nb * 16 * 64 + 32 * ks); Ba[nb][ks] = *(const bf16x8_t*)(lat + (size_t)nb * 16 * 64 + 32 * ks); }
                if (iter + 1 < 36) S3_PREFETCH(4 * (iter + 1) + pw);
                S3_LDS_FENCE();
                f32x4 accw[4], acca[4];
#pragma unroll
                for (int nb = 0; nb < 4; ++nb) { accw[nb] = (f32x4){0.f, 0.f, 0.f, 0.f}; acca[nb] = (f32x4){0.f, 0.f, 0.f, 0.f}; }
#pragma unroll
                for (int ks = 0; ks < 2; ++ks) {
                    const bf16x8_t aw = *(const LAS bf16x8_t*)(LWt + fr * 64 + 8 * fq + 32 * ks), aa = *(const LAS bf16x8_t*)(LAt + fr * 64 + 8 * fq + 32 * ks);
#pragma unroll
                    for (int nb = 0; nb < 4; ++nb) { accw[nb] = MFMA16(aw, Bw[nb][ks], accw[nb]); acca[nb] = MFMA16(aa, Ba[nb][ks], acca[nb]); }
                }
                float rawk[4][4], rawr[4][4], rnv[4];
#pragma unroll
                for (int i = 0; i < 4; ++i) { rnv[i] = RN[4 * fq + i];
#pragma unroll
                    for (int nb = 0; nb < 4; ++nb) { rawk[nb][i] = bf2f(RK[(4 * fq + i) * 64 + 16 * nb + fr]); rawr[nb][i] = bf2f(RR[(4 * fq + i) * 64 + 16 * nb + fr]); } }
                S3_LDS_FENCE();
                LAS bf16_t* KR = (LAS bf16_t*)(set + S3_KR); LAS bf16_t* BK = (LAS bf16_t*)(set + S3_BD);
                LAS bf16_t* KD = (LAS bf16_t*)(set + S3_KD); LAS bf16_t* BT = (LAS bf16_t*)(set + S3_BT);
#pragma unroll
                for (int nb = 0; nb < 4; ++nb) {
                    float ev[4], kkv[4], bv[4], kdv[4];
#pragma unroll
                    for (int i = 0; i < 4; ++i) {
                        const float wl = accw[nb][i] + w0c[nb], al = acca[nb][i] + a0c[nb];
                        ev[i] = 0.60653065971f * frcp(1.f + __expf(-wl));
                        const float a = frcp(1.f + __expf(-al));
                        const float k = rawk[nb][i];
                        kkv[i] = k * kkc[nb] * rnv[i]; bv[i] = kkv[i] * a; kdv[i] = k * (1.f + (a - 1.f) * kac[nb]); }
                    const float c0 = ev[0], c1 = c0 + ev[1], c2 = c1 + ev[2], c3 = c2 + ev[3];
                    const float T0 = __int_as_float(__builtin_amdgcn_ds_bpermute(fr * 4, __float_as_int(c3))), T1 = __int_as_float(__builtin_amdgcn_ds_bpermute((fr + 16) * 4, __float_as_int(c3))),
                                T2 = __int_as_float(__builtin_amdgcn_ds_bpermute((fr + 32) * 4, __float_as_int(c3)));
                    const float off = (fq > 0 ? T0 : 0.f) + (fq > 1 ? T1 : 0.f) + (fq > 2 ? T2 : 0.f);
                    const float cs[4] = {off + c0, off + c1, off + c2, off + c3};
                    const int colp = 16 * nb + Pfr, c = 16 * nb + fr;
                    float ktl[4], nbet[4];
#pragma unroll
                    for (int i = 0; i < 4; ++i) { const int t = 4 * fq + i;
                        const float E1 = __expf(cs[i]); const float E2 = frcp(E1); const float E3 = E2 * __expf(ev[i]);
                        const float kap = kkv[i] * E3, bet = bv[i] * E1, kt = kdv[i] * E1, rt = rawr[nb][i] * E2;
                        KR[t * 64 + colp] = f2bf_fast(kap); KR[(16 + t) * 64 + colp] = f2bf_fast(rt);
                        BK[t * 64 + colp] = f2bf_fast(bet); BK[(16 + t) * 64 + colp] = f2bf_fast(kt);
                        ktl[i] = kt; nbet[i] = -bet;
                        if (i == 3 && fq == 3) ((LAS float*)(set + S3_PC))[64 + c] = E2; }
                    v2u wk, wb; wk.x = pg8::cvt_pk_bf16(ktl[0], ktl[1]); wk.y = pg8::cvt_pk_bf16(ktl[2], ktl[3]);
                    wb.x = pg8::cvt_pk_bf16(nbet[0], nbet[1]); wb.y = pg8::cvt_pk_bf16(nbet[2], nbet[3]);
                    *(LAS v2u*)(KD + c * 16 + 4 * fq) = wk; *(LAS v2u*)(BT + c * 16 + 4 * fq) = wb;
                }
                S3_LDS_FENCE();
                f32x16_t G;
#pragma unroll
                for (int r = 0; r < 16; ++r) G[r] = 0.f;
                { const int n = lane & 31, hi = lane >> 5;
#pragma unroll
                  for (int ks = 0; ks < 4; ++ks) { const bf16x8_t af = *(const LAS bf16x8_t*)(BK + n * 64 + ks * 16 + 8 * hi), bf = *(const LAS bf16x8_t*)(KR + n * 64 + ks * 16 + 8 * hi); G = MFMA32(af, bf, G); }
                  S3_LDS_FENCE();
                  const int tt = n & 15; const bool isr = n >= 16;
                  float gm[16];
#pragma unroll
                  for (int r = 0; r < 16; ++r) { const int i = (r & 3) + 8 * ((r >> 2) & 1) + 4 * hi; const bool keep = isr ? (i <= tt) : (i < tt); gm[r] = keep ? G[r] : 0.f; }
                  LAS float* Am = (LAS float*)(set + S3_A);
                  if (!isr) {
#pragma unroll
                      for (int r = 0; r < 8; ++r) { const int i = (r & 3) + 8 * (r >> 2) + 4 * hi; Am[i * 16 + tt] = gm[r]; } }
                  { v2u e0, e1; float ge[8];
#pragma unroll
                    for (int r = 0; r < 8; ++r) ge[r] = isr ? -gm[r] : 0.f;
                    e0.x = pg8::cvt_pk_bf16(ge[0], ge[1]); e0.y = pg8::cvt_pk_bf16(ge[2], ge[3]); e1.x = pg8::cvt_pk_bf16(ge[4], ge[5]); e1.y = pg8::cvt_pk_bf16(ge[6], ge[7]);
                    LAS bf16_t* ET = (LAS bf16_t*)(set + S3_ET); *(LAS v2u*)(ET + n * 16 + 4 * hi) = e0; *(LAS v2u*)(ET + n * 16 + 8 + 4 * hi) = e1; }
                  { v2u d0, d1; d0.x = pg8::cvt_pk_bf16(gm[8], gm[9]); d0.y = pg8::cvt_pk_bf16(gm[10], gm[11]); d1.x = pg8::cvt_pk_bf16(gm[12], gm[13]); d1.y = pg8::cvt_pk_bf16(gm[14], gm[15]);
                    LAS bf16_t* BD = (LAS bf16_t*)(set + S3_BD); *(LAS v2u*)(BD + n * 16 + 4 * hi) = d0; *(LAS v2u*)(BD + n * 16 + 8 + 4 * hi) = d1; } }
                { LAS bf16_t* VTt = (LAS bf16_t*)(set + S3_VT); const int jv = lane >> 2, qv = lane & 3;
#pragma unroll
                  for (int e = 0; e < 4; ++e) { const unsigned w = e == 0 ? vkeep.x : e == 1 ? vkeep.y : e == 2 ? vkeep.z : vkeep.w;
                      VTt[(8 * qv + 2 * e) * 16 + jv] = (bf16_t)(w & 0xffffu); VTt[(8 * qv + 2 * e + 1) * 16 + jv] = (bf16_t)(w >> 16); } }
                { const float pcv = ((LAS float*)(set + S3_PC))[64 + lane]; S3_LDS_FENCE(); ((LAS float*)(set + S3_PC))[lane] = pcv; }
            }
#undef S3_PREFETCH
        } else {
            const int ft = tid - 320;
            for (int iter = 0; iter < 38; ++iter) {
                __syncthreads();
                if (iter < 2) continue;
                const int ch = iter - 2, buf = ch & 1;
                if (last && ch < 4) continue;
                for (int idx = ft; idx < 1024; idx += 192) {
                    const int sub = idx >> 8, j = (idx >> 4) & 15, v2 = (idx & 15) * 2;
                    const LAS float* sy = (const LAS float*)(L + S3_SY + (buf * 4 + sub) * S3_SYSUB);
                    const int row = scan3_row(4 * ch + sub, j, dir, b);
                    *(unsigned*)(Y + ((size_t)dir * LR + row) * 512 + h * 64 + half * 32 + v2) = pk2(sy[v2 * 20 + j], sy[(v2 + 1) * 20 + j]);
                }
            }
        }
    }
    __syncthreads();
}

constexpr int S4_KR = 0, S4_BK = 4096, S4_KD = 8192, S4_BT = 10240, S4_VT = 12288, S4_A = 13312, S4_PC = 14336, S4_SET = 14592;
constexpr int S4_SY = 6 * S4_SET, S4_SYSUB = 32 * 20 * 4;
__device__ __forceinline__ void ph_scan4(const Params& p, unsigned char* ldsb, int l, int wg, int nwg) {
    const int tid = otid(), lane = tid & 63;
    const int wv = __builtin_amdgcn_readfirstlane(tid >> 6);
    LAS unsigned char* L = (LAS unsigned char*)ldsb;
    const bf16_t* Z = (const bf16_t*)(p.ws + WS_Z);
    bf16_t* Y = (bf16_t*)(p.ws + WS_Y2);
    const bool last = (l == 1);
    for (int task = wg; task < 256; task += nwg) {
        const int b = task >> 5, h = (task >> 2) & 7, dir = (task >> 1) & 1, half = task & 1;
        __syncthreads();
        if (wv == 0) {
            const int vcol = lane & 31, hi = lane >> 5;
            const int tt = vcol & 15; const bool isr = vcol >= 16;
            f32x16_t st0, st1;
#pragma unroll
            for (int r = 0; r < 16; ++r) { st0[r] = 0.f; st1[r] = 0.f; }
            for (int iter = 0; iter < 50; ++iter) {
                __syncthreads();
                if (iter < 1 || iter > 48) continue;
                const int buf = (iter - 1) & 1;
#pragma unroll 1
                for (int sub = 0; sub < 3; ++sub) {
                    LAS unsigned char* set = L + (buf * 3 + sub) * S4_SET;
                    bf16x8_t krf[4];
#pragma unroll
                    for (int ks = 0; ks < 4; ++ks) krf[ks] = *(const LAS bf16x8_t*)(set + S4_KR + vcol * 128 + (ks * 16 + 8 * hi) * 2);
                    float gm[16];
                    { f32x16_t G;
#pragma unroll
                      for (int r = 0; r < 16; ++r) G[r] = 0.f;
#pragma unroll
                      for (int ks = 0; ks < 4; ++ks) { const bf16x8_t bkf = *(const LAS bf16x8_t*)(set + S4_BK + vcol * 128 + (ks * 16 + 8 * hi) * 2); G = MFMA32(bkf, krf[ks], G); }
#pragma unroll
                      for (int r = 0; r < 16; ++r) { const int i = (r & 3) + 8 * ((r >> 2) & 1) + 4 * hi; const bool keep = isr ? (i <= tt) : (i < tt); gm[r] = keep ? G[r] : 0.f; } }
                    LAS float* Am = (LAS float*)(set + S4_A);
                    if (!isr) {
#pragma unroll
                        for (int r = 0; r < 8; ++r) { const int i = (r & 3) + 8 * (r >> 2) + 4 * hi; Am[i * 16 + tt] = gm[r]; } }
                    bf16x8_t etf, bdf;
                    { v4u w; float ge[8];
#pragma unroll
                      for (int r = 0; r < 8; ++r) ge[r] = isr ? -gm[r] : 0.f;
                      w.x = pg8::cvt_pk_bf16(ge[0], ge[1]); w.y = pg8::cvt_pk_bf16(ge[2], ge[3]); w.z = pg8::cvt_pk_bf16(ge[4], ge[5]); w.w = pg8::cvt_pk_bf16(ge[6], ge[7]); etf = __builtin_bit_cast(bf16x8_t, w);
                      w.x = pg8::cvt_pk_bf16(gm[8], gm[9]); w.y = pg8::cvt_pk_bf16(gm[10], gm[11]); w.z = pg8::cvt_pk_bf16(gm[12], gm[13]); w.w = pg8::cvt_pk_bf16(gm[14], gm[15]); bdf = __builtin_bit_cast(bf16x8_t, w); }
                    bf16x8_t sb[4];
                    { v4u w;
                      w.x = pg8::cvt_pk_bf16(st0[0], st0[1]); w.y = pg8::cvt_pk_bf16(st0[2], st0[3]); w.z = pg8::cvt_pk_bf16(st0[4], st0[5]); w.w = pg8::cvt_pk_bf16(st0[6], st0[7]); sb[0] = __builtin_bit_cast(bf16x8_t, w);
                      w.x = pg8::cvt_pk_bf16(st0[8], st0[9]); w.y = pg8::cvt_pk_bf16(st0[10], st0[11]); w.z = pg8::cvt_pk_bf16(st0[12], st0[13]); w.w = pg8::cvt_pk_bf16(st0[14], st0[15]); sb[1] = __builtin_bit_cast(bf16x8_t, w);
                      w.x = pg8::cvt_pk_bf16(st1[0], st1[1]); w.y = pg8::cvt_pk_bf16(st1[2], st1[3]); w.z = pg8::cvt_pk_bf16(st1[4], st1[5]); w.w = pg8::cvt_pk_bf16(st1[6], st1[7]); sb[2] = __builtin_bit_cast(bf16x8_t, w);
                      w.x = pg8::cvt_pk_bf16(st1[8], st1[9]); w.y = pg8::cvt_pk_bf16(st1[10], st1[11]); w.z = pg8::cvt_pk_bf16(st1[12], st1[13]); w.w = pg8::cvt_pk_bf16(st1[14], st1[15]); sb[3] = __builtin_bit_cast(bf16x8_t, w); }
                    f32x16_t acc;
#pragma unroll
                    for (int r = 0; r < 16; ++r) acc[r] = 0.f;
#pragma unroll
                    for (int ks = 0; ks < 4; ++ks) acc = MFMA32(krf[ks], sb[ks], acc);
                    bf16x8_t vtf;
                    { const v2u a = *(const LAS v2u*)(set + S4_VT + vcol * 32 + 4 * hi * 2), c = *(const LAS v2u*)(set + S4_VT + vcol * 32 + (8 + 4 * hi) * 2); const v4u w = {a.x, a.y, c.x, c.y}; vtf = __builtin_bit_cast(bf16x8_t, w); }
                    acc = MFMA32(bdf, vtf, acc);
                    float rhs[16];
#pragma unroll
                    for (int r = 0; r < 8; ++r) { auto rr = __builtin_amdgcn_permlane32_swap(__float_as_uint(acc[r]), __float_as_uint(acc[r]), false, false);
                        const int t0 = (r & 3) + 8 * (r >> 2); rhs[t0] = __uint_as_float(rr[0]); rhs[t0 + 4] = __uint_as_float(rr[1]); }
                    S3_LDS_FENCE();
                    float u[16];
#pragma unroll
                    for (int i = 0; i < 16; ++i) {
                        u[i] = rhs[i];
                        if (i < 15) {
                            const LAS float* ar = Am + i * 16;
                            const f32x4 a0 = *(const LAS f32x4*)(ar), a1 = *(const LAS f32x4*)(ar + 4), a2 = *(const LAS f32x4*)(ar + 8), a3 = *(const LAS f32x4*)(ar + 12);
                            const float av[16] = {a0[0], a0[1], a0[2], a0[3], a1[0], a1[1], a1[2], a1[3], a2[0], a2[1], a2[2], a2[3], a3[0], a3[1], a3[2], a3[3]};
#pragma unroll
                            for (int t = i + 1; t < 16; ++t) rhs[t] -= u[i] * av[t];
                        }
                    }
                    bf16x8_t ub;
                    { v4u w; w.x = pg8::cvt_pk_bf16(hi ? u[4] : u[0], hi ? u[5] : u[1]); w.y = pg8::cvt_pk_bf16(hi ? u[6] : u[2], hi ? u[7] : u[3]);
                      w.z = pg8::cvt_pk_bf16(hi ? u[12] : u[8], hi ? u[13] : u[9]); w.w = pg8::cvt_pk_bf16(hi ? u[14] : u[10], hi ? u[15] : u[11]); ub = __builtin_bit_cast(bf16x8_t, w); }
                    acc = MFMA32(etf, ub, acc);
                    { LAS float* sy = (LAS float*)(L + S4_SY + (buf * 3 + sub) * S4_SYSUB) + vcol * 20;
                      *(LAS f32x4*)(sy + 4 * hi) = (f32x4){acc[8], acc[9], acc[10], acc[11]};
                      *(LAS f32x4*)(sy + 8 + 4 * hi) = (f32x4){acc[12], acc[13], acc[14], acc[15]}; }
#define S4_FRAG2(base_, row_) ({ const v2u a_ = *(const LAS v2u*)(set + (base_) + (row_) * 32 + 4 * hi * 2), c_ = *(const LAS v2u*)(set + (base_) + (row_) * 32 + (8 + 4 * hi) * 2); const v4u w_ = {a_.x, a_.y, c_.x, c_.y}; __builtin_bit_cast(bf16x8_t, w_); })
                    { const bf16x8_t kd0 = S4_FRAG2(S4_KD, vcol), kd1 = S4_FRAG2(S4_KD, 32 + vcol), bt0 = S4_FRAG2(S4_BT, vcol), bt1 = S4_FRAG2(S4_BT, 32 + vcol);
                      st0 = MFMA32(kd0, vtf, st0); st0 = MFMA32(bt0, ub, st0);
                      st1 = MFMA32(kd1, vtf, st1); st1 = MFMA32(bt1, ub, st1); }
#undef S4_FRAG2
#pragma unroll
                    for (int g = 0; g < 4; ++g) {
                        const f32x4 p0 = *(const LAS f32x4*)((const LAS float*)(set + S4_PC) + 8 * g + 4 * hi), p1 = *(const LAS f32x4*)((const LAS float*)(set + S4_PC) + 32 + 8 * g + 4 * hi);
#pragma unroll
                        for (int e = 0; e < 4; ++e) { st0[4 * g + e] *= p0[e]; st1[4 * g + e] *= p1[e]; }
                    }
                }
            }
        } else if (wv <= 6) {
            const int fr = lane & 15, fq = lane >> 4, hp = wv - 1, sub = hp >> 1, chh = hp & 1;
            float w0c[2], a0c[2], kac[2], kkc4[4];
            bf16x8_t Bw[2][2], Ba[2][2];
#pragma unroll
            for (int nb = 0; nb < 4; ++nb) kkc4[nb] = p.rw_k_k[l * 512 + h * 64 + nb * 16 + fr];
#pragma unroll
            for (int q = 0; q < 2; ++q) { const int cch = h * 64 + (2 * chh + q) * 16 + fr;
                w0c[q] = p.rw_w0[(l * 2 + dir) * 512 + cch]; a0c[q] = p.rw_a0[(l * 2 + dir) * 512 + cch]; kac[q] = p.rw_k_a[l * 512 + cch];
#pragma unroll
                for (int ks = 0; ks < 2; ++ks) {
                    Bw[q][ks] = *(const bf16x8_t*)((const bf16_t*)(p.ws + WS_LW_T) + ((size_t)(dir * 512 + cch) * 64 + 8 * fq + 32 * ks));
                    Ba[q][ks] = *(const bf16x8_t*)((const bf16_t*)(p.ws + WS_LA_T) + ((size_t)(dir * 512 + cch) * 64 + 8 * fq + 32 * ks)); } }
            const int Pfr = (fr & 3) | ((fr & 4) << 1) | ((fr & 8) >> 1);
            v4u plw[2], pla[2]; bf16_t pk[4][4], pr[2][4];
#define S4_PREFETCH(sc_) do { const bf16_t* za_ = Z + (size_t)scan3_row((sc_), fr, dir, b) * ZC; \
                _Pragma("unroll") for (int ks_ = 0; ks_ < 2; ++ks_) { plw[ks_] = *(const v4u*)(za_ + C_LW + dir * 64 + 8 * fq + 32 * ks_); pla[ks_] = *(const v4u*)(za_ + C_LA + dir * 64 + 8 * fq + 32 * ks_); } \
                _Pragma("unroll") for (int i_ = 0; i_ < 4; ++i_) { const bf16_t* zt_ = Z + (size_t)scan3_row((sc_), 4 * fq + i_, dir, b) * ZC; \
                    _Pragma("unroll") for (int nb_ = 0; nb_ < 4; ++nb_) pk[nb_][i_] = zt_[C_K + h * 64 + nb_ * 16 + fr]; \
                    _Pragma("unroll") for (int q_ = 0; q_ < 2; ++q_) pr[q_][i_] = zt_[C_R + h * 64 + (2 * chh + q_) * 16 + fr]; } } while (0)
            S4_PREFETCH(sub);
            for (int iter = 0; iter < 50; ++iter) {
                __syncthreads();
                if (iter >= 48) continue;
                LAS unsigned char* set = L + ((iter & 1) * 3 + sub) * S4_SET;
                bf16x8_t aw[2], aa[2];
#pragma unroll
                for (int ks = 0; ks < 2; ++ks) { float g[8]; unpack8(plw[ks], g);
#pragma unroll
                    for (int e = 0; e < 8; ++e) { const float ex = __expf(2.f * g[e]); g[e] = 1.f - 2.f * frcp(ex + 1.f); }
                    v4u o; o.x = pg8::cvt_pk_bf16(g[0], g[1]); o.y = pg8::cvt_pk_bf16(g[2], g[3]); o.z = pg8::cvt_pk_bf16(g[4], g[5]); o.w = pg8::cvt_pk_bf16(g[6], g[7]);
                    aw[ks] = __builtin_bit_cast(bf16x8_t, o); aa[ks] = __builtin_bit_cast(bf16x8_t, pla[ks]); }
                float kf[4][4], rf[2][4];
#pragma unroll
                for (int i = 0; i < 4; ++i) {
#pragma unroll
                    for (int nb = 0; nb < 4; ++nb) kf[nb][i] = bf2f(pk[nb][i]);
#pragma unroll
                    for (int q = 0; q < 2; ++q) rf[q][i] = bf2f(pr[q][i]); }
                if (iter + 1 < 48) S4_PREFETCH(3 * (iter + 1) + sub);
                f32x4 accw[2], acca[2];
#pragma unroll
                for (int q = 0; q < 2; ++q) { accw[q] = (f32x4){0.f, 0.f, 0.f, 0.f}; acca[q] = (f32x4){0.f, 0.f, 0.f, 0.f}; }
#pragma unroll
                for (int ks = 0; ks < 2; ++ks)
#pragma unroll
                    for (int q = 0; q < 2; ++q) { accw[q] = MFMA16(aw[ks], Bw[q][ks], accw[q]); acca[q] = MFMA16(aa[ks], Ba[q][ks], acca[q]); }
                float rnv[4];
#pragma unroll
                for (int i = 0; i < 4; ++i) { float ss = 0.f;
#pragma unroll
                    for (int nb = 0; nb < 4; ++nb) { const float t_ = kf[nb][i] * kkc4[nb]; ss += t_ * t_; }
                    rnv[i] = rsqrtf(fmaxf(row16_sum(ss), 1e-12f)); }
                LAS bf16_t* KR = (LAS bf16_t*)(set + S4_KR); LAS bf16_t* BK = (LAS bf16_t*)(set + S4_BK);
                LAS bf16_t* KD = (LAS bf16_t*)(set + S4_KD); LAS bf16_t* BT = (LAS bf16_t*)(set + S4_BT);
#pragma unroll
                for (int q = 0; q < 2; ++q) { const int nb = 2 * chh + q;
                    float ev[4], kkv[4], bv[4], kdv[4];
#pragma unroll
                    for (int i = 0; i < 4; ++i) {
                        const float wl = accw[q][i] + w0c[q], al = acca[q][i] + a0c[q];
                        ev[i] = 0.60653065971f * frcp(1.f + __expf(-wl));
                        const float a = frcp(1.f + __expf(-al));
                        const float k = kf[nb][i];
                        kkv[i] = k * kkc4[nb] * rnv[i]; bv[i] = kkv[i] * a; kdv[i] = k * (1.f + (a - 1.f) * kac[q]); }
                    const float c0 = ev[0], c1 = c0 + ev[1], c2 = c1 + ev[2], c3 = c2 + ev[3];
                    const float T0 = __int_as_float(__builtin_amdgcn_ds_bpermute(fr * 4, __float_as_int(c3))), T1 = __int_as_float(__builtin_amdgcn_ds_bpermute((fr + 16) * 4, __float_as_int(c3))),
                                T2 = __int_as_float(__builtin_amdgcn_ds_bpermute((fr + 32) * 4, __float_as_int(c3)));
                    const float off = (fq > 0 ? T0 : 0.f) + (fq > 1 ? T1 : 0.f) + (fq > 2 ? T2 : 0.f);
                    const float cs[4] = {off + c0, off + c1, off + c2, off + c3};
                    const int colp = 16 * nb + Pfr, c = 16 * nb + fr;
                    float ktl[4], nbet[4];
#pragma unroll
                    for (int i = 0; i < 4; ++i) { const int t = 4 * fq + i;
                        const float E1 = __expf(cs[i]); const float E2 = frcp(E1); const float E3 = E2 * __expf(ev[i]);
                        const float kap = kkv[i] * E3, bet = bv[i] * E1, kt = kdv[i] * E1, rt = rf[q][i] * E2;
                        KR[t * 64 + colp] = f2bf_fast(kap); KR[(16 + t) * 64 + colp] = f2bf_fast(rt);
                        BK[t * 64 + colp] = f2bf_fast(bet); BK[(16 + t) * 64 + colp] = f2bf_fast(kt);
                        ktl[i] = kt; nbet[i] = -bet;
                        if (i == 3 && fq == 3) ((LAS float*)(set + S4_PC))[c] = E2; }
                    v2u wk, wb; wk.x = pg8::cvt_pk_bf16(ktl[0], ktl[1]); wk.y = pg8::cvt_pk_bf16(ktl[2], ktl[3]);
                    wb.x = pg8::cvt_pk_bf16(nbet[0], nbet[1]); wb.y = pg8::cvt_pk_bf16(nbet[2], nbet[3]);
                    *(LAS v2u*)(KD + c * 16 + 4 * fq) = wk; *(LAS v2u*)(BT + c * 16 + 4 * fq) = wb;
                }
            }
#undef S4_PREFETCH
        } else {
            const int jv = lane >> 2, qv = lane & 3;
            v4u pv[3];
#define S4_PREFV(ch_) do { _Pragma("unroll") for (int s_ = 0; s_ < 3; ++s_) pv[s_] = *(const v4u*)(Z + (size_t)scan3_row(3 * (ch_) + s_, jv, dir, b) * ZC + C_V + h * 64 + half * 32 + qv * 8); } while (0)
            S4_PREFV(0);
            for (int iter = 0; iter < 50; ++iter) {
                __syncthreads();
                if (iter < 48) {
#pragma unroll
                    for (int s_ = 0; s_ < 3; ++s_) { LAS bf16_t* VTt = (LAS bf16_t*)(L + ((iter & 1) * 3 + s_) * S4_SET + S4_VT);
#pragma unroll
                        for (int e = 0; e < 4; ++e) { const unsigned w = e == 0 ? pv[s_].x : e == 1 ? pv[s_].y : e == 2 ? pv[s_].z : pv[s_].w;
                            VTt[(8 * qv + 2 * e) * 16 + jv] = (bf16_t)(w & 0xffffu); VTt[(8 * qv + 2 * e + 1) * 16 + jv] = (bf16_t)(w >> 16); } }
                    if (iter + 1 < 48) S4_PREFV(iter + 1);
                }
                if (iter >= 2) {
                    const int ch = iter - 2, buf = ch & 1;
                    for (int idx = lane; idx < 768; idx += 64) {
                        const int s_ = idx >> 8, j = (idx >> 4) & 15, v2 = (idx & 15) * 2; const int sc = 3 * ch + s_;
                        if (last && sc < 16) continue;
                        const LAS float* sy = (const LAS float*)(L + S4_SY + (buf * 3 + s_) * S4_SYSUB);
                        const int row = scan3_row(sc, j, dir, b);
                        *(unsigned*)(Y + ((size_t)dir * LR + row) * 512 + h * 64 + half * 32 + v2) = pk2(sy[v2 * 20 + j], sy[(v2 + 1) * 20 + j]);
                    }
                }
            }
#undef S4_PREFV
        }
    }
    __syncthreads();
}

constexpr int S5_KR = 0, S5_BK = 4608, S5_KD = 9216, S5_BT = 11776, S5_VT = 14336, S5_A = 16896, S5_PC = 18944, S5_SET = 19200;
constexpr int S5_SY = 6 * S5_SET, S5_SYSUB = 32 * 20 * 4;
__device__ __forceinline__ void ph_scan5(const Params& p, unsigned char* ldsb, int l, int wg, int nwg) {
    const int tid = otid(), lane = tid & 63;
    const int wv = __builtin_amdgcn_readfirstlane(tid >> 6);
    LAS unsigned char* L = (LAS unsigned char*)ldsb;
    const bf16_t* Z = (const bf16_t*)(p.ws + WS_Z);
    bf16_t* Y = (bf16_t*)(p.ws + WS_Y2);
    const bool last = (l == 1);
    for (int task = wg; task < 128; task += nwg) {
        const int b = task >> 4, h = (task >> 1) & 7, dir = task & 1;
        __syncthreads();
        if (wv <= 1) {
            const int half = wv;
            const int lane_c = otid() & 63;
            const int vcol = lane_c & 31, hi = lane_c >> 5;
            const int tt = vcol & 15; const bool isr = vcol >= 16;
            f32x16_t st0, st1;
#pragma unroll
            for (int r = 0; r < 16; ++r) { st0[r] = 0.f; st1[r] = 0.f; }
            for (int iter = 0; iter < 50; ++iter) {
                __syncthreads();
                if (iter < 1 || iter > 48) continue;
                const int buf = (iter - 1) & 1;
                bf16x8_t etf3[3], bdf3[3];
                int tto = tt; asm volatile("" : "+v"(tto));
#pragma unroll
                for (int sub = 0; sub < 3; ++sub) {
                    LAS unsigned char* set = L + (buf * 3 + sub) * S5_SET;
                    float gm[16];
                    { f32x16_t G;
#pragma unroll
                      for (int r = 0; r < 16; ++r) G[r] = 0.f;
#pragma unroll
                      for (int ks = 0; ks < 4; ++ks) { const bf16x8_t kq = *(const LAS bf16x8_t*)(set + S5_KR + vcol * 144 + (ks * 16 + 8 * hi) * 2), bkf = *(const LAS bf16x8_t*)(set + S5_BK + vcol * 144 + (ks * 16 + 8 * hi) * 2); G = MFMA32(bkf, kq, G); }
#pragma unroll
                      for (int r = 0; r < 16; ++r) { const int i = (r & 3) + 8 * ((r >> 2) & 1) + 4 * hi; const bool keep = isr ? (i <= tto) : (i < tto); gm[r] = keep ? G[r] : 0.f; } }
                    LAS float* Am = (LAS float*)(set + S5_A + half * 1024);
                    if (!isr) {
#pragma unroll
                        for (int r = 0; r < 8; ++r) { const int i = (r & 3) + 8 * (r >> 2) + 4 * hi; Am[i * 16 + tt] = gm[r]; } }
                    { v4u w; float ge[8];
#pragma unroll
                      for (int r = 0; r < 8; ++r) ge[r] = isr ? -gm[r] : 0.f;
                      w.x = pg8::cvt_pk_bf16(ge[0], ge[1]); w.y = pg8::cvt_pk_bf16(ge[2], ge[3]); w.z = pg8::cvt_pk_bf16(ge[4], ge[5]); w.w = pg8::cvt_pk_bf16(ge[6], ge[7]); etf3[sub] = __builtin_bit_cast(bf16x8_t, w);
                      w.x = pg8::cvt_pk_bf16(gm[8], gm[9]); w.y = pg8::cvt_pk_bf16(gm[10], gm[11]); w.z = pg8::cvt_pk_bf16(gm[12], gm[13]); w.w = pg8::cvt_pk_bf16(gm[14], gm[15]); bdf3[sub] = __builtin_bit_cast(bf16x8_t, w); }
                }
                S3_LDS_FENCE();
#pragma unroll 1
                for (int sub = 0; sub < 3; ++sub) {
                    LAS unsigned char* set = L + (buf * 3 + sub) * S5_SET;
                    bf16x8_t krf[4];
#pragma unroll
                    for (int ks = 0; ks < 4; ++ks) krf[ks] = *(const LAS bf16x8_t*)(set + S5_KR + vcol * 144 + (ks * 16 + 8 * hi) * 2);
                    LAS float* Am = (LAS float*)(set + S5_A + half * 1024);
                    const bf16x8_t etf = sub == 0 ? etf3[0] : sub == 1 ? etf3[1] : etf3[2], bdf = sub == 0 ? bdf3[0] : sub == 1 ? bdf3[1] : bdf3[2];
                    bf16x8_t sb[4];
                    { v4u w;
                      w.x = pg8::cvt_pk_bf16(st0[0], st0[1]); w.y = pg8::cvt_pk_bf16(st0[2], st0[3]); w.z = pg8::cvt_pk_bf16(st0[4], st0[5]); w.w = pg8::cvt_pk_bf16(st0[6], st0[7]); sb[0] = __builtin_bit_cast(bf16x8_t, w);
                      w.x = pg8::cvt_pk_bf16(st0[8], st0[9]); w.y = pg8::cvt_pk_bf16(st0[10], st0[11]); w.z = pg8::cvt_pk_bf16(st0[12], st0[13]); w.w = pg8::cvt_pk_bf16(st0[14], st0[15]); sb[1] = __builtin_bit_cast(bf16x8_t, w);
                      w.x = pg8::cvt_pk_bf16(st1[0], st1[1]); w.y = pg8::cvt_pk_bf16(st1[2], st1[3]); w.z = pg8::cvt_pk_bf16(st1[4], st1[5]); w.w = pg8::cvt_pk_bf16(st1[6], st1[7]); sb[2] = __builtin_bit_cast(bf16x8_t, w);
                      w.x = pg8::cvt_pk_bf16(st1[8], st1[9]); w.y = pg8::cvt_pk_bf16(st1[10], st1[11]); w.z = pg8::cvt_pk_bf16(st1[12], st1[13]); w.w = pg8::cvt_pk_bf16(st1[14], st1[15]); sb[3] = __builtin_bit_cast(bf16x8_t, w); }
                    f32x16_t acc;
#pragma unroll
                    for (int r = 0; r < 16; ++r) acc[r] = 0.f;
#pragma unroll
                    for (int ks = 0; ks < 4; ++ks) acc = MFMA32(krf[ks], sb[ks], acc);
#define S5_FRAG2(base_, row_) ({ const v2u a_ = *(const LAS v2u*)(set + (base_) + (row_) * 40 + 4 * hi * 2), c_ = *(const LAS v2u*)(set + (base_) + (row_) * 40 + (8 + 4 * hi) * 2); const v4u w_ = {a_.x, a_.y, c_.x, c_.y}; __builtin_bit_cast(bf16x8_t, w_); })
                    const bf16x8_t vtf = S5_FRAG2(S5_VT, half * 32 + vcol);
                    acc = MFMA32(bdf, vtf, acc);
                    float rhs[16];
#pragma unroll
                    for (int r = 0; r < 8; ++r) { auto rr = __builtin_amdgcn_permlane32_swap(__float_as_uint(acc[r]), __float_as_uint(acc[r]), false, false);
                        const int t0 = (r & 3) + 8 * (r >> 2); rhs[t0] = __uint_as_float(rr[0]); rhs[t0 + 4] = __uint_as_float(rr[1]); }
                    S3_LDS_FENCE();
                    float u[16];
#pragma unroll
                    for (int i = 0; i < 16; ++i) {
                        u[i] = rhs[i];
                        if (i < 15) {
                            const LAS float* ar = Am + i * 16;
                            const f32x4 a0 = *(const LAS f32x4*)(ar), a1 = *(const LAS f32x4*)(ar + 4), a2 = *(const LAS f32x4*)(ar + 8), a3 = *(const LAS f32x4*)(ar + 12);
                            const float av[16] = {a0[0], a0[1], a0[2], a0[3], a1[0], a1[1], a1[2], a1[3], a2[0], a2[1], a2[2], a2[3], a3[0], a3[1], a3[2], a3[3]};
#pragma unroll
                            for (int t = i + 1; t < 16; ++t) rhs[t] -= u[i] * av[t];
                        }
                    }
                    bf16x8_t ub;
                    { v4u w; w.x = pg8::cvt_pk_bf16(hi ? u[4] : u[0], hi ? u[5] : u[1]); w.y = pg8::cvt_pk_bf16(hi ? u[6] : u[2], hi ? u[7] : u[3]);
                      w.z = pg8::cvt_pk_bf16(hi ? u[12] : u[8], hi ? u[13] : u[9]); w.w = pg8::cvt_pk_bf16(hi ? u[14] : u[10], hi ? u[15] : u[11]); ub = __builtin_bit_cast(bf16x8_t, w); }
                    acc = MFMA32(etf, ub, acc);
                    { LAS float* sy = (LAS float*)(L + S5_SY + ((buf * 3 + sub) * 2 + half) * S5_SYSUB) + vcol * 20;
                      *(LAS f32x4*)(sy + 4 * hi) = (f32x4){acc[8], acc[9], acc[10], acc[11]};
                      *(LAS f32x4*)(sy + 8 + 4 * hi) = (f32x4){acc[12], acc[13], acc[14], acc[15]}; }
                    { const bf16x8_t kd0 = S5_FRAG2(S5_KD, vcol), kd1 = S5_FRAG2(S5_KD, 32 + vcol), bt0 = S5_FRAG2(S5_BT, vcol), bt1 = S5_FRAG2(S5_BT, 32 + vcol);
                      st0 = MFMA32(kd0, vtf, st0); st0 = MFMA32(bt0, ub, st0);
                      st1 = MFMA32(kd1, vtf, st1); st1 = MFMA32(bt1, ub, st1); }
#undef S5_FRAG2
#pragma unroll
                    for (int g = 0; g < 4; ++g) {
                        const f32x4 p0 = *(const LAS f32x4*)((const LAS float*)(set + S5_PC) + 8 * g + 4 * hi), p1 = *(const LAS f32x4*)((const LAS float*)(set + S5_PC) + 32 + 8 * g + 4 * hi);
#pragma unroll
                        for (int e = 0; e < 4; ++e) { st0[4 * g + e] *= p0[e]; st1[4 * g + e] *= p1[e]; }
                    }
                }
            }
        } else {
            const int lane = otid() & 63;
            const int fr = lane & 15, fq = lane >> 4, hp = wv - 2, sub = hp >> 1, chh = hp & 1;
            float w0c[2], a0c[2], kac[2], kkc4[4];
            bf16x8_t Bw[2][2], Ba[2][2];
#pragma unroll
            for (int nb = 0; nb < 4; ++nb) kkc4[nb] = p.rw_k_k[l * 512 + h * 64 + nb * 16 + fr];
#pragma unroll
            for (int q = 0; q < 2; ++q) { const int cch = h * 64 + (2 * chh + q) * 16 + fr;
                w0c[q] = p.rw_w0[(l * 2 + dir) * 512 + cch]; a0c[q] = p.rw_a0[(l * 2 + dir) * 512 + cch]; kac[q] = p.rw_k_a[l * 512 + cch];
#pragma unroll
                for (int ks = 0; ks < 2; ++ks) {
                    Bw[q][ks] = *(const bf16x8_t*)((const bf16_t*)(p.ws + WS_LW_T) + ((size_t)(dir * 512 + cch) * 64 + 8 * fq + 32 * ks));
                    Ba[q][ks] = *(const bf16x8_t*)((const bf16_t*)(p.ws + WS_LA_T) + ((size_t)(dir * 512 + cch) * 64 + 8 * fq + 32 * ks)); } }
            const int Pfr = (fr & 3) | ((fr & 4) << 1) | ((fr & 8) >> 1);
            const int jv = lane >> 2, qv = lane & 3;
            v4u plw[2], pla[2], pvv, pkf[2], prf;
            bf16x8_t Idm[2];
#pragma unroll
            for (int o_ = 0; o_ < 2; ++o_) { const int jsel = 16 * o_ + fr - 8 * fq; v4u w = {0u, 0u, 0u, 0u};
                if (jsel >= 0 && jsel < 8) { const unsigned one = (jsel & 1) ? 0x3f800000u : 0x00003f80u; if ((jsel >> 1) == 0) w.x = one; else if ((jsel >> 1) == 1) w.y = one; else if ((jsel >> 1) == 2) w.z = one; else w.w = one; }
                Idm[o_] = __builtin_bit_cast(bf16x8_t, w); }
#define S5_PREFETCH(sc_) do { const bf16_t* za_ = Z + (size_t)scan3_row((sc_), fr, dir, b) * ZC; \
                _Pragma("unroll") for (int ks_ = 0; ks_ < 2; ++ks_) { plw[ks_] = *(const v4u*)(za_ + C_LW + dir * 64 + 8 * fq + 32 * ks_); pla[ks_] = *(const v4u*)(za_ + C_LA + dir * 64 + 8 * fq + 32 * ks_); \
                    pkf[ks_] = *(const v4u*)(za_ + C_K + h * 64 + 8 * fq + 32 * ks_); } \
                prf = *(const v4u*)(za_ + C_R + h * 64 + 8 * fq + 32 * chh); \
                pvv = *(const v4u*)(Z + (size_t)scan3_row((sc_), jv, dir, b) * ZC + C_V + h * 64 + chh * 32 + qv * 8); } while (0)
            S5_PREFETCH(sub);
            for (int iter = 0; iter < 50; ++iter) {
                __syncthreads();
                if (iter >= 2) {
                    const int ch = iter - 2, buf = ch & 1, sc = 3 * ch + sub;
                    if (!(last && sc < 16)) {
                        const LAS float* sy = (const LAS float*)(L + S5_SY + ((buf * 3 + sub) * 2 + chh) * S5_SYSUB);
#pragma unroll
                        for (int k4 = 0; k4 < 4; ++k4) { const int idx = lane + 64 * k4, j = idx >> 4, v2 = (idx & 15) * 2;
                            const int row = scan3_row(sc, j, dir, b);
                            *(unsigned*)(Y + ((size_t)dir * LR + row) * 512 + h * 64 + chh * 32 + v2) = pk2(sy[v2 * 20 + j], sy[(v2 + 1) * 20 + j]); }
                    }
                }
                if (iter >= 48) continue;
                LAS unsigned char* set = L + ((iter & 1) * 3 + sub) * S5_SET;
                bf16x8_t aw[2], aa[2];
#pragma unroll
                for (int ks = 0; ks < 2; ++ks) { aw[ks] = __builtin_bit_cast(bf16x8_t, plw[ks]); aa[ks] = __builtin_bit_cast(bf16x8_t, pla[ks]); }
                f32x4 kf[4], rf[2];
                { const f32x4 z4 = {0.f, 0.f, 0.f, 0.f};
#pragma unroll
                  for (int nb = 0; nb < 4; ++nb) kf[nb] = MFMA16(__builtin_bit_cast(bf16x8_t, pkf[nb >> 1]), Idm[nb & 1], z4);
#pragma unroll
                  for (int q = 0; q < 2; ++q) rf[q] = MFMA16(__builtin_bit_cast(bf16x8_t, prf), Idm[q], z4); }
                { LAS bf16_t* VTt = (LAS bf16_t*)(set + S5_VT);
#pragma unroll
                  for (int e = 0; e < 4; ++e) { const unsigned w = e == 0 ? pvv.x : e == 1 ? pvv.y : e == 2 ? pvv.z : pvv.w;
                      VTt[(chh * 32 + 8 * qv + 2 * e) * 20 + jv] = (bf16_t)(w & 0xffffu); VTt[(chh * 32 + 8 * qv + 2 * e + 1) * 20 + jv] = (bf16_t)(w >> 16); } }
                if (iter + 1 < 48) S5_PREFETCH(3 * (iter + 1) + sub);
                f32x4 accw[2], acca[2];
#pragma unroll
                for (int q = 0; q < 2; ++q) { accw[q] = (f32x4){0.f, 0.f, 0.f, 0.f}; acca[q] = (f32x4){0.f, 0.f, 0.f, 0.f}; }
#pragma unroll
                for (int ks = 0; ks < 2; ++ks)
#pragma unroll
                    for (int q = 0; q < 2; ++q) { accw[q] = MFMA16(aw[ks], Bw[q][ks], accw[q]); acca[q] = MFMA16(aa[ks], Ba[q][ks], acca[q]); }
                float rnv[4];
#pragma unroll
                for (int i = 0; i < 4; ++i) { float ss = 0.f;
#pragma unroll
                    for (int nb = 0; nb < 4; ++nb) { const float t_ = kf[nb][i] * kkc4[nb]; ss += t_ * t_; }
                    rnv[i] = rsqrtf(fmaxf(row16_sum(ss), 1e-12f)); }
                LAS bf16_t* KR = (LAS bf16_t*)(set + S5_KR); LAS bf16_t* BK = (LAS bf16_t*)(set + S5_BK);
                LAS bf16_t* KD = (LAS bf16_t*)(set + S5_KD); LAS bf16_t* BT = (LAS bf16_t*)(set + S5_BT);
#pragma unroll
                for (int q = 0; q < 2; ++q) { const int nb = 2 * chh + q;
                    float ev[4], kkv[4], bv[4], kdv[4];
#pragma unroll
                    for (int i = 0; i < 4; ++i) {
                        const float wl = accw[q][i] + w0c[q], al = acca[q][i] + a0c[q];
                        ev[i] = 0.60653065971f * frcp(1.f + __expf(-wl));
                        const float a = frcp(1.f + __expf(-al));
                        const float k = kf[nb][i];
                        kkv[i] = k * kkc4[nb] * rnv[i]; bv[i] = kkv[i] * a; kdv[i] = k * (1.f + (a - 1.f) * kac[q]); }
                    const float c0 = ev[0], c1 = c0 + ev[1], c2 = c1 + ev[2], c3 = c2 + ev[3];
                    const float T0 = __int_as_float(__builtin_amdgcn_ds_bpermute(fr * 4, __float_as_int(c3))), T1 = __int_as_float(__builtin_amdgcn_ds_bpermute((fr + 16) * 4, __float_as_int(c3))),
                                T2 = __int_as_float(__builtin_amdgcn_ds_bpermute((fr + 32) * 4, __float_as_int(c3)));
                    const float off = (fq > 0 ? T0 : 0.f) + (fq > 1 ? T1 : 0.f) + (fq > 2 ? T2 : 0.f);
                    const float cs[4] = {off + c0, off + c1, off + c2, off + c3};
                    const int colp = 16 * nb + Pfr, c = 16 * nb + fr;
                    float ktl[4], nbet[4];
                    float E2p = 0.f;
#pragma unroll
                    for (int i = 0; i < 4; ++i) { const int t = 4 * fq + i;
                        const float E1 = __expf(cs[i]); const float E2 = frcp(E1); const float E3 = (i == 0) ? E2 * __expf(ev[0]) : E2p; E2p = E2;
                        const float kap = kkv[i] * E3, bet = bv[i] * E1, kt = kdv[i] * E1, rt = rf[q][i] * E2;
                        KR[t * 72 + colp] = f2bf_fast(kap); KR[(16 + t) * 72 + colp] = f2bf_fast(rt);
                        BK[t * 72 + colp] = f2bf_fast(bet); BK[(16 + t) * 72 + colp] = f2bf_fast(kt);
                        ktl[i] = kt; nbet[i] = -bet;
                        if (i == 3 && fq == 3) ((LAS float*)(set + S5_PC))[c] = E2; }
                    v2u wk, wb; wk.x = pg8::cvt_pk_bf16(ktl[0], ktl[1]); wk.y = pg8::cvt_pk_bf16(ktl[2], ktl[3]);
                    wb.x = pg8::cvt_pk_bf16(nbet[0], nbet[1]); wb.y = pg8::cvt_pk_bf16(nbet[2], nbet[3]);
                    *(LAS v2u*)(KD + c * 20 + 4 * fq) = wk; *(LAS v2u*)(BT + c * 20 + 4 * fq) = wb;
                }
            }
#undef S5_PREFETCH
        }
    }
    __syncthreads();
}
__device__ __forceinline__ void na_block(const bf16_t* kbase, const bf16x8_t (&qf)[2], bool lat, int dr31, int c0, int jq, int cs, const LAS float* rp,
                                         int fr, int fq, float (&pv)[4], float& lsum) {
    const bf16x8_t k0 = *(const bf16x8_t*)(kbase + (size_t)fr * ZC + 8 * fq), k1 = *(const bf16x8_t*)(kbase + (size_t)fr * ZC + 8 * fq + 32);
    float ss = 0.f;
#pragma unroll
    for (int e = 0; e < 8; ++e) { const float a = bf2f((bf16_t)k0[e]), b = bf2f((bf16_t)k1[e]); ss += a * a + b * b; }
    ss += swz_xor<16>(ss); ss = xor32_add(ss);
    const float rk = rsqrtf(ss * (1.f / 64.f) + RMS_EPS);
    f32x4 st = {0.f, 0.f, 0.f, 0.f};
    st = __builtin_amdgcn_mfma_f32_16x16x32_bf16(k0, qf[0], st, 0, 0, 0);
    st = __builtin_amdgcn_mfma_f32_16x16x32_bf16(k1, qf[1], st, 0, 0, 0);
#pragma unroll
    for (int i = 0; i < 4; ++i) {
        const float rki = __int_as_float(__builtin_amdgcn_ds_bpermute((4 * fq + i) * 4, __float_as_int(rk)));
        float x = st[i] * rki;
        if (lat) { const int c = c0 + 4 * fq + i; const bool valid = (c >= cs) && (c < cs + 16);
            const int di = min(max(c - jq + 15, 0), 30);
            x = valid ? __expf(fminf(x + rp[dr31 + di], 80.f)) : 0.f; }
        else x = __expf(fminf(x, 80.f));
        pv[i] = x; lsum += x;
    }
}
__device__ __forceinline__ void ph_natt2(const Params& p, unsigned char* ldsb, int l, int wg, int nwg) {
    const int tid = otid(), lane = tid & 63, wv = tid >> 6, fr = lane & 15, fq = lane >> 4;
    LAS float* rp = (LAS float*)ldsb + wv * 512;
    const bf16_t* Z = (const bf16_t*)(p.ws + WS_Z); const bf16_t* VT = (const bf16_t*)(p.ws + WS_VT); bf16_t* YB = (bf16_t*)(p.ws + WS_YB);
    const bool last = (l == 1);
    const int nunits = last ? 8192 : 9216;
    float gsc[2][8];
#pragma unroll
    for (int ks = 0; ks < 2; ++ks)
#pragma unroll
        for (int j = 0; j < 8; ++j) { const int d = 8 * fq + j + 32 * ks; gsc[ks][j] = p.na_q_g[l * 64 + d] * p.na_k_g[l * 64 + d] * 0.125f; }
    int cur_h = -1;
    for (int unit = wg * 8 + wv; unit < nunits; unit += nwg * 8) {
        int b, h, i = 0, qb, qrow0; bool isl;
        if (unit < 8192) { b = unit >> 10; h = (unit >> 7) & 7; i = (unit >> 2) & 31; qb = unit & 3; isl = true; qrow0 = b * SEQ + i * 64 + qb * 16; }
        else { const int u2 = unit - 8192; b = u2 >> 7; h = (u2 >> 4) & 7; qb = u2 & 15; isl = false; qrow0 = NLAT + b * CTXL + qb * 16; }
        if (h != cur_h) { for (int idx = lane; idx < 465; idx += 64) rp[idx] = p.na_rpb[(size_t)(l * 8 + h) * 465 + idx]; cur_h = h; }
        bf16x8_t qf[2];
        { const bf16_t* qp = Z + (size_t)(qrow0 + fr) * ZC + C_Q + h * 64 + 8 * fq;
          const bf16x8_t q0 = *(const bf16x8_t*)qp, q1 = *(const bf16x8_t*)(qp + 32);
          float f0[8], f1[8]; float ss = 0.f;
#pragma unroll
          for (int e = 0; e < 8; ++e) { f0[e] = bf2f((bf16_t)q0[e]); f1[e] = bf2f((bf16_t)q1[e]); ss += f0[e] * f0[e] + f1[e] * f1[e]; }
          ss += swz_xor<16>(ss); ss = xor32_add(ss);
          const float rq = rsqrtf(ss * (1.f / 64.f) + RMS_EPS);
#pragma unroll
          for (int e = 0; e < 8; ++e) { qf[0][e] = (short)f2bf(f0[e] * rq * gsc[0][e]); qf[1][e] = (short)f2bf(f1[e] * rq * gsc[1][e]); } }
        f32x4 o[4];
#pragma unroll
        for (int db = 0; db < 4; ++db) o[db] = (f32x4){0.f, 0.f, 0.f, 0.f};
        float lsum = 0.f;
        const bf16_t* vtb = VT + ((size_t)((b * 8 + h) * 64 + fr)) * 2304 + 4 * fq;
        const int jq = qb * 16 + fr, cs = min(max(jq - 8, 0), 48);
        const int r0 = min(max(i - 4, 0), 24);
        const int kb_lo = (qb <= 1) ? 0 : qb - 1, nkb = (qb == 0 || qb == 3) ? 2 : 3;
        const int nlat = isl ? 8 * nkb : 0, ntot = nlat + 16;
        for (int t = 0; t < ntot; t += 2) {
            float pa[4], pb[4]; int tposA, tposB;
            { const int tt = t; const bool lt = tt < nlat; int krow, dr31 = 0, c0 = 0;
              if (lt) { const int a = tt / nkb, kb = kb_lo + tt % nkb; krow = b * SEQ + (r0 + a) * 64 + 16 * kb; tposA = 256 + (r0 + a) * 64 + 16 * kb; dr31 = (r0 + a - i + 7) * 31; c0 = 16 * kb; }
              else { const int cbk = tt - nlat; krow = NLAT + b * CTXL + 16 * cbk; tposA = 16 * cbk; }
              na_block(Z + (size_t)krow * ZC + C_KB + h * 64, qf, lt, dr31, c0, jq, cs, rp, fr, fq, pa, lsum); }
            { const int tt = t + 1; const bool lt = tt < nlat; int krow, dr31 = 0, c0 = 0;
              if (lt) { const int a = tt / nkb, kb = kb_lo + tt % nkb; krow = b * SEQ + (r0 + a) * 64 + 16 * kb; tposB = 256 + (r0 + a) * 64 + 16 * kb; dr31 = (r0 + a - i + 7) * 31; c0 = 16 * kb; }
              else { const int cbk = tt - nlat; krow = NLAT + b * CTXL + 16 * cbk; tposB = 16 * cbk; }
              na_block(Z + (size_t)krow * ZC + C_KB + h * 64, qf, lt, dr31, c0, jq, cs, rp, fr, fq, pb, lsum); }
            bf16x8_t pf;
            pf[0] = (short)f2bf(pa[0]); pf[1] = (short)f2bf(pa[1]); pf[2] = (short)f2bf(pa[2]); pf[3] = (short)f2bf(pa[3]);
            pf[4] = (short)f2bf(pb[0]); pf[5] = (short)f2bf(pb[1]); pf[6] = (short)f2bf(pb[2]); pf[7] = (short)f2bf(pb[3]);
#pragma unroll
            for (int db = 0; db < 4; ++db) {
                typedef short s16x4_t __attribute__((ext_vector_type(4)));
                const s16x4_t va = *(const s16x4_t*)(vtb + (size_t)db * 16 * 2304 + tposA), vb = *(const s16x4_t*)(vtb + (size_t)db * 16 * 2304 + tposB);
                const bf16x8_t vf = {va[0], va[1], va[2], va[3], vb[0], vb[1], vb[2], vb[3]};
                o[db] = __builtin_amdgcn_mfma_f32_16x16x32_bf16(pf, vf, o[db], 0, 0, 0);
            }
        }
        lsum += swz_xor<16>(lsum); lsum = xor32_add(lsum);
        const float linv = 1.f / lsum;
#pragma unroll
        for (int i2 = 0; i2 < 4; ++i2) {
            const float li = __int_as_float(__builtin_amdgcn_ds_bpermute((4 * fq + i2) * 4, __float_as_int(linv)));
            bf16_t* yp = YB + (size_t)(qrow0 + 4 * fq + i2) * 512 + h * 64 + fr;
#pragma unroll
            for (int db = 0; db < 4; ++db) yp[db * 16] = f2bf(o[db][i2] * li);
        }
    }
}

typedef short s16x4_t __attribute__((ext_vector_type(4)));
__device__ __forceinline__ void na_soft(const f32x4 st, const float (&rki)[4], bool lat, int dr31, int c0, int jq, int cs, const LAS float* rp, int fq, float (&pv)[4], float& lsum) {
    if (lat) {
        float bi[4];
#pragma unroll
        for (int i = 0; i < 4; ++i) { const int c = c0 + i; bi[i] = rp[dr31 + min(max(c - jq + 15, 0), 30)]; }
#pragma unroll
        for (int i = 0; i < 4; ++i) { const int c = c0 + i; const bool valid = (c >= cs) && (c < cs + 16);
            const float x = valid ? fminf(st[i] * rki[i] + bi[i], 80.f) : -1e30f;
            const float e = __expf(x); pv[i] = e; lsum += e; }
    } else {
#pragma unroll
        for (int i = 0; i < 4; ++i) { const float e = __expf(fminf(st[i] * rki[i], 80.f)); pv[i] = e; lsum += e; }
    }
}
__device__ __forceinline__ void ph_natt3(const Params& p, unsigned char* ldsb, int l, int wg, int nwg) {
    const int wv = otid() >> 6;
    LAS unsigned char* L = (LAS unsigned char*)ldsb;
    LAS bf16_t* sK = (LAS bf16_t*)(L + 0);
    LAS bf16_t* sVT = (LAS bf16_t*)(L + 36864);
    LAS float* sRK = (LAS float*)(L + 70656);
    LAS float* rp = (LAS float*)(L + 71680);
    LAS float* sG = (LAS float*)(L + 73728);
    const bf16_t* Z = (const bf16_t*)(p.ws + WS_Z); const bf16_t* VT = (const bf16_t*)(p.ws + WS_VT); bf16_t* YB = (bf16_t*)(p.ws + WS_YB);
    const bool last = (l == 1);
    const int per = (256 + nwg - 1) / nwg;
    int staged = -1;
    for (int tk = 0; tk < per; ++tk) {
        const int task = wg * per + tk; if (task >= 256) break;
        const int b = task >> 5, h = (task >> 2) & 7, quarter = task & 3;
        const int tid = otid();
        __syncthreads();
        if ((task >> 2) != staged) {
        staged = task >> 2;
#pragma unroll
        for (int it = 0; it < 4; ++it) { const int pc = tid + 512 * it, key = pc >> 3, q = pc & 7;
            const v4u kw = *(const v4u*)(Z + (size_t)(NLAT + b * CTXL + key) * ZC + C_KB + h * 64 + 8 * q);
            *(LAS v4u*)(sK + key * 72 + 8 * q) = kw;
            float f[8]; unpack8(kw, f); float ss = 0.f;
#pragma unroll
            for (int e = 0; e < 8; ++e) ss += f[e] * f[e];
            ss += swz_xor<1>(ss); ss += swz_xor<2>(ss); ss += swz_xor<4>(ss);
            if (q == 0) sRK[key] = rsqrtf(ss * (1.f / 64.f) + RMS_EPS);
            const int d = pc >> 5, q2 = pc & 31;
            *(LAS v4u*)(sVT + d * 264 + 8 * q2) = *(const v4u*)(VT + ((size_t)((b * 8 + h) * 64 + d)) * 2304 + 8 * q2); }
        if (tid < 465) rp[tid] = p.na_rpb[(size_t)(l * 8 + h) * 465 + tid];
        if (tid < 64) sG[tid] = p.na_q_g[l * 64 + tid] * p.na_k_g[l * 64 + tid] * 0.125f;
        }
        __syncthreads();
        const int nun = last ? 32 : 36;
        for (int u = wv; u < nun; u += 8) {
            const int lane2 = otid() & 63, fr = lane2 & 15, fq = lane2 >> 4;
            const bool isl = u < 32;
            const int i = 8 * quarter + (u >> 2), qb = isl ? (u & 3) : (4 * quarter + (u - 32));
            const int qrow0 = isl ? (b * SEQ + i * 64 + qb * 16) : (NLAT + b * CTXL + qb * 16);
            bf16x8_t qf[2];
            { const bf16_t* qp = Z + (size_t)(qrow0 + fr) * ZC + C_Q + h * 64 + 8 * fq;
              const bf16x8_t q0 = *(const bf16x8_t*)qp, q1 = *(const bf16x8_t*)(qp + 32);
              float f0[8], f1[8]; float ss = 0.f;
#pragma unroll
              for (int e = 0; e < 8; ++e) { f0[e] = bf2f((bf16_t)q0[e]); f1[e] = bf2f((bf16_t)q1[e]); ss += f0[e] * f0[e] + f1[e] * f1[e]; }
              ss += swz_xor<16>(ss); ss = xor32_add(ss);
              const float rq = rsqrtf(ss * (1.f / 64.f) + RMS_EPS);
              const f32x4 g00 = *(const LAS f32x4*)(sG + 8 * fq), g01 = *(const LAS f32x4*)(sG + 8 * fq + 4), g10 = *(const LAS f32x4*)(sG + 32 + 8 * fq), g11 = *(const LAS f32x4*)(sG + 36 + 8 * fq);
#pragma unroll
              for (int e = 0; e < 4; ++e) { f0[e] *= rq * g00[e]; f0[4 + e] *= rq * g01[e]; f1[e] *= rq * g10[e]; f1[4 + e] *= rq * g11[e]; }
              v4u w0, w1; w0.x = pg8::cvt_pk_bf16(f0[0], f0[1]); w0.y = pg8::cvt_pk_bf16(f0[2], f0[3]); w0.z = pg8::cvt_pk_bf16(f0[4], f0[5]); w0.w = pg8::cvt_pk_bf16(f0[6], f0[7]);
              w1.x = pg8::cvt_pk_bf16(f1[0], f1[1]); w1.y = pg8::cvt_pk_bf16(f1[2], f1[3]); w1.z = pg8::cvt_pk_bf16(f1[4], f1[5]); w1.w = pg8::cvt_pk_bf16(f1[6], f1[7]);
              qf[0] = __builtin_bit_cast(bf16x8_t, w0); qf[1] = __builtin_bit_cast(bf16x8_t, w1); }
            f32x4 o[4];
#pragma unroll
            for (int db = 0; db < 4; ++db) o[db] = (f32x4){0.f, 0.f, 0.f, 0.f};
            float lsum = 0.f;
            const bf16_t* vtb = VT + ((size_t)((b * 8 + h) * 64 + fr)) * 2304 + 4 * fq;
            const int jq = qb * 16 + fr, cs = min(max(jq - 8, 0), 48);
            const int r0 = min(max(i - 4, 0), 24);
            const int c0 = (qb == 0) ? 0 : (qb == 1) ? 8 : (qb == 2) ? 24 : 32;
            const int krow_in = 8 * (fr >> 2) + (fr & 3);
#define NA_LOAD(a_, KA_, KB_, V_) do { const int tok_ = (r0 + (a_)) * 64 + c0; \
                const bf16_t* kp_ = Z + (size_t)(b * SEQ + tok_ + krow_in) * ZC + C_KB + h * 64 + 8 * fq; KA_[0] = *(const bf16x8_t*)kp_; KA_[1] = *(const bf16x8_t*)(kp_ + 32); \
                KB_[0] = *(const bf16x8_t*)(kp_ + 4 * ZC); KB_[1] = *(const bf16x8_t*)(kp_ + 4 * ZC + 32); \
                _Pragma("unroll") for (int db_ = 0; db_ < 4; ++db_) V_[db_] = *(const bf16x8_t*)(VT + ((size_t)((b * 8 + h) * 64 + 16 * db_ + fr)) * 2304 + 256 + tok_ + 8 * fq); } while (0)
#define NA_SCORE_LAT(a_, K_, cofs_, P_) do { \
                float ss_ = 0.f; _Pragma("unroll") for (int e_ = 0; e_ < 8; ++e_) { const float x_ = bf2f((bf16_t)K_[0][e_]), y_ = bf2f((bf16_t)K_[1][e_]); ss_ += x_ * x_ + y_ * y_; } \
                ss_ += swz_xor<16>(ss_); ss_ = xor32_add(ss_); const float rk_ = rsqrtf(ss_ * (1.f / 64.f) + RMS_EPS); \
                f32x4 st_ = {0.f, 0.f, 0.f, 0.f}; st_ = __builtin_amdgcn_mfma_f32_16x16x32_bf16(K_[0], qf[0], st_, 0, 0, 0); st_ = __builtin_amdgcn_mfma_f32_16x16x32_bf16(K_[1], qf[1], st_, 0, 0, 0); \
                float rki_[4]; _Pragma("unroll") for (int i_ = 0; i_ < 4; ++i_) rki_[i_] = __int_as_float(__builtin_amdgcn_ds_bpermute((4 * fq + i_) * 4, __float_as_int(rk_))); \
                na_soft(st_, rki_, true, (r0 + (a_) - i + 7) * 31, c0 + (cofs_) + 8 * fq, jq, cs, rp, fq, P_, lsum); } while (0)
#define NA_PV(PA_, PB_, V_) do { v4u pw_; pw_.x = pg8::cvt_pk_bf16(PA_[0], PA_[1]); pw_.y = pg8::cvt_pk_bf16(PA_[2], PA_[3]); pw_.z = pg8::cvt_pk_bf16(PB_[0], PB_[1]); pw_.w = pg8::cvt_pk_bf16(PB_[2], PB_[3]); \
                const bf16x8_t pf_ = __builtin_bit_cast(bf16x8_t, pw_); \
                _Pragma("unroll") for (int db_ = 0; db_ < 4; ++db_) o[db_] = __builtin_amdgcn_mfma_f32_16x16x32_bf16(pf_, V_[db_], o[db_], 0, 0, 0); } while (0)
#define NA_CTX_LOAD(sidx_) do { \
                _Pragma("unroll") for (int hb = 0; hb < 2; ++hb) { const int key = 32 * (sidx_) + krow_in + 4 * hb; \
                    ck[hb][0] = *(const LAS bf16x8_t*)(sK + key * 72 + 8 * fq); ck[hb][1] = *(const LAS bf16x8_t*)(sK + key * 72 + 8 * fq + 32); \
                    crk[hb] = *(const LAS f32x4*)(sRK + 32 * (sidx_) + 8 * fq + 4 * hb); } \
                _Pragma("unroll") for (int db = 0; db < 4; ++db) cv[db] = *(const LAS bf16x8_t*)(sVT + (16 * db + fr) * 264 + 32 * (sidx_) + 8 * fq); } while (0)
#define NA_CTX_COMPUTE() do { float pa_[4], pb_[4]; \
                _Pragma("unroll") for (int hb = 0; hb < 2; ++hb) { \
                    f32x4 st = {0.f, 0.f, 0.f, 0.f}; \
                    st = __builtin_amdgcn_mfma_f32_16x16x32_bf16(ck[hb][0], qf[0], st, 0, 0, 0); st = __builtin_amdgcn_mfma_f32_16x16x32_bf16(ck[hb][1], qf[1], st, 0, 0, 0); \
                    const float rki[4] = {crk[hb][0], crk[hb][1], crk[hb][2], crk[hb][3]}; \
                    if (hb == 0) na_soft(st, rki, false, 0, 0, 0, 0, rp, fq, pa_, lsum); else na_soft(st, rki, false, 0, 0, 0, 0, rp, fq, pb_, lsum); } \
                NA_PV(pa_, pb_, cv); } while (0)
            bf16x8_t ck[2][2], cv[4]; f32x4 crk[2];
            if (isl) {
                bf16x8_t kA[2][2], kB[2][2], vv[2][4];
                NA_LOAD(0, kA[0], kB[0], vv[0]);
#pragma unroll 1
                for (int s2 = 0; s2 < 8; s2 += 2) {
#pragma unroll
                    for (int si = 0; si < 2; ++si) { const int sidx = s2 + si;
                        if (sidx + 1 < 8) NA_LOAD(sidx + 1, kA[si ^ 1], kB[si ^ 1], vv[si ^ 1]);
                        NA_CTX_LOAD(sidx);
                        __builtin_amdgcn_sched_barrier(0);
                        float pa[4], pb[4];
                        NA_SCORE_LAT(sidx, kA[si], 0, pa); NA_SCORE_LAT(sidx, kB[si], 4, pb);
                        NA_PV(pa, pb, vv[si]);
                        __builtin_amdgcn_sched_barrier(0);
                        NA_CTX_COMPUTE();
                        __builtin_amdgcn_sched_barrier(0);
                    }
                }
            } else {
#pragma unroll 1
                for (int sidx = 0; sidx < 8; ++sidx) { NA_CTX_LOAD(sidx); __builtin_amdgcn_sched_barrier(0); NA_CTX_COMPUTE(); }
            }
#undef NA_CTX_LOAD
#undef NA_CTX_COMPUTE
#undef NA_LOAD
#undef NA_SCORE_LAT
#undef NA_PV
            lsum += swz_xor<16>(lsum); lsum = xor32_add(lsum);
            const float linv = 1.f / lsum;
#pragma unroll
            for (int i2 = 0; i2 < 4; ++i2) {
                const float li = __int_as_float(__builtin_amdgcn_ds_bpermute((4 * fq + i2) * 4, __float_as_int(linv)));
                bf16_t* yp = YB + (size_t)(qrow0 + 4 * fq + i2) * 512 + h * 64 + fr;
#pragma unroll
                for (int db = 0; db < 4; ++db) yp[db * 16] = f2bf(o[db][i2] * li);
            }
        }
    }
    __syncthreads();
}

__device__ __forceinline__ void ph_convert_moe(const Params& p, unsigned char* ldsb, int l, int wg, int nwg);
__device__ __forceinline__ void ph_scan_natt(const Params& p, unsigned char* ldsb, int l, int wg, int nwg) {
    const int hs_ = nwg >> 1;
    if (nwg < 2) { ph_scan5(p, ldsb, l, 0, 1); __syncthreads(); ph_natt3(p, ldsb, l, 0, 1); }
    else if (wg < hs_) ph_scan5(p, ldsb, l, wg, hs_);
    else { ph_natt3(p, ldsb, l, wg - hs_, nwg - hs_); ph_convert_moe(p, ldsb, l, wg - hs_, nwg - hs_); }
}

__device__ __forceinline__ void ph_rwkvout(const Params& p, float* sm, int l, int wg, int nwg) {
    const bf16_t* Z = (const bf16_t*)(p.ws + WS_Z);
    const bf16_t* Y2 = (const bf16_t*)(p.ws + WS_Y2);
    bf16_t* OA = (bf16_t*)(p.ws + WS_OUTA);
    const int c = otid(); const int nrows = (l == 1) ? NLAT : LR;
    const float lng = p.rw_ln_g[l * 512 + c], lnb = p.rw_ln_b[l * 512 + c], rk = p.rw_r_k[l * 512 + c];
    const float* glb = p.rw_g_lora_b + (size_t)l * 128 * 512 + c;
    for (int r = wg; r < nrows; r += nwg) {
        __syncthreads();
        if (c < 128) sm[c] = sigmoidf_(bf2f(Z[(size_t)r * ZC + C_LG + c]));
        __syncthreads();
        const float yv = bf2f(Y2[(size_t)r * 512 + c]) + bf2f(Y2[((size_t)LR + r) * 512 + c]);
        const float mu = wave_sum(yv) * (1.f / 64.f); const float d = yv - mu; const float var = wave_sum(d * d) * (1.f / 64.f);
        const float yn = d * rsqrtf(var + GN_EPS) * lng + lnb;
        const float rr = bf2f(Z[(size_t)r * ZC + C_R + c]), kk = bf2f(Z[(size_t)r * ZC + C_K + c]), vv = bf2f(Z[(size_t)r * ZC + C_V + c]);
        const float bon = wave_sum(rr * kk * rk) * vv;
        float g = 0.f;
#pragma unroll 4
        for (int j = 0; j < 128; ++j) g += sm[j] * glb[(size_t)j * 512];
        OA[(size_t)r * 512 + c] = f2bf((yn + bon) * g);
    }
}

struct EpiOutA {
    static constexpr bool PERM = true, AFTER_DRAIN = false;
    const bf16_t* PRE; bf16_t* OA;
    __device__ __forceinline__ void operator()(const f32x4 (&acc)[2][2][4][2], const pg8::Unit& u, int wr, int wc, int fr, int fq) const {
        const int row0 = u.pm * 256 + wr * 64 + fr, colb = u.pn * 256 + wc * 32 + 8 * fq;
#pragma unroll
        for (int ai = 0; ai < 2; ++ai)
#pragma unroll
            for (int bj = 0; bj < 2; ++bj) { const int col = colb + bj * 128;
                v4u pw[4];
#pragma unroll
                for (int m = 0; m < 4; ++m) pw[m] = *(const v4u*)(PRE + (size_t)(row0 + ai * 128 + m * 16) * 512 + col);
#pragma unroll
                for (int m = 0; m < 4; ++m) { const int row = row0 + ai * 128 + m * 16;
                    float pr[8]; unpack8(pw[m], pr);
                    const f32x4 v0 = acc[ai][bj][m][0], v1 = acc[ai][bj][m][1];
                    v4u w; w.x = pg8::cvt_pk_bf16(pr[0] * v0[0], pr[1] * v0[1]); w.y = pg8::cvt_pk_bf16(pr[2] * v0[2], pr[3] * v0[3]);
                    w.z = pg8::cvt_pk_bf16(pr[4] * v1[0], pr[5] * v1[1]); w.w = pg8::cvt_pk_bf16(pr[6] * v1[2], pr[7] * v1[3]);
                    *(v4u*)(OA + (size_t)row * 512 + col) = w; } }
    }
};
__device__ __forceinline__ void ph_rwkvout2(const Params& p, unsigned char* ldsb, int l, int wg, int nwg) {
    const int nrows = (l == 1) ? NLAT : LR;
    pg8::StaticOrder S; S.init(nrows, 512, nwg, wg);
    {
        const int tid = otid(), lane = tid & 63, wv = tid >> 6;
        const bf16_t* Z = (const bf16_t*)(p.ws + WS_Z); bf16_t* Y2 = (bf16_t*)(p.ws + WS_Y2);
        pg8::Unit u;
        for (int it = 0; S.next(it, u); ++it) {
            const int c = u.pn * 256 + 4 * lane;
            const f32x4 lng = *(const f32x4*)(p.rw_ln_g + l * 512 + c), lnb = *(const f32x4*)(p.rw_ln_b + l * 512 + c), rkk = *(const f32x4*)(p.rw_r_k + l * 512 + c);
            for (int rr0 = wv; rr0 < 256; rr0 += 32) {
                v2u lyf[4], lyb[4], lr[4], lk[4], lv[4];
#pragma unroll
                for (int q = 0; q < 4; ++q) { const int row = u.pm * 256 + rr0 + 8 * q;
                    lyf[q] = *(const v2u*)(Y2 + (size_t)row * 512 + c); lyb[q] = *(const v2u*)(Y2 + ((size_t)LR + row) * 512 + c);
                    lr[q] = *(const v2u*)(Z + (size_t)row * ZC + C_R + c); lk[q] = *(const v2u*)(Z + (size_t)row * ZC + C_K + c); lv[q] = *(const v2u*)(Z + (size_t)row * ZC + C_V + c); }
#pragma unroll
                for (int q = 0; q < 4; ++q) { const int row = u.pm * 256 + rr0 + 8 * q;
                    float yf[4], yb[4], r4[4], k4[4], v4[4];
                    unpack4(lyf[q], yf); unpack4(lyb[q], yb); unpack4(lr[q], r4); unpack4(lk[q], k4); unpack4(lv[q], v4);
                    float y[4]; float sy = 0.f, sb = 0.f;
#pragma unroll
                    for (int e = 0; e < 4; ++e) { y[e] = yf[e] + yb[e]; sy += y[e]; sb += r4[e] * k4[e] * rkk[e]; }
                    sy = row16_sum(sy); sb = row16_sum(sb);
                    const float mu = sy * (1.f / 64.f); float sq = 0.f;
#pragma unroll
                    for (int e = 0; e < 4; ++e) { y[e] -= mu; sq += y[e] * y[e]; }
                    sq = row16_sum(sq);
                    const float rs = rsqrtf(sq * (1.f / 64.f) + GN_EPS);
                    float o[4];
#pragma unroll
                    for (int e = 0; e < 4; ++e) o[e] = y[e] * rs * lng[e] + lnb[e] + sb * v4[e];
                    v2u w; w.x = pk2(o[0], o[1]); w.y = pk2(o[2], o[3]);
                    *(v2u*)(Y2 + (size_t)row * 512 + c) = w; }
            }
        }
    }
    asm volatile("s_waitcnt vmcnt(0)" ::: "memory");
    __syncthreads();
    pg8::Gemm g{(const bf16_t*)(p.ws + WS_SG), (const bf16_t*)(p.ws + WS_GL_T), nrows, 512, 256};
    EpiOutA E{(const bf16_t*)(p.ws + WS_Y2), (bf16_t*)(p.ws + WS_OUTA)};
    pg8::gemm_phase<EpiOutA, pg8::StaticOrder, true, true>((LAS unsigned char*)ldsb, g, S, E);
}

__device__ __forceinline__ void ph_merge(const Params& p, float* sm, int l, int wg, int nwg) {
    const bf16_t* Z = (const bf16_t*)(p.ws + WS_Z);
    bf16_t* MG = (bf16_t*)(p.ws + WS_MERGED);
    float* TMP = (float*)(p.ws + WS_YS);
    const int nrows = (l == 1) ? NLAT : LR;
    gemm_naive<bf16_t>(sm, wg, nwg, nrows, DM, 512, (const bf16_t*)(p.ws + WS_OUTA), 512, nullptr, 0, p.proj_a + (size_t)l * 512 * DM, DM,
                       [=](int r, int c, float v) { TMP[(size_t)r * DM + c] = sigmoidf_(bf2f(Z[(size_t)r * ZC + C_GA + c])) * v; });
    gemm_naive<bf16_t>(sm, wg, nwg, nrows, DM, 512, (const bf16_t*)(p.ws + WS_YB), 512, nullptr, 0, p.proj_b + (size_t)l * 512 * DM, DM,
                       [=](int r, int c, float v) { MG[(size_t)r * DM + c] = f2bf(TMP[(size_t)r * DM + c] + sigmoidf_(bf2f(Z[(size_t)r * ZC + C_GB + c])) * v); });
}

__device__ __forceinline__ void ph_wout(const Params& p, float* sm, int l, int wg, int nwg) {
    const float* MOD = (const float*)(p.ws + WS_MOD);
    const int nrows = (l == 1) ? NLAT : LR;
    const Params pp = p;
    gemm_naive<bf16_t>(sm, wg, nwg, nrows, DM, DM, (const bf16_t*)(p.ws + WS_MERGED), DM, nullptr, 0, p.w_out + (size_t)l * DM * DM, DM,
                       [=](int r, int c, float v) { const float base = (l == 0 ? in_row(pp, r) : st_row(pp, r))[c];
                           st_row(pp, r)[c] = base + MOD[(l * 9 + mod_row(r)) * 6144 + 2 * DM + c] * v; });
}

__device__ __forceinline__ void ph_route(const Params& p, float* sm, int l, int wg, int nwg) {
    const int lane = otid() & 63, wv = otid() >> 6, nwv = blockDim.x >> 6;
    const float* MOD = (const float*)(p.ws + WS_MOD);
    bf16_t* H2 = (bf16_t*)(p.ws + WS_H2);
    const int nrows = (l == 1) ? NLAT : LR;
    for (int r = wg * nwv + wv; r < nrows; r += nwg * nwv) {
        const float* xr = st_row(p, r);
        float v[16]; float ss = 0.f;
#pragma unroll
        for (int i = 0; i < 16; ++i) { v[i] = xr[lane + 64 * i]; ss += v[i] * v[i]; }
        ss = wave_sum(ss);
        const float rs = rsqrtf(ss * (1.f / DM) + RMS_EPS);
        const float* m = MOD + (l * 9 + mod_row(r)) * 6144;
        float* hs = sm + wv * 1024;
#pragma unroll
        for (int i = 0; i < 16; ++i) { const int d = lane + 64 * i;
            const float h = (v[i] * rs * p.norm2_g[l * DM + d]) * (1.f + m[4 * DM + d]) + m[3 * DM + d];
            H2[(size_t)r * DM + d] = f2bf(h); hs[d] = h; }
        float dsum = 0.f;
        { const int e = lane & 15, part = lane >> 4; const float* rw = p.router_w + (size_t)(part * 256) * 16 + e; const float* hp = hs + part * 256;
#pragma unroll 4
            for (int d = 0; d < 256; ++d) dsum += hp[d] * rw[(size_t)d * 16]; }
        dsum += swz_xor<16>(dsum); dsum = xor32_add(dsum);
        const float myscore = 1.f / (1.f + expf(-dsum));
        float sc[16], sel[16];
#pragma unroll
        for (int e = 0; e < 16; ++e) { sc[e] = rdlane(myscore, e); sel[e] = sc[e] + p.router_bias[e]; }
        int best = 0; float bestv = -INFINITY;
#pragma unroll
        for (int g = 0; g < 4; ++g) { float m1 = -INFINITY, m2 = -INFINITY;
#pragma unroll
            for (int j = 0; j < 4; ++j) { const float s = sel[g * 4 + j]; if (s > m1) { m2 = m1; m1 = s; } else if (s > m2) m2 = s; }
            const float gs = m1 + m2; if (gs > bestv) { bestv = gs; best = g; } }
        int i0 = -1; float v0 = -INFINITY;
#pragma unroll
        for (int e = 0; e < 16; ++e) if ((e >> 2) == best && sel[e] > v0) { v0 = sel[e]; i0 = e; }
        int i1 = -1; float v1 = -INFINITY;
#pragma unroll
        for (int e = 0; e < 16; ++e) if ((e >> 2) == best && e != i0 && sel[e] > v1) { v1 = sel[e]; i1 = e; }
        float s0 = 0.f, s1 = 0.f;
#pragma unroll
        for (int e = 0; e < 16; ++e) { if (e == i0) s0 = sc[e]; if (e == i1) s1 = sc[e]; }
        const float inv = 1.f / (s0 + s1);
        if (lane == 0) {
            ((int*)(p.ws + WS_TOKI))[r] = i0 | (i1 << 8);
            ((float2*)(p.ws + WS_TOKG))[r] = make_float2(s0 * inv, s1 * inv);
        }
    }
}

__device__ __forceinline__ void ph_lists(const Params& p, float* sm, int l, int wg, int nwg) {
    int* cnt = (int*)(p.ws + WS_CTL) + l * 16;
    int* LT = (int*)(p.ws + WS_LTOK); float* LGt = (float*)(p.ws + WS_LGATE);
    const int* TI = (const int*)(p.ws + WS_TOKI); const float2* TG = (const float2*)(p.ws + WS_TOKG);
    const int nrows = (l == 1) ? NLAT : LR;
    const int tid = otid(), lane = tid & 63, wv = tid >> 6;
    int* wcnt = (int*)sm;
    for (int e = wg; e < NE; e += nwg) {
        int base = 0;
        for (int c0 = 0; c0 < nrows; c0 += 512) {
            const int t = c0 + tid;
            int slot = -1; float g = 0.f;
            if (t < nrows) { const int ti = TI[t]; const float2 tg = TG[t];
                if ((ti & 255) == e) { slot = 0; g = tg.x; } else if ((ti >> 8) == e) { slot = 1; g = tg.y; } }
            const unsigned long long bal = __ballot(slot >= 0);
            __syncthreads();
            if (lane == 0) wcnt[wv] = __popcll(bal);
            __syncthreads();
            int woff = 0, tot = 0;
#pragma unroll
            for (int w = 0; w < 8; ++w) { const int c = wcnt[w]; if (w < wv) woff += c; tot += c; }
            if (slot >= 0) { const int pos = base + woff + __popcll(bal & ((1ull << lane) - 1ull));
                LT[e * LR + pos] = t * 2 + slot; LGt[e * LR + pos] = g; }
            base += tot;
        }
        if (tid == 0) cnt[e] = base;
    }
}

__device__ __forceinline__ void ph_convert_moe(const Params& p, unsigned char* ldsb, int l, int wg, int nwg) {
    const int lane = otid() & 63, wv = __builtin_amdgcn_readfirstlane(otid() >> 6);
    LAS float* scr = (LAS float*)((LAS unsigned char*)ldsb + 32768 + wv * 8704);
    const int gw = wg * 8 + wv, NGW = nwg * 8;
    for (int it = gw; it < 16 * 768; it += NGW) {
        const int e = it / 768, r = it % 768, which = r >> 8, q = r & 255;
        if (which < 2) { const int kb = q >> 4, nb = q & 15, n0 = nb * 32;
            const float* W = (which == 0 ? p.moe_w1 : p.moe_w3) + (size_t)(l * NE + e) * DM * DE;
            tr_item(W, DE, kb * 64, n0, (bf16_t*)(p.ws + WS_W13T) + (size_t)e * 1024 * 1024, DM, (n0 >> 7) * 256 + (n0 & 127) + which * 128, scr, lane); }
        else { const int kb = q >> 5, nb = q & 31;
            tr_item(p.moe_w2 + (size_t)(l * NE + e) * DE * DM, DM, kb * 64, nb * 32, (bf16_t*)(p.ws + WS_W2T) + (size_t)e * 1024 * 512, DE, nb * 32, scr, lane); }
    }
}
__device__ __forceinline__ void ph_route2(const Params& p, float* sm, int l, int wg, int nwg) {
    const int tid = otid(), lane = tid & 63, wv = tid >> 6, fr = lane & 15, fq = lane >> 4;
    const float* MOD = (const float*)(p.ws + WS_MOD);
    bf16_t* H2 = (bf16_t*)(p.ws + WS_H2T);
    int* TI = (int*)(p.ws + WS_TOKI); float2* TG = (float2*)(p.ws + WS_TOKG);
    const int nrows = (l == 1) ? NLAT : LR;
    const int per = (nrows + nwg - 1) / nwg, r_beg = wg * per, r_end = min(nrows, r_beg + per);
    float* hs = sm;
    float* part = sm + 16 * 1028;
    int* lcnt = (int*)(part + 8 * 256);
    if (tid < 16) lcnt[tid] = 0;
    float Bw[32];
#pragma unroll
    for (int kk = 0; kk < 32; ++kk) Bw[kk] = p.router_w[(size_t)(128 * wv + 4 * kk + fq) * 16 + fr];
    for (int blk = r_beg; blk < r_end; blk += 16) {
        __syncthreads();
#pragma unroll
        for (int tt = 0; tt < 2; ++tt) { const int tl = wv * 2 + tt, r = blk + tl;
            if (r < r_end) {
                const bf16_t* xr = (const bf16_t*)(p.ws + WS_X1B) + (size_t)r * DM;
                const float* m = MOD + (l * 9 + mod_row(r)) * 6144;
                f32x4 v[4]; float ss = 0.f;
#pragma unroll
                for (int j = 0; j < 4; ++j) { float t4[4]; unpack4(*(const v2u*)(xr + 4 * lane + 256 * j), t4); v[j] = (f32x4){t4[0], t4[1], t4[2], t4[3]}; ss += (v[j][0] * v[j][0] + v[j][1] * v[j][1]) + (v[j][2] * v[j][2] + v[j][3] * v[j][3]); }
                ss = wave_sum(ss);
                const float rs = rsqrtf(ss * (1.f / DM) + RMS_EPS);
#pragma unroll
                for (int j = 0; j < 4; ++j) { const int d = 4 * lane + 256 * j;
                    const f32x4 g = *(const f32x4*)(p.norm2_g + l * DM + d), sh = *(const f32x4*)(m + 3 * DM + d), scl = *(const f32x4*)(m + 4 * DM + d);
                    const f32x4 h = v[j] * rs * g * (scl + 1.f) + sh;
                    v2u w; w.x = pk2(h[0], h[1]); w.y = pk2(h[2], h[3]);
                    *(v2u*)(H2 + (size_t)r * DM + d) = w;
                    *(f32x4*)(hs + tl * 1028 + d) = h; }
            } else {
#pragma unroll
                for (int j = 0; j < 4; ++j) *(f32x4*)(hs + tl * 1028 + 4 * lane + 256 * j) = (f32x4){0.f, 0.f, 0.f, 0.f};
            }
        }
        __syncthreads();
        { f32x4 acc = {0.f, 0.f, 0.f, 0.f};
#pragma unroll
          for (int kk = 0; kk < 32; ++kk) { const float a = hs[fr * 1028 + 128 * wv + 4 * kk + fq]; acc = __builtin_amdgcn_mfma_f32_16x16x4f32(a, Bw[kk], acc, 0, 0, 0); }
#pragma unroll
          for (int i = 0; i < 4; ++i) part[wv * 256 + (4 * fq + i) * 16 + fr] = acc[i]; }
        __syncthreads();
        if (tid < 16 && blk + tid < r_end) {
            const int r = blk + tid;
            float sc[16], sel[16];
#pragma unroll
            for (int e = 0; e < 16; ++e) { float d = 0.f;
#pragma unroll
                for (int w8 = 0; w8 < 8; ++w8) d += part[w8 * 256 + tid * 16 + e];
                sc[e] = 1.f / (1.f + expf(-d)); sel[e] = sc[e] + p.router_bias[e]; }
            int best = 0; float bestv = -INFINITY;
#pragma unroll
            for (int g = 0; g < 4; ++g) { float m1 = -INFINITY, m2 = -INFINITY;
#pragma unroll
                for (int j = 0; j < 4; ++j) { const float s_ = sel[g * 4 + j]; if (s_ > m1) { m2 = m1; m1 = s_; } else if (s_ > m2) m2 = s_; }
                const float gs = m1 + m2; if (gs > bestv) { bestv = gs; best = g; } }
            int i0 = -1; float v0 = -INFINITY;
#pragma unroll
            for (int e = 0; e < 16; ++e) if ((e >> 2) == best && sel[e] > v0) { v0 = sel[e]; i0 = e; }
            int i1 = -1; float v1 = -INFINITY;
#pragma unroll
            for (int e = 0; e < 16; ++e) if ((e >> 2) == best && e != i0 && sel[e] > v1) { v1 = sel[e]; i1 = e; }
            float s0 = 0.f, s1 = 0.f;
#pragma unroll
            for (int e = 0; e < 16; ++e) { if (e == i0) s0 = sc[e]; if (e == i1) s1 = sc[e]; }
            const float inv = 1.f / (s0 + s1);
            TI[r] = i0 | (i1 << 8); TG[r] = make_float2(s0 * inv, s1 * inv); atomicAdd(&lcnt[i0], 1); atomicAdd(&lcnt[i1], 1);
        }
    }
    __syncthreads();
    if (tid < 16) ((int*)(p.ws + WS_CNTWG))[wg * 16 + tid] = lcnt[tid];
}
__device__ __forceinline__ void ph_lists2(const Params& p, float* sm, int l, int wg, int nwg) {
    const int tid = otid(), lane = tid & 63, wv = tid >> 6;
    const int* CW = (const int*)(p.ws + WS_CNTWG);
    const int* TI = (const int*)(p.ws + WS_TOKI); const float2* TG = (const float2*)(p.ws + WS_TOKG);
    int* RD = (int*)(p.ws + WS_ROWDST); float* RG = (float*)(p.ws + WS_ROWGATE);
    const bf16_t* H2 = (const bf16_t*)(p.ws + WS_H2T); bf16_t* H2S = (bf16_t*)(p.ws + WS_H2S);
    const int nrows = (l == 1) ? NLAT : LR;
    const int per = (nrows + nwg - 1) / nwg, r_beg = wg * per, r_end = min(nrows, r_beg + per);
    int* s_tot = (int*)sm;
    int* s_before = s_tot + 16;
    int* s_off = s_tot + 32;
    int* s_ti = s_tot + 64;
    int* s_pos = s_tot + 64 + 128;
    int* s_cw = s_tot + 512;
    for (int i = tid; i < nwg * 16; i += 512) s_cw[i] = CW[i];
    for (int i = tid; i < r_end - r_beg; i += 512) s_ti[i] = TI[r_beg + i];
    __syncthreads();
    if (tid < 256) {
        const int e = tid & 15, part = tid >> 4; int tot = 0, bef = 0;
        for (int w = part; w < nwg; w += 16) { const int c = s_cw[w * 16 + e]; tot += c; if (w < wg) bef += c; }
        s_cw[4096 + tid] = tot; s_cw[4096 + 256 + tid] = bef;
    }
    __syncthreads();
    if (tid < 16) { int tot = 0, bef = 0; for (int q = 0; q < 16; ++q) { tot += s_cw[4096 + q * 16 + tid]; bef += s_cw[4096 + 256 + q * 16 + tid]; } s_tot[tid] = tot; s_before[tid] = bef; }
    __syncthreads();
    if (tid == 0) { int o = 0; for (int e = 0; e < 16; ++e) { s_off[e] = o; o += (s_tot[e] + 255) & ~255; } s_off[16] = o; }
    __syncthreads();
    if (wg == 0) {
        int* OFFS = (int*)(p.ws + WS_OFFS); int* TEXP = (int*)(p.ws + WS_TEXP);
        if (tid < 17) OFFS[tid] = s_off[tid];
        if (tid == 17) OFFS[17] = s_off[16] >> 8;
        if (tid < 160) { int e = 0; for (int k = 1; k < 16; ++k) if (tid * 256 >= s_off[k]) e = k; TEXP[tid] = e; }
    }
    if (wg < 16) { const int beg = s_off[wg] + s_tot[wg], end = s_off[wg + 1]; for (int i = beg + tid; i < end; i += 512) { RD[i] = -1; RG[i] = 0.f; } }
    const int n = r_end - r_beg;
    if (tid < n) { const int ti = s_ti[tid], e0 = ti & 255, e1 = ti >> 8; int k0 = 0, k1 = 0;
        for (int j = 0; j < tid; ++j) { const int tj = s_ti[j]; k0 += ((tj & 255) == e0) + ((tj >> 8) == e0); k1 += ((tj & 255) == e1) + ((tj >> 8) == e1); }
        const int p0 = s_off[e0] + s_before[e0] + k0, p1 = s_off[e1] + s_before[e1] + k1;
        s_pos[2 * tid] = p0; s_pos[2 * tid + 1] = p1;
        const float2 g = TG[r_beg + tid];
        RD[p0] = (r_beg + tid) * 2; RG[p0] = g.x; RD[p1] = (r_beg + tid) * 2 + 1; RG[p1] = g.y; }
    (void)H2; (void)H2S; (void)lane; (void)wv; (void)s_pos;
}
struct MoeOrder : pg8::StaticOrder {
    const int* texp; unsigned stride;
    __device__ __forceinline__ bool next(int i, pg8::Unit& u) const { if (!pg8::StaticOrder::next(i, u)) return false; u.boff = (unsigned)texp[u.pm] * stride; return true; }
};
constexpr int CW_RDY = 8192;
__device__ __forceinline__ void st16_wt(void* ptr, v4u v) { asm volatile("global_store_dwordx4 %0, %1, off sc1\n\ts_nop 1" :: "v"(ptr), "v"(v) : "memory"); }
struct MoeOrderPub : MoeOrder {
    static constexpr bool GATHER = true;
    unsigned* rdy;
    __device__ __forceinline__ void done(const pg8::Unit& u) const {
        asm volatile("s_waitcnt vmcnt(0)" ::: "memory");
        if ((otid() & 63) == 0) (void)__hip_atomic_fetch_add(rdy + 16 * u.pm, 1u, __ATOMIC_RELAXED, __HIP_MEMORY_SCOPE_AGENT);
    }
};
struct MoeOrderSub : pg8::StaticOrder {
    const int* texp; unsigned stride; const unsigned* rdy; int nx, J, x, j, rr, nl, base; bool classed;
    __device__ __forceinline__ void init2(int M, int N, int G_, int c_) {
        init(M, N, G_, c_);
        classed = (G_ % 8) == 0 && G_ >= 8;
        if (classed) { J = G_ / 8; x = c_ % 8; j = c_ / 8; nx = (nwg - x + 7) / 8; if (nx < 0) nx = 0; rr = nx % J; nl = J - rr; base = min(nx, 2 * nl); }
    }
    __device__ __forceinline__ bool next(int i, pg8::Unit& u) const {
        if (!classed) { if (!pg8::StaticOrder::next(i, u)) return false; u.boff = (unsigned)texp[u.pm] * stride; return true; }
        int s;
        if (j >= rr) { const int rank = j - rr; s = (i == 0) ? rank : (i == 1) ? nl + rank : base + j + (i - 2) * J; if (i < 2 && s >= base) return false; }
        else s = base + j + i * J;
        if (s >= nx) return false;
        unit_of(s * 8 + x, u); u.boff = (unsigned)texp[u.pm] * stride; return true;
    }
    __device__ __forceinline__ void a_ready(const pg8::Unit& u) const {
        if (otid() < 64) {
            unsigned sp = 0u;
            while ((unsigned)__builtin_amdgcn_readfirstlane(__hip_atomic_load(rdy + 16 * u.pm, __ATOMIC_RELAXED, __HIP_MEMORY_SCOPE_AGENT)) < 32u) { __builtin_amdgcn_s_sleep(2); if (++sp > (1u << 22)) break; }
            __builtin_amdgcn_fence(__ATOMIC_ACQUIRE, "agent");
            asm volatile("s_waitcnt vmcnt(0)" ::: "memory");
        }
        asm volatile("" ::: "memory"); __builtin_amdgcn_s_barrier(); asm volatile("" ::: "memory");
    }
};
struct EpiHid {
    static constexpr bool PERM = true, AFTER_DRAIN = false;
    bf16_t* HID;
    __device__ __forceinline__ void operator()(const f32x4 (&acc)[2][2][4][2], const pg8::Unit& u, int wr, int wc, int fr, int fq) const {
        const int row0 = u.pm * 256 + wr * 64 + fr, col = u.pn * 128 + wc * 32 + 8 * fq;
#pragma unroll
        for (int ai = 0; ai < 2; ++ai)
#pragma unroll
            for (int m = 0; m < 4; ++m) {
                const f32x4 a0 = acc[ai][0][m][0], a1 = acc[ai][0][m][1], b0 = acc[ai][1][m][0], b1 = acc[ai][1][m][1];
                float o[8];
#pragma unroll
                for (int e = 0; e < 4; ++e) { o[e] = a0[e] * sigmoidf_(a0[e]) * b0[e]; o[4 + e] = a1[e] * sigmoidf_(a1[e]) * b1[e]; }
                v4u w; w.x = pg8::cvt_pk_bf16(o[0], o[1]); w.y = pg8::cvt_pk_bf16(o[2], o[3]); w.z = pg8::cvt_pk_bf16(o[4], o[5]); w.w = pg8::cvt_pk_bf16(o[6], o[7]);
                st16_wt(HID + (size_t)(row0 + ai * 128 + m * 16) * DE + col, w); }
    }
};
struct EpiYs {
    static constexpr bool PERM = true, AFTER_DRAIN = false;
    bf16_t* YS; const int* RD; const float* RG;
    __device__ __forceinline__ void operator()(const f32x4 (&acc)[2][2][4][2], const pg8::Unit& u, int wr, int wc, int fr, int fq) const {
        const int row0 = u.pm * 256 + wr * 64 + fr, colb = u.pn * 256 + wc * 32 + 8 * fq;
        int dsts[2][4]; float gs[2][4];
#pragma unroll
        for (int ai = 0; ai < 2; ++ai)
#pragma unroll
            for (int m = 0; m < 4; ++m) { const int row = row0 + ai * 128 + m * 16; dsts[ai][m] = RD[row]; gs[ai][m] = RG[row]; }
#pragma unroll
        for (int ai = 0; ai < 2; ++ai)
#pragma unroll
            for (int m = 0; m < 4; ++m) { const int dst = dsts[ai][m]; const float g = gs[ai][m];
                if (dst >= 0) {
#pragma unroll
                    for (int bj = 0; bj < 2; ++bj) { const f32x4 v0 = acc[ai][bj][m][0] * g, v1 = acc[ai][bj][m][1] * g;
                        v4u w; w.x = pg8::cvt_pk_bf16(v0[0], v0[1]); w.y = pg8::cvt_pk_bf16(v0[2], v0[3]); w.z = pg8::cvt_pk_bf16(v1[0], v1[1]); w.w = pg8::cvt_pk_bf16(v1[2], v1[3]);
                        *(v4u*)(YS + (size_t)dst * DM + colb + bj * 128) = w; } } }
    }
};
__device__ __forceinline__ void ph_moe1_mfma(const Params& p, unsigned char* ldsb, int l, int wg, int nwg) {
    const int ntiles = ((const int*)(p.ws + WS_OFFS))[17];
    pg8::Gemm g{(const bf16_t*)(p.ws + WS_H2T), (const bf16_t*)(p.ws + WS_W13T), ntiles * 256, 1024, DM};
    MoeOrderPub S; S.init(ntiles * 256, 1024, nwg, wg); S.texp = (const int*)(p.ws + WS_TEXP); S.stride = 1024u * 1024u * 2u; S.rdy = (unsigned*)(p.ws + WS_CTL) + CW_RDY + l * 4096; S.rowsrc = (const int*)(p.ws + WS_ROWDST);
    EpiHid E{(bf16_t*)(p.ws + WS_HID2)};
    pg8::gemm_phase<EpiHid, MoeOrderPub, true, true>((LAS unsigned char*)ldsb, g, S, E);
}
__device__ __forceinline__ void ph_moe2_mfma(const Params& p, unsigned char* ldsb, int l, int wg, int nwg) {
    const int ntiles = ((const int*)(p.ws + WS_OFFS))[17];
    pg8::Gemm g{(const bf16_t*)(p.ws + WS_HID2), (const bf16_t*)(p.ws + WS_W2T), ntiles * 256, 1024, DE};
    MoeOrderSub S; S.init2(ntiles * 256, 1024, nwg, wg); S.texp = (const int*)(p.ws + WS_TEXP); S.stride = 1024u * 512u * 2u; S.rdy = (const unsigned*)(p.ws + WS_CTL) + CW_RDY + l * 4096;
    EpiYs E{(bf16_t*)(p.ws + WS_YS2), (const int*)(p.ws + WS_ROWDST), (const float*)(p.ws + WS_ROWGATE)};
    pg8::gemm_phase<EpiYs, MoeOrderSub, true, true>((LAS unsigned char*)ldsb, g, S, E);
}
__device__ __forceinline__ void ph_combine2(const Params& p, int l, int wg, int nwg) {
    const float* MOD = (const float*)(p.ws + WS_MOD);
    const bf16_t* YS = (const bf16_t*)(p.ws + WS_YS2);
    const int nrows = (l == 1) ? NLAT : LR;
    for (size_t i = (size_t)wg * 512 + otid(); i < (size_t)nrows * DM; i += (size_t)nwg * 512) {
        const int r = (int)(i >> 10), d = (int)(i & 1023);
        float* xp = st_row(p, r) + d;
        *xp = *xp + MOD[(l * 9 + mod_row(r)) * 6144 + 5 * DM + d] * (bf2f(YS[(size_t)(2 * r) * DM + d]) + bf2f(YS[(size_t)(2 * r + 1) * DM + d]));
    }
}

__device__ __forceinline__ void ph_moe1(const Params& p, float* sm, int l, int wg, int nwg) {
    const int* cnt = (const int*)(p.ws + WS_CTL) + l * 16;
    const int* LT = (const int*)(p.ws + WS_LTOK);
    float* T1 = (float*)(p.ws + WS_TMP1); bf16_t* HID = (bf16_t*)(p.ws + WS_HID);
    int off = 0;
    for (int e = 0; e < NE; ++e) {
        const int M = cnt[e];
        float* t1 = T1 + (size_t)off * DE; bf16_t* hid = HID + (size_t)off * DE;
        gemm_naive<bf16_t>(sm, wg, nwg, M, DE, DM, (const bf16_t*)(p.ws + WS_H2), DM, LT + e * LR, 1, p.moe_w1 + ((size_t)(l * NE + e) * DM) * DE, DE,
                           [=](int r, int c, float v) { t1[(size_t)r * DE + c] = v; });
        gemm_naive<bf16_t>(sm, wg, nwg, M, DE, DM, (const bf16_t*)(p.ws + WS_H2), DM, LT + e * LR, 1, p.moe_w3 + ((size_t)(l * NE + e) * DM) * DE, DE,
                           [=](int r, int c, float v) { const float a = t1[(size_t)r * DE + c]; hid[(size_t)r * DE + c] = f2bf(a * sigmoidf_(a) * v); });
        off += (M + 255) & ~255;
    }
}
__device__ __forceinline__ void ph_moe2(const Params& p, float* sm, int l, int wg, int nwg) {
    const int* cnt = (const int*)(p.ws + WS_CTL) + l * 16;
    const int* LT = (const int*)(p.ws + WS_LTOK); const float* LGt = (const float*)(p.ws + WS_LGATE);
    const bf16_t* HID = (const bf16_t*)(p.ws + WS_HID); bf16_t* YS = (bf16_t*)(p.ws + WS_YS);
    int off = 0;
    for (int e = 0; e < NE; ++e) {
        const int M = cnt[e];
        const int* lt = LT + e * LR; const float* lgt = LGt + e * LR;
        gemm_naive<bf16_t>(sm, wg, nwg, M, DM, DE, HID + (size_t)off * DE, DE, nullptr, 0, p.moe_w2 + ((size_t)(l * NE + e) * DE) * DM, DM,
                           [=](int r, int c, float v) { YS[(size_t)lt[r] * DM + c] = f2bf(lgt[r] * v); });
        off += (M + 255) & ~255;
    }
}
__device__ __forceinline__ void ph_combine(const Params& p, int l, int wg, int nwg) {
    const float* MOD = (const float*)(p.ws + WS_MOD);
    const bf16_t* YS = (const bf16_t*)(p.ws + WS_YS);
    const int nrows = (l == 1) ? NLAT : LR;
    for (size_t i = (size_t)wg * blockDim.x + otid(); i < (size_t)nrows * DM; i += (size_t)nwg * blockDim.x) {
        const int r = (int)(i >> 10), d = (int)(i & 1023);
        float* xp = st_row(p, r) + d;
        *xp = *xp + MOD[(l * 9 + mod_row(r)) * 6144 + 5 * DM + d] * (bf2f(YS[(size_t)(2 * r) * DM + d]) + bf2f(YS[(size_t)(2 * r + 1) * DM + d]));
    }
}

#define GAS __attribute__((address_space(1)))
#define XB_TMO      128
#define XB_XCNT(j)  (256  + 64 * (j))
#define XB_XSUB(j)  (1280 + 64 * (j))
#define XB_XGEN(j)  (2304 + 64 * (j))
#define XB_TOP      3328
#define XB_TOPGEN   3392
#define XCD_BAR_WORDS 3456
#define XB_SPIN_CAP (1u << 24)
__device__ __forceinline__ unsigned xb_ld(unsigned* p)              { return __hip_atomic_load(p, __ATOMIC_RELAXED, __HIP_MEMORY_SCOPE_AGENT); }
__device__ __forceinline__ unsigned xb_add(unsigned* p, unsigned v) { return __hip_atomic_fetch_add(p, v, __ATOMIC_RELAXED, __HIP_MEMORY_SCOPE_AGENT); }
__device__ __forceinline__ unsigned xb_xcc_id() { return (unsigned)__builtin_amdgcn_s_getreg((3 << 11) | 20) & 0xFu; }
#define XB_SPIN(cond, bar) do { unsigned _sp = 0; while (cond) { __builtin_amdgcn_s_sleep(1); \
    if ((++_sp & 255u) == 0u) { if (xb_ld(&(bar)[XB_TMO])) break; if (_sp > XB_SPIN_CAP) { atomicAdd(&(bar)[XB_TMO], 1u); break; } } } } while (0)
struct XcdBarrier { unsigned* bar; unsigned x; volatile LAS unsigned* st; };
__device__ __forceinline__ XcdBarrier xcd_barrier_post(unsigned* bar, volatile LAS unsigned* st) {
    XcdBarrier b; b.bar = bar; b.x = xb_xcc_id(); b.st = st;
    if (threadIdx.x == 0) (void)xb_add(&bar[XB_XCNT(b.x)], 1u);
    return b;
}
__device__ __forceinline__ void xcd_barrier_complete(unsigned* bar, unsigned x, unsigned& nloc, unsigned& nx) {
    const unsigned G = gridDim.x * gridDim.y * gridDim.z;
    unsigned sum, cnt, mine, sp = 0u;
    for (;;) {
        sum = 0u; cnt = 0u; mine = 0u;
#pragma unroll
        for (unsigned j = 0; j < 16; ++j) { const unsigned c = xb_ld(&bar[XB_XCNT(j)]); sum += c; cnt += (c > 0u) ? 1u : 0u; mine = (j == x) ? c : mine; }
        if (sum == G) break;
        __builtin_amdgcn_s_sleep(1);
        if ((++sp & 255u) == 0u) { if (xb_ld(&bar[XB_TMO])) break; if (sp > XB_SPIN_CAP) { atomicAdd(&bar[XB_TMO], 1u); break; } }
    }
    nloc = mine > 0u ? mine : 1u; nx = cnt > 0u ? cnt : 1u;
}
__device__ __forceinline__ void xcd_barrier(const XcdBarrier& b) {
    asm volatile("s_waitcnt vmcnt(0)" ::: "memory");
    __syncthreads();
    if (threadIdx.x == 0) {
        unsigned* bar = b.bar;
        __builtin_amdgcn_s_waitcnt(0);
        unsigned nloc = b.st[0], nx = b.st[1];
        if (nloc == 0u) { xcd_barrier_complete(bar, b.x, nloc, nx); b.st[0] = nloc; b.st[1] = nx; }
        const unsigned old = xb_add(&bar[XB_XSUB(b.x)], 1u);
        const unsigned gen = old / nloc;
        if (old + 1u == (gen + 1u) * nloc) {
            __builtin_amdgcn_fence(__ATOMIC_RELEASE, "agent");
            asm volatile("s_waitcnt vmcnt(0)" ::: "memory");
            const unsigned og = xb_add(&bar[XB_TOP], 1u);
            const unsigned tg = og / nx;
            if (og + 1u == (tg + 1u) * nx) xb_add(&bar[XB_TOPGEN], 1u);
            else XB_SPIN(xb_ld(&bar[XB_TOPGEN]) == tg, bar);
            __builtin_amdgcn_fence(__ATOMIC_ACQUIRE, "agent");
            xb_add(&bar[XB_XGEN(b.x)], 1u);
            asm volatile("s_waitcnt vmcnt(0)" ::: "memory");
        } else {
            XB_SPIN(xb_ld(&bar[XB_XGEN(b.x)]) == gen, bar);
            __builtin_amdgcn_fence(__ATOMIC_ACQUIRE, "agent");
            asm volatile("s_waitcnt vmcnt(0)" ::: "memory");
        }
    }
    __syncthreads();
}

__device__ __forceinline__ void xcd_barrier_lean(const XcdBarrier& b) {
    asm volatile("s_waitcnt vmcnt(0)" ::: "memory");
    __syncthreads();
    if (threadIdx.x == 0) {
        unsigned* bar = b.bar;
        __builtin_amdgcn_s_waitcnt(0);
        unsigned nloc = b.st[0], nx = b.st[1];
        const unsigned old = xb_add(&bar[XB_XSUB(b.x)], 1u);
        const unsigned gen = old / nloc;
        if (old + 1u == (gen + 1u) * nloc) {
            __builtin_amdgcn_fence(__ATOMIC_RELEASE, "agent");
            asm volatile("s_waitcnt vmcnt(0)" ::: "memory");
            const unsigned og = xb_add(&bar[XB_TOP], 1u);
            const unsigned tg = og / nx;
            if (og + 1u == (tg + 1u) * nx) xb_add(&bar[XB_TOPGEN], 1u);
            else XB_SPIN(xb_ld(&bar[XB_TOPGEN]) == tg, bar);
            __builtin_amdgcn_fence(__ATOMIC_ACQUIRE, "agent");
            xb_add(&bar[XB_XGEN(b.x)], 1u);
            asm volatile("s_waitcnt vmcnt(0)" ::: "memory");
        } else {
            XB_SPIN(xb_ld(&bar[XB_XGEN(b.x)]) == gen, bar);
            __builtin_amdgcn_fence(__ATOMIC_ACQUIRE, "agent");
            asm volatile("s_waitcnt vmcnt(0)" ::: "memory");
        }
    }
    __syncthreads();
}

constexpr int LDS_BYTES = 147456;
constexpr int MISC_OFF = 147456 - 128;
constexpr int CW_BAR = 4096;

__device__ __forceinline__ int owg(int w) { asm volatile("" : "+s"(w)); return w; }
__device__ __forceinline__ Params load_params() {
    Params r{};
#if defined(__HIP_DEVICE_COMPILE__)
    typedef const __attribute__((address_space(4))) unsigned long long* kq_t;
    kq_t k = (kq_t)__builtin_amdgcn_kernarg_segment_ptr(); asm volatile("" : "+s"(k));
    r.x = (const float*)(const __attribute__((address_space(1))) float*)k[0];
    r.c = (const float*)(const __attribute__((address_space(1))) float*)k[1];
    r.ctx = (const float*)(const __attribute__((address_space(1))) float*)k[2];
    r.c_ctx = (const float*)(const __attribute__((address_space(1))) float*)k[3];
    r.mod_w = (const float*)(const __attribute__((address_space(1))) float*)k[4];
    r.mod_b = (const float*)(const __attribute__((address_space(1))) float*)k[5];
    r.norm1_g = (const float*)(const __attribute__((address_space(1))) float*)k[6];
    r.norm2_g = (const float*)(const __attribute__((address_space(1))) float*)k[7];
    r.w_in = (const float*)(const __attribute__((address_space(1))) float*)k[8];
    r.rw_w0 = (const float*)(const __attribute__((address_space(1))) float*)k[9];
    r.rw_w_lora_b = (const float*)(const __attribute__((address_space(1))) float*)k[10];
    r.rw_a0 = (const float*)(const __attribute__((address_space(1))) float*)k[11];
    r.rw_a_lora_b = (const float*)(const __attribute__((address_space(1))) float*)k[12];
    r.rw_g_lora_b = (const float*)(const __attribute__((address_space(1))) float*)k[13];
    r.rw_k_k = (const float*)(const __attribute__((address_space(1))) float*)k[14];
    r.rw_k_a = (const float*)(const __attribute__((address_space(1))) float*)k[15];
    r.rw_r_k = (const float*)(const __attribute__((address_space(1))) float*)k[16];
    r.rw_ln_g = (const float*)(const __attribute__((address_space(1))) float*)k[17];
    r.rw_ln_b = (const float*)(const __attribute__((address_space(1))) float*)k[18];
    r.na_q_g = (const float*)(const __attribute__((address_space(1))) float*)k[19];
    r.na_k_g = (const float*)(const __attribute__((address_space(1))) float*)k[20];
    r.na_rpb = (const float*)(const __attribute__((address_space(1))) float*)k[21];
    r.proj_a = (const float*)(const __attribute__((address_space(1))) float*)k[22];
    r.proj_b = (const float*)(const __attribute__((address_space(1))) float*)k[23];
    r.w_out = (const float*)(const __attribute__((address_space(1))) float*)k[24];
    r.router_w = (const float*)(const __attribute__((address_space(1))) float*)k[25];
    r.router_bias = (const float*)(const __attribute__((address_space(1))) float*)k[26];
    r.moe_w1 = (const float*)(const __attribute__((address_space(1))) float*)k[27];
    r.moe_w3 = (const float*)(const __attribute__((address_space(1))) float*)k[28];
    r.moe_w2 = (const float*)(const __attribute__((address_space(1))) float*)k[29];
    r.out = (float*)(__attribute__((address_space(1))) float*)k[30]; r.ws = (unsigned char*)(__attribute__((address_space(1))) unsigned char*)k[31];
#endif
    return r;
}
#define PRM(name) const Params name = load_params()
__global__ void __launch_bounds__(512, 2) mega(Params p_unused) {
    extern __shared__ __attribute__((aligned(16))) unsigned char lds[];
    float* sm = (float*)lds;
    volatile LAS unsigned* MISC = (volatile LAS unsigned*)((LAS unsigned char*)lds + MISC_OFF);
    if (threadIdx.x < 32) MISC[threadIdx.x] = 0u;
    __syncthreads();
    { PRM(p); (void)xcd_barrier_post((unsigned*)(p.ws + WS_CTL) + CW_BAR, MISC + 8); }
    const int wg0 = blockIdx.x, nwg = gridDim.x;
#define wg owg(wg0)
#define MKBAR(b_) PRM(pb_); XcdBarrier b_; b_.bar = (unsigned*)(pb_.ws + WS_CTL) + CW_BAR; b_.x = xb_xcc_id(); b_.st = MISC + 8
#define GRID_BAR_FIRST() do { MKBAR(b_); xcd_barrier(b_); } while (0)
#define GRID_BAR() do { MKBAR(b_); xcd_barrier_lean(b_); } while (0)
    { PRM(p); ph_mod2(p, sm, wg, nwg); }
    __syncthreads();
    { PRM(p); ph_convert_dense(p, lds, 0, wg, nwg); } GRID_BAR_FIRST();
    { PRM(p); ph_norm1v(p, wg, nwg); } GRID_BAR();
#define LAYER_BODY(l) do { \
        { PRM(p); ph_win_mfma(p, lds, l, wg, nwg); } GRID_BAR(); \
        { PRM(p); ph_scan_natt(p, lds, l, wg, nwg); } GRID_BAR(); \
        { PRM(p); ph_rwkvout2(p, lds, l, wg, nwg); } GRID_BAR(); \
        { PRM(p); ph_merge_mfma(p, lds, l, wg, nwg); } GRID_BAR(); \
        { PRM(p); ph_wout_mfma(p, lds, l, wg, nwg); } GRID_BAR(); \
        { PRM(p); ph_route2(p, sm, l, wg, nwg); } \
        if (l == 0) { __syncthreads(); PRM(p); ph_convert_dense(p, lds, 1, wg, nwg); } \
        GRID_BAR(); \
        { PRM(p); ph_lists2(p, sm, l, wg, nwg); } GRID_BAR(); \
        { PRM(p); ph_moe1_mfma(p, lds, l, wg, nwg); } \
        { PRM(p); ph_moe2_mfma(p, lds, l, wg, nwg); } GRID_BAR(); \
        { PRM(p); ph_combine_norm(p, l, wg, nwg); } if (l == 0) GRID_BAR(); \
    } while (0)
    LAYER_BODY(0);
    LAYER_BODY(1);
}
#undef wg
__global__ void k_zero(float* o, int n) { int i = blockIdx.x * blockDim.x + threadIdx.x; if (i < n) o[i] = 0.f; }

extern "C" void kernel_launch(void* const* d_in, const int* in_sizes, int n_in, void* d_out, int out_size, void* d_ws, size_t ws_size, hipStream_t stream) {
    static int grid = 0;
    if (grid == 0) {
        int dev = 0, cus = 0, per_cu = 0;
        if (hipGetDevice(&dev) != hipSuccess || hipDeviceGetAttribute(&cus, hipDeviceAttributeMultiprocessorCount, dev) != hipSuccess) { grid = -1; }
        else if (hipFuncSetAttribute((const void*)mega, hipFuncAttributeMaxDynamicSharedMemorySize, LDS_BYTES) != hipSuccess) { grid = -1; }
        else {
            if (hipOccupancyMaxActiveBlocksPerMultiprocessor(&per_cu, (const void*)mega, 512, LDS_BYTES) != hipSuccess || per_cu < 1) { fprintf(stderr, "occupancy query says %d\n", per_cu); }
            (void)hipGetLastError();
            grid = cus;
        }
    }
    if (grid <= 0 || n_in != 30 || ws_size < WS_END || out_size != NLAT * DM) {
        fprintf(stderr, "kernel_launch: unexpected grid %d n_in %d / ws_size %zu / out_size %d\n", grid, n_in, ws_size, out_size);
        hipLaunchKernelGGL(k_zero, dim3((out_size + 255) / 256), dim3(256), 0, stream, (float*)d_out, out_size);
        return;
    }
    Params p{};
    const float** pp = (const float**)&p;
    for (int i = 0; i < 30; ++i) pp[i] = (const float*)d_in[i];
    p.out = (float*)d_out; p.ws = (unsigned char*)d_ws;
    (void)hipMemsetAsync((char*)d_ws + WS_CTL, 0, 65536, stream);
    hipLaunchKernelGGL(mega, dim3(grid), dim3(512), LDS_BYTES, stream, p);
}
```

```cpp
#include <hip/hip_runtime.h>
#include <stdint.h>
#include <cstdio>

typedef unsigned short bf16_t;
__device__ __forceinline__ float bf2f(bf16_t v) { return __uint_as_float(((unsigned)v) << 16); }
__device__ __forceinline__ bf16_t f2bf(float f) { unsigned u = __float_as_uint(f); return (bf16_t)((u + 0x7fffu + ((u >> 16) & 1u)) >> 16); }

typedef unsigned v4u __attribute__((ext_vector_type(4)));
typedef unsigned v2u __attribute__((ext_vector_type(2)));
typedef float f32x4 __attribute__((ext_vector_type(4)));
__device__ __forceinline__ unsigned pk2(float lo, float hi) { return (unsigned)f2bf(lo) | ((unsigned)f2bf(hi) << 16); }
__device__ __forceinline__ void unpack8(const v4u w, float (&f)[8]) {
#pragma unroll
    for (int i = 0; i < 4; ++i) { f[2 * i] = __uint_as_float(w[i] << 16); f[2 * i + 1] = __uint_as_float(w[i] & 0xffff0000u); }
}
__device__ __forceinline__ void unpack4(const v2u w, float (&f)[4]) { f[0] = __uint_as_float(w.x << 16); f[1] = __uint_as_float(w.x & 0xffff0000u); f[2] = __uint_as_float(w.y << 16); f[3] = __uint_as_float(w.y & 0xffff0000u); }
constexpr int DM = 1024, NB = 8, SEQ = 2048, CTXL = 256, GW = 64;
constexpr int NLAT = NB * SEQ, NCTX = NB * CTXL, LR = NLAT + NCTX;
constexpr int ZC = 5504;
constexpr int C_R = 0, C_K = 512, C_V = 1024, C_LW = 1536, C_LA = 1664, C_LG = 1792, C_Q = 1920, C_KB = 2432, C_VB = 2944, C_GA = 3456, C_GB = 4480;
constexpr int NE = 16, DE = 512;
constexpr float RMS_EPS = 1e-6f, GN_EPS = 64e-5f;

constexpr size_t MiB = 1u << 20;
constexpr size_t WS_MOD = 0;
constexpr size_t WS_CTL = 1 * MiB;
constexpr size_t WS_LTOK = 2 * MiB;
constexpr size_t WS_LGATE = 4 * MiB;
constexpr size_t WS_TOKI = 6 * MiB;
constexpr size_t WS_TOKG = 6 * MiB + 512 * 1024;
constexpr size_t WS_CNTWG = 2 * MiB;
constexpr size_t WS_OFFS = 2 * MiB + 64 * 1024;
constexpr size_t WS_TEXP = 2 * MiB + 68 * 1024;
constexpr size_t WS_ROWDST = 3 * MiB;
constexpr size_t WS_ROWGATE = 3 * MiB + 512 * 1024;
constexpr size_t WS_CTXS = 8 * MiB;
constexpr size_t WS_W = 16 * MiB;
constexpr size_t WS_WIN_T = WS_W;
constexpr size_t WS_PA_T = WS_W + 11 * MiB;
constexpr size_t WS_PB_T = WS_W + 12 * MiB;
constexpr size_t WS_WO_T = WS_W + 13 * MiB;
constexpr size_t WS_GL_T = WS_W + 15 * MiB;
constexpr size_t WS_LW_T = WS_W + 15 * MiB + 256 * 1024;
constexpr size_t WS_LA_T = WS_W + 15 * MiB + 384 * 1024;
constexpr size_t WS_Z = 32 * MiB;
constexpr size_t WS_X1B = WS_Z;
constexpr size_t WS_H2 = WS_Z;
constexpr size_t WS_TMP1 = WS_Z + 36 * MiB;
constexpr size_t WS_HID = WS_Z + 116 * MiB;
constexpr size_t WS_H2S = WS_Z;
constexpr size_t WS_HID2 = WS_Z + 80 * MiB;
constexpr size_t WS_YS2 = WS_Z + 120 * MiB;
constexpr size_t WS_B = 226 * MiB;
constexpr size_t WS_W13T = WS_B;
constexpr size_t WS_W2T = WS_B + 32 * MiB;
constexpr size_t WS_H2T = WS_B + 84 * MiB;
constexpr size_t WS_VT = WS_B + 54 * MiB;
constexpr size_t WS_SG = WS_B + 72 * MiB;
constexpr size_t WS_Y2 = WS_B + 90 * MiB;
constexpr size_t WS_H = WS_B;
constexpr size_t WS_SW = WS_B;
constexpr size_t WS_SB = WS_B + 36 * MiB;
constexpr size_t WS_SKD = WS_B + 54 * MiB;
constexpr size_t WS_SKK = WS_B + 72 * MiB;
constexpr size_t WS_Y = WS_B + 90 * MiB;
constexpr size_t WS_YB = WS_B + 126 * MiB;
constexpr size_t WS_OUTA = WS_B + 54 * MiB;
constexpr size_t WS_MERGED = WS_B + 90 * MiB;
constexpr size_t WS_YS = WS_B + 54 * MiB;
constexpr size_t WS_END = WS_B + 144 * MiB;

struct Params {
    const float *x, *c, *ctx, *c_ctx, *mod_w, *mod_b, *norm1_g, *norm2_g, *w_in,
        *rw_w0, *rw_w_lora_b, *rw_a0, *rw_a_lora_b, *rw_g_lora_b, *rw_k_k, *rw_k_a, *rw_r_k, *rw_ln_g, *rw_ln_b,
        *na_q_g, *na_k_g, *na_rpb, *proj_a, *proj_b, *w_out, *router_w, *router_bias, *moe_w1, *moe_w3, *moe_w2;
    float* out; unsigned char* ws;
};

__device__ __forceinline__ int otid() { int t = threadIdx.x; asm volatile("" : "+v"(t)); return t; }
template <int M> __device__ __forceinline__ float swz_xor(float v) { return __int_as_float(__builtin_amdgcn_ds_swizzle(__float_as_int(v), (M << 10) | 0x1f)); }
__device__ __forceinline__ float xor32_add(float v) { auto rr = __builtin_amdgcn_permlane32_swap(__float_as_uint(v), __float_as_uint(v), false, false); return __uint_as_float(rr[0]) + __uint_as_float(rr[1]); }
__device__ __forceinline__ float xor32_max(float v) { auto rr = __builtin_amdgcn_permlane32_swap(__float_as_uint(v), __float_as_uint(v), false, false); return fmaxf(__uint_as_float(rr[0]), __uint_as_float(rr[1])); }
__device__ __forceinline__ float wave_sum(float v) {
    v += swz_xor<1>(v); v += swz_xor<2>(v); v += swz_xor<4>(v); v += swz_xor<8>(v); v += swz_xor<16>(v);
    return xor32_add(v);
}
__device__ __forceinline__ float wave_max(float v) {
    v = fmaxf(v, swz_xor<1>(v)); v = fmaxf(v, swz_xor<2>(v)); v = fmaxf(v, swz_xor<4>(v)); v = fmaxf(v, swz_xor<8>(v)); v = fmaxf(v, swz_xor<16>(v));
    return xor32_max(v);
}
__device__ __forceinline__ float rdlane(float v, int l) { return __int_as_float(__builtin_amdgcn_readlane(__float_as_int(v), l)); }
__device__ __forceinline__ float sigmoidf_(float x) { return __builtin_amdgcn_rcpf(1.f + __expf(-x)); }
__device__ __forceinline__ int mod_row(int r) { return r < NLAT ? (r >> 11) : 8; }
__device__ __forceinline__ const float* in_row(const Params& p, int r) { return r < NLAT ? p.x + (size_t)r * DM : p.ctx + (size_t)(r - NLAT) * DM; }
__device__ __forceinline__ float* st_row(const Params& p, int r) { return r < NLAT ? p.out + (size_t)r * DM : (float*)(p.ws + WS_CTXS) + (size_t)(r - NLAT) * DM; }

__device__ __forceinline__ void ph_mod(const Params& p, float* sm, int wg, int nwg) {
    for (int i = otid(); i < 9 * DM; i += blockDim.x) {
        int j = i >> 10, k = i & 1023; float v = j < 8 ? p.c[j * DM + k] : p.c_ctx[k];
        sm[i] = v * sigmoidf_(v);
    }
    __syncthreads();
    float* MOD = (float*)(p.ws + WS_MOD);
    for (int o = wg * blockDim.x + otid(); o < 2 * 6144; o += nwg * blockDim.x) {
        int l = o / 6144, n = o % 6144;
        float acc[9];
#pragma unroll
        for (int j = 0; j < 9; ++j) acc[j] = 0.f;
        const float* w = p.mod_w + (size_t)l * DM * 6144 + n;
        for (int k = 0; k < DM; ++k) { float wv = w[(size_t)k * 6144];
#pragma unroll
            for (int j = 0; j < 9; ++j) acc[j] += sm[j * DM + k] * wv; }
        float bb = p.mod_b[l * 6144 + n];
#pragma unroll
        for (int j = 0; j < 9; ++j) MOD[(l * 9 + j) * 6144 + n] = acc[j] + bb;
    }
}

__device__ __forceinline__ void ph_mod2(const Params& p, float* sm, int wg, int nwg) {
    const int tid = otid(), lane = tid & 63, wv = tid >> 6;
    float* sc = sm;
    float* red = sm + 9 * 1024;
    for (int i = tid; i < 9 * DM; i += 512) { const int j = i >> 10, k = i & 1023; const float v = j < 8 ? p.c[j * DM + k] : p.c_ctx[k]; sc[i] = v * sigmoidf_(v); }
    __syncthreads();
    float* MOD = (float*)(p.ws + WS_MOD);
    for (int unit = wg; unit < 192; unit += nwg) {
        const int l = unit / 96, n0 = (unit % 96) * 64;
        const float* w = p.mod_w + ((size_t)l * DM + wv * 128) * 6144 + n0 + lane;
        float acc[9];
#pragma unroll
        for (int j = 0; j < 9; ++j) acc[j] = 0.f;
        for (int k0 = 0; k0 < 128; k0 += 16) {
            float wv_[16];
#pragma unroll
            for (int i = 0; i < 16; ++i) wv_[i] = w[(size_t)(k0 + i) * 6144];
#pragma unroll
            for (int i4 = 0; i4 < 4; ++i4)
#pragma unroll
                for (int j = 0; j < 9; ++j) { const float4 s4 = *(const float4*)(sc + j * DM + wv * 128 + k0 + i4 * 4);
                    acc[j] += s4.x * wv_[i4 * 4] + s4.y * wv_[i4 * 4 + 1] + s4.z * wv_[i4 * 4 + 2] + s4.w * wv_[i4 * 4 + 3]; }
        }
        __syncthreads();
#pragma unroll
        for (int j = 0; j < 9; ++j) red[(wv * 9 + j) * 64 + lane] = acc[j];
        __syncthreads();
        for (int o = tid; o < 9 * 64; o += 512) { const int j = o >> 6, cc = o & 63; float sum = p.mod_b[l * 6144 + n0 + cc];
#pragma unroll
            for (int w8 = 0; w8 < 8; ++w8) sum += red[(w8 * 9 + j) * 64 + cc];
            MOD[(l * 9 + j) * 6144 + n0 + cc] = sum; }
    }
}
__device__ __forceinline__ void norm_row_to_h(const f32x4 (&v)[4], const float* g1, const float* m, bf16_t* hrow, int lane) {
    float ss = 0.f;
#pragma unroll
    for (int j = 0; j < 4; ++j) ss += (v[j][0] * v[j][0] + v[j][1] * v[j][1]) + (v[j][2] * v[j][2] + v[j][3] * v[j][3]);
    ss = wave_sum(ss);
    const float rs = rsqrtf(ss * (1.f / DM) + RMS_EPS);
#pragma unroll
    for (int j = 0; j < 4; ++j) { const int d = 4 * lane + 256 * j;
        const f32x4 g = *(const f32x4*)(g1 + d), sh = *(const f32x4*)(m + d), scl = *(const f32x4*)(m + DM + d);
        const f32x4 y = v[j] * rs * g * (scl + 1.f) + sh;
        v2u w; w.x = pk2(y[0], y[1]); w.y = pk2(y[2], y[3]);
        *(v2u*)(hrow + d) = w; }
}
__device__ __forceinline__ void ph_norm1v(const Params& p, int wg, int nwg) {
    const int lane = otid() & 63, wv = otid() >> 6;
    const float* MOD = (const float*)(p.ws + WS_MOD);
    bf16_t* H = (bf16_t*)(p.ws + WS_H);
    for (int r = wg * 8 + wv; r < LR; r += nwg * 8) {
        const float* xr = in_row(p, r);
        f32x4 v[4];
#pragma unroll
        for (int j = 0; j < 4; ++j) v[j] = *(const f32x4*)(xr + 4 * lane + 256 * j);
        norm_row_to_h(v, p.norm1_g, MOD + (0 * 9 + mod_row(r)) * 6144, H + (size_t)r * DM, lane);
    }
}
__device__ __forceinline__ void ph_combine_norm(const Params& p, int l, int wg, int nwg) {
    const int lane = otid() & 63, wv = otid() >> 6;
    const float* MOD = (const float*)(p.ws + WS_MOD);
    const bf16_t* YS = (const bf16_t*)(p.ws + WS_YS2);
    bf16_t* H = (bf16_t*)(p.ws + WS_H);
    const int nrows = (l == 1) ? NLAT : LR;
    for (int r = wg * 8 + wv; r < nrows; r += nwg * 8) {
        float* xr = st_row(p, r);
        bf16_t* xb = (r < NLAT) ? (bf16_t*)p.out + (size_t)r * DM : (bf16_t*)(p.ws + WS_CTXS) + (size_t)(r - NLAT) * DM;
        const float* m = MOD + (l * 9 + mod_row(r)) * 6144;
        f32x4 v[4];
#pragma unroll
        for (int j = 0; j < 4; ++j) { const int d = 4 * lane + 256 * j;
            float a[4], b[4]; unpack4(*(const v2u*)(YS + (size_t)(2 * r) * DM + d), a); unpack4(*(const v2u*)(YS + (size_t)(2 * r + 1) * DM + d), b);
            const f32x4 gt = *(const f32x4*)(m + 5 * DM + d);
            float x4[4]; unpack4(*(const v2u*)((const bf16_t*)(p.ws + WS_X1B) + (size_t)r * DM + d), x4);
            f32x4 x = {x4[0], x4[1], x4[2], x4[3]};
            x[0] += gt[0] * (a[0] + b[0]); x[1] += gt[1] * (a[1] + b[1]); x[2] += gt[2] * (a[2] + b[2]); x[3] += gt[3] * (a[3] + b[3]);
            if (l == 0) { v2u w; w.x = pk2(x[0], x[1]); w.y = pk2(x[2], x[3]); *(v2u*)(xb + d) = w; } else *(f32x4*)(xr + d) = x;
            v[j] = x; }
        if (l == 0) norm_row_to_h(v, p.norm1_g + DM, MOD + (1 * 9 + mod_row(r)) * 6144, H + (size_t)r * DM, lane);
    }
}

__device__ __forceinline__ void ph_norm1(const Params& p, int l, int wg, int nwg) {
    const int lane = otid() & 63, wv = otid() >> 6, nwv = blockDim.x >> 6;
    const float* MOD = (const float*)(p.ws + WS_MOD);
    bf16_t* H = (bf16_t*)(p.ws + WS_H);
    for (int r = wg * nwv + wv; r < LR; r += nwg * nwv) {
        const float* xr = l == 0 ? in_row(p, r) : st_row(p, r);
        float v[16]; float ss = 0.f;
#pragma unroll
        for (int i = 0; i < 16; ++i) { v[i] = xr[lane + 64 * i]; ss += v[i] * v[i]; }
        ss = wave_sum(ss);
        const float rs = rsqrtf(ss * (1.f / DM) + RMS_EPS);
        const float* m = MOD + (l * 9 + mod_row(r)) * 6144;
#pragma unroll
        for (int i = 0; i < 16; ++i) { int d = lane + 64 * i;
            float y = v[i] * rs * p.norm1_g[l * DM + d];
            H[(size_t)r * DM + d] = f2bf(y * (1.f + m[DM + d]) + m[d]); }
    }
}

namespace pg8 {
#define PG8_LAS __attribute__((address_space(3)))
typedef unsigned short bf16_t;
typedef short bf16x8 __attribute__((ext_vector_type(8)));
typedef float f32x4 __attribute__((ext_vector_type(4)));
typedef unsigned u32x4 __attribute__((ext_vector_type(4)));
constexpr int BM = 256, BK = 64, HALF = 128, HTB = HALF * BK * 2  , STAGE_BYTES = 8 * HTB, NXCD = 8, WGM = 8;

__host__ __device__ __forceinline__ int lds_byte(int r, int c) { const int st = (r >> 4) * 2 + (c >> 5), rr = r & 15, cc = c & 31, ob = rr * 64 + cc * 2; return st * 1024 + (ob ^ (((ob >> 9) & 1) << 5)); }
__host__ __device__ __forceinline__ void stage_rc(int b, int& R, int& C) { const int st = b / 1024, sb = b % 1024, swz = sb ^ (((sb >> 9) & 1) << 5); R = (st >> 1) * 16 + swz / 64; C = (st & 1) * 32 + (swz % 64) / 2; }
__host__ __device__ __forceinline__ int perm32(int rho) { const int n = rho >> 4, i = rho & 15; return 8 * (i >> 2) + 4 * n + (i & 3); }

struct Unit { int pm, pn; unsigned boff; };
struct Gemm { const bf16_t* A; const bf16_t* Bt; int M, N, K; };

struct StaticOrder {
    int nM, nN, nwg, G, c;
    __host__ __device__ void init(int M, int N, int G_, int c_) { nM = M / BM; nN = N / BM; nwg = nM * nN; G = G_; c = c_; }
    __host__ __device__ void unit_of(int L, Unit& u) const {
        int wgid = L; { const int q = nwg / NXCD, r = nwg % NXCD, xcd = wgid % NXCD, off = wgid / NXCD; wgid = (xcd < r ? xcd * (q + 1) : r * (q + 1) + (xcd - r) * q) + off; }
        const int nig = WGM * nN, gid = wgid / nig, fm = gid * WGM, gsz = (nM - fm) < WGM ? (nM - fm) : WGM;
        u.pm = fm + ((wgid % nig) % gsz); u.pn = (wgid % nig) / gsz; u.boff = 0u;
    }
    __host__ __device__ bool next(int i, Unit& u) const {
        const long L = (long)i * G + c; if (L >= nwg) return false;
        unit_of((int)L, u); return true;
    }
    __device__ __forceinline__ void a_ready(const Unit&) const {}
    __device__ __forceinline__ void done(const Unit&) const {}
    static constexpr bool GATHER = false;
    const int* rowsrc = nullptr;
    static constexpr bool DUALK = false;
    long dA = 0, dB = 0;
};

typedef float cvt_f32x2_t __attribute__((ext_vector_type(2))); typedef __bf16 cvt_bf16x2_t __attribute__((ext_vector_type(2)));
__device__ __forceinline__ unsigned cvt_pk_bf16(float lo, float hi) { const cvt_f32x2_t v = {lo, hi}; const cvt_bf16x2_t b = __builtin_convertvector(v, cvt_bf16x2_t); return __builtin_bit_cast(unsigned, b); }
template <class Epi, class Sched, bool ALIGN_EPI = false, bool SP2 = false>
__device__ __forceinline__ void gemm_phase(PG8_LAS unsigned char* lds, const Gemm g, const Sched& S, const Epi& E) {
    const int tid = otid(), wid = __builtin_amdgcn_readfirstlane(tid >> 6), lane = tid & 63, wr = wid >> 2, wc = wid & 3, fr = lane & 15, fq = lane >> 4;
    constexpr bool DUALK = Sched::DUALK;
    const int K = g.K, nt = DUALK ? 2 * (K / BK) : K / BK;
    constexpr bool GATH = Sched::GATHER;
    static_assert(!GATH || SP2, "gather needs the SP2 loop");
    unsigned voffA[2], voffB[2];
#pragma unroll
    for (int i = 0; i < 2; ++i) { int R, C; stage_rc(tid * 16 + i * 8192, R, C); const int Rb = Epi::PERM ? ((R & ~31) + perm32(R & 31)) : R;
        voffA[i] = (unsigned)(R * K + C) * 2u; voffB[i] = (unsigned)(Rb * K + C) * 2u; }
    const size_t kstep = (size_t)(BK * 2);
    const size_t hstep = (size_t)HALF * K * 2;
    const size_t tstep = 2 * hstep;
    const unsigned ldsw = (unsigned)wid * 1024u;
    const int aoff = lds_byte(wr * 64 + fr, fq * 8), boff = lds_byte(wc * 32 + fr, fq * 8);
#define PG8_SA(b, h) (((b) * 2 + (h)) * HTB)
#define PG8_SB(b, h) ((4 + (b) * 2 + (h)) * HTB)
#define PG8_STAGE(bufoff, gbase, voff) do { _Pragma("unroll") for (int _i = 0; _i < 2; ++_i) \
        __builtin_amdgcn_global_load_lds((const unsigned*)((const char*)(gbase) + (voff)[_i]), (PG8_LAS unsigned*)(lds + (bufoff) + ldsw + _i * 8192), 16, 0, 0); } while (0)
#define PG8_STAGEG(bufoff, off2, kb) do { _Pragma("unroll") for (int _i = 0; _i < 2; ++_i) \
        __builtin_amdgcn_global_load_lds((const unsigned*)((const char*)g.A + (kb) + (off2)[_i]), (PG8_LAS unsigned*)(lds + (bufoff) + ldsw + _i * 8192), 16, 0, 0); } while (0)
#define PG8_STA(bufoff, pexpr, hh, usenext, kb) do { if constexpr (GATH) { if (usenext) PG8_STAGEG(bufoff, gn[hh], kb); else PG8_STAGEG(bufoff, go[hh], kb); } else { PG8_STAGE(bufoff, pexpr, voffA); } } while (0)
#define PG8_GOFF(dst, pm_) do { if constexpr (GATH) { _Pragma("unroll") for (int h_ = 0; h_ < 2; ++h_) _Pragma("unroll") for (int i_ = 0; i_ < 2; ++i_) { int R_, C_; stage_rc(tid * 16 + i_ * 8192, R_, C_); \
        const int v_ = S.rowsrc[(pm_) * 256 + h_ * 128 + R_]; dst[h_][i_] = (unsigned)((v_ < 0 ? 0 : v_) >> 1) * (unsigned)(K * 2) + (unsigned)(C_ * 2); } } } while (0)
#define PG8_LDA(dst, b, h) do { _Pragma("unroll") for (int m = 0; m < 4; ++m) _Pragma("unroll") for (int k = 0; k < 2; ++k) dst[m][k] = *(const PG8_LAS bf16x8*)(lds + PG8_SA(b, h) + aoff + m * 2048 + k * 1024); } while (0)
#define PG8_LDB(dst, b, h) do { _Pragma("unroll") for (int n = 0; n < 2; ++n) _Pragma("unroll") for (int k = 0; k < 2; ++k) dst[n][k] = *(const PG8_LAS bf16x8*)(lds + PG8_SB(b, h) + boff + n * 2048 + k * 1024); } while (0)
#define PG8_MMA(ai, bj, At, Bt) do { __builtin_amdgcn_s_setprio(1); _Pragma("unroll") for (int m = 0; m < 4; ++m) _Pragma("unroll") for (int n = 0; n < 2; ++n) _Pragma("unroll") for (int k = 0; k < 2; ++k) \
        acc[ai][bj][m][n] = __builtin_amdgcn_mfma_f32_16x16x32_bf16(Bt[n][k], At[m][k], acc[ai][bj][m][n], 0, 0, 0); __builtin_amdgcn_s_setprio(0); } while (0)
#define PG8_WAIT_V(n) asm volatile("s_waitcnt vmcnt(" #n ")" ::: "memory")
#define PG8_WAIT_L(n) asm volatile("s_waitcnt lgkmcnt(" #n ")" ::: "memory")
#define PG8_BAR __builtin_amdgcn_s_barrier()
#define PG8_SCHED __builtin_amdgcn_sched_barrier(0)
    Unit cur, nxt; int ui = 0;
    if (!S.next(0, cur)) return;
    f32x4 acc[2][2][4][2];
#pragma unroll
    for (int a = 0; a < 2; ++a)
#pragma unroll
        for (int b = 0; b < 2; ++b)
#pragma unroll
            for (int m = 0; m < 4; ++m)
#pragma unroll
                for (int n = 0; n < 2; ++n) acc[a][b][m][n] = (f32x4){0.f, 0.f, 0.f, 0.f};
    bf16x8 At[4][2], B0[2][2], B1[2][2];
    const char* cA = (const char*)g.A + (size_t)cur.pm * tstep; const char* cB = (const char*)g.Bt + cur.boff + (size_t)cur.pn * tstep;
    unsigned go[2][2] = {{0u, 0u}, {0u, 0u}}, gn[2][2] = {{0u, 0u}, {0u, 0u}};
    PG8_GOFF(go, cur.pm);
    S.a_ready(cur);
    if constexpr (SP2) {
        PG8_STAGE(PG8_SB(0, 0), cB, voffB); PG8_STAGE(PG8_SB(0, 1), cB + hstep, voffB); PG8_STA(PG8_SA(0, 0), cA, 0, false, (size_t)0); PG8_STA(PG8_SA(0, 1), cA + hstep, 1, false, (size_t)0);
        if (wr == 1) PG8_BAR;
        PG8_WAIT_V(2); PG8_BAR;
        PG8_STAGE(PG8_SB(1, 0), cB + kstep, voffB); PG8_STA(PG8_SA(1, 0), cA + kstep, 0, false, kstep); PG8_STAGE(PG8_SB(1, 1), cB + hstep + kstep, voffB);
        PG8_WAIT_V(6); PG8_BAR;
    } else {
        PG8_STAGE(PG8_SB(0, 0), cB, voffB); PG8_STAGE(PG8_SA(0, 0), cA, voffA); PG8_STAGE(PG8_SB(0, 1), cB + hstep, voffB); PG8_STAGE(PG8_SA(0, 1), cA + hstep, voffA);
        if (wr == 1) PG8_BAR;
        PG8_WAIT_V(4); PG8_BAR;
        PG8_STAGE(PG8_SB(1, 0), cB + kstep, voffB); PG8_STAGE(PG8_SA(1, 0), cA + kstep, voffA); PG8_STAGE(PG8_SB(1, 1), cB + hstep + kstep, voffB);
        PG8_WAIT_V(6); PG8_BAR;
    }
    for (;;) {
        const bool has_next = S.next(ui + 1, nxt);
        if constexpr (GATH) { if (has_next) PG8_GOFF(gn, nxt.pm); else { _Pragma("unroll") for (int h_ = 0; h_ < 2; ++h_) _Pragma("unroll") for (int i_ = 0; i_ < 2; ++i_) gn[h_][i_] = go[h_][i_]; } }
        const char* nA = has_next ? (const char*)g.A + (size_t)nxt.pm * tstep : cA; const char* nB = has_next ? (const char*)g.Bt + nxt.boff + (size_t)nxt.pn * tstep : cB;
        for (int t = 0; t < nt; t += 2) {
            const bool last = (t == nt - 2);
            const long ja1 = (DUALK && t + 1 >= nt / 2) ? S.dA : 0, ja2 = (DUALK && t + 2 >= nt / 2) ? S.dA : 0, ja3 = (DUALK && t + 3 >= nt / 2) ? S.dA : 0, jb2 = (DUALK && t + 2 >= nt / 2) ? S.dB : 0, jb3 = (DUALK && t + 3 >= nt / 2) ? S.dB : 0;
            const char* a1 = cA + (size_t)(t + 1) * kstep + ja1;
            const char* a2 = last ? nA : cA + (size_t)(t + 2) * kstep + ja2; const char* b2 = last ? nB : cB + (size_t)(t + 2) * kstep + jb2;
            const char* a3 = last ? nA + kstep : cA + (size_t)(t + 3) * kstep + ja3; const char* b3 = last ? nB + kstep : cB + (size_t)(t + 3) * kstep + jb3;
            if constexpr (DUALK) { if (t == nt / 2) E.mid(acc, cur, wr, wc, fr, fq); }
            if (last && has_next) S.a_ready(nxt);
            const size_t kb2 = last ? (size_t)0 : (size_t)(t + 2) * kstep;
            if constexpr (SP2) {
            PG8_LDB(B0, 0, 0); PG8_LDB(B1, 0, 1); PG8_SCHED; PG8_LDA(At, 0, 0); PG8_STA(PG8_SA(1, 1), a1 + hstep, 1, false, (size_t)(t + 1) * kstep);
            PG8_WAIT_V(8); PG8_WAIT_L(0); PG8_BAR; PG8_MMA(0, 0, At, B0); PG8_MMA(0, 1, At, B1); PG8_BAR; PG8_SCHED;
            PG8_LDA(At, 0, 1); PG8_STAGE(PG8_SB(0, 0), b2, voffB); PG8_STAGE(PG8_SB(0, 1), b2 + hstep, voffB); PG8_STA(PG8_SA(0, 0), a2, 0, last, kb2);
            PG8_WAIT_V(8); PG8_WAIT_L(0); PG8_BAR; PG8_MMA(1, 0, At, B0); PG8_MMA(1, 1, At, B1); PG8_BAR; PG8_SCHED;
            PG8_LDB(B0, 1, 0); PG8_LDB(B1, 1, 1); PG8_SCHED; PG8_LDA(At, 1, 0); PG8_STA(PG8_SA(0, 1), a2 + hstep, 1, last, kb2);
            PG8_WAIT_V(8); PG8_WAIT_L(0); PG8_BAR; PG8_MMA(0, 0, At, B0); PG8_MMA(0, 1, At, B1); PG8_BAR; PG8_SCHED;
            PG8_LDA(At, 1, 1); PG8_STAGE(PG8_SB(1, 0), b3, voffB); PG8_STAGE(PG8_SB(1, 1), b3 + hstep, voffB); PG8_STA(PG8_SA(1, 0), a3, 0, last, kb2 + kstep);
            PG8_WAIT_V(8); PG8_WAIT_L(0); PG8_BAR; PG8_MMA(1, 0, At, B0); PG8_MMA(1, 1, At, B1); PG8_BAR; PG8_SCHED;
            } else {
            PG8_LDB(B0, 0, 0); PG8_SCHED; PG8_LDA(At, 0, 0); PG8_STAGE(PG8_SA(1, 1), a1 + hstep, voffA);
            PG8_WAIT_L(8); PG8_BAR; PG8_WAIT_L(0); PG8_MMA(0, 0, At, B0); PG8_BAR; PG8_SCHED;
            PG8_LDB(B1, 0, 1); PG8_STAGE(PG8_SB(0, 0), b2, voffB);
            PG8_BAR; PG8_WAIT_L(0); PG8_MMA(0, 1, At, B1); PG8_BAR;
            PG8_LDA(At, 0, 1); PG8_STAGE(PG8_SA(0, 0), a2, voffA);
            PG8_BAR; PG8_WAIT_L(0); PG8_MMA(1, 0, At, B0); PG8_BAR; PG8_SCHED;
            PG8_STAGE(PG8_SB(0, 1), b2 + hstep, voffB);
            PG8_WAIT_V(6); PG8_BAR; PG8_MMA(1, 1, At, B1); PG8_BAR;
            PG8_LDB(B0, 1, 0); PG8_SCHED; PG8_LDA(At, 1, 0); PG8_STAGE(PG8_SA(0, 1), a2 + hstep, voffA);
            PG8_WAIT_L(8); PG8_BAR; PG8_WAIT_L(0); PG8_MMA(0, 0, At, B0); PG8_BAR; PG8_SCHED;
            PG8_LDB(B1, 1, 1); PG8_STAGE(PG8_SB(1, 0), b3, voffB);
            PG8_BAR; PG8_WAIT_L(0); PG8_MMA(0, 1, At, B1); PG8_BAR;
            PG8_LDA(At, 1, 1); PG8_STAGE(PG8_SA(1, 0), a3, voffA);
            PG8_BAR; PG8_WAIT_L(0); PG8_MMA(1, 0, At, B0); PG8_BAR; PG8_SCHED;
            PG8_STAGE(PG8_SB(1, 1), b3 + hstep, voffB);
            PG8_WAIT_V(6); PG8_BAR; PG8_MMA(1, 1, At, B1); PG8_BAR;
            }
        }
        if constexpr (ALIGN_EPI) { if (wr == 0) PG8_BAR; }
        if constexpr (!Epi::AFTER_DRAIN) { E(acc, cur, wr, wc, fr, fq); S.done(cur); }
        if (!has_next) break;
#pragma unroll
        for (int a = 0; a < 2; ++a)
#pragma unroll
            for (int b = 0; b < 2; ++b)
#pragma unroll
                for (int m = 0; m < 4; ++m)
#pragma unroll
                    for (int n = 0; n < 2; ++n) acc[a][b][m][n] = (f32x4){0.f, 0.f, 0.f, 0.f};
        cur = nxt; cA = nA; cB = nB; ++ui;
        if constexpr (GATH) { _Pragma("unroll") for (int h_ = 0; h_ < 2; ++h_) _Pragma("unroll") for (int i_ = 0; i_ < 2; ++i_) go[h_][i_] = gn[h_][i_]; }
        if constexpr (ALIGN_EPI) { if (wr == 1) PG8_BAR; }
    }
    PG8_WAIT_V(0);
    if constexpr (!ALIGN_EPI) { if (wr == 0) PG8_BAR; }
    PG8_BAR;
    if constexpr (Epi::AFTER_DRAIN) { E.fused(acc, cur, wr, wc, fr, fq, lds, wid, lane); S.done(cur); }
#undef PG8_SA
#undef PG8_SB
#undef PG8_STAGE
#undef PG8_STAGEG
#undef PG8_STA
#undef PG8_GOFF
#undef PG8_LDA
#undef PG8_LDB
#undef PG8_MMA
#undef PG8_WAIT_V
#undef PG8_WAIT_L
#undef PG8_BAR
#undef PG8_SCHED
}
}

#define LAS __attribute__((address_space(3)))
__device__ __forceinline__ void tr_item(const float* W, int ldw, int k0, int n0, bf16_t* WT, int ldt, int dst_row0, LAS float* scr, int lane) {
    const int rr = lane >> 3, c4 = (lane & 7) * 4;
    f32x4 v[8];
#pragma unroll
    for (int i = 0; i < 8; ++i) v[i] = *(const f32x4*)(W + (size_t)(k0 + 8 * i + rr) * ldw + n0 + c4);
#pragma unroll
    for (int i = 0; i < 8; ++i) { LAS float* d = scr + (8 * i + rr) * 33 + c4; d[0] = v[i][0]; d[1] = v[i][1]; d[2] = v[i][2]; d[3] = v[i][3]; }
    asm volatile("s_waitcnt lgkmcnt(0)" ::: "memory");
    const int c = lane & 7;
#pragma unroll
    for (int j = 0; j < 4; ++j) { const int n = (lane >> 3) + 8 * j; const LAS float* sp = scr + (8 * c) * 33 + n;
        v4u o; o.x = pk2(sp[0 * 33], sp[1 * 33]); o.y = pk2(sp[2 * 33], sp[3 * 33]); o.z = pk2(sp[4 * 33], sp[5 * 33]); o.w = pk2(sp[6 * 33], sp[7 * 33]);
        *(v4u*)(WT + (size_t)(dst_row0 + n) * ldt + k0 + 8 * c) = o; }
    asm volatile("s_waitcnt lgkmcnt(0)" ::: "memory");
}
__device__ __forceinline__ void ph_convert_dense(const Params& p, unsigned char* ldsb, int l, int wg, int nwg) {
    const int lane = otid() & 63, wv = __builtin_amdgcn_readfirstlane(otid() >> 6);
    LAS float* scr = (LAS float*)((LAS unsigned char*)ldsb + wv * 16384);
    const int gw = wg * 8 + wv, NGW = nwg * 8;
    constexpr int I_WIN = 16 * 172, I_PA = 8 * 32, I_WO = 16 * 32, I_LO = 64, I_GL = 32, NIT = I_WIN + 2 * I_PA + I_WO + I_LO + I_GL;
    for (int it = gw; it < NIT; it += NGW) {
        int r = it;
        if (r < I_WIN) { const int kb = r / 172, nb = r % 172; tr_item(p.w_in + (size_t)l * DM * ZC, ZC, kb * 64, nb * 32, (bf16_t*)(p.ws + WS_WIN_T), DM, nb * 32, scr, lane); continue; } r -= I_WIN;
        if (r < I_PA) { const int kb = r / 32, nb = r % 32; tr_item(p.proj_a + (size_t)l * 512 * DM, DM, kb * 64, nb * 32, (bf16_t*)(p.ws + WS_PA_T), 512, nb * 32, scr, lane); continue; } r -= I_PA;
        if (r < I_PA) { const int kb = r / 32, nb = r % 32; tr_item(p.proj_b + (size_t)l * 512 * DM, DM, kb * 64, nb * 32, (bf16_t*)(p.ws + WS_PB_T), 512, nb * 32, scr, lane); continue; } r -= I_PA;
        if (r < I_WO) { const int kb = r / 32, nb = r % 32; tr_item(p.w_out + (size_t)l * DM * DM, DM, kb * 64, nb * 32, (bf16_t*)(p.ws + WS_WO_T), DM, nb * 32, scr, lane); continue; } r -= I_WO;
        if (r >= I_LO) { r -= I_LO; const int kb = r >> 4, nb = r & 15;
            tr_item(p.rw_g_lora_b + (size_t)l * 128 * 512, 512, kb * 64, nb * 32, (bf16_t*)(p.ws + WS_GL_T), 256, nb * 32, scr, lane); continue; }
        { const int which = r >> 5, dir = (r >> 4) & 1, nb = r & 15;
          const float* W = (which ? p.rw_a_lora_b : p.rw_w_lora_b) + (size_t)((l * 2 + dir) * 64) * 512;
          tr_item(W, 512, 0, nb * 32, (bf16_t*)(p.ws + (which ? WS_LA_T : WS_LW_T)) + (size_t)dir * 512 * 64, 64, nb * 32, scr, lane); }
    }
    for (int i = wg * 512 + otid(); i < 512 * 16; i += nwg * 512) ((v4u*)(p.ws + WS_GL_T))[(i >> 4) * 32 + 16 + (i & 15)] = (v4u){0u, 0u, 0u, 0u};
    for (int i = wg * 512 + otid(); i < 16384; i += nwg * 512) ((v4u*)(p.ws + WS_WIN_T + (size_t)ZC * DM * 2))[i] = (v4u){0u, 0u, 0u, 0u};
}

struct EpiZ {
    static constexpr bool PERM = true, AFTER_DRAIN = false;
    bf16_t* Z; bf16_t* SG; bf16_t* VT;
    __device__ __forceinline__ void operator()(const f32x4 (&acc)[2][2][4][2], const pg8::Unit& u, int wr, int wc, int fr, int fq) const {
        const int row0 = u.pm * 256 + wr * 64 + fr;
        const bool lat = u.pm < 64;
        const int bb = lat ? (u.pm >> 3) : (u.pm - 64);
#pragma unroll
        for (int ai = 0; ai < 2; ++ai)
#pragma unroll
            for (int m = 0; m < 4; ++m) { const int row = row0 + ai * 128 + m * 16;
#pragma unroll
                for (int bj = 0; bj < 2; ++bj) { const int cb = u.pn * 256 + bj * 128; if (cb >= ZC) continue;
                    const int col = cb + wc * 32 + 8 * fq;
                    const f32x4 v0 = acc[ai][bj][m][0], v1 = acc[ai][bj][m][1];
                    float o[8] = {v0[0], v0[1], v0[2], v0[3], v1[0], v1[1], v1[2], v1[3]};
                    if (cb == C_LG) {
#pragma unroll
                        for (int e = 0; e < 8; ++e) o[e] = sigmoidf_(o[e]);
                        v4u w; w.x = pg8::cvt_pk_bf16(o[0], o[1]); w.y = pg8::cvt_pk_bf16(o[2], o[3]); w.z = pg8::cvt_pk_bf16(o[4], o[5]); w.w = pg8::cvt_pk_bf16(o[6], o[7]);
                        *(v4u*)(SG + (size_t)row * 256 + (col - C_LG)) = w;
                        *(v4u*)(SG + (size_t)row * 256 + 128 + (col - C_LG)) = (v4u){0u, 0u, 0u, 0u};
                    } else if (cb >= C_GA) {
                        unsigned q[8];
#pragma unroll
                        for (int e = 0; e < 8; ++e) q[e] = (unsigned)(sigmoidf_(o[e]) * 255.f + 0.5f);
                        v2u w; w.x = q[0] | (q[1] << 8) | (q[2] << 16) | (q[3] << 24); w.y = q[4] | (q[5] << 8) | (q[6] << 16) | (q[7] << 24);
                        const int gbase = (col >= C_GB) ? C_GB : C_GA;
                        *(v2u*)((unsigned char*)Z + ((size_t)row * ZC + gbase) * 2 + (col - gbase)) = w;
                    } else {
                        if (cb == C_LW) {
#pragma unroll
                            for (int e = 0; e < 8; ++e) { const float ex = __expf(2.f * o[e]); o[e] = 1.f - 2.f * __builtin_amdgcn_rcpf(ex + 1.f); } }
                        v4u w; w.x = pg8::cvt_pk_bf16(o[0], o[1]); w.y = pg8::cvt_pk_bf16(o[2], o[3]); w.z = pg8::cvt_pk_bf16(o[4], o[5]); w.w = pg8::cvt_pk_bf16(o[6], o[7]);
                        if (!(cb >= C_VB && cb < C_VB + 512)) *(v4u*)(Z + (size_t)row * ZC + col) = w;
                        if (cb >= C_VB && cb < C_VB + 512) {
                            const int hd = (col - C_VB) >> 6, d0 = (col - C_VB) & 63;
                            const int tpos = lat ? 256 + (row & 2047) : (row & 255);
                            bf16_t* vt = VT + ((size_t)((bb * 8 + hd) * 64 + d0)) * 2304 + tpos;
#pragma unroll
                            for (int e = 0; e < 8; ++e) vt[(size_t)e * 2304] = (bf16_t)((e & 1) ? (((e >> 1) == 0 ? w.x : (e >> 1) == 1 ? w.y : (e >> 1) == 2 ? w.z : w.w) >> 16) : (((e >> 1) == 0 ? w.x : (e >> 1) == 1 ? w.y : (e >> 1) == 2 ? w.z : w.w) & 0xffffu));
                        }
                    } } }
    }
};
struct DualOrder : pg8::StaticOrder { static constexpr bool DUALK = true; };
struct EpiMergeF {
    static constexpr bool PERM = true, AFTER_DRAIN = false;
    const bf16_t* Z; bf16_t* MG;
    __device__ __forceinline__ void mid(f32x4 (&acc)[2][2][4][2], const pg8::Unit& u, int wr, int wc, int fr, int fq) const {
        int row0 = u.pm * 256 + wr * 64 + fr, colb = u.pn * 256 + wc * 32 + 8 * fq;
        asm volatile("" : "+v"(row0), "+v"(colb));
#pragma unroll
        for (int ai = 0; ai < 2; ++ai)
#pragma unroll
            for (int bj = 0; bj < 2; ++bj) {
                v2u qa[4], qb[4];
#pragma unroll
                for (int m = 0; m < 4; ++m) { const int row = row0 + ai * 128 + m * 16, col = colb + bj * 128;
                    qa[m] = *(const v2u*)((const unsigned char*)Z + ((size_t)row * ZC + C_GA) * 2 + col);
                    qb[m] = *(const v2u*)((const unsigned char*)Z + ((size_t)row * ZC + C_GB) * 2 + col); }
#pragma unroll
                for (int m = 0; m < 4; ++m)
#pragma unroll
                    for (int e = 0; e < 4; ++e) {
                        const unsigned b0 = (qb[m].x >> (8 * e)) & 255u, b1 = (qb[m].y >> (8 * e)) & 255u;
                        const float r0 = (float)((qa[m].x >> (8 * e)) & 255u) * __builtin_amdgcn_rcpf((float)(b0 ? b0 : 1u));
                        const float r1 = (float)((qa[m].y >> (8 * e)) & 255u) * __builtin_amdgcn_rcpf((float)(b1 ? b1 : 1u));
                        acc[ai][bj][m][0][e] *= r0; acc[ai][bj][m][1][e] *= r1; }
                __builtin_amdgcn_sched_barrier(0);
            }
    }
    __device__ __forceinline__ void operator()(const f32x4 (&acc)[2][2][4][2], const pg8::Unit& u, int wr, int wc, int fr, int fq) const {
        const int row0 = u.pm * 256 + wr * 64 + fr, colb = u.pn * 256 + wc * 32 + 8 * fq;
#pragma unroll
        for (int ai = 0; ai < 2; ++ai) {
            v2u qb[2][4];
#pragma unroll
            for (int bj = 0; bj < 2; ++bj)
#pragma unroll
                for (int m = 0; m < 4; ++m) { const int row = row0 + ai * 128 + m * 16, col = colb + bj * 128;
                    qb[bj][m] = *(const v2u*)((const unsigned char*)Z + ((size_t)row * ZC + C_GB) * 2 + col); }
#pragma unroll
            for (int bj = 0; bj < 2; ++bj)
#pragma unroll
                for (int m = 0; m < 4; ++m) { const int row = row0 + ai * 128 + m * 16, col = colb + bj * 128;
                    float o[8];
#pragma unroll
                    for (int e = 0; e < 4; ++e) { const unsigned b0 = (qb[bj][m].x >> (8 * e)) & 255u, b1 = (qb[bj][m].y >> (8 * e)) & 255u;
                        o[e] = acc[ai][bj][m][0][e] * ((float)(b0 ? b0 : 1u) * (1.f / 255.f)); o[4 + e] = acc[ai][bj][m][1][e] * ((float)(b1 ? b1 : 1u) * (1.f / 255.f)); }
                    v4u w; w.x = pg8::cvt_pk_bf16(o[0], o[1]); w.y = pg8::cvt_pk_bf16(o[2], o[3]); w.z = pg8::cvt_pk_bf16(o[4], o[5]); w.w = pg8::cvt_pk_bf16(o[6], o[7]);
                    *(v4u*)(MG + (size_t)row * DM + col) = w; } }
    }
};
struct EpiWout {
    static constexpr bool PERM = true, AFTER_DRAIN = false;
    const float* x; const float* ctx; const float* out; const float* ctxs; const float* mod; bf16_t* x1b; int l;
    __device__ __forceinline__ void operator()(const f32x4 (&acc)[2][2][4][2], const pg8::Unit& u, int wr, int wc, int fr, int fq) const {
        const bool lat = u.pm < 64;
        const float* base = lat ? x + (size_t)u.pm * 256 * DM : ctx + (size_t)(u.pm - 64) * 256 * DM;
        const bf16_t* baseb = lat ? (const bf16_t*)out + (size_t)u.pm * 256 * DM : (const bf16_t*)ctxs + (size_t)(u.pm - 64) * 256 * DM;
        bf16_t* dst = x1b + (size_t)u.pm * 256 * DM;
        const float* g = mod + (l * 9 + (lat ? (u.pm >> 3) : 8)) * 6144 + 2 * DM;
        const int r0 = wr * 64 + fr, col0 = u.pn * 256 + wc * 32 + 8 * fq;
        f32x4 gv[2][2];
#pragma unroll
        for (int bj = 0; bj < 2; ++bj)
#pragma unroll
            for (int n = 0; n < 2; ++n) gv[bj][n] = *(const f32x4*)(g + col0 + bj * 128 + n * 4);
#pragma unroll
        for (int ai = 0; ai < 2; ++ai)
#pragma unroll
            for (int mp = 0; mp < 2; ++mp) {
                f32x4 bs[2][2][2];
#pragma unroll
                for (int mm = 0; mm < 2; ++mm) { const size_t off = (size_t)(r0 + ai * 128 + (2 * mp + mm) * 16) * DM + col0;
#pragma unroll
                    for (int bj = 0; bj < 2; ++bj) {
                        if (l == 0) {
#pragma unroll
                            for (int n = 0; n < 2; ++n) bs[mm][bj][n] = *(const f32x4*)(base + off + bj * 128 + n * 4);
                        } else { float f8[8]; unpack8(*(const v4u*)(baseb + off + bj * 128), f8);
                            bs[mm][bj][0] = (f32x4){f8[0], f8[1], f8[2], f8[3]}; bs[mm][bj][1] = (f32x4){f8[4], f8[5], f8[6], f8[7]}; } } }
#pragma unroll
                for (int mm = 0; mm < 2; ++mm) { const int m = 2 * mp + mm; const size_t off = (size_t)(r0 + ai * 128 + m * 16) * DM + col0;
#pragma unroll
                    for (int bj = 0; bj < 2; ++bj) { const f32x4 v0 = bs[mm][bj][0] + gv[bj][0] * acc[ai][bj][m][0], v1 = bs[mm][bj][1] + gv[bj][1] * acc[ai][bj][m][1];
                        v4u w; w.x = pg8::cvt_pk_bf16(v0[0], v0[1]); w.y = pg8::cvt_pk_bf16(v0[2], v0[3]); w.z = pg8::cvt_pk_bf16(v1[0], v1[1]); w.w = pg8::cvt_pk_bf16(v1[2], v1[3]);
                        *(v4u*)(dst + off + bj * 128) = w; } } }
    }
};

template <typename AT> __device__ __forceinline__ float ldA(const AT* p);
template <> __device__ __forceinline__ float ldA<bf16_t>(const bf16_t* p) { return bf2f(*p); }
template <> __device__ __forceinline__ float ldA<float>(const float* p) { return *p; }

template <typename AT, class Epi>
__device__ __forceinline__ void gemm_naive(float* sm, int wg, int nwg, int M, int N, int K, const AT* A, int lda, const int* rowmap, int rowshift,
                           const float* B, int ldb, Epi epi) {
    float* As = sm;
    float* Bs = sm + 16 * 132;
    const int tid = otid(), ty = tid >> 4, tx = tid & 15;
    const int ntm = (M + 127) / 128, ntn = N / 64;
    for (int tile = wg; tile < ntm * ntn; tile += nwg) {
        const int tm = tile / ntn, tn = tile % ntn, m0 = tm * 128, n0 = tn * 64;
        float acc[4][4];
#pragma unroll
        for (int i = 0; i < 4; ++i)
#pragma unroll
            for (int j = 0; j < 4; ++j) acc[i][j] = 0.f;
        const int ar = m0 + (tid >> 2);
        int arow = -1;
        if (ar < M) arow = rowmap ? (rowmap[ar] >> rowshift) : ar;
        const AT* ap = A + (size_t)(arow < 0 ? 0 : arow) * lda + (tid & 3) * 4;
        const int bk = tid >> 4, bn = (tid & 15) * 4;
        for (int k0 = 0; k0 < K; k0 += 16) {
#pragma unroll
            for (int i = 0; i < 4; ++i) As[((tid & 3) * 4 + i) * 132 + (tid >> 2)] = arow >= 0 ? ldA<AT>(ap + k0 + i) : 0.f;
            if (tid < 256) { const float4 b = *(const float4*)(B + (size_t)(k0 + bk) * ldb + n0 + bn); *(float4*)(Bs + bk * 68 + bn) = b; }
            __syncthreads();
#pragma unroll
            for (int kk = 0; kk < 16; ++kk) {
                const float4 a = *(const float4*)(As + kk * 132 + ty * 4), b = *(const float4*)(Bs + kk * 68 + tx * 4);
                const float av[4] = {a.x, a.y, a.z, a.w}, bv[4] = {b.x, b.y, b.z, b.w};
#pragma unroll
                for (int i = 0; i < 4; ++i)
#pragma unroll
                    for (int j = 0; j < 4; ++j) acc[i][j] += av[i] * bv[j];
            }
            __syncthreads();
        }
#pragma unroll
        for (int i = 0; i < 4; ++i) { const int row = m0 + ty * 4 + i; if (row < M) {
#pragma unroll
            for (int j = 0; j < 4; ++j) epi(row, n0 + tx * 4 + j, acc[i][j]); } }
    }
}

__device__ __forceinline__ void ph_win(const Params& p, float* sm, int l, int wg, int nwg) {
    bf16_t* Z = (bf16_t*)(p.ws + WS_Z);
    gemm_naive<bf16_t>(sm, wg, nwg, LR, ZC, DM, (const bf16_t*)(p.ws + WS_H), DM, nullptr, 0, p.w_in + (size_t)l * DM * ZC, ZC,
                       [=](int r, int c, float v) { Z[(size_t)r * ZC + c] = f2bf(v); });
}

__device__ __forceinline__ void ph_convert_moe(const Params& p, unsigned char* ldsb, int l, int wg, int nwg);
struct WinOrderLast : pg8::StaticOrder {
    __device__ __forceinline__ bool next(int i, pg8::Unit& u) const {
        const int L = i * G + c;
        if (L < nwg) { unit_of(L, u); return true; }
        const int e = L - nwg; if (e >= 96) return false;
        const int t = e % 12; u.pm = 64 + e / 12; u.pn = t < 7 ? t : t + 2; u.boff = 0u; return true;
    }
};
__device__ __forceinline__ void ph_win_mfma(const Params& p, unsigned char* ldsb, int l, int wg, int nwg) {
    pg8::Gemm g{(const bf16_t*)(p.ws + WS_H), (const bf16_t*)(p.ws + WS_WIN_T), LR, 5632, DM};
    EpiZ E{(bf16_t*)(p.ws + WS_Z), (bf16_t*)(p.ws + WS_SG), (bf16_t*)(p.ws + WS_VT)};
    if (l == 1) {
        WinOrderLast S; S.init(NLAT, 5632, nwg, wg);
        pg8::gemm_phase<EpiZ, WinOrderLast, true, true>((LAS unsigned char*)ldsb, g, S, E);
    } else {
        pg8::StaticOrder S; S.init(LR, 5632, nwg, wg);
        pg8::gemm_phase<EpiZ, pg8::StaticOrder, true, true>((LAS unsigned char*)ldsb, g, S, E);
    }
    const int ntail = (72 * 22) % nwg;
    (void)ntail;
}
__device__ __forceinline__ void ph_merge_mfma(const Params& p, unsigned char* ldsb, int l, int wg, int nwg) {
    const int nrows = (l == 1) ? NLAT : LR;
    pg8::Gemm g{(const bf16_t*)(p.ws + WS_OUTA), (const bf16_t*)(p.ws + WS_PA_T), nrows, DM, 512};
    DualOrder S; S.init(nrows, DM, nwg, wg);
    S.dA = (long)WS_YB - (long)WS_OUTA - 8 * 128; S.dB = (long)WS_PB_T - (long)WS_PA_T - 8 * 128;
    EpiMergeF E{(const bf16_t*)(p.ws + WS_Z), (bf16_t*)(p.ws + WS_MERGED)};
    pg8::gemm_phase<EpiMergeF, DualOrder, true, true>((LAS unsigned char*)ldsb, g, S, E);
}
__device__ __forceinline__ void ph_wout_mfma(const Params& p, unsigned char* ldsb, int l, int wg, int nwg) {
    const int nrows = (l == 1) ? NLAT : LR;
    pg8::Gemm g{(const bf16_t*)(p.ws + WS_MERGED), (const bf16_t*)(p.ws + WS_WO_T), nrows, DM, DM};
    pg8::StaticOrder S; S.init(nrows, DM, nwg, wg);
    EpiWout E{p.x, p.ctx, p.out, (const float*)(p.ws + WS_CTXS), (const float*)(p.ws + WS_MOD), (bf16_t*)(p.ws + WS_X1B), l};
    pg8::gemm_phase<EpiWout, pg8::StaticOrder, true, true>((LAS unsigned char*)ldsb, g, S, E);
}

__device__ __forceinline__ void ph_prep(const Params& p, float* sm, int l, int dir, int wg, int nwg) {
    const bf16_t* Z = (const bf16_t*)(p.ws + WS_Z);
    float* SW = (float*)(p.ws + WS_SW); bf16_t* SB = (bf16_t*)(p.ws + WS_SB); bf16_t* SKD = (bf16_t*)(p.ws + WS_SKD); bf16_t* SKK = (bf16_t*)(p.ws + WS_SKK);
    const int c = otid();
    const float* wlb = p.rw_w_lora_b + ((size_t)(l * 2 + dir) * 64) * 512 + c;
    const float* alb = p.rw_a_lora_b + ((size_t)(l * 2 + dir) * 64) * 512 + c;
    const float w0 = p.rw_w0[(l * 2 + dir) * 512 + c], a0 = p.rw_a0[(l * 2 + dir) * 512 + c];
    const float kkc = p.rw_k_k[l * 512 + c], kac = p.rw_k_a[l * 512 + c];
    for (int r = wg; r < LR; r += nwg) {
        __syncthreads();
        if (c < 64) sm[c] = tanhf(bf2f(Z[(size_t)r * ZC + C_LW + dir * 64 + c]));
        else if (c < 128) sm[c] = bf2f(Z[(size_t)r * ZC + C_LA + dir * 64 + (c - 64)]);
        __syncthreads();
        float wl = w0, al = a0;
#pragma unroll 4
        for (int j = 0; j < 64; ++j) { wl += sm[j] * wlb[(size_t)j * 512]; al += sm[64 + j] * alb[(size_t)j * 512]; }
        const float nx = -wl; const float sp = fmaxf(nx, 0.f) + log1pf(expf(-fabsf(nx)));
        const float decay = expf(-expf(-sp - 0.5f));
        const float a = sigmoidf_(al);
        const float k = bf2f(Z[(size_t)r * ZC + C_K + c]);
        const float kv = k * kkc;
        const float n2 = wave_sum(kv * kv);
        const float kk = kv * rsqrtf(fmaxf(n2, 1e-12f));
        SW[(size_t)r * 512 + c] = decay;
        SB[(size_t)r * 512 + c] = f2bf(kk * a);
        SKD[(size_t)r * 512 + c] = f2bf(k * (1.f + (a - 1.f) * kac));
        SKK[(size_t)r * 512 + c] = f2bf(kk);
    }
}

__device__ __forceinline__ int scan_row(int step, int dir, int b) {
    if (step < CTXL) { int t = dir ? (CTXL - 1 - step) : step; return NLAT + b * CTXL + t; }
    int tt = step - CTXL; int t = dir ? (SEQ - 1 - tt) : tt; return b * SEQ + t;
}
__device__ __forceinline__ void ph_scan(const Params& p, float* sm, int l, int dir, int wg, int nwg) {
    const bf16_t* Z = (const bf16_t*)(p.ws + WS_Z);
    const float* SW = (const float*)(p.ws + WS_SW); const bf16_t* SB = (const bf16_t*)(p.ws + WS_SB); const bf16_t* SKD = (const bf16_t*)(p.ws + WS_SKD); const bf16_t* SKK = (const bf16_t*)(p.ws + WS_SKK);
    float* Y = (float*)(p.ws + WS_Y);
    const int lane = otid() & 63, wv = otid() >> 6, nwv = blockDim.x >> 6;
    const bool last = (l == 1);
    for (int task = wg * nwv + wv; task < 512; task += nwg * nwv) {
        const int b = task >> 6, hd = (task >> 3) & 7, v0 = (task & 7) * 8;
        float s[8];
#pragma unroll
        for (int j = 0; j < 8; ++j) s[j] = 0.f;
        int row = scan_row(0, dir, b);
        float cw = SW[(size_t)row * 512 + hd * 64 + lane], ckk = bf2f(SKK[(size_t)row * 512 + hd * 64 + lane]), cb = bf2f(SB[(size_t)row * 512 + hd * 64 + lane]),
              ckd = bf2f(SKD[(size_t)row * 512 + hd * 64 + lane]), cr = bf2f(Z[(size_t)row * ZC + C_R + hd * 64 + lane]), cv = bf2f(Z[(size_t)row * ZC + C_V + hd * 64 + lane]);
        for (int step = 0; step < CTXL + SEQ; ++step) {
            const int nrow = scan_row(step + 1 < CTXL + SEQ ? step + 1 : step, dir, b);
            const float nw = SW[(size_t)nrow * 512 + hd * 64 + lane], nkk = bf2f(SKK[(size_t)nrow * 512 + hd * 64 + lane]), nb = bf2f(SB[(size_t)nrow * 512 + hd * 64 + lane]),
                        nkd = bf2f(SKD[(size_t)nrow * 512 + hd * 64 + lane]), nr = bf2f(Z[(size_t)nrow * ZC + C_R + hd * 64 + lane]), nv = bf2f(Z[(size_t)nrow * ZC + C_V + hd * 64 + lane]);
            float ysel = 0.f;
#pragma unroll
            for (int j = 0; j < 8; ++j) {
                const float skk = wave_sum(s[j] * ckk);
                const float vj = rdlane(cv, __builtin_amdgcn_readfirstlane(v0 + j));
                s[j] = s[j] * cw - skk * cb + vj * ckd;
                const float y = wave_sum(s[j] * cr);
                if (lane == j) ysel = y;
            }
            const bool isctx = step < CTXL;
            if (!(isctx && last) && lane < 8) {
                float* yp = Y + (size_t)row * 512 + hd * 64 + v0 + lane;
                if (dir == 0) *yp = ysel; else *yp += ysel;
            }
            row = nrow; cw = nw; ckk = nkk; cb = nb; ckd = nkd; cr = nr; cv = nv;
        }
    }
}

typedef short bf16x8_t __attribute__((ext_vector_type(8)));
template <int CTRL> __device__ __forceinline__ float dpp_f(float v) { return __int_as_float(__builtin_amdgcn_update_dpp(0, __float_as_int(v), CTRL, 0xf, 0xf, false)); }
__device__ __forceinline__ float row16_sum(float x) {
    x += dpp_f<0xB1>(x);
    x += dpp_f<0x4E>(x);
    x += dpp_f<0x124>(x);
    x += dpp_f<0x128>(x);
    return x;
}
__device__ __forceinline__ int scan_chunk_row(int ci, int j, int dir, int b) {
    if (ci < 8) { const int t = ci * 32 + j; return NLAT + b * CTXL + (dir ? (CTXL - 1 - t) : t); }
    const int t = (ci - 8) * 32 + j; return b * SEQ + (dir ? (SEQ - 1 - t) : t);
}
__device__ __forceinline__ void ph_scan2(const Params& p, unsigned char* ldsb, int l, int wg, int nwg) {
    const int tid = otid(), lane = tid & 63, wv = tid >> 6;
    LAS unsigned char* L = (LAS unsigned char*)ldsb;
    LAS float* sW = (LAS float*)(L + 0);
    LAS float* sKK = (LAS float*)(L + 8192);
    LAS float* sB = (LAS float*)(L + 16384);
    LAS float* sKD = (LAS float*)(L + 24576);
    LAS float* sR = (LAS float*)(L + 32768);
    LAS float* sV = (LAS float*)(L + 40960);
    LAS float* sY = (LAS float*)(L + 45056);
    LAS float* sKF = (LAS float*)(L + 49664);
    LAS float* sRN = (LAS float*)(L + 57856);
    LAS bf16_t* sLW = (LAS bf16_t*)(L + 58112);
    LAS bf16_t* sLA = (LAS bf16_t*)(L + 62208);
    const bf16_t* Z = (const bf16_t*)(p.ws + WS_Z);
    bf16_t* Y = (bf16_t*)(p.ws + WS_Y2);
    const bool last = (l == 1);
    for (int task = wg; task < 256; task += nwg) {
        const int b = task >> 5, h = (task >> 2) & 7, dir = (task >> 1) & 1, half = task & 1;
        const int mb = wv >> 2, nb = wv & 3, fr = lane & 15, fq = lane >> 4;
        const int cch = h * 64 + nb * 16 + fr;
        const float w0c = p.rw_w0[(l * 2 + dir) * 512 + cch], a0c = p.rw_a0[(l * 2 + dir) * 512 + cch];
        const float kkc = p.rw_k_k[l * 512 + cch], kac = p.rw_k_a[l * 512 + cch];
        bf16x8_t Bw[2], Ba[2];
#pragma unroll
        for (int ks = 0; ks < 2; ++ks) {
            Bw[ks] = *(const bf16x8_t*)((const bf16_t*)(p.ws + WS_LW_T) + ((size_t)(dir * 512 + cch) * 64 + 8 * fq + 32 * ks));
            Ba[ks] = *(const bf16x8_t*)((const bf16_t*)(p.ws + WS_LA_T) + ((size_t)(dir * 512 + cch) * 64 + 8 * fq + 32 * ks));
        }
        const int pj = (tid & 255) >> 3, pq = tid & 7;
        const bool roleK = tid < 256;
        const int vj = tid >> 2, vq = tid & 3;
        float kk8[8];
#pragma unroll
        for (int e = 0; e < 8; ++e) kk8[e] = p.rw_k_k[l * 512 + h * 64 + pq * 8 + e];
        const int g = lane >> 4, kc = lane & 15, vrow = wv * 4 + g;
        float s0 = 0.f, s1 = 0.f, s2 = 0.f, s3 = 0.f;
        v4u pf0, pf1, pfv;
#define SCAN_PREFETCH(ci_) do { const int row_ = scan_chunk_row((ci_), pj, dir, b); const bf16_t* zr_ = Z + (size_t)row_ * ZC; \
            pf0 = *(const v4u*)(zr_ + (roleK ? C_K : C_R) + h * 64 + pq * 8); pf1 = *(const v4u*)(zr_ + (roleK ? C_LW : C_LA) + dir * 64 + pq * 8); \
            if (tid < 128) { const int rowv_ = scan_chunk_row((ci_), vj, dir, b); pfv = *(const v4u*)(Z + (size_t)rowv_ * ZC + C_V + h * 64 + half * 32 + vq * 8); } } while (0)
        SCAN_PREFETCH(0);
        for (int ci = 0; ci < 72; ++ci) {
            float f0[8]; unpack8(pf0, f0);
            if (roleK) {
                float ss = 0.f;
#pragma unroll
                for (int e = 0; e < 8; ++e) { const float t_ = f0[e] * kk8[e]; ss += t_ * t_; }
                ss += swz_xor<1>(ss); ss += swz_xor<2>(ss); ss += swz_xor<4>(ss);
                *(LAS f32x4*)(sKF + pj * 64 + pq * 8) = (f32x4){f0[0], f0[1], f0[2], f0[3]};
                *(LAS f32x4*)(sKF + pj * 64 + pq * 8 + 4) = (f32x4){f0[4], f0[5], f0[6], f0[7]};
                if (pq == 0) sRN[pj] = rsqrtf(fmaxf(ss, 1e-12f));
                float f1[8]; unpack8(pf1, f1);
#pragma unroll
                for (int e = 0; e < 8; ++e) { const float ex = __expf(2.f * f1[e]); f1[e] = 1.f - 2.f / (ex + 1.f); }
                v4u o; o.x = pk2(f1[0], f1[1]); o.y = pk2(f1[2], f1[3]); o.z = pk2(f1[4], f1[5]); o.w = pk2(f1[6], f1[7]);
                *(LAS v4u*)(sLW + pj * 64 + pq * 8) = o;
            } else {
                *(LAS v4u*)(sLA + pj * 64 + pq * 8) = pf1;
            }
            __syncthreads();
            {
                f32x4 accw = {0.f, 0.f, 0.f, 0.f}, acca = {0.f, 0.f, 0.f, 0.f};
#pragma unroll
                for (int ks = 0; ks < 2; ++ks) {
                    const bf16x8_t aw = *(const LAS bf16x8_t*)(sLW + (mb * 16 + fr) * 64 + 8 * fq + 32 * ks);
                    const bf16x8_t aa = *(const LAS bf16x8_t*)(sLA + (mb * 16 + fr) * 64 + 8 * fq + 32 * ks);
                    accw = __builtin_amdgcn_mfma_f32_16x16x32_bf16(aw, Bw[ks], accw, 0, 0, 0);
                    acca = __builtin_amdgcn_mfma_f32_16x16x32_bf16(aa, Ba[ks], acca, 0, 0, 0);
                }
#pragma unroll
                for (int i = 0; i < 4; ++i) {
                    const int j = mb * 16 + fq * 4 + i, c = nb * 16 + fr;
                    const float wl = accw[i] + w0c, al = acca[i] + a0c;
                    const float nx = -wl; const float sp = fmaxf(nx, 0.f) + __logf(1.f + __expf(-fabsf(nx)));
                    const float decay = __expf(-__expf(-sp - 0.5f));
                    const float a = 1.f / (1.f + __expf(-al));
                    const float k = sKF[j * 64 + c]; const float kk = k * kkc * sRN[j];
                    sW[j * 64 + c] = decay; sKK[j * 64 + c] = kk; sB[j * 64 + c] = kk * a; sKD[j * 64 + c] = k * (1.f + (a - 1.f) * kac);
                }
                if (!roleK) { *(LAS f32x4*)(sR + pj * 64 + pq * 8) = (f32x4){f0[0], f0[1], f0[2], f0[3]}; *(LAS f32x4*)(sR + pj * 64 + pq * 8 + 4) = (f32x4){f0[4], f0[5], f0[6], f0[7]}; }
                if (tid < 128) { float fv[8]; unpack8(pfv, fv); *(LAS f32x4*)(sV + vj * 32 + vq * 8) = (f32x4){fv[0], fv[1], fv[2], fv[3]}; *(LAS f32x4*)(sV + vj * 32 + vq * 8 + 4) = (f32x4){fv[4], fv[5], fv[6], fv[7]}; }
                if (ci > 0 && !(last && ci <= 8)) {
                    const int j = tid >> 4, r2 = (tid & 15) * 2; const int row = scan_chunk_row(ci - 1, j, dir, b);
                    *(unsigned*)(Y + ((size_t)dir * LR + row) * 512 + h * 64 + half * 32 + r2) = pk2(sY[r2 * 36 + j], sY[(r2 + 1) * 36 + j]);
                }
            }
            __syncthreads();
            if (ci + 1 < 72) SCAN_PREFETCH(ci + 1);
#define SCAN_LD(j_, W_, KK_, BB_, KD_, RR_, V_) do { W_ = *(const LAS f32x4*)(sW + (j_) * 64 + kc * 4); KK_ = *(const LAS f32x4*)(sKK + (j_) * 64 + kc * 4); BB_ = *(const LAS f32x4*)(sB + (j_) * 64 + kc * 4); \
                KD_ = *(const LAS f32x4*)(sKD + (j_) * 64 + kc * 4); RR_ = *(const LAS f32x4*)(sR + (j_) * 64 + kc * 4); V_ = sV[(j_) * 32 + vrow]; } while (0)
#define SCAN_STEP(W_, KK_, BB_, KD_, RR_, V_, Y_) do { float pd = s0 * KK_[0] + s1 * KK_[1] + s2 * KK_[2] + s3 * KK_[3]; pd = row16_sum(pd); \
                s0 = s0 * W_[0] + (V_ * KD_[0] - pd * BB_[0]); s1 = s1 * W_[1] + (V_ * KD_[1] - pd * BB_[1]); s2 = s2 * W_[2] + (V_ * KD_[2] - pd * BB_[2]); s3 = s3 * W_[3] + (V_ * KD_[3] - pd * BB_[3]); \
                float y_ = s0 * RR_[0] + s1 * RR_[1] + s2 * RR_[2] + s3 * RR_[3]; Y_ = row16_sum(y_); } while (0)
            {
                f32x4 wA, kkA, bbA, kdA, rrA, wB, kkB, bbB, kdB, rrB; float vA, vB;
                SCAN_LD(0, wA, kkA, bbA, kdA, rrA, vA);
#pragma unroll 1
                for (int j = 0; j < 32; j += 4) {
                    f32x4 y4;
                    SCAN_LD(j + 1, wB, kkB, bbB, kdB, rrB, vB);
                    SCAN_STEP(wA, kkA, bbA, kdA, rrA, vA, y4[0]);
                    SCAN_LD(j + 2, wA, kkA, bbA, kdA, rrA, vA);
                    SCAN_STEP(wB, kkB, bbB, kdB, rrB, vB, y4[1]);
                    SCAN_LD(j + 3, wB, kkB, bbB, kdB, rrB, vB);
                    SCAN_STEP(wA, kkA, bbA, kdA, rrA, vA, y4[2]);
                    SCAN_LD((j + 4) & 31, wA, kkA, bbA, kdA, rrA, vA);
                    SCAN_STEP(wB, kkB, bbB, kdB, rrB, vB, y4[3]);
                    *(LAS f32x4*)(sY + vrow * 36 + j) = y4;
                }
            }
#undef SCAN_LD
#undef SCAN_STEP
        }
        __syncthreads();
        {
            const int j = tid >> 4, r2 = (tid & 15) * 2; const int row = scan_chunk_row(71, j, dir, b);
            *(unsigned*)(Y + ((size_t)dir * LR + row) * 512 + h * 64 + half * 32 + r2) = pk2(sY[r2 * 36 + j], sY[(r2 + 1) * 36 + j]);
        }
        __syncthreads();
#undef SCAN_PREFETCH
    }
}

__device__ __forceinline__ void ph_natt(const Params& p, float* sm, int l, int wg, int nwg) {
    const bf16_t* Z = (const bf16_t*)(p.ws + WS_Z);
    bf16_t* YB = (bf16_t*)(p.ws + WS_YB);
    const int lane = otid() & 63, wv = otid() >> 6, nwv = blockDim.x >> 6;
    float* qs = sm + wv * 512;
    float* ps = qs + 64;
    const bool last = (l == 1);
    const int nq = last ? NLAT : LR;
    const float* rpb = p.na_rpb + (size_t)l * 8 * 15 * 31;
    const float kg = p.na_k_g[l * 64 + lane], qg = p.na_q_g[l * 64 + lane];
    for (int task = wg * nwv + wv; task < nq * 8; task += nwg * nwv) {
        const int r = task >> 3, hd = task & 7;
        const bool isl = r < NLAT;
        const int b = isl ? (r >> 11) : ((r - NLAT) >> 8);
        const int t = r & 2047, qi = t >> 6, qj = t & 63;
        const int r0 = min(max(qi - 4, 0), 32 - 8), cs = min(max(qj - 8, 0), 64 - 16);
        const int nkeys = isl ? 384 : 256;
        {
            const float qv = bf2f(Z[(size_t)r * ZC + C_Q + hd * 64 + lane]);
            const float ss = wave_sum(qv * qv);
            qs[lane] = qv * rsqrtf(ss * (1.f / 64.f) + RMS_EPS) * qg * 0.125f * kg;
        }
        float lg[6]; float mx = -INFINITY;
#pragma unroll
        for (int i = 0; i < 6; ++i) {
            const int kidx = lane + 64 * i; lg[i] = -INFINITY;
            if (kidx < nkeys) {
                int krow; float bias = 0.f;
                if (isl && kidx < 128) { const int a = kidx >> 4, cc = kidx & 15; krow = b * SEQ + (r0 + a) * 64 + cs + cc;
                    bias = rpb[(hd * 15 + (r0 + a - qi + 7)) * 31 + (cs + cc - qj + 15)]; }
                else krow = NLAT + b * CTXL + (isl ? kidx - 128 : kidx);
                const uint4* kp = (const uint4*)(Z + (size_t)krow * ZC + C_KB + hd * 64);
                float ss = 0.f, dot = 0.f;
#pragma unroll 2
                for (int u = 0; u < 8; ++u) { const uint4 w = kp[u]; const unsigned ww[4] = {w.x, w.y, w.z, w.w};
                    const float4 qa = *(const float4*)(qs + u * 8), qb = *(const float4*)(qs + u * 8 + 4);
                    const float q[8] = {qa.x, qa.y, qa.z, qa.w, qb.x, qb.y, qb.z, qb.w};
#pragma unroll
                    for (int e = 0; e < 4; ++e) { const float k0 = __uint_as_float(ww[e] << 16), k1 = __uint_as_float(ww[e] & 0xffff0000u);
                        ss += k0 * k0 + k1 * k1; dot += k0 * q[e * 2] + k1 * q[e * 2 + 1]; } }
                lg[i] = dot * rsqrtf(ss * (1.f / 64.f) + RMS_EPS) + bias;
                mx = fmaxf(mx, lg[i]);
            }
        }
        mx = wave_max(mx);
        float sum = 0.f;
#pragma unroll
        for (int i = 0; i < 6; ++i) { const int kidx = lane + 64 * i; if (kidx < nkeys) { lg[i] = __expf(lg[i] - mx); sum += lg[i]; } }
        sum = wave_sum(sum);
        const float inv = 1.f / sum;
#pragma unroll
        for (int i = 0; i < 6; ++i) { const int kidx = lane + 64 * i; if (kidx < nkeys) ps[kidx] = lg[i] * inv; }
        float acc = 0.f;
        for (int kidx = 0; kidx < nkeys; ++kidx) {
            int krow;
            if (isl && kidx < 128) krow = b * SEQ + (r0 + (kidx >> 4)) * 64 + cs + (kidx & 15);
            else krow = NLAT + b * CTXL + (isl ? kidx - 128 : kidx);
            acc += ps[kidx] * bf2f(Z[(size_t)krow * ZC + C_VB + hd * 64 + lane]);
        }
        YB[(size_t)r * 512 + hd * 64 + lane] = f2bf(acc);
    }
}

typedef float f32x16_t __attribute__((ext_vector_type(16)));
#define MFMA32(a_, b_, c_) __builtin_amdgcn_mfma_f32_32x32x16_bf16((a_), (b_), (c_), 0, 0, 0)
#define MFMA16(a_, b_, c_) __builtin_amdgcn_mfma_f32_16x16x32_bf16((a_), (b_), (c_), 0, 0, 0)
__device__ __forceinline__ int scan3_row(int sc, int j, int dir, int b) {
    if (sc < 16) { const int t = sc * 16 + j; return NLAT + b * CTXL + (dir ? (CTXL - 1 - t) : t); }
    const int t = (sc - 16) * 16 + j; return b * SEQ + (dir ? (SEQ - 1 - t) : t);
}
constexpr int S3_KR = 0, S3_KD = 4096, S3_BT = 6144, S3_BD = 8192, S3_ET = 9216, S3_VT = 10240, S3_A = 11264, S3_PC = 12288, S3_SET = 12800;
constexpr int S3_SY = 8 * S3_SET;
constexpr int S3_SYSUB = 32 * 20 * 4;
#define S3_LDS_FENCE() asm volatile("s_waitcnt lgkmcnt(0)" ::: "memory")
__device__ __forceinline__ float frcp(float x) { return __builtin_amdgcn_rcpf(x); }
__device__ __forceinline__ bf16_t f2bf_fast(float x) { const __bf16 b = (__bf16)x; return __builtin_bit_cast(bf16_t, b); }
__device__ __forceinline__ void row_gather4(float x, float& r0, float& r1, float& r2, float& r3) {
    auto a = __builtin_amdgcn_permlane32_swap(__float_as_uint(x), __float_as_uint(x), false, false);
    auto b0 = __builtin_amdgcn_permlane16_swap(a[0], a[0], false, false);
    auto b1 = __builtin_amdgcn_permlane16_swap(a[1], a[1], false, false);
    r0 = __uint_as_float(b0[0]); r1 = __uint_as_float(b0[1]); r2 = __uint_as_float(b1[0]); r3 = __uint_as_float(b1[1]);
}
__device__ __forceinline__ void ph_scan3(const Params& p, unsigned char* ldsb, int l, int wg, int nwg) {
    const int tid = otid(), lane = tid & 63;
    const int wv = __builtin_amdgcn_readfirstlane(tid >> 6);
    LAS unsigned char* L = (LAS unsigned char*)ldsb;
    const bf16_t* Z = (const bf16_t*)(p.ws + WS_Z);
    bf16_t* Y = (bf16_t*)(p.ws + WS_Y2);
    const bool last = (l == 1);
    for (int task = wg; task < 256; task += nwg) {
        const int b = task >> 5, h = (task >> 2) & 7, dir = (task >> 1) & 1, half = task & 1;
        __syncthreads();
        if (wv == 0) {
            const int vcol = lane & 31, hi = lane >> 5;
            f32x16_t st0, st1;
#pragma unroll
            for (int r = 0; r < 16; ++r) { st0[r] = 0.f; st1[r] = 0.f; }
            for (int iter = 0; iter < 38; ++iter) {
                __syncthreads();
                if (iter < 1 || iter > 36) continue;
                const int buf = (iter - 1) & 1;
#pragma unroll 1
                for (int sub = 0; sub < 4; ++sub) {
                    LAS unsigned char* set = L + (buf * 4 + sub) * S3_SET;
                    bf16x8_t sb[4];
                    { v4u w;
                      w.x = pg8::cvt_pk_bf16(st0[0], st0[1]); w.y = pg8::cvt_pk_bf16(st0[2], st0[3]); w.z = pg8::cvt_pk_bf16(st0[4], st0[5]); w.w = pg8::cvt_pk_bf16(st0[6], st0[7]); sb[0] = __builtin_bit_cast(bf16x8_t, w);
                      w.x = pg8::cvt_pk_bf16(st0[8], st0[9]); w.y = pg8::cvt_pk_bf16(st0[10], st0[11]); w.z = pg8::cvt_pk_bf16(st0[12], st0[13]); w.w = pg8::cvt_pk_bf16(st0[14], st0[15]); sb[1] = __builtin_bit_cast(bf16x8_t, w);
                      w.x = pg8::cvt_pk_bf16(st1[0], st1[1]); w.y = pg8::cvt_pk_bf16(st1[2], st1[3]); w.z = pg8::cvt_pk_bf16(st1[4], st1[5]); w.w = pg8::cvt_pk_bf16(st1[6], st1[7]); sb[2] = __builtin_bit_cast(bf16x8_t, w);
                      w.x = pg8::cvt_pk_bf16(st1[8], st1[9]); w.y = pg8::cvt_pk_bf16(st1[10], st1[11]); w.z = pg8::cvt_pk_bf16(st1[12], st1[13]); w.w = pg8::cvt_pk_bf16(st1[14], st1[15]); sb[3] = __builtin_bit_cast(bf16x8_t, w); }
                    f32x16_t acc;
#pragma unroll
                    for (int r = 0; r < 16; ++r) acc[r] = 0.f;
#pragma unroll
                    for (int ks = 0; ks < 4; ++ks) { const bf16x8_t af = *(const LAS bf16x8_t*)(set + S3_KR + vcol * 128 + (ks * 16 + 8 * hi) * 2); acc = MFMA32(af, sb[ks], acc); }
                    const bf16x8_t vtf = *(const LAS bf16x8_t*)(set + S3_VT + vcol * 32 + 8 * hi * 2);
                    { const bf16x8_t bdf = *(const LAS bf16x8_t*)(set + S3_BD + vcol * 32 + 8 * hi * 2); acc = MFMA32(bdf, vtf, acc); }
                    float rhs[16];
#pragma unroll
                    for (int r = 0; r < 8; ++r) { auto rr = __builtin_amdgcn_permlane32_swap(__float_as_uint(acc[r]), __float_as_uint(acc[r]), false, false);
                        const int t0 = (r & 3) + 8 * (r >> 2); rhs[t0] = __uint_as_float(rr[0]); rhs[t0 + 4] = __uint_as_float(rr[1]); }
                    float u[16];
#pragma unroll
                    for (int i = 0; i < 16; ++i) {
                        u[i] = rhs[i];
                        if (i < 15) {
                            const LAS float* ar = (const LAS float*)(set + S3_A) + i * 16;
                            const f32x4 a0 = *(const LAS f32x4*)(ar), a1 = *(const LAS f32x4*)(ar + 4), a2 = *(const LAS f32x4*)(ar + 8), a3 = *(const LAS f32x4*)(ar + 12);
                            const float av[16] = {a0[0], a0[1], a0[2], a0[3], a1[0], a1[1], a1[2], a1[3], a2[0], a2[1], a2[2], a2[3], a3[0], a3[1], a3[2], a3[3]};
#pragma unroll
                            for (int t = i + 1; t < 16; ++t) rhs[t] -= u[i] * av[t];
                        }
                    }
                    bf16x8_t ub;
                    { v4u w; w.x = pg8::cvt_pk_bf16(hi ? u[8] : u[0], hi ? u[9] : u[1]); w.y = pg8::cvt_pk_bf16(hi ? u[10] : u[2], hi ? u[11] : u[3]);
                      w.z = pg8::cvt_pk_bf16(hi ? u[12] : u[4], hi ? u[13] : u[5]); w.w = pg8::cvt_pk_bf16(hi ? u[14] : u[6], hi ? u[15] : u[7]); ub = __builtin_bit_cast(bf16x8_t, w); }
                    { const bf16x8_t etf = *(const LAS bf16x8_t*)(set + S3_ET + vcol * 32 + 8 * hi * 2); acc = MFMA32(etf, ub, acc); }
                    { LAS float* sy = (LAS float*)(L + S3_SY + (buf * 4 + sub) * S3_SYSUB) + vcol * 20;
                      *(LAS f32x4*)(sy + 4 * hi) = (f32x4){acc[8], acc[9], acc[10], acc[11]};
                      *(LAS f32x4*)(sy + 8 + 4 * hi) = (f32x4){acc[12], acc[13], acc[14], acc[15]}; }
                    { const bf16x8_t kd0 = *(const LAS bf16x8_t*)(set + S3_KD + vcol * 32 + 8 * hi * 2), kd1 = *(const LAS bf16x8_t*)(set + S3_KD + (32 + vcol) * 32 + 8 * hi * 2);
                      const bf16x8_t bt0 = *(const LAS bf16x8_t*)(set + S3_BT + vcol * 32 + 8 * hi * 2), bt1 = *(const LAS bf16x8_t*)(set + S3_BT + (32 + vcol) * 32 + 8 * hi * 2);
                      st0 = MFMA32(kd0, vtf, st0); st0 = MFMA32(bt0, ub, st0);
                      st1 = MFMA32(kd1, vtf, st1); st1 = MFMA32(bt1, ub, st1); }
#pragma unroll
                    for (int g = 0; g < 4; ++g) {
                        const f32x4 p0 = *(const LAS f32x4*)((const LAS float*)(set + S3_PC) + 8 * g + 4 * hi), p1 = *(const LAS f32x4*)((const LAS float*)(set + S3_PC) + 32 + 8 * g + 4 * hi);
#pragma unroll
                        for (int e = 0; e < 4; ++e) { st0[4 * g + e] *= p0[e]; st1[4 * g + e] *= p1[e]; }
                    }
                }
            }
        } else if (wv <= 4) {
            const int fr = lane & 15, fq = lane >> 4, pw = wv - 1;
            float w0c[4], a0c[4], kkc[4], kac[4];
#pragma unroll
            for (int nb = 0; nb < 4; ++nb) { const int cch = h * 64 + nb * 16 + fr;
                w0c[nb] = p.rw_w0[(l * 2 + dir) * 512 + cch]; a0c[nb] = p.rw_a0[(l * 2 + dir) * 512 + cch]; kkc[nb] = p.rw_k_k[l * 512 + cch]; kac[nb] = p.rw_k_a[l * 512 + cch]; }
            const bf16_t* lwt = (const bf16_t*)(p.ws + WS_LW_T) + ((size_t)(dir * 512 + h * 64 + fr) * 64 + 8 * fq);
            const bf16_t* lat = (const bf16_t*)(p.ws + WS_LA_T) + ((size_t)(dir * 512 + h * 64 + fr) * 64 + 8 * fq);
            const int pq = lane & 7;
            float kk8[8];
#pragma unroll
            for (int e = 0; e < 8; ++e) kk8[e] = p.rw_k_k[l * 512 + h * 64 + pq * 8 + e];
            const int Pfr = (fr & 3) | ((fr & 4) << 1) | ((fr & 8) >> 1);
            v4u pk_[2], pr_[2], plw_[2], pla_[2], pv_;
#define S3_PREFETCH(sc_) do { _Pragma("unroll") for (int it_ = 0; it_ < 2; ++it_) { const int pp_ = lane + 64 * it_; const bf16_t* zr_ = Z + (size_t)scan3_row((sc_), pp_ >> 3, dir, b) * ZC; \
                pk_[it_] = *(const v4u*)(zr_ + C_K + h * 64 + pq * 8); pr_[it_] = *(const v4u*)(zr_ + C_R + h * 64 + pq * 8); plw_[it_] = *(const v4u*)(zr_ + C_LW + dir * 64 + pq * 8); pla_[it_] = *(const v4u*)(zr_ + C_LA + dir * 64 + pq * 8); } \
                pv_ = *(const v4u*)(Z + (size_t)scan3_row((sc_), lane >> 2, dir, b) * ZC + C_V + h * 64 + half * 32 + (lane & 3) * 8); } while (0)
            S3_PREFETCH(pw);
            for (int iter = 0; iter < 38; ++iter) {
                __syncthreads();
                if (iter >= 36) continue;
                LAS unsigned char* set = L + ((iter & 1) * 4 + pw) * S3_SET;
                LAS bf16_t* RK = (LAS bf16_t*)(set + S3_KR); LAS bf16_t* RR = (LAS bf16_t*)(set + S3_KR + 2048);
                LAS bf16_t* LWt = (LAS bf16_t*)(set + S3_KD); LAS bf16_t* LAt = (LAS bf16_t*)(set + S3_BT);
                LAS float* RN = (LAS float*)(set + S3_PC);
#pragma unroll
                for (int it = 0; it < 2; ++it) { const int pp = lane + 64 * it, j = pp >> 3;
                    float f[8]; unpack8(pk_[it], f); float ss = 0.f;
#pragma unroll
                    for (int e = 0; e < 8; ++e) { const float t_ = f[e] * kk8[e]; ss += t_ * t_; }
                    ss += swz_xor<1>(ss); ss += swz_xor<2>(ss); ss += swz_xor<4>(ss);
                    if (pq == 0) RN[j] = rsqrtf(fmaxf(ss, 1e-12f));
                    *(LAS v4u*)(RK + j * 64 + pq * 8) = pk_[it]; *(LAS v4u*)(RR + j * 64 + pq * 8) = pr_[it]; *(LAS v4u*)(LAt + j * 64 + pq * 8) = pla_[it];
                    float g[8]; unpack8(plw_[it], g);
#pragma unroll
                    for (int e = 0; e < 8; ++e) { const float ex = __expf(2.f * g[e]); g[e] = 1.f - 2.f * frcp(ex + 1.f); }
                    v4u o; o.x = pg8::cvt_pk_bf16(g[0], g[1]); o.y = pg8::cvt_pk_bf16(g[2], g[3]); o.z = pg8::cvt_pk_bf16(g[4], g[5]); o.w = pg8::cvt_pk_bf16(g[6], g[7]);
                    *(LAS v4u*)(LWt + j * 64 + pq * 8) = o; }
                const v4u vkeep = pv_;
                bf16x8_t Bw[4][2], Ba[4][2];
#pragma unroll
                for (int nb = 0; nb < 4; ++nb)
#pragma unroll
                    for (int ks = 0; ks < 2; ++ks) { Bw[nb][ks] = *(const bf16x8_t*)(lwt + (size_t)nb * 16 * 64 + 32 * ks); Ba[nb][ks] = *(const bf16x8_t*)(lat + (size_t)nb * 16 * 64 + 32 * ks); }
                if (iter + 1 < 36) S3_PREFETCH(4 * (iter + 1) + pw);
                S3_LDS_FENCE();
                f32x4 accw[4], acca[4];
#pragma unroll
                for (int nb = 0; nb < 4; ++nb) { accw[nb] = (f32x4){0.f, 0.f, 0.f, 0.f}; acca[nb] = (f32x4){0.f, 0.f, 0.f, 0.f}; }
#pragma unroll
                for (int ks = 0; ks < 2; ++ks) {
                    const bf16x8_t aw = *(const LAS bf16x8_t*)(LWt + fr * 64 + 8 * fq + 32 * ks), aa = *(const LAS bf16x8_t*)(LAt + fr * 64 + 8 * fq + 32 * ks);
#pragma unroll
                    for (int nb = 0; nb < 4; ++nb) { accw[nb] = MFMA16(aw, Bw[nb][ks], accw[nb]); acca[nb] = MFMA16(aa, Ba[nb][ks], acca[nb]); }
                }
                float rawk[4][4], rawr[4][4], rnv[4];
#pragma unroll
                for (int i = 0; i < 4; ++i) { rnv[i] = RN[4 * fq + i];
#pragma unroll
                    for (int nb = 0; nb < 4; ++nb) { rawk[nb][i] = bf2f(RK[(4 * fq + i) * 64 + 16 * nb + fr]); rawr[nb][i] = bf2f(RR[(4 * fq + i) * 64 + 16 * nb + fr]); } }
                S3_LDS_FENCE();
                LAS bf16_t* KR = (LAS bf16_t*)(set + S3_KR); LAS bf16_t* BK = (LAS bf16_t*)(set + S3_BD);
                LAS bf16_t* KD = (LAS bf16_t*)(set + S3_KD); LAS bf16_t* BT = (LAS bf16_t*)(set + S3_BT);
#pragma unroll
                for (int nb = 0; nb < 4; ++nb) {
                    float ev[4], kkv[4], bv[4], kdv[4];
#pragma unroll
                    for (int i = 0; i < 4; ++i) {
                        const float wl = accw[nb][i] + w0c[nb], al = acca[nb][i] + a0c[nb];
                        ev[i] = 0.60653065971f * frcp(1.f + __expf(-wl));
                        const float a = frcp(1.f + __expf(-al));
                        const float k = rawk[nb][i];
                        kkv[i] = k * kkc[nb] * rnv[i]; bv[i] = kkv[i] * a; kdv[i] = k * (1.f + (a - 1.f) * kac[nb]); }
                    const float c0 = ev[0], c1 = c0 + ev[1], c2 = c1 + ev[2], c3 = c2 + ev[3];
                    const float T0 = __int_as_float(__builtin_amdgcn_ds_bpermute(fr * 4, __float_as_int(c3))), T1 = __int_as_float(__builtin_amdgcn_ds_bpermute((fr + 16) * 4, __float_as_int(c3))),
                                T2 = __int_as_float(__builtin_amdgcn_ds_bpermute((fr + 32) * 4, __float_as_int(c3)));
                    const float off = (fq > 0 ? T0 : 0.f) + (fq > 1 ? T1 : 0.f) + (fq > 2 ? T2 : 0.f);
                    const float cs[4] = {off + c0, off + c1, off + c2, off + c3};
                    const int colp = 16 * nb + Pfr, c = 16 * nb + fr;
                    float ktl[4], nbet[4];
#pragma unroll
                    for (int i = 0; i < 4; ++i) { const int t = 4 * fq + i;
                        const float E1 = __expf(cs[i]); const float E2 = frcp(E1); const float E3 = E2 * __expf(ev[i]);
                        const float kap = kkv[i] * E3, bet = bv[i] * E1, kt = kdv[i] * E1, rt = rawr[nb][i] * E2;
                        KR[t * 64 + colp] = f2bf_fast(kap); KR[(16 + t) * 64 + colp] = f2bf_fast(rt);
                        BK[t * 64 + colp] = f2bf_fast(bet); BK[(16 + t) * 64 + colp] = f2bf_fast(kt);
                        ktl[i] = kt; nbet[i] = -bet;
                        if (i == 3 && fq == 3) ((LAS float*)(set + S3_PC))[64 + c] = E2; }
                    v2u wk, wb; wk.x = pg8::cvt_pk_bf16(ktl[0], ktl[1]); wk.y = pg8::cvt_pk_bf16(ktl[2], ktl[3]);
                    wb.x = pg8::cvt_pk_bf16(nbet[0], nbet[1]); wb.y = pg8::cvt_pk_bf16(nbet[2], nbet[3]);
                    *(LAS v2u*)(KD + c * 16 + 4 * fq) = wk; *(LAS v2u*)(BT + c * 16 + 4 * fq) = wb;
                }
                S3_LDS_FENCE();
                f32x16_t G;
#pragma unroll
                for (int r = 0; r < 16; ++r) G[r] = 0.f;
                { const int n = lane & 31, hi = lane >> 5;
#pragma unroll
                  for (int ks = 0; ks < 4; ++ks) { const bf16x8_t af = *(const LAS bf16x8_t*)(BK + n * 64 + ks * 16 + 8 * hi), bf = *(const LAS bf16x8_t*)(KR + n * 64 + ks * 16 + 8 * hi); G = MFMA32(af, bf, G); }
                  S3_LDS_FENCE();
                  const int tt = n & 15; const bool isr = n >= 16;
                  float gm[16];
#pragma unroll
                  for (int r = 0; r < 16; ++r) { const int i = (r & 3) + 8 * ((r >> 2) & 1) + 4 * hi; const bool keep = isr ? (i <= tt) : (i < tt); gm[r] = keep ? G[r] : 0.f; }
                  LAS float* Am = (LAS float*)(set + S3_A);
                  if (!isr) {
#pragma unroll
                      for (int r = 0; r < 8; ++r) { const int i = (r & 3) + 8 * (r >> 2) + 4 * hi; Am[i * 16 + tt] = gm[r]; } }
                  { v2u e0, e1; float ge[8];
#pragma unroll
                    for (int r = 0; r < 8; ++r) ge[r] = isr ? -gm[r] : 0.f;
                    e0.x = pg8::cvt_pk_bf16(ge[0], ge[1]); e0.y = pg8::cvt_pk_bf16(ge[2], ge[3]); e1.x = pg8::cvt_pk_bf16(ge[4], ge[5]); e1.y = pg8::cvt_pk_bf16(ge[6], ge[7]);
                    LAS bf16_t* ET = (LAS bf16_t*)(set + S3_ET); *(LAS v2u*)(ET + n * 16 + 4 * hi) = e0; *(LAS v2u*)(ET + n * 16 + 8 + 4 * hi) = e1; }
                  { v2u d0, d1; d0.x = pg8::cvt_pk_bf16(gm[8], gm[9]); d0.y = pg8::cvt_pk_bf16(gm[10], gm[11]); d1.x = pg8::cvt_pk_bf16(gm[12], gm[13]); d1.y = pg8::cvt_pk_bf16(gm[14], gm[15]);
                    LAS bf16_t* BD = (LAS bf16_t*)(set + S3_BD); *(LAS v2u*)(BD + n * 16 + 4 * hi) = d0; *(LAS v2u*)(BD + n * 16 + 8 + 4 * hi) = d1; } }
                { LAS bf16_t* VTt = (LAS bf16_t*)(set + S3_VT); const int jv = lane >> 2, qv = lane & 3;
#pragma unroll
                  for (int e = 0; e < 4; ++e) { const unsigned w = e == 0 ? vkeep.x : e == 1 ? vkeep.y : e == 2 ? vkeep.z : vkeep.w;
                      VTt[(8 * qv + 2 * e) * 16 + jv] = (bf16_t)(w & 0xffffu); VTt[(8 * qv + 2 * e + 1) * 16 + jv] = (bf16_t)(w >> 16); } }
                { const float pcv = ((LAS float*)(set + S3_PC))[64 + lane]; S3_LDS_FENCE(); ((LAS float*)(set + S3_PC))[lane] = pcv; }
            }
#undef S3_PREFETCH
        } else {
            const int ft = tid - 320;
            for (int iter = 0; iter < 38; ++iter) {
                __syncthreads();
                if (iter < 2) continue;
                const int ch = iter - 2, buf = ch & 1;
                if (last && ch < 4) continue;
                for (int idx = ft; idx < 1024; idx += 192) {
                    const int sub = idx >> 8, j = (idx >> 4) & 15, v2 = (idx & 15) * 2;
                    const LAS float* sy = (const LAS float*)(L + S3_SY + (buf * 4 + sub) * S3_SYSUB);
                    const int row = scan3_row(4 * ch + sub, j, dir, b);
                    *(unsigned*)(Y + ((size_t)dir * LR + row) * 512 + h * 64 + half * 32 + v2) = pk2(sy[v2 * 20 + j], sy[(v2 + 1) * 20 + j]);
                }
            }
        }
    }
    __syncthreads();
}

constexpr int S4_KR = 0, S4_BK = 4096, S4_KD = 8192, S4_BT = 10240, S4_VT = 12288, S4_A = 13312, S4_PC = 14336, S4_SET = 14592;
constexpr int S4_SY = 6 * S4_SET, S4_SYSUB = 32 * 20 * 4;
__device__ __forceinline__ void ph_scan4(const Params& p, unsigned char* ldsb, int l, int wg, int nwg) {
    const int tid = otid(), lane = tid & 63;
    const int wv = __builtin_amdgcn_readfirstlane(tid >> 6);
    LAS unsigned char* L = (LAS unsigned char*)ldsb;
    const bf16_t* Z = (const bf16_t*)(p.ws + WS_Z);
    bf16_t* Y = (bf16_t*)(p.ws + WS_Y2);
    const bool last = (l == 1);
    for (int task = wg; task < 256; task += nwg) {
        const int b = task >> 5, h = (task >> 2) & 7, dir = (task >> 1) & 1, half = task & 1;
        __syncthreads();
        if (wv == 0) {
            const int vcol = lane & 31, hi = lane >> 5;
            const int tt = vcol & 15; const bool isr = vcol >= 16;
            f32x16_t st0, st1;
#pragma unroll
            for (int r = 0; r < 16; ++r) { st0[r] = 0.f; st1[r] = 0.f; }
            for (int iter = 0; iter < 50; ++iter) {
                __syncthreads();
                if (iter < 1 || iter > 48) continue;
                const int buf = (iter - 1) & 1;
#pragma unroll 1
                for (int sub = 0; sub < 3; ++sub) {
                    LAS unsigned char* set = L + (buf * 3 + sub) * S4_SET;
                    bf16x8_t krf[4];
#pragma unroll
                    for (int ks = 0; ks < 4; ++ks) krf[ks] = *(const LAS bf16x8_t*)(set + S4_KR + vcol * 128 + (ks * 16 + 8 * hi) * 2);
                    float gm[16];
                    { f32x16_t G;
#pragma unroll
                      for (int r = 0; r < 16; ++r) G[r] = 0.f;
#pragma unroll
                      for (int ks = 0; ks < 4; ++ks) { const bf16x8_t bkf = *(const LAS bf16x8_t*)(set + S4_BK + vcol * 128 + (ks * 16 + 8 * hi) * 2); G = MFMA32(bkf, krf[ks], G); }
#pragma unroll
                      for (int r = 0; r < 16; ++r) { const int i = (r & 3) + 8 * ((r >> 2) & 1) + 4 * hi; const bool keep = isr ? (i <= tt) : (i < tt); gm[r] = keep ? G[r] : 0.f; } }
                    LAS float* Am = (LAS float*)(set + S4_A);
                    if (!isr) {
#pragma unroll
                        for (int r = 0; r < 8; ++r) { const int i = (r & 3) + 8 * (r >> 2) + 4 * hi; Am[i * 16 + tt] = gm[r]; } }
                    bf16x8_t etf, bdf;
                    { v4u w; float ge[8];
#pragma unroll
                      for (int r = 0; r < 8; ++r) ge[r] = isr ? -gm[r] : 0.f;
                      w.x = pg8::cvt_pk_bf16(ge[0], ge[1]); w.y = pg8::cvt_pk_bf16(ge[2], ge[3]); w.z = pg8::cvt_pk_bf16(ge[4], ge[5]); w.w = pg8::cvt_pk_bf16(ge[6], ge[7]); etf = __builtin_bit_cast(bf16x8_t, w);
                      w.x = pg8::cvt_pk_bf16(gm[8], gm[9]); w.y = pg8::cvt_pk_bf16(gm[10], gm[11]); w.z = pg8::cvt_pk_bf16(gm[12], gm[13]); w.w = pg8::cvt_pk_bf16(gm[14], gm[15]); bdf = __builtin_bit_cast(bf16x8_t, w); }
                    bf16x8_t sb[4];
                    { v4u w;
                      w.x = pg8::cvt_pk_bf16(st0[0], st0[1]); w.y = pg8::cvt_pk_bf16(st0[2], st0[3]); w.z = pg8::cvt_pk_bf16(st0[4], st0[5]); w.w = pg8::cvt_pk_bf16(st0[6], st0[7]); sb[0] = __builtin_bit_cast(bf16x8_t, w);
                      w.x = pg8::cvt_pk_bf16(st0[8], st0[9]); w.y = pg8::cvt_pk_bf16(st0[10], st0[11]); w.z = pg8::cvt_pk_bf16(st0[12], st0[13]); w.w = pg8::cvt_pk_bf16(st0[14], st0[15]); sb[1] = __builtin_bit_cast(bf16x8_t, w);
                      w.x = pg8::cvt_pk_bf16(st1[0], st1[1]); w.y = pg8::cvt_pk_bf16(st1[2], st1[3]); w.z = pg8::cvt_pk_bf16(st1[4], st1[5]); w.w = pg8::cvt_pk_bf16(st1[6], st1[7]); sb[2] = __builtin_bit_cast(bf16x8_t, w);
                      w.x = pg8::cvt_pk_bf16(st1[8], st1[9]); w.y = pg8::cvt_pk_bf16(st1[10], st1[11]); w.z = pg8::cvt_pk_bf16(st1[12], st1[13]); w.w = pg8::cvt_pk_bf16(st1[14], st1[15]); sb[3] = __builtin_bit_cast(bf16x8_t, w); }
                    f32x16_t acc;
#pragma unroll
                    for (int r = 0; r < 16; ++r) acc[r] = 0.f;
#pragma unroll
                    for (int ks = 0; ks < 4; ++ks) acc = MFMA32(krf[ks], sb[ks], acc);
                    bf16x8_t vtf;
                    { const v2u a = *(const LAS v2u*)(set + S4_VT + vcol * 32 + 4 * hi * 2), c = *(const LAS v2u*)(set + S4_VT + vcol * 32 + (8 + 4 * hi) * 2); const v4u w = {a.x, a.y, c.x, c.y}; vtf = __builtin_bit_cast(bf16x8_t, w); }
                    acc = MFMA32(bdf, vtf, acc);
                    float rhs[16];
#pragma unroll
                    for (int r = 0; r < 8; ++r) { auto rr = __builtin_amdgcn_permlane32_swap(__float_as_uint(acc[r]), __float_as_uint(acc[r]), false, false);
                        const int t0 = (r & 3) + 8 * (r >> 2); rhs[t0] = __uint_as_float(rr[0]); rhs[t0 + 4] = __uint_as_float(rr[1]); }
                    S3_LDS_FENCE();
                    float u[16];
#pragma unroll
                    for (int i = 0; i < 16; ++i) {
                        u[i] = rhs[i];
                        if (i < 15) {
                            const LAS float* ar = Am + i * 16;
                            const f32x4 a0 = *(const LAS f32x4*)(ar), a1 = *(const LAS f32x4*)(ar + 4), a2 = *(const LAS f32x4*)(ar + 8), a3 = *(const LAS f32x4*)(ar + 12);
                            const float av[16] = {a0[0], a0[1], a0[2], a0[3], a1[0], a1[1], a1[2], a1[3], a2[0], a2[1], a2[2], a2[3], a3[0], a3[1], a3[2], a3[3]};
#pragma unroll
                            for (int t = i + 1; t < 16; ++t) rhs[t] -= u[i] * av[t];
                        }
                    }
                    bf16x8_t ub;
                    { v4u w; w.x = pg8::cvt_pk_bf16(hi ? u[4] : u[0], hi ? u[5] : u[1]); w.y = pg8::cvt_pk_bf16(hi ? u[6] : u[2], hi ? u[7] : u[3]);
                      w.z = pg8::cvt_pk_bf16(hi ? u[12] : u[8], hi ? u[13] : u[9]); w.w = pg8::cvt_pk_bf16(hi ? u[14] : u[10], hi ? u[15] : u[11]); ub = __builtin_bit_cast(bf16x8_t, w); }
                    acc = MFMA32(etf, ub, acc);
                    { LAS float* sy = (LAS float*)(L + S4_SY + (buf * 3 + sub) * S4_SYSUB) + vcol * 20;
                      *(LAS f32x4*)(sy + 4 * hi) = (f32x4){acc[8], acc[9], acc[10], acc[11]};
                      *(LAS f32x4*)(sy + 8 + 4 * hi) = (f32x4){acc[12], acc[13], acc[14], acc[15]}; }
#define S4_FRAG2(base_, row_) ({ const v2u a_ = *(const LAS v2u*)(set + (base_) + (row_) * 32 + 4 * hi * 2), c_ = *(const LAS v2u*)(set + (base_) + (row_) * 32 + (8 + 4 * hi) * 2); const v4u w_ = {a_.x, a_.y, c_.x, c_.y}; __builtin_bit_cast(bf16x8_t, w_); })
                    { const bf16x8_t kd0 = S4_FRAG2(S4_KD, vcol), kd1 = S4_FRAG2(S4_KD, 32 + vcol), bt0 = S4_FRAG2(S4_BT, vcol), bt1 = S4_FRAG2(S4_BT, 32 + vcol);
                      st0 = MFMA32(kd0, vtf, st0); st0 = MFMA32(bt0, ub, st0);
                      st1 = MFMA32(kd1, vtf, st1); st1 = MFMA32(bt1, ub, st1); }
#undef S4_FRAG2
#pragma unroll
                    for (int g = 0; g < 4; ++g) {
                        const f32x4 p0 = *(const LAS f32x4*)((const LAS float*)(set + S4_PC) + 8 * g + 4 * hi), p1 = *(const LAS f32x4*)((const LAS float*)(set + S4_PC) + 32 + 8 * g + 4 * hi);
#pragma unroll
                        for (int e = 0; e < 4; ++e) { st0[4 * g + e] *= p0[e]; st1[4 * g + e] *= p1[e]; }
                    }
                }
            }
        } else if (wv <= 6) {
            const int fr = lane & 15, fq = lane >> 4, hp = wv - 1, sub = hp >> 1, chh = hp & 1;
            float w0c[2], a0c[2], kac[2], kkc4[4];
            bf16x8_t Bw[2][2], Ba[2][2];
#pragma unroll
            for (int nb = 0; nb < 4; ++nb) kkc4[nb] = p.rw_k_k[l * 512 + h * 64 + nb * 16 + fr];
#pragma unroll
            for (int q = 0; q < 2; ++q) { const int cch = h * 64 + (2 * chh + q) * 16 + fr;
                w0c[q] = p.rw_w0[(l * 2 + dir) * 512 + cch]; a0c[q] = p.rw_a0[(l * 2 + dir) * 512 + cch]; kac[q] = p.rw_k_a[l * 512 + cch];
#pragma unroll
                for (int ks = 0; ks < 2; ++ks) {
                    Bw[q][ks] = *(const bf16x8_t*)((const bf16_t*)(p.ws + WS_LW_T) + ((size_t)(dir * 512 + cch) * 64 + 8 * fq + 32 * ks));
                    Ba[q][ks] = *(const bf16x8_t*)((const bf16_t*)(p.ws + WS_LA_T) + ((size_t)(dir * 512 + cch) * 64 + 8 * fq + 32 * ks)); } }
            const int Pfr = (fr & 3) | ((fr & 4) << 1) | ((fr & 8) >> 1);
            v4u plw[2], pla[2]; bf16_t pk[4][4], pr[2][4];
#define S4_PREFETCH(sc_) do { const bf16_t* za_ = Z + (size_t)scan3_row((sc_), fr, dir, b) * ZC; \
                _Pragma("unroll") for (int ks_ = 0; ks_ < 2; ++ks_) { plw[ks_] = *(const v4u*)(za_ + C_LW + dir * 64 + 8 * fq + 32 * ks_); pla[ks_] = *(const v4u*)(za_ + C_LA + dir * 64 + 8 * fq + 32 * ks_); } \
                _Pragma("unroll") for (int i_ = 0; i_ < 4; ++i_) { const bf16_t* zt_ = Z + (size_t)scan3_row((sc_), 4 * fq + i_, dir, b) * ZC; \
                    _Pragma("unroll") for (int nb_ = 0; nb_ < 4; ++nb_) pk[nb_][i_] = zt_[C_K + h * 64 + nb_ * 16 + fr]; \
                    _Pragma("unroll") for (int q_ = 0; q_ < 2; ++q_) pr[q_][i_] = zt_[C_R + h * 64 + (2 * chh + q_) * 16 + fr]; } } while (0)
            S4_PREFETCH(sub);
            for (int iter = 0; iter < 50; ++iter) {
                __syncthreads();
                if (iter >= 48) continue;
                LAS unsigned char* set = L + ((iter & 1) * 3 + sub) * S4_SET;
                bf16x8_t aw[2], aa[2];
#pragma unroll
                for (int ks = 0; ks < 2; ++ks) { float g[8]; unpack8(plw[ks], g);
#pragma unroll
                    for (int e = 0; e < 8; ++e) { const float ex = __expf(2.f * g[e]); g[e] = 1.f - 2.f * frcp(ex + 1.f); }
                    v4u o; o.x = pg8::cvt_pk_bf16(g[0], g[1]); o.y = pg8::cvt_pk_bf16(g[2], g[3]); o.z = pg8::cvt_pk_bf16(g[4], g[5]); o.w = pg8::cvt_pk_bf16(g[6], g[7]);
                    aw[ks] = __builtin_bit_cast(bf16x8_t, o); aa[ks] = __builtin_bit_cast(bf16x8_t, pla[ks]); }
                float kf[4][4], rf[2][4];
#pragma unroll
                for (int i = 0; i < 4; ++i) {
#pragma unroll
                    for (int nb = 0; nb < 4; ++nb) kf[nb][i] = bf2f(pk[nb][i]);
#pragma unroll
                    for (int q = 0; q < 2; ++q) rf[q][i] = bf2f(pr[q][i]); }
                if (iter + 1 < 48) S4_PREFETCH(3 * (iter + 1) + sub);
                f32x4 accw[2], acca[2];
#pragma unroll
                for (int q = 0; q < 2; ++q) { accw[q] = (f32x4){0.f, 0.f, 0.f, 0.f}; acca[q] = (f32x4){0.f, 0.f, 0.f, 0.f}; }
#pragma unroll
                for (int ks = 0; ks < 2; ++ks)
#pragma unroll
                    for (int q = 0; q < 2; ++q) { accw[q] = MFMA16(aw[ks], Bw[q][ks], accw[q]); acca[q] = MFMA16(aa[ks], Ba[q][ks], acca[q]); }
                float rnv[4];
#pragma unroll
                for (int i = 0; i < 4; ++i) { float ss = 0.f;
#pragma unroll
                    for (int nb = 0; nb < 4; ++nb) { const float t_ = kf[nb][i] * kkc4[nb]; ss += t_ * t_; }
                    rnv[i] = rsqrtf(fmaxf(row16_sum(ss), 1e-12f)); }
                LAS bf16_t* KR = (LAS bf16_t*)(set + S4_KR); LAS bf16_t* BK = (LAS bf16_t*)(set + S4_BK);
                LAS bf16_t* KD = (LAS bf16_t*)(set + S4_KD); LAS bf16_t* BT = (LAS bf16_t*)(set + S4_BT);
#pragma unroll
                for (int q = 0; q < 2; ++q) { const int nb = 2 * chh + q;
                    float ev[4], kkv[4], bv[4], kdv[4];
#pragma unroll
                    for (int i = 0; i < 4; ++i) {
                        const float wl = accw[q][i] + w0c[q], al = acca[q][i] + a0c[q];
                        ev[i] = 0.60653065971f * frcp(1.f + __expf(-wl));
                        const float a = frcp(1.f + __expf(-al));
                        const float k = kf[nb][i];
                        kkv[i] = k * kkc4[nb] * rnv[i]; bv[i] = kkv[i] * a; kdv[i] = k * (1.f + (a - 1.f) * kac[q]); }
                    const float c0 = ev[0], c1 = c0 + ev[1], c2 = c1 + ev[2], c3 = c2 + ev[3];
                    const float T0 = __int_as_float(__builtin_amdgcn_ds_bpermute(fr * 4, __float_as_int(c3))), T1 = __int_as_float(__builtin_amdgcn_ds_bpermute((fr + 16) * 4, __float_as_int(c3))),
                                T2 = __int_as_float(__builtin_amdgcn_ds_bpermute((fr + 32) * 4, __float_as_int(c3)));
                    const float off = (fq > 0 ? T0 : 0.f) + (fq > 1 ? T1 : 0.f) + (fq > 2 ? T2 : 0.f);
                    const float cs[4] = {off + c0, off + c1, off + c2, off + c3};
                    const int colp = 16 * nb + Pfr, c = 16 * nb + fr;
                    float ktl[4], nbet[4];
#pragma unroll
                    for (int i = 0; i < 4; ++i) { const int t = 4 * fq + i;
                        const float E1 = __expf(cs[i]); const float E2 = frcp(E1); const float E3 = E2 * __expf(ev[i]);
                        const float kap = kkv[i] * E3, bet = bv[i] * E1, kt = kdv[i] * E1, rt = rf[q][i] * E2;
                        KR[t * 64 + colp] = f2bf_fast(kap); KR[(16 + t) * 64 + colp] = f2bf_fast(rt);
                        BK[t * 64 + colp] = f2bf_fast(bet); BK[(16 + t) * 64 + colp] = f2bf_fast(kt);
                        ktl[i] = kt; nbet[i] = -bet;
                        if (i == 3 && fq == 3) ((LAS float*)(set + S4_PC))[c] = E2; }
                    v2u wk, wb; wk.x = pg8::cvt_pk_bf16(ktl[0], ktl[1]); wk.y = pg8::cvt_pk_bf16(ktl[2], ktl[3]);
                    wb.x = pg8::cvt_pk_bf16(nbet[0], nbet[1]); wb.y = pg8::cvt_pk_bf16(nbet[2], nbet[3]);
                    *(LAS v2u*)(KD + c * 16 + 4 * fq) = wk; *(LAS v2u*)(BT + c * 16 + 4 * fq) = wb;
                }
            }
#undef S4_PREFETCH
        } else {
            const int jv = lane >> 2, qv = lane & 3;
            v4u pv[3];
#define S4_PREFV(ch_) do { _Pragma("unroll") for (int s_ = 0; s_ < 3; ++s_) pv[s_] = *(const v4u*)(Z + (size_t)scan3_row(3 * (ch_) + s_, jv, dir, b) * ZC + C_V + h * 64 + half * 32 + qv * 8); } while (0)
            S4_PREFV(0);
            for (int iter = 0; iter < 50; ++iter) {
                __syncthreads();
                if (iter < 48) {
#pragma unroll
                    for (int s_ = 0; s_ < 3; ++s_) { LAS bf16_t* VTt = (LAS bf16_t*)(L + ((iter & 1) * 3 + s_) * S4_SET + S4_VT);
#pragma unroll
                        for (int e = 0; e < 4; ++e) { const unsigned w = e == 0 ? pv[s_].x : e == 1 ? pv[s_].y : e == 2 ? pv[s_].z : pv[s_].w;
                            VTt[(8 * qv + 2 * e) * 16 + jv] = (bf16_t)(w & 0xffffu); VTt[(8 * qv + 2 * e + 1) * 16 + jv] = (bf16_t)(w >> 16); } }
                    if (iter + 1 < 48) S4_PREFV(iter + 1);
                }
                if (iter >= 2) {
                    const int ch = iter - 2, buf = ch & 1;
                    for (int idx = lane; idx < 768; idx += 64) {
                        const int s_ = idx >> 8, j = (idx >> 4) & 15, v2 = (idx & 15) * 2; const int sc = 3 * ch + s_;
                        if (last && sc < 16) continue;
                        const LAS float* sy = (const LAS float*)(L + S4_SY + (buf * 3 + s_) * S4_SYSUB);
                        const int row = scan3_row(sc, j, dir, b);
                        *(unsigned*)(Y + ((size_t)dir * LR + row) * 512 + h * 64 + half * 32 + v2) = pk2(sy[v2 * 20 + j], sy[(v2 + 1) * 20 + j]);
                    }
                }
            }
#undef S4_PREFV
        }
    }
    __syncthreads();
}

constexpr int S5_KR = 0, S5_BK = 4608, S5_KD = 9216, S5_BT = 11776, S5_VT = 14336, S5_A = 16896, S5_PC = 18944, S5_SET = 19200;
constexpr int S5_SY = 6 * S5_SET, S5_SYSUB = 32 * 20 * 4;
__device__ __forceinline__ void ph_scan5(const Params& p, unsigned char* ldsb, int l, int wg, int nwg) {
    const int tid = otid(), lane = tid & 63;
    const int wv = __builtin_amdgcn_readfirstlane(tid >> 6);
    LAS unsigned char* L = (LAS unsigned char*)ldsb;
    const bf16_t* Z = (const bf16_t*)(p.ws + WS_Z);
    bf16_t* Y = (bf16_t*)(p.ws + WS_Y2);
    const bool last = (l == 1);
    for (int task = wg; task < 128; task += nwg) {
        const int b = task >> 4, h = (task >> 1) & 7, dir = task & 1;
        __syncthreads();
        if (wv <= 1) {
            const int half = wv;
            const int lane_c = otid() & 63;
            const int vcol = lane_c & 31, hi = lane_c >> 5;
            const int tt = vcol & 15; const bool isr = vcol >= 16;
            f32x16_t st0, st1;
#pragma unroll
            for (int r = 0; r < 16; ++r) { st0[r] = 0.f; st1[r] = 0.f; }
            for (int iter = 0; iter < 50; ++iter) {
                __syncthreads();
                if (iter < 1 || iter > 48) continue;
                const int buf = (iter - 1) & 1;
                bf16x8_t etf3[3], bdf3[3];
                int tto = tt; asm volatile("" : "+v"(tto));
#pragma unroll
                for (int sub = 0; sub < 3; ++sub) {
                    LAS unsigned char* set = L + (buf * 3 + sub) * S5_SET;
                    float gm[16];
                    { f32x16_t G;
#pragma unroll
                      for (int r = 0; r < 16; ++r) G[r] = 0.f;
#pragma unroll
                      for (int ks = 0; ks < 4; ++ks) { const bf16x8_t kq = *(const LAS bf16x8_t*)(set + S5_KR + vcol * 144 + (ks * 16 + 8 * hi) * 2), bkf = *(const LAS bf16x8_t*)(set + S5_BK + vcol * 144 + (ks * 16 + 8 * hi) * 2); G = MFMA32(bkf, kq, G); }
#pragma unroll
                      for (int r = 0; r < 16; ++r) { const int i = (r & 3) + 8 * ((r >> 2) & 1) + 4 * hi; const bool keep = isr ? (i <= tto) : (i < tto); gm[r] = keep ? G[r] : 0.f; } }
                    LAS float* Am = (LAS float*)(set + S5_A + half * 1024);
                    if (!isr) {
#pragma unroll
                        for (int r = 0; r < 8; ++r) { const int i = (r & 3) + 8 * (r >> 2) + 4 * hi; Am[i * 16 + tt] = gm[r]; } }
                    { v4u w; float ge[8];
#pragma unroll
                      for (int r = 0; r < 8; ++r) ge[r] = isr ? -gm[r] : 0.f;
                      w.x = pg8::cvt_pk_bf16(ge[0], ge[1]); w.y = pg8::cvt_pk_bf16(ge[2], ge[3]); w.z = pg8::cvt_pk_bf16(ge[4], ge[5]); w.w = pg8::cvt_pk_bf16(ge[6], ge[7]); etf3[sub] = __builtin_bit_cast(bf16x8_t, w);
                      w.x = pg8::cvt_pk_bf16(gm[8], gm[9]); w.y = pg8::cvt_pk_bf16(gm[10], gm[11]); w.z = pg8::cvt_pk_bf16(gm[12], gm[13]); w.w = pg8::cvt_pk_bf16(gm[14], gm[15]); bdf3[sub] = __builtin_bit_cast(bf16x8_t, w); }
                }
                S3_LDS_FENCE();
#pragma unroll 1
                for (int sub = 0; sub < 3; ++sub) {
                    LAS unsigned char* set = L + (buf * 3 + sub) * S5_SET;
                    bf16x8_t krf[4];
#pragma unroll
                    for (int ks = 0; ks < 4; ++ks) krf[ks] = *(const LAS bf16x8_t*)(set + S5_KR + vcol * 144 + (ks * 16 + 8 * hi) * 2);
                    LAS float* Am = (LAS float*)(set + S5_A + half * 1024);
                    const bf16x8_t etf = sub == 0 ? etf3[0] : sub == 1 ? etf3[1] : etf3[2], bdf = sub == 0 ? bdf3[0] : sub == 1 ? bdf3[1] : bdf3[2];
                    bf16x8_t sb[4];
                    { v4u w;
                      w.x = pg8::cvt_pk_bf16(st0[0], st0[1]); w.y = pg8::cvt_pk_bf16(st0[2], st0[3]); w.z = pg8::cvt_pk_bf16(st0[4], st0[5]); w.w = pg8::cvt_pk_bf16(st0[6], st0[7]); sb[0] = __builtin_bit_cast(bf16x8_t, w);
                      w.x = pg8::cvt_pk_bf16(st0[8], st0[9]); w.y = pg8::cvt_pk_bf16(st0[10], st0[11]); w.z = pg8::cvt_pk_bf16(st0[12], st0[13]); w.w = pg8::cvt_pk_bf16(st0[14], st0[15]); sb[1] = __builtin_bit_cast(bf16x8_t, w);
                      w.x = pg8::cvt_pk_bf16(st1[0], st1[1]); w.y = pg8::cvt_pk_bf16(st1[2], st1[3]); w.z = pg8::cvt_pk_bf16(st1[4], st1[5]); w.w = pg8::cvt_pk_bf16(st1[6], st1[7]); sb[2] = __builtin_bit_cast(bf16x8_t, w);
                      w.x = pg8::cvt_pk_bf16(st1[8], st1[9]); w.y = pg8::cvt_pk_bf16(st1[10], st1[11]); w.z = pg8::cvt_pk_bf16(st1[12], st1[13]); w.w = pg8::cvt_pk_bf16(st1[14], st1[15]); sb[3] = __builtin_bit_cast(bf16x8_t, w); }
                    f32x16_t acc;
#pragma unroll
                    for (int r = 0; r < 16; ++r) acc[r] = 0.f;
#pragma unroll
                    for (int ks = 0; ks < 4; ++ks) acc = MFMA32(krf[ks], sb[ks], acc);
#define S5_FRAG2(base_, row_) ({ const v2u a_ = *(const LAS v2u*)(set + (base_) + (row_) * 40 + 4 * hi * 2), c_ = *(const LAS v2u*)(set + (base_) + (row_) * 40 + (8 + 4 * hi) * 2); const v4u w_ = {a_.x, a_.y, c_.x, c_.y}; __builtin_bit_cast(bf16x8_t, w_); })
                    const bf16x8_t vtf = S5_FRAG2(S5_VT, half * 32 + vcol);
                    acc = MFMA32(bdf, vtf, acc);
                    float rhs[16];
#pragma unroll
                    for (int r = 0; r < 8; ++r) { auto rr = __builtin_amdgcn_permlane32_swap(__float_as_uint(acc[r]), __float_as_uint(acc[r]), false, false);
                        const int t0 = (r & 3) + 8 * (r >> 2); rhs[t0] = __uint_as_float(rr[0]); rhs[t0 + 4] = __uint_as_float(rr[1]); }
                    S3_LDS_FENCE();
                    float u[16];
#pragma unroll
                    for (int i = 0; i < 16; ++i) {
                        u[i] = rhs[i];
                        if (i < 15) {
                            const LAS float* ar = Am + i * 16;
                            const f32x4 a0 = *(const LAS f32x4*)(ar), a1 = *(const LAS f32x4*)(ar + 4), a2 = *(const LAS f32x4*)(ar + 8), a3 = *(const LAS f32x4*)(ar + 12);
                            const float av[16] = {a0[0], a0[1], a0[2], a0[3], a1[0], a1[1], a1[2], a1[3], a2[0], a2[1], a2[2], a2[3], a3[0], a3[1], a3[2], a3[3]};
#pragma unroll
                            for (int t = i + 1; t < 16; ++t) rhs[t] -= u[i] * av[t];
                        }
                    }
                    bf16x8_t ub;
                    { v4u w; w.x = pg8::cvt_pk_bf16(hi ? u[4] : u[0], hi ? u[5] : u[1]); w.y = pg8::cvt_pk_bf16(hi ? u[6] : u[2], hi ? u[7] : u[3]);
                      w.z = pg8::cvt_pk_bf16(hi ? u[12] : u[8], hi ? u[13] : u[9]); w.w = pg8::cvt_pk_bf16(hi ? u[14] : u[10], hi ? u[15] : u[11]); ub = __builtin_bit_cast(bf16x8_t, w); }
                    acc = MFMA32(etf, ub, acc);
                    { LAS float* sy = (LAS float*)(L + S5_SY + ((buf * 3 + sub) * 2 + half) * S5_SYSUB) + vcol * 20;
                      *(LAS f32x4*)(sy + 4 * hi) = (f32x4){acc[8], acc[9], acc[10], acc[11]};
                      *(LAS f32x4*)(sy + 8 + 4 * hi) = (f32x4){acc[12], acc[13], acc[14], acc[15]}; }
                    { const bf16x8_t kd0 = S5_FRAG2(S5_KD, vcol), kd1 = S5_FRAG2(S5_KD, 32 + vcol), bt0 = S5_FRAG2(S5_BT, vcol), bt1 = S5_FRAG2(S5_BT, 32 + vcol);
                      st0 = MFMA32(kd0, vtf, st0); st0 = MFMA32(bt0, ub, st0);
                      st1 = MFMA32(kd1, vtf, st1); st1 = MFMA32(bt1, ub, st1); }
#undef S5_FRAG2
#pragma unroll
                    for (int g = 0; g < 4; ++g) {
                        const f32x4 p0 = *(const LAS f32x4*)((const LAS float*)(set + S5_PC) + 8 * g + 4 * hi), p1 = *(const LAS f32x4*)((const LAS float*)(set + S5_PC) + 32 + 8 * g + 4 * hi);
#pragma unroll
                        for (int e = 0; e < 4; ++e) { st0[4 * g + e] *= p0[e]; st1[4 * g + e] *= p1[e]; }
                    }
                }
            }
        } else {
            const int lane = otid() & 63;
            const int fr = lane & 15, fq = lane >> 4, hp = wv - 2, sub = hp >> 1, chh = hp & 1;
            float w0c[2], a0c[2], kac[2], kkc4[4];
            bf16x8_t Bw[2][2], Ba[2][2];
#pragma unroll
            for (int nb = 0; nb < 4; ++nb) kkc4[nb] = p.rw_k_k[l * 512 + h * 64 + nb * 16 + fr];
#pragma unroll
            for (int q = 0; q < 2; ++q) { const int cch = h * 64 + (2 * chh + q) * 16 + fr;
                w0c[q] = p.rw_w0[(l * 2 + dir) * 512 + cch]; a0c[q] = p.rw_a0[(l * 2 + dir) * 512 + cch]; kac[q] = p.rw_k_a[l * 512 + cch];
#pragma unroll
                for (int ks = 0; ks < 2; ++ks) {
                    Bw[q][ks] = *(const bf16x8_t*)((const bf16_t*)(p.ws + WS_LW_T) + ((size_t)(dir * 512 + cch) * 64 + 8 * fq + 32 * ks));
                    Ba[q][ks] = *(const bf16x8_t*)((const bf16_t*)(p.ws + WS_LA_T) + ((size_t)(dir * 512 + cch) * 64 + 8 * fq + 32 * ks)); } }
            const int Pfr = (fr & 3) | ((fr & 4) << 1) | ((fr & 8) >> 1);
            const int jv = lane >> 2, qv = lane & 3;
            v4u plw[2], pla[2], pvv, pkf[2], prf;
            bf16x8_t Idm[2];
#pragma unroll
            for (int o_ = 0; o_ < 2; ++o_) { const int jsel = 16 * o_ + fr - 8 * fq; v4u w = {0u, 0u, 0u, 0u};
                if (jsel >= 0 && jsel < 8) { const unsigned one = (jsel & 1) ? 0x3f800000u : 0x00003f80u; if ((jsel >> 1) == 0) w.x = one; else if ((jsel >> 1) == 1) w.y = one; else if ((jsel >> 1) == 2) w.z = one; else w.w = one; }
                Idm[o_] = __builtin_bit_cast(bf16x8_t, w); }
#define S5_PREFETCH(sc_) do { const bf16_t* za_ = Z + (size_t)scan3_row((sc_), fr, dir, b) * ZC; \
                _Pragma("unroll") for (int ks_ = 0; ks_ < 2; ++ks_) { plw[ks_] = *(const v4u*)(za_ + C_LW + dir * 64 + 8 * fq + 32 * ks_); pla[ks_] = *(const v4u*)(za_ + C_LA + dir * 64 + 8 * fq + 32 * ks_); \
                    pkf[ks_] = *(const v4u*)(za_ + C_K + h * 64 + 8 * fq + 32 * ks_); } \
                prf = *(const v4u*)(za_ + C_R + h * 64 + 8 * fq + 32 * chh); \
                pvv = *(const v4u*)(Z + (size_t)scan3_row((sc_), jv, dir, b) * ZC + C_V + h * 64 + chh * 32 + qv * 8); } while (0)
            S5_PREFETCH(sub);
            for (int iter = 0; iter < 50; ++iter) {
                __syncthreads();
                if (iter >= 2) {
                    const int ch = iter - 2, buf = ch & 1, sc = 3 * ch + sub;
                    if (!(last && sc < 16)) {
                        const LAS float* sy = (const LAS float*)(L + S5_SY + ((buf * 3 + sub) * 2 + chh) * S5_SYSUB);
#pragma unroll
                        for (int k4 = 0; k4 < 4; ++k4) { const int idx = lane + 64 * k4, j = idx >> 4, v2 = (idx & 15) * 2;
                            const int row = scan3_row(sc, j, dir, b);
                            *(unsigned*)(Y + ((size_t)dir * LR + row) * 512 + h * 64 + chh * 32 + v2) = pk2(sy[v2 * 20 + j], sy[(v2 + 1) * 20 + j]); }
                    }
                }
                if (iter >= 48) continue;
                LAS unsigned char* set = L + ((iter & 1) * 3 + sub) * S5_SET;
                bf16x8_t aw[2], aa[2];
#pragma unroll
                for (int ks = 0; ks < 2; ++ks) { aw[ks] = __builtin_bit_cast(bf16x8_t, plw[ks]); aa[ks] = __builtin_bit_cast(bf16x8_t, pla[ks]); }
                f32x4 kf[4], rf[2];
                { const f32x4 z4 = {0.f, 0.f, 0.f, 0.f};
#pragma unroll
                  for (int nb = 0; nb < 4; ++nb) kf[nb] = MFMA16(__builtin_bit_cast(bf16x8_t, pkf[nb >> 1]), Idm[nb & 1], z4);
#pragma unroll
                  for (int q = 0; q < 2; ++q) rf[q] = MFMA16(__builtin_bit_cast(bf16x8_t, prf), Idm[q], z4); }
                { LAS bf16_t* VTt = (LAS bf16_t*)(set + S5_VT);
#pragma unroll
                  for (int e = 0; e < 4; ++e) { const unsigned w = e == 0 ? pvv.x : e == 1 ? pvv.y : e == 2 ? pvv.z : pvv.w;
                      VTt[(chh * 32 + 8 * qv + 2 * e) * 20 + jv] = (bf16_t)(w & 0xffffu); VTt[(chh * 32 + 8 * qv + 2 * e + 1) * 20 + jv] = (bf16_t)(w >> 16); } }
                if (iter + 1 < 48) S5_PREFETCH(3 * (iter + 1) + sub);
                f32x4 accw[2], acca[2];
#pragma unroll
                for (int q = 0; q < 2; ++q) { accw[q] = (f32x4){0.f, 0.f, 0.f, 0.f}; acca[q] = (f32x4){0.f, 0.f, 0.f, 0.f}; }
#pragma unroll
                for (int ks = 0; ks < 2; ++ks)
#pragma unroll
                    for (int q = 0; q < 2; ++q) { accw[q] = MFMA16(aw[ks], Bw[q][ks], accw[q]); acca[q] = MFMA16(aa[ks], Ba[q][ks], acca[q]); }
                float rnv[4];
#pragma unroll
                for (int i = 0; i < 4; ++i) { float ss = 0.f;
#pragma unroll
                    for (int nb = 0; nb < 4; ++nb) { const float t_ = kf[nb][i] * kkc4[nb]; ss += t_ * t_; }
                    rnv[i] = rsqrtf(fmaxf(row16_sum(ss), 1e-12f)); }
                LAS bf16_t* KR = (LAS bf16_t*)(set + S5_KR); LAS bf16_t* BK = (LAS bf16_t*)(set + S5_BK);
                LAS bf16_t* KD = (LAS bf16_t*)(set + S5_KD); LAS bf16_t* BT = (LAS bf16_t*)(set + S5_BT);
#pragma unroll
                for (int q = 0; q < 2; ++q) { const int nb = 2 * chh + q;
                    float ev[4], kkv[4], bv[4], kdv[4];
#pragma unroll
                    for (int i = 0; i < 4; ++i) {
                        const float wl = accw[q][i] + w0c[q], al = acca[q][i] + a0c[q];
                        ev[i] = 0.60653065971f * frcp(1.f + __expf(-wl));
                        const float a = frcp(1.f + __expf(-al));
                        const float k = kf[nb][i];
                        kkv[i] = k * kkc4[nb] * rnv[i]; bv[i] = kkv[i] * a; kdv[i] = k * (1.f + (a - 1.f) * kac[q]); }
                    const float c0 = ev[0], c1 = c0 + ev[1], c2 = c1 + ev[2], c3 = c2 + ev[3];
                    const float T0 = __int_as_float(__builtin_amdgcn_ds_bpermute(fr * 4, __float_as_int(c3))), T1 = __int_as_float(__builtin_amdgcn_ds_bpermute((fr + 16) * 4, __float_as_int(c3))),
                                T2 = __int_as_float(__builtin_amdgcn_ds_bpermute((fr + 32) * 4, __float_as_int(c3)));
                    const float off = (fq > 0 ? T0 : 0.f) + (fq > 1 ? T1 : 0.f) + (fq > 2 ? T2 : 0.f);
                    const float cs[4] = {off + c0, off + c1, off + c2, off + c3};
                    const int colp = 16 * nb + Pfr, c = 16 * nb + fr;
                    float ktl[4], nbet[4];
                    float E2p = 0.f;
#pragma unroll
                    for (int i = 0; i < 4; ++i) { const int t = 4 * fq + i;
                        const float E1 = __expf(cs[i]); const float E2 = frcp(E1); const float E3 = (i == 0) ? E2 * __expf(ev[0]) : E2p; E2p = E2;
                        const float kap = kkv[i] * E3, bet = bv[i] * E1, kt = kdv[i] * E1, rt = rf[q][i] * E2;
                        KR[t * 72 + colp] = f2bf_fast(kap); KR[(16 + t) * 72 + colp] = f2bf_fast(rt);
                        BK[t * 72 + colp] = f2bf_fast(bet); BK[(16 + t) * 72 + colp] = f2bf_fast(kt);
                        ktl[i] = kt; nbet[i] = -bet;
                        if (i == 3 && fq == 3) ((LAS float*)(set + S5_PC))[c] = E2; }
                    v2u wk, wb; wk.x = pg8::cvt_pk_bf16(ktl[0], ktl[1]); wk.y = pg8::cvt_pk_bf16(ktl[2], ktl[3]);
                    wb.x = pg8::cvt_pk_bf16(nbet[0], nbet[1]); wb.y = pg8::cvt_pk_bf16(nbet[2], nbet[3]);
                    *(LAS v2u*)(KD + c * 20 + 4 * fq) = wk; *(LAS v2u*)(BT + c * 20 + 4 * fq) = wb;
                }
            }
#undef S5_PREFETCH
        }
    }
    __syncthreads();
}
__device__ __forceinline__ void na_block(const bf16_t* kbase, const bf16x8_t (&qf)[2], bool lat, int dr31, int c0, int jq, int cs, const LAS float* rp,
                                         int fr, int fq, float (&pv)[4], float& lsum) {
    const bf16x8_t k0 = *(const bf16x8_t*)(kbase + (size_t)fr * ZC + 8 * fq), k1 = *(const bf16x8_t*)(kbase + (size_t)fr * ZC + 8 * fq + 32);
    float ss = 0.f;
#pragma unroll
    for (int e = 0; e < 8; ++e) { const float a = bf2f((bf16_t)k0[e]), b = bf2f((bf16_t)k1[e]); ss += a * a + b * b; }
    ss += swz_xor<16>(ss); ss = xor32_add(ss);
    const float rk = rsqrtf(ss * (1.f / 64.f) + RMS_EPS);
    f32x4 st = {0.f, 0.f, 0.f, 0.f};
    st = __builtin_amdgcn_mfma_f32_16x16x32_bf16(k0, qf[0], st, 0, 0, 0);
    st = __builtin_amdgcn_mfma_f32_16x16x32_bf16(k1, qf[1], st, 0, 0, 0);
#pragma unroll
    for (int i = 0; i < 4; ++i) {
        const float rki = __int_as_float(__builtin_amdgcn_ds_bpermute((4 * fq + i) * 4, __float_as_int(rk)));
        float x = st[i] * rki;
        if (lat) { const int c = c0 + 4 * fq + i; const bool valid = (c >= cs) && (c < cs + 16);
            const int di = min(max(c - jq + 15, 0), 30);
            x = valid ? __expf(fminf(x + rp[dr31 + di], 80.f)) : 0.f; }
        else x = __expf(fminf(x, 80.f));
        pv[i] = x; lsum += x;
    }
}
__device__ __forceinline__ void ph_natt2(const Params& p, unsigned char* ldsb, int l, int wg, int nwg) {
    const int tid = otid(), lane = tid & 63, wv = tid >> 6, fr = lane & 15, fq = lane >> 4;
    LAS float* rp = (LAS float*)ldsb + wv * 512;
    const bf16_t* Z = (const bf16_t*)(p.ws + WS_Z); const bf16_t* VT = (const bf16_t*)(p.ws + WS_VT); bf16_t* YB = (bf16_t*)(p.ws + WS_YB);
    const bool last = (l == 1);
    const int nunits = last ? 8192 : 9216;
    float gsc[2][8];
#pragma unroll
    for (int ks = 0; ks < 2; ++ks)
#pragma unroll
        for (int j = 0; j < 8; ++j) { const int d = 8 * fq + j + 32 * ks; gsc[ks][j] = p.na_q_g[l * 64 + d] * p.na_k_g[l * 64 + d] * 0.125f; }
    int cur_h = -1;
    for (int unit = wg * 8 + wv; unit < nunits; unit += nwg * 8) {
        int b, h, i = 0, qb, qrow0; bool isl;
        if (unit < 8192) { b = unit >> 10; h = (unit >> 7) & 7; i = (unit >> 2) & 31; qb = unit & 3; isl = true; qrow0 = b * SEQ + i * 64 + qb * 16; }
        else { const int u2 = unit - 8192; b = u2 >> 7; h = (u2 >> 4) & 7; qb = u2 & 15; isl = false; qrow0 = NLAT + b * CTXL + qb * 16; }
        if (h != cur_h) { for (int idx = lane; idx < 465; idx += 64) rp[idx] = p.na_rpb[(size_t)(l * 8 + h) * 465 + idx]; cur_h = h; }
        bf16x8_t qf[2];
        { const bf16_t* qp = Z + (size_t)(qrow0 + fr) * ZC + C_Q + h * 64 + 8 * fq;
          const bf16x8_t q0 = *(const bf16x8_t*)qp, q1 = *(const bf16x8_t*)(qp + 32);
          float f0[8], f1[8]; float ss = 0.f;
#pragma unroll
          for (int e = 0; e < 8; ++e) { f0[e] = bf2f((bf16_t)q0[e]); f1[e] = bf2f((bf16_t)q1[e]); ss += f0[e] * f0[e] + f1[e] * f1[e]; }
          ss += swz_xor<16>(ss); ss = xor32_add(ss);
          const float rq = rsqrtf(ss * (1.f / 64.f) + RMS_EPS);
#pragma unroll
          for (int e = 0; e < 8; ++e) { qf[0][e] = (short)f2bf(f0[e] * rq * gsc[0][e]); qf[1][e] = (short)f2bf(f1[e] * rq * gsc[1][e]); } }
        f32x4 o[4];
#pragma unroll
        for (int db = 0; db < 4; ++db) o[db] = (f32x4){0.f, 0.f, 0.f, 0.f};
        float lsum = 0.f;
        const bf16_t* vtb = VT + ((size_t)((b * 8 + h) * 64 + fr)) * 2304 + 4 * fq;
        const int jq = qb * 16 + fr, cs = min(max(jq - 8, 0), 48);
        const int r0 = min(max(i - 4, 0), 24);
        const int kb_lo = (qb <= 1) ? 0 : qb - 1, nkb = (qb == 0 || qb == 3) ? 2 : 3;
        const int nlat = isl ? 8 * nkb : 0, ntot = nlat + 16;
        for (int t = 0; t < ntot; t += 2) {
            float pa[4], pb[4]; int tposA, tposB;
            { const int tt = t; const bool lt = tt < nlat; int krow, dr31 = 0, c0 = 0;
              if (lt) { const int a = tt / nkb, kb = kb_lo + tt % nkb; krow = b * SEQ + (r0 + a) * 64 + 16 * kb; tposA = 256 + (r0 + a) * 64 + 16 * kb; dr31 = (r0 + a - i + 7) * 31; c0 = 16 * kb; }
              else { const int cbk = tt - nlat; krow = NLAT + b * CTXL + 16 * cbk; tposA = 16 * cbk; }
              na_block(Z + (size_t)krow * ZC + C_KB + h * 64, qf, lt, dr31, c0, jq, cs, rp, fr, fq, pa, lsum); }
            { const int tt = t + 1; const bool lt = tt < nlat; int krow, dr31 = 0, c0 = 0;
              if (lt) { const int a = tt / nkb, kb = kb_lo + tt % nkb; krow = b * SEQ + (r0 + a) * 64 + 16 * kb; tposB = 256 + (r0 + a) * 64 + 16 * kb; dr31 = (r0 + a - i + 7) * 31; c0 = 16 * kb; }
              else { const int cbk = tt - nlat; krow = NLAT + b * CTXL + 16 * cbk; tposB = 16 * cbk; }
              na_block(Z + (size_t)krow * ZC + C_KB + h * 64, qf, lt, dr31, c0, jq, cs, rp, fr, fq, pb, lsum); }
            bf16x8_t pf;
            pf[0] = (short)f2bf(pa[0]); pf[1] = (short)f2bf(pa[1]); pf[2] = (short)f2bf(pa[2]); pf[3] = (short)f2bf(pa[3]);
            pf[4] = (short)f2bf(pb[0]); pf[5] = (short)f2bf(pb[1]); pf[6] = (short)f2bf(pb[2]); pf[7] = (short)f2bf(pb[3]);
#pragma unroll
            for (int db = 0; db < 4; ++db) {
                typedef short s16x4_t __attribute__((ext_vector_type(4)));
                const s16x4_t va = *(const s16x4_t*)(vtb + (size_t)db * 16 * 2304 + tposA), vb = *(const s16x4_t*)(vtb + (size_t)db * 16 * 2304 + tposB);
                const bf16x8_t vf = {va[0], va[1], va[2], va[3], vb[0], vb[1], vb[2], vb[3]};
                o[db] = __builtin_amdgcn_mfma_f32_16x16x32_bf16(pf, vf, o[db], 0, 0, 0);
            }
        }
        lsum += swz_xor<16>(lsum); lsum = xor32_add(lsum);
        const float linv = 1.f / lsum;
#pragma unroll
        for (int i2 = 0; i2 < 4; ++i2) {
            const float li = __int_as_float(__builtin_amdgcn_ds_bpermute((4 * fq + i2) * 4, __float_as_int(linv)));
            bf16_t* yp = YB + (size_t)(qrow0 + 4 * fq + i2) * 512 + h * 64 + fr;
#pragma unroll
            for (int db = 0; db < 4; ++db) yp[db * 16] = f2bf(o[db][i2] * li);
        }
    }
}

typedef short s16x4_t __attribute__((ext_vector_type(4)));
__device__ __forceinline__ void na_soft(const f32x4 st, const float (&rki)[4], bool lat, int dr31, int c0, int jq, int cs, const LAS float* rp, int fq, float (&pv)[4], float& lsum) {
    if (lat) {
        float bi[4];
#pragma unroll
        for (int i = 0; i < 4; ++i) { const int c = c0 + i; bi[i] = rp[dr31 + min(max(c - jq + 15, 0), 30)]; }
#pragma unroll
        for (int i = 0; i < 4; ++i) { const int c = c0 + i; const bool valid = (c >= cs) && (c < cs + 16);
            const float x = valid ? fminf(st[i] * rki[i] + bi[i], 80.f) : -1e30f;
            const float e = __expf(x); pv[i] = e; lsum += e; }
    } else {
#pragma unroll
        for (int i = 0; i < 4; ++i) { const float e = __expf(fminf(st[i] * rki[i], 80.f)); pv[i] = e; lsum += e; }
    }
}
__device__ __forceinline__ void ph_natt3(const Params& p, unsigned char* ldsb, int l, int wg, int nwg) {
    const int wv = otid() >> 6;
    LAS unsigned char* L = (LAS unsigned char*)ldsb;
    LAS bf16_t* sK = (LAS bf16_t*)(L + 0);
    LAS bf16_t* sVT = (LAS bf16_t*)(L + 36864);
    LAS float* sRK = (LAS float*)(L + 70656);
    LAS float* rp = (LAS float*)(L + 71680);
    LAS float* sG = (LAS float*)(L + 73728);
    const bf16_t* Z = (const bf16_t*)(p.ws + WS_Z); const bf16_t* VT = (const bf16_t*)(p.ws + WS_VT); bf16_t* YB = (bf16_t*)(p.ws + WS_YB);
    const bool last = (l == 1);
    const int per = (256 + nwg - 1) / nwg;
    int staged = -1;
    for (int tk = 0; tk < per; ++tk) {
        const int task = wg * per + tk; if (task >= 256) break;
        const int b = task >> 5, h = (task >> 2) & 7, quarter = task & 3;
        const int tid = otid();
        __syncthreads();
        if ((task >> 2) != staged) {
        staged = task >> 2;
#pragma unroll
        for (int it = 0; it < 4; ++it) { const int pc = tid + 512 * it, key = pc >> 3, q = pc & 7;
            const v4u kw = *(const v4u*)(Z + (size_t)(NLAT + b * CTXL + key) * ZC + C_KB + h * 64 + 8 * q);
            *(LAS v4u*)(sK + key * 72 + 8 * q) = kw;
            float f[8]; unpack8(kw, f); float ss = 0.f;
#pragma unroll
            for (int e = 0; e < 8; ++e) ss += f[e] * f[e];
            ss += swz_xor<1>(ss); ss += swz_xor<2>(ss); ss += swz_xor<4>(ss);
            if (q == 0) sRK[key] = rsqrtf(ss * (1.f / 64.f) + RMS_EPS);
            const int d = pc >> 5, q2 = pc & 31;
            *(LAS v4u*)(sVT + d * 264 + 8 * q2) = *(const v4u*)(VT + ((size_t)((b * 8 + h) * 64 + d)) * 2304 + 8 * q2); }
        if (tid < 465) rp[tid] = p.na_rpb[(size_t)(l * 8 + h) * 465 + tid];
        if (tid < 64) sG[tid] = p.na_q_g[l * 64 + tid] * p.na_k_g[l * 64 + tid] * 0.125f;
        }
        __syncthreads();
        const int nun = last ? 32 : 36;
        for (int u = wv; u < nun; u += 8) {
            const int lane2 = otid() & 63, fr = lane2 & 15, fq = lane2 >> 4;
            const bool isl = u < 32;
            const int i = 8 * quarter + (u >> 2), qb = isl ? (u & 3) : (4 * quarter + (u - 32));
            const int qrow0 = isl ? (b * SEQ + i * 64 + qb * 16) : (NLAT + b * CTXL + qb * 16);
            bf16x8_t qf[2];
            { const bf16_t* qp = Z + (size_t)(qrow0 + fr) * ZC + C_Q + h * 64 + 8 * fq;
              const bf16x8_t q0 = *(const bf16x8_t*)qp, q1 = *(const bf16x8_t*)(qp + 32);
              float f0[8], f1[8]; float ss = 0.f;
#pragma unroll
              for (int e = 0; e < 8; ++e) { f0[e] = bf2f((bf16_t)q0[e]); f1[e] = bf2f((bf16_t)q1[e]); ss += f0[e] * f0[e] + f1[e] * f1[e]; }
              ss += swz_xor<16>(ss); ss = xor32_add(ss);
              const float rq = rsqrtf(ss * (1.f / 64.f) + RMS_EPS);
              const f32x4 g00 = *(const LAS f32x4*)(sG + 8 * fq), g01 = *(const LAS f32x4*)(sG + 8 * fq + 4), g10 = *(const LAS f32x4*)(sG + 32 + 8 * fq), g11 = *(const LAS f32x4*)(sG + 36 + 8 * fq);
#pragma unroll
              for (int e = 0; e < 4; ++e) { f0[e] *= rq * g00[e]; f0[4 + e] *= rq * g01[e]; f1[e] *= rq * g10[e]; f1[4 + e] *= rq * g11[e]; }
              v4u w0, w1; w0.x = pg8::cvt_pk_bf16(f0[0], f0[1]); w0.y = pg8::cvt_pk_bf16(f0[2], f0[3]); w0.z = pg8::cvt_pk_bf16(f0[4], f0[5]); w0.w = pg8::cvt_pk_bf16(f0[6], f0[7]);
              w1.x = pg8::cvt_pk_bf16(f1[0], f1[1]); w1.y = pg8::cvt_pk_bf16(f1[2], f1[3]); w1.z = pg8::cvt_pk_bf16(f1[4], f1[5]); w1.w = pg8::cvt_pk_bf16(f1[6], f1[7]);
              qf[0] = __builtin_bit_cast(bf16x8_t, w0); qf[1] = __builtin_bit_cast(bf16x8_t, w1); }
            f32x4 o[4];
#pragma unroll
            for (int db = 0; db < 4; ++db) o[db] = (f32x4){0.f, 0.f, 0.f, 0.f};
            float lsum = 0.f;
            const bf16_t* vtb = VT + ((size_t)((b * 8 + h) * 64 + fr)) * 2304 + 4 * fq;
            const int jq = qb * 16 + fr, cs = min(max(jq - 8, 0), 48);
            const int r0 = min(max(i - 4, 0), 24);
            const int c0 = (qb == 0) ? 0 : (qb == 1) ? 8 : (qb == 2) ? 24 : 32;
            const int krow_in = 8 * (fr >> 2) + (fr & 3);
#define NA_LOAD(a_, KA_, KB_, V_) do { const int tok_ = (r0 + (a_)) * 64 + c0; \
                const bf16_t* kp_ = Z + (size_t)(b * SEQ + tok_ + krow_in) * ZC + C_KB + h * 64 + 8 * fq; KA_[0] = *(const bf16x8_t*)kp_; KA_[1] = *(const bf16x8_t*)(kp_ + 32); \
                KB_[0] = *(const bf16x8_t*)(kp_ + 4 * ZC); KB_[1] = *(const bf16x8_t*)(kp_ + 4 * ZC + 32); \
                _Pragma("unroll") for (int db_ = 0; db_ < 4; ++db_) V_[db_] = *(const bf16x8_t*)(VT + ((size_t)((b * 8 + h) * 64 + 16 * db_ + fr)) * 2304 + 256 + tok_ + 8 * fq); } while (0)
#define NA_SCORE_LAT(a_, K_, cofs_, P_) do { \
                float ss_ = 0.f; _Pragma("unroll") for (int e_ = 0; e_ < 8; ++e_) { const float x_ = bf2f((bf16_t)K_[0][e_]), y_ = bf2f((bf16_t)K_[1][e_]); ss_ += x_ * x_ + y_ * y_; } \
                ss_ += swz_xor<16>(ss_); ss_ = xor32_add(ss_); const float rk_ = rsqrtf(ss_ * (1.f / 64.f) + RMS_EPS); \
                f32x4 st_ = {0.f, 0.f, 0.f, 0.f}; st_ = __builtin_amdgcn_mfma_f32_16x16x32_bf16(K_[0], qf[0], st_, 0, 0, 0); st_ = __builtin_amdgcn_mfma_f32_16x16x32_bf16(K_[1], qf[1], st_, 0, 0, 0); \
                float rki_[4]; _Pragma("unroll") for (int i_ = 0; i_ < 4; ++i_) rki_[i_] = __int_as_float(__builtin_amdgcn_ds_bpermute((4 * fq + i_) * 4, __float_as_int(rk_))); \
                na_soft(st_, rki_, true, (r0 + (a_) - i + 7) * 31, c0 + (cofs_) + 8 * fq, jq, cs, rp, fq, P_, lsum); } while (0)
#define NA_PV(PA_, PB_, V_) do { v4u pw_; pw_.x = pg8::cvt_pk_bf16(PA_[0], PA_[1]); pw_.y = pg8::cvt_pk_bf16(PA_[2], PA_[3]); pw_.z = pg8::cvt_pk_bf16(PB_[0], PB_[1]); pw_.w = pg8::cvt_pk_bf16(PB_[2], PB_[3]); \
                const bf16x8_t pf_ = __builtin_bit_cast(bf16x8_t, pw_); \
                _Pragma("unroll") for (int db_ = 0; db_ < 4; ++db_) o[db_] = __builtin_amdgcn_mfma_f32_16x16x32_bf16(pf_, V_[db_], o[db_], 0, 0, 0); } while (0)
#define NA_CTX_LOAD(sidx_) do { \
                _Pragma("unroll") for (int hb = 0; hb < 2; ++hb) { const int key = 32 * (sidx_) + krow_in + 4 * hb; \
                    ck[hb][0] = *(const LAS bf16x8_t*)(sK + key * 72 + 8 * fq); ck[hb][1] = *(const LAS bf16x8_t*)(sK + key * 72 + 8 * fq + 32); \
                    crk[hb] = *(const LAS f32x4*)(sRK + 32 * (sidx_) + 8 * fq + 4 * hb); } \
                _Pragma("unroll") for (int db = 0; db < 4; ++db) cv[db] = *(const LAS bf16x8_t*)(sVT + (16 * db + fr) * 264 + 32 * (sidx_) + 8 * fq); } while (0)
#define NA_CTX_COMPUTE() do { float pa_[4], pb_[4]; \
                _Pragma("unroll") for (int hb = 0; hb < 2; ++hb) { \
                    f32x4 st = {0.f, 0.f, 0.f, 0.f}; \
                    st = __builtin_amdgcn_mfma_f32_16x16x32_bf16(ck[hb][0], qf[0], st, 0, 0, 0); st = __builtin_amdgcn_mfma_f32_16x16x32_bf16(ck[hb][1], qf[1], st, 0, 0, 0); \
                    const float rki[4] = {crk[hb][0], crk[hb][1], crk[hb][2], crk[hb][3]}; \
                    if (hb == 0) na_soft(st, rki, false, 0, 0, 0, 0, rp, fq, pa_, lsum); else na_soft(st, rki, false, 0, 0, 0, 0, rp, fq, pb_, lsum); } \
                NA_PV(pa_, pb_, cv); } while (0)
            bf16x8_t ck[2][2], cv[4]; f32x4 crk[2];
            if (isl) {
                bf16x8_t kA[2][2], kB[2][2], vv[2][4];
                NA_LOAD(0, kA[0], kB[0], vv[0]);
#pragma unroll 1
                for (int s2 = 0; s2 < 8; s2 += 2) {
#pragma unroll
                    for (int si = 0; si < 2; ++si) { const int sidx = s2 + si;
                        if (sidx + 1 < 8) NA_LOAD(sidx + 1, kA[si ^ 1], kB[si ^ 1], vv[si ^ 1]);
                        NA_CTX_LOAD(sidx);
                        __builtin_amdgcn_sched_barrier(0);
                        float pa[4], pb[4];
                        NA_SCORE_LAT(sidx, kA[si], 0, pa); NA_SCORE_LAT(sidx, kB[si], 4, pb);
                        NA_PV(pa, pb, vv[si]);
                        __builtin_amdgcn_sched_barrier(0);
                        NA_CTX_COMPUTE();
                        __builtin_amdgcn_sched_barrier(0);
                    }
                }
            } else {
#pragma unroll 1
                for (int sidx = 0; sidx < 8; ++sidx) { NA_CTX_LOAD(sidx); __builtin_amdgcn_sched_barrier(0); NA_CTX_COMPUTE(); }
            }
#undef NA_CTX_LOAD
#undef NA_CTX_COMPUTE
#undef NA_LOAD
#undef NA_SCORE_LAT
#undef NA_PV
            lsum += swz_xor<16>(lsum); lsum = xor32_add(lsum);
            const float linv = 1.f / lsum;
#pragma unroll
            for (int i2 = 0; i2 < 4; ++i2) {
                const float li = __int_as_float(__builtin_amdgcn_ds_bpermute((4 * fq + i2) * 4, __float_as_int(linv)));
                bf16_t* yp = YB + (size_t)(qrow0 + 4 * fq + i2) * 512 + h * 64 + fr;
#pragma unroll
                for (int db = 0; db < 4; ++db) yp[db * 16] = f2bf(o[db][i2] * li);
            }
        }
    }
    __syncthreads();
}

__device__ __forceinline__ void ph_convert_moe(const Params& p, unsigned char* ldsb, int l, int wg, int nwg);
__device__ __forceinline__ void ph_scan_natt(const Params& p, unsigned char* ldsb, int l, int wg, int nwg) {
    const int hs_ = nwg >> 1;
    if (nwg < 2) { ph_scan5(p, ldsb, l, 0, 1); __syncthreads(); ph_natt3(p, ldsb, l, 0, 1); ph_convert_moe(p, ldsb, l, 0, 1); }
    else if (wg < hs_) ph_scan5(p, ldsb, l, wg, hs_);
    else { ph_natt3(p, ldsb, l, wg - hs_, nwg - hs_); ph_convert_moe(p, ldsb, l, wg - hs_, nwg - hs_); }
}

__device__ __forceinline__ void ph_rwkvout(const Params& p, float* sm, int l, int wg, int nwg) {
    const bf16_t* Z = (const bf16_t*)(p.ws + WS_Z);
    const bf16_t* Y2 = (const bf16_t*)(p.ws + WS_Y2);
    bf16_t* OA = (bf16_t*)(p.ws + WS_OUTA);
    const int c = otid(); const int nrows = (l == 1) ? NLAT : LR;
    const float lng = p.rw_ln_g[l * 512 + c], lnb = p.rw_ln_b[l * 512 + c], rk = p.rw_r_k[l * 512 + c];
    const float* glb = p.rw_g_lora_b + (size_t)l * 128 * 512 + c;
    for (int r = wg; r < nrows; r += nwg) {
        __syncthreads();
        if (c < 128) sm[c] = sigmoidf_(bf2f(Z[(size_t)r * ZC + C_LG + c]));
        __syncthreads();
        const float yv = bf2f(Y2[(size_t)r * 512 + c]) + bf2f(Y2[((size_t)LR + r) * 512 + c]);
        const float mu = wave_sum(yv) * (1.f / 64.f); const float d = yv - mu; const float var = wave_sum(d * d) * (1.f / 64.f);
        const float yn = d * rsqrtf(var + GN_EPS) * lng + lnb;
        const float rr = bf2f(Z[(size_t)r * ZC + C_R + c]), kk = bf2f(Z[(size_t)r * ZC + C_K + c]), vv = bf2f(Z[(size_t)r * ZC + C_V + c]);
        const float bon = wave_sum(rr * kk * rk) * vv;
        float g = 0.f;
#pragma unroll 4
        for (int j = 0; j < 128; ++j) g += sm[j] * glb[(size_t)j * 512];
        OA[(size_t)r * 512 + c] = f2bf((yn + bon) * g);
    }
}

struct EpiOutA {
    static constexpr bool PERM = true, AFTER_DRAIN = false;
    const bf16_t* PRE; bf16_t* OA;
    __device__ __forceinline__ void operator()(const f32x4 (&acc)[2][2][4][2], const pg8::Unit& u, int wr, int wc, int fr, int fq) const {
        const int row0 = u.pm * 256 + wr * 64 + fr, colb = u.pn * 256 + wc * 32 + 8 * fq;
#pragma unroll
        for (int ai = 0; ai < 2; ++ai)
#pragma unroll
            for (int bj = 0; bj < 2; ++bj) { const int col = colb + bj * 128;
                v4u pw[4];
#pragma unroll
                for (int m = 0; m < 4; ++m) pw[m] = *(const v4u*)(PRE + (size_t)(row0 + ai * 128 + m * 16) * 512 + col);
#pragma unroll
                for (int m = 0; m < 4; ++m) { const int row = row0 + ai * 128 + m * 16;
                    float pr[8]; unpack8(pw[m], pr);
                    const f32x4 v0 = acc[ai][bj][m][0], v1 = acc[ai][bj][m][1];
                    v4u w; w.x = pg8::cvt_pk_bf16(pr[0] * v0[0], pr[1] * v0[1]); w.y = pg8::cvt_pk_bf16(pr[2] * v0[2], pr[3] * v0[3]);
                    w.z = pg8::cvt_pk_bf16(pr[4] * v1[0], pr[5] * v1[1]); w.w = pg8::cvt_pk_bf16(pr[6] * v1[2], pr[7] * v1[3]);
                    *(v4u*)(OA + (size_t)row * 512 + col) = w; } }
    }
};
__device__ __forceinline__ void ph_rwkvout2(const Params& p, unsigned char* ldsb, int l, int wg, int nwg) {
    const int nrows = (l == 1) ? NLAT : LR;
    pg8::StaticOrder S; S.init(nrows, 512, nwg, wg);
    {
        const int tid = otid(), lane = tid & 63, wv = tid >> 6;
        const bf16_t* Z = (const bf16_t*)(p.ws + WS_Z); bf16_t* Y2 = (bf16_t*)(p.ws + WS_Y2);
        pg8::Unit u;
        for (int it = 0; S.next(it, u); ++it) {
            const int c = u.pn * 256 + 4 * lane;
            const f32x4 lng = *(const f32x4*)(p.rw_ln_g + l * 512 + c), lnb = *(const f32x4*)(p.rw_ln_b + l * 512 + c), rkk = *(const f32x4*)(p.rw_r_k + l * 512 + c);
            for (int rr0 = wv; rr0 < 256; rr0 += 32) {
                v2u lyf[4], lyb[4], lr[4], lk[4], lv[4];
#pragma unroll
                for (int q = 0; q < 4; ++q) { const int row = u.pm * 256 + rr0 + 8 * q;
                    lyf[q] = *(const v2u*)(Y2 + (size_t)row * 512 + c); lyb[q] = *(const v2u*)(Y2 + ((size_t)LR + row) * 512 + c);
                    lr[q] = *(const v2u*)(Z + (size_t)row * ZC + C_R + c); lk[q] = *(const v2u*)(Z + (size_t)row * ZC + C_K + c); lv[q] = *(const v2u*)(Z + (size_t)row * ZC + C_V + c); }
#pragma unroll
                for (int q = 0; q < 4; ++q) { const int row = u.pm * 256 + rr0 + 8 * q;
                    float yf[4], yb[4], r4[4], k4[4], v4[4];
                    unpack4(lyf[q], yf); unpack4(lyb[q], yb); unpack4(lr[q], r4); unpack4(lk[q], k4); unpack4(lv[q], v4);
                    float y[4]; float sy = 0.f, sb = 0.f;
#pragma unroll
                    for (int e = 0; e < 4; ++e) { y[e] = yf[e] + yb[e]; sy += y[e]; sb += r4[e] * k4[e] * rkk[e]; }
                    sy = row16_sum(sy); sb = row16_sum(sb);
                    const float mu = sy * (1.f / 64.f); float sq = 0.f;
#pragma unroll
                    for (int e = 0; e < 4; ++e) { y[e] -= mu; sq += y[e] * y[e]; }
                    sq = row16_sum(sq);
                    const float rs = rsqrtf(sq * (1.f / 64.f) + GN_EPS);
                    float o[4];
#pragma unroll
                    for (int e = 0; e < 4; ++e) o[e] = y[e] * rs * lng[e] + lnb[e] + sb * v4[e];
                    v2u w; w.x = pk2(o[0], o[1]); w.y = pk2(o[2], o[3]);
                    *(v2u*)(Y2 + (size_t)row * 512 + c) = w; }
            }
        }
    }
    asm volatile("s_waitcnt vmcnt(0)" ::: "memory");
    __syncthreads();
    pg8::Gemm g{(const bf16_t*)(p.ws + WS_SG), (const bf16_t*)(p.ws + WS_GL_T), nrows, 512, 256};
    EpiOutA E{(const bf16_t*)(p.ws + WS_Y2), (bf16_t*)(p.ws + WS_OUTA)};
    pg8::gemm_phase<EpiOutA, pg8::StaticOrder, true, true>((LAS unsigned char*)ldsb, g, S, E);
}

__device__ __forceinline__ void ph_merge(const Params& p, float* sm, int l, int wg, int nwg) {
    const bf16_t* Z = (const bf16_t*)(p.ws + WS_Z);
    bf16_t* MG = (bf16_t*)(p.ws + WS_MERGED);
    float* TMP = (float*)(p.ws + WS_YS);
    const int nrows = (l == 1) ? NLAT : LR;
    gemm_naive<bf16_t>(sm, wg, nwg, nrows, DM, 512, (const bf16_t*)(p.ws + WS_OUTA), 512, nullptr, 0, p.proj_a + (size_t)l * 512 * DM, DM,
                       [=](int r, int c, float v) { TMP[(size_t)r * DM + c] = sigmoidf_(bf2f(Z[(size_t)r * ZC + C_GA + c])) * v; });
    gemm_naive<bf16_t>(sm, wg, nwg, nrows, DM, 512, (const bf16_t*)(p.ws + WS_YB), 512, nullptr, 0, p.proj_b + (size_t)l * 512 * DM, DM,
                       [=](int r, int c, float v) { MG[(size_t)r * DM + c] = f2bf(TMP[(size_t)r * DM + c] + sigmoidf_(bf2f(Z[(size_t)r * ZC + C_GB + c])) * v); });
}

__device__ __forceinline__ void ph_wout(const Params& p, float* sm, int l, int wg, int nwg) {
    const float* MOD = (const float*)(p.ws + WS_MOD);
    const int nrows = (l == 1) ? NLAT : LR;
    const Params pp = p;
    gemm_naive<bf16_t>(sm, wg, nwg, nrows, DM, DM, (const bf16_t*)(p.ws + WS_MERGED), DM, nullptr, 0, p.w_out + (size_t)l * DM * DM, DM,
                       [=](int r, int c, float v) { const float base = (l == 0 ? in_row(pp, r) : st_row(pp, r))[c];
                           st_row(pp, r)[c] = base + MOD[(l * 9 + mod_row(r)) * 6144 + 2 * DM + c] * v; });
}

__device__ __forceinline__ void ph_route(const Params& p, float* sm, int l, int wg, int nwg) {
    const int lane = otid() & 63, wv = otid() >> 6, nwv = blockDim.x >> 6;
    const float* MOD = (const float*)(p.ws + WS_MOD);
    bf16_t* H2 = (bf16_t*)(p.ws + WS_H2);
    const int nrows = (l == 1) ? NLAT : LR;
    for (int r = wg * nwv + wv; r < nrows; r += nwg * nwv) {
        const float* xr = st_row(p, r);
        float v[16]; float ss = 0.f;
#pragma unroll
        for (int i = 0; i < 16; ++i) { v[i] = xr[lane + 64 * i]; ss += v[i] * v[i]; }
        ss = wave_sum(ss);
        const float rs = rsqrtf(ss * (1.f / DM) + RMS_EPS);
        const float* m = MOD + (l * 9 + mod_row(r)) * 6144;
        float* hs = sm + wv * 1024;
#pragma unroll
        for (int i = 0; i < 16; ++i) { const int d = lane + 64 * i;
            const float h = (v[i] * rs * p.norm2_g[l * DM + d]) * (1.f + m[4 * DM + d]) + m[3 * DM + d];
            H2[(size_t)r * DM + d] = f2bf(h); hs[d] = h; }
        float dsum = 0.f;
        { const int e = lane & 15, part = lane >> 4; const float* rw = p.router_w + (size_t)(part * 256) * 16 + e; const float* hp = hs + part * 256;
#pragma unroll 4
            for (int d = 0; d < 256; ++d) dsum += hp[d] * rw[(size_t)d * 16]; }
        dsum += swz_xor<16>(dsum); dsum = xor32_add(dsum);
        const float myscore = 1.f / (1.f + expf(-dsum));
        float sc[16], sel[16];
#pragma unroll
        for (int e = 0; e < 16; ++e) { sc[e] = rdlane(myscore, e); sel[e] = sc[e] + p.router_bias[e]; }
        int best = 0; float bestv = -INFINITY;
#pragma unroll
        for (int g = 0; g < 4; ++g) { float m1 = -INFINITY, m2 = -INFINITY;
#pragma unroll
            for (int j = 0; j < 4; ++j) { const float s = sel[g * 4 + j]; if (s > m1) { m2 = m1; m1 = s; } else if (s > m2) m2 = s; }
            const float gs = m1 + m2; if (gs > bestv) { bestv = gs; best = g; } }
        int i0 = -1; float v0 = -INFINITY;
#pragma unroll
        for (int e = 0; e < 16; ++e) if ((e >> 2) == best && sel[e] > v0) { v0 = sel[e]; i0 = e; }
        int i1 = -1; float v1 = -INFINITY;
#pragma unroll
        for (int e = 0; e < 16; ++e) if ((e >> 2) == best && e != i0 && sel[e] > v1) { v1 = sel[e]; i1 = e; }
        float s0 = 0.f, s1 = 0.f;
#pragma unroll
        for (int e = 0; e < 16; ++e) { if (e == i0) s0 = sc[e]; if (e == i1) s1 = sc[e]; }
        const float inv = 1.f / (s0 + s1);
        if (lane == 0) {
            ((int*)(p.ws + WS_TOKI))[r] = i0 | (i1 << 8);
            ((float2*)(p.ws + WS_TOKG))[r] = make_float2(s0 * inv, s1 * inv);
        }
    }
}

__device__ __forceinline__ void ph_lists(const Params& p, float* sm, int l, int wg, int nwg) {
    int* cnt = (int*)(p.ws + WS_CTL) + l * 16;
    int* LT = (int*)(p.ws + WS_LTOK); float* LGt = (float*)(p.ws + WS_LGATE);
    const int* TI = (const int*)(p.ws + WS_TOKI); const float2* TG = (const float2*)(p.ws + WS_TOKG);
    const int nrows = (l == 1) ? NLAT : LR;
    const int tid = otid(), lane = tid & 63, wv = tid >> 6;
    int* wcnt = (int*)sm;
    for (int e = wg; e < NE; e += nwg) {
        int base = 0;
        for (int c0 = 0; c0 < nrows; c0 += 512) {
            const int t = c0 + tid;
            int slot = -1; float g = 0.f;
            if (t < nrows) { const int ti = TI[t]; const float2 tg = TG[t];
                if ((ti & 255) == e) { slot = 0; g = tg.x; } else if ((ti >> 8) == e) { slot = 1; g = tg.y; } }
            const unsigned long long bal = __ballot(slot >= 0);
            __syncthreads();
            if (lane == 0) wcnt[wv] = __popcll(bal);
            __syncthreads();
            int woff = 0, tot = 0;
#pragma unroll
            for (int w = 0; w < 8; ++w) { const int c = wcnt[w]; if (w < wv) woff += c; tot += c; }
            if (slot >= 0) { const int pos = base + woff + __popcll(bal & ((1ull << lane) - 1ull));
                LT[e * LR + pos] = t * 2 + slot; LGt[e * LR + pos] = g; }
            base += tot;
        }
        if (tid == 0) cnt[e] = base;
    }
}

__device__ __forceinline__ void ph_convert_moe(const Params& p, unsigned char* ldsb, int l, int wg, int nwg) {
    const int lane = otid() & 63, wv = __builtin_amdgcn_readfirstlane(otid() >> 6);
    LAS float* scr = (LAS float*)((LAS unsigned char*)ldsb + 32768 + wv * 8704);
    const int gw = wg * 8 + wv, NGW = nwg * 8;
    for (int it = gw; it < 16 * 768; it += NGW) {
        const int e = it / 768, r = it % 768, which = r >> 8, q = r & 255;
        if (which < 2) { const int kb = q >> 4, nb = q & 15, n0 = nb * 32;
            const float* W = (which == 0 ? p.moe_w1 : p.moe_w3) + (size_t)(l * NE + e) * DM * DE;
            tr_item(W, DE, kb * 64, n0, (bf16_t*)(p.ws + WS_W13T) + (size_t)e * 1024 * 1024, DM, (n0 >> 7) * 256 + (n0 & 127) + which * 128, scr, lane); }
        else { const int kb = q >> 5, nb = q & 31;
            tr_item(p.moe_w2 + (size_t)(l * NE + e) * DE * DM, DM, kb * 64, nb * 32, (bf16_t*)(p.ws + WS_W2T) + (size_t)e * 1024 * 512, DE, nb * 32, scr, lane); }
    }
}
__device__ __forceinline__ void ph_route2(const Params& p, float* sm, int l, int wg, int nwg) {
    const int tid = otid(), lane = tid & 63, wv = tid >> 6, fr = lane & 15, fq = lane >> 4;
    const float* MOD = (const float*)(p.ws + WS_MOD);
    bf16_t* H2 = (bf16_t*)(p.ws + WS_H2T);
    int* TI = (int*)(p.ws + WS_TOKI); float2* TG = (float2*)(p.ws + WS_TOKG);
    const int nrows = (l == 1) ? NLAT : LR;
    const int per = (nrows + nwg - 1) / nwg, r_beg = wg * per, r_end = min(nrows, r_beg + per);
    float* hs = sm;
    float* part = sm + 16 * 1028;
    int* lcnt = (int*)(part + 8 * 256);
    if (tid < 16) lcnt[tid] = 0;
    float Bw[32];
#pragma unroll
    for (int kk = 0; kk < 32; ++kk) Bw[kk] = p.router_w[(size_t)(128 * wv + 4 * kk + fq) * 16 + fr];
    for (int blk = r_beg; blk < r_end; blk += 16) {
        __syncthreads();
#pragma unroll
        for (int tt = 0; tt < 2; ++tt) { const int tl = wv * 2 + tt, r = blk + tl;
            if (r < r_end) {
                const bf16_t* xr = (const bf16_t*)(p.ws + WS_X1B) + (size_t)r * DM;
                const float* m = MOD + (l * 9 + mod_row(r)) * 6144;
                f32x4 v[4]; float ss = 0.f;
#pragma unroll
                for (int j = 0; j < 4; ++j) { float t4[4]; unpack4(*(const v2u*)(xr + 4 * lane + 256 * j), t4); v[j] = (f32x4){t4[0], t4[1], t4[2], t4[3]}; ss += (v[j][0] * v[j][0] + v[j][1] * v[j][1]) + (v[j][2] * v[j][2] + v[j][3] * v[j][3]); }
                ss = wave_sum(ss);
                const float rs = rsqrtf(ss * (1.f / DM) + RMS_EPS);
#pragma unroll
                for (int j = 0; j < 4; ++j) { const int d = 4 * lane + 256 * j;
                    const f32x4 g = *(const f32x4*)(p.norm2_g + l * DM + d), sh = *(const f32x4*)(m + 3 * DM + d), scl = *(const f32x4*)(m + 4 * DM + d);
                    const f32x4 h = v[j] * rs * g * (scl + 1.f) + sh;
                    v2u w; w.x = pk2(h[0], h[1]); w.y = pk2(h[2], h[3]);
                    *(v2u*)(H2 + (size_t)r * DM + d) = w;
                    *(f32x4*)(hs + tl * 1028 + d) = h; }
            } else {
#pragma unroll
                for (int j = 0; j < 4; ++j) *(f32x4*)(hs + tl * 1028 + 4 * lane + 256 * j) = (f32x4){0.f, 0.f, 0.f, 0.f};
            }
        }
        __syncthreads();
        { f32x4 acc = {0.f, 0.f, 0.f, 0.f};
#pragma unroll
          for (int kk = 0; kk < 32; ++kk) { const float a = hs[fr * 1028 + 128 * wv + 4 * kk + fq]; acc = __builtin_amdgcn_mfma_f32_16x16x4f32(a, Bw[kk], acc, 0, 0, 0); }
#pragma unroll
          for (int i = 0; i < 4; ++i) part[wv * 256 + (4 * fq + i) * 16 + fr] = acc[i]; }
        __syncthreads();
        if (tid < 16 && blk + tid < r_end) {
            const int r = blk + tid;
            float sc[16], sel[16];
#pragma unroll
            for (int e = 0; e < 16; ++e) { float d = 0.f;
#pragma unroll
                for (int w8 = 0; w8 < 8; ++w8) d += part[w8 * 256 + tid * 16 + e];
                sc[e] = 1.f / (1.f + expf(-d)); sel[e] = sc[e] + p.router_bias[e]; }
            int best = 0; float bestv = -INFINITY;
#pragma unroll
            for (int g = 0; g < 4; ++g) { float m1 = -INFINITY, m2 = -INFINITY;
#pragma unroll
                for (int j = 0; j < 4; ++j) { const float s_ = sel[g * 4 + j]; if (s_ > m1) { m2 = m1; m1 = s_; } else if (s_ > m2) m2 = s_; }
                const float gs = m1 + m2; if (gs > bestv) { bestv = gs; best = g; } }
            int i0 = -1; float v0 = -INFINITY;
#pragma unroll
            for (int e = 0; e < 16; ++e) if ((e >> 2) == best && sel[e] > v0) { v0 = sel[e]; i0 = e; }
            int i1 = -1; float v1 = -INFINITY;
#pragma unroll
            for (int e = 0; e < 16; ++e) if ((e >> 2) == best && e != i0 && sel[e] > v1) { v1 = sel[e]; i1 = e; }
            float s0 = 0.f, s1 = 0.f;
#pragma unroll
            for (int e = 0; e < 16; ++e) { if (e == i0) s0 = sc[e]; if (e == i1) s1 = sc[e]; }
            const float inv = 1.f / (s0 + s1);
            TI[r] = i0 | (i1 << 8); TG[r] = make_float2(s0 * inv, s1 * inv); atomicAdd(&lcnt[i0], 1); atomicAdd(&lcnt[i1], 1);
        }
    }
    __syncthreads();
    if (tid < 16) ((int*)(p.ws + WS_CNTWG))[wg * 16 + tid] = lcnt[tid];
}
__device__ __forceinline__ void ph_lists2(const Params& p, float* sm, int l, int wg, int nwg) {
    const int tid = otid(), lane = tid & 63, wv = tid >> 6;
    const int* CW = (const int*)(p.ws + WS_CNTWG);
    const int* TI = (const int*)(p.ws + WS_TOKI); const float2* TG = (const float2*)(p.ws + WS_TOKG);
    int* RD = (int*)(p.ws + WS_ROWDST); float* RG = (float*)(p.ws + WS_ROWGATE);
    const bf16_t* H2 = (const bf16_t*)(p.ws + WS_H2T); bf16_t* H2S = (bf16_t*)(p.ws + WS_H2S);
    const int nrows = (l == 1) ? NLAT : LR;
    const int per = (nrows + nwg - 1) / nwg, r_beg = wg * per, r_end = min(nrows, r_beg + per);
    int* s_tot = (int*)sm;
    int* s_before = s_tot + 16;
    int* s_off = s_tot + 32;
    int* s_ti = s_tot + 64;
    int* s_pos = s_tot + 64 + 128;
    int* s_cw = s_tot + 512;
    for (int i = tid; i < nwg * 16; i += 512) s_cw[i] = CW[i];
    for (int i = tid; i < r_end - r_beg; i += 512) s_ti[i] = TI[r_beg + i];
    __syncthreads();
    if (tid < 256) {
        const int e = tid & 15, part = tid >> 4; int tot = 0, bef = 0;
        for (int w = part; w < nwg; w += 16) { const int c = s_cw[w * 16 + e]; tot += c; if (w < wg) bef += c; }
        s_cw[4096 + tid] = tot; s_cw[4096 + 256 + tid] = bef;
    }
    __syncthreads();
    if (tid < 16) { int tot = 0, bef = 0; for (int q = 0; q < 16; ++q) { tot += s_cw[4096 + q * 16 + tid]; bef += s_cw[4096 + 256 + q * 16 + tid]; } s_tot[tid] = tot; s_before[tid] = bef; }
    __syncthreads();
    if (tid == 0) { int o = 0; for (int e = 0; e < 16; ++e) { s_off[e] = o; o += (s_tot[e] + 255) & ~255; } s_off[16] = o; }
    __syncthreads();
    if (wg == 0) {
        int* OFFS = (int*)(p.ws + WS_OFFS); int* TEXP = (int*)(p.ws + WS_TEXP);
        if (tid < 17) OFFS[tid] = s_off[tid];
        if (tid == 17) OFFS[17] = s_off[16] >> 8;
        if (tid < 160) { int e = 0; for (int k = 1; k < 16; ++k) if (tid * 256 >= s_off[k]) e = k; TEXP[tid] = e; }
    }
    if (wg < 16) { const int beg = s_off[wg] + s_tot[wg], end = s_off[wg + 1]; for (int i = beg + tid; i < end; i += 512) { RD[i] = -1; RG[i] = 0.f; } }
    const int n = r_end - r_beg;
    if (tid < n) { const int ti = s_ti[tid], e0 = ti & 255, e1 = ti >> 8; int k0 = 0, k1 = 0;
        for (int j = 0; j < tid; ++j) { const int tj = s_ti[j]; k0 += ((tj & 255) == e0) + ((tj >> 8) == e0); k1 += ((tj & 255) == e1) + ((tj >> 8) == e1); }
        const int p0 = s_off[e0] + s_before[e0] + k0, p1 = s_off[e1] + s_before[e1] + k1;
        s_pos[2 * tid] = p0; s_pos[2 * tid + 1] = p1;
        const float2 g = TG[r_beg + tid];
        RD[p0] = (r_beg + tid) * 2; RG[p0] = g.x; RD[p1] = (r_beg + tid) * 2 + 1; RG[p1] = g.y; }
    (void)H2; (void)H2S; (void)lane; (void)wv; (void)s_pos;
}
struct MoeOrder : pg8::StaticOrder {
    const int* texp; unsigned stride;
    __device__ __forceinline__ bool next(int i, pg8::Unit& u) const { if (!pg8::StaticOrder::next(i, u)) return false; u.boff = (unsigned)texp[u.pm] * stride; return true; }
};
constexpr int CW_RDY = 8192;
__device__ __forceinline__ void st16_wt(void* ptr, v4u v) { asm volatile("global_store_dwordx4 %0, %1, off sc1\n\ts_nop 1" :: "v"(ptr), "v"(v) : "memory"); }
struct MoeOrderPub : MoeOrder {
    static constexpr bool GATHER = true;
    unsigned* rdy;
    __device__ __forceinline__ void done(const pg8::Unit& u) const {
        asm volatile("s_waitcnt vmcnt(0)" ::: "memory");
        if ((otid() & 63) == 0) (void)__hip_atomic_fetch_add(rdy + 16 * u.pm, 1u, __ATOMIC_RELAXED, __HIP_MEMORY_SCOPE_AGENT);
    }
};
struct MoeOrderSub : pg8::StaticOrder {
    const int* texp; unsigned stride; const unsigned* rdy; int nx, J, x, j, rr, nl, base; bool classed;
    __device__ __forceinline__ void init2(int M, int N, int G_, int c_) {
        init(M, N, G_, c_);
        classed = (G_ % 8) == 0 && G_ >= 8;
        if (classed) { J = G_ / 8; x = c_ % 8; j = c_ / 8; nx = (nwg - x + 7) / 8; if (nx < 0) nx = 0; rr = nx % J; nl = J - rr; base = min(nx, 2 * nl); }
    }
    __device__ __forceinline__ bool next(int i, pg8::Unit& u) const {
        if (!classed) { if (!pg8::StaticOrder::next(i, u)) return false; u.boff = (unsigned)texp[u.pm] * stride; return true; }
        int s;
        if (j >= rr) { const int rank = j - rr; s = (i == 0) ? rank : (i == 1) ? nl + rank : base + j + (i - 2) * J; if (i < 2 && s >= base) return false; }
        else s = base + j + i * J;
        if (s >= nx) return false;
        unit_of(s * 8 + x, u); u.boff = (unsigned)texp[u.pm] * stride; return true;
    }
    __device__ __forceinline__ void a_ready(const pg8::Unit& u) const {
        if (otid() < 64) {
            unsigned sp = 0u;
            while ((unsigned)__builtin_amdgcn_readfirstlane(__hip_atomic_load(rdy + 16 * u.pm, __ATOMIC_RELAXED, __HIP_MEMORY_SCOPE_AGENT)) < 32u) { __builtin_amdgcn_s_sleep(2); if (++sp > (1u << 22)) break; }
            __builtin_amdgcn_fence(__ATOMIC_ACQUIRE, "agent");
            asm volatile("s_waitcnt vmcnt(0)" ::: "memory");
        }
        asm volatile("" ::: "memory"); __builtin_amdgcn_s_barrier(); asm volatile("" ::: "memory");
    }
};
struct EpiHid {
    static constexpr bool PERM = true, AFTER_DRAIN = false;
    bf16_t* HID;
    __device__ __forceinline__ void operator()(const f32x4 (&acc)[2][2][4][2], const pg8::Unit& u, int wr, int wc, int fr, int fq) const {
        const int row0 = u.pm * 256 + wr * 64 + fr, col = u.pn * 128 + wc * 32 + 8 * fq;
#pragma unroll
        for (int ai = 0; ai < 2; ++ai)
#pragma unroll
            for (int m = 0; m < 4; ++m) {
                const f32x4 a0 = acc[ai][0][m][0], a1 = acc[ai][0][m][1], b0 = acc[ai][1][m][0], b1 = acc[ai][1][m][1];
                float o[8];
#pragma unroll
                for (int e = 0; e < 4; ++e) { o[e] = a0[e] * sigmoidf_(a0[e]) * b0[e]; o[4 + e] = a1[e] * sigmoidf_(a1[e]) * b1[e]; }
                v4u w; w.x = pg8::cvt_pk_bf16(o[0], o[1]); w.y = pg8::cvt_pk_bf16(o[2], o[3]); w.z = pg8::cvt_pk_bf16(o[4], o[5]); w.w = pg8::cvt_pk_bf16(o[6], o[7]);
                st16_wt(HID + (size_t)(row0 + ai * 128 + m * 16) * DE + col, w); }
    }
};
struct EpiYs {
    static constexpr bool PERM = true, AFTER_DRAIN = false;
    bf16_t* YS; const int* RD; const float* RG;
    __device__ __forceinline__ void operator()(const f32x4 (&acc)[2][2][4][2], const pg8::Unit& u, int wr, int wc, int fr, int fq) const {
        const int row0 = u.pm * 256 + wr * 64 + fr, colb = u.pn * 256 + wc * 32 + 8 * fq;
        int dsts[2][4]; float gs[2][4];
#pragma unroll
        for (int ai = 0; ai < 2; ++ai)
#pragma unroll
            for (int m = 0; m < 4; ++m) { const int row = row0 + ai * 128 + m * 16; dsts[ai][m] = RD[row]; gs[ai][m] = RG[row]; }
#pragma unroll
        for (int ai = 0; ai < 2; ++ai)
#pragma unroll
            for (int m = 0; m < 4; ++m) { const int dst = dsts[ai][m]; const float g = gs[ai][m];
                if (dst >= 0) {
#pragma unroll
                    for (int bj = 0; bj < 2; ++bj) { const f32x4 v0 = acc[ai][bj][m][0] * g, v1 = acc[ai][bj][m][1] * g;
                        v4u w; w.x = pg8::cvt_pk_bf16(v0[0], v0[1]); w.y = pg8::cvt_pk_bf16(v0[2], v0[3]); w.z = pg8::cvt_pk_bf16(v1[0], v1[1]); w.w = pg8::cvt_pk_bf16(v1[2], v1[3]);
                        *(v4u*)(YS + (size_t)dst * DM + colb + bj * 128) = w; } } }
    }
};
__device__ __forceinline__ void ph_moe1_mfma(const Params& p, unsigned char* ldsb, int l, int wg, int nwg) {
    const int ntiles = ((const int*)(p.ws + WS_OFFS))[17];
    pg8::Gemm g{(const bf16_t*)(p.ws + WS_H2T), (const bf16_t*)(p.ws + WS_W13T), ntiles * 256, 1024, DM};
    MoeOrderPub S; S.init(ntiles * 256, 1024, nwg, wg); S.texp = (const int*)(p.ws + WS_TEXP); S.stride = 1024u * 1024u * 2u; S.rdy = (unsigned*)(p.ws + WS_CTL) + CW_RDY + l * 4096; S.rowsrc = (const int*)(p.ws + WS_ROWDST);
    EpiHid E{(bf16_t*)(p.ws + WS_HID2)};
    pg8::gemm_phase<EpiHid, MoeOrderPub, true, true>((LAS unsigned char*)ldsb, g, S, E);
}
__device__ __forceinline__ void ph_moe2_mfma(const Params& p, unsigned char* ldsb, int l, int wg, int nwg) {
    const int ntiles = ((const int*)(p.ws + WS_OFFS))[17];
    pg8::Gemm g{(const bf16_t*)(p.ws + WS_HID2), (const bf16_t*)(p.ws + WS_W2T), ntiles * 256, 1024, DE};
    MoeOrderSub S; S.init2(ntiles * 256, 1024, nwg, wg); S.texp = (const int*)(p.ws + WS_TEXP); S.stride = 1024u * 512u * 2u; S.rdy = (const unsigned*)(p.ws + WS_CTL) + CW_RDY + l * 4096;
    EpiYs E{(bf16_t*)(p.ws + WS_YS2), (const int*)(p.ws + WS_ROWDST), (const float*)(p.ws + WS_ROWGATE)};
    pg8::gemm_phase<EpiYs, MoeOrderSub, true, true>((LAS unsigned char*)ldsb, g, S, E);
}
__device__ __forceinline__ void ph_combine2(const Params& p, int l, int wg, int nwg) {
    const float* MOD = (const float*)(p.ws + WS_MOD);
    const bf16_t* YS = (const bf16_t*)(p.ws + WS_YS2);
    const int nrows = (l == 1) ? NLAT : LR;
    for (size_t i = (size_t)wg * 512 + otid(); i < (size_t)nrows * DM; i += (size_t)nwg * 512) {
        const int r = (int)(i >> 10), d = (int)(i & 1023);
        float* xp = st_row(p, r) + d;
        *xp = *xp + MOD[(l * 9 + mod_row(r)) * 6144 + 5 * DM + d] * (bf2f(YS[(size_t)(2 * r) * DM + d]) + bf2f(YS[(size_t)(2 * r + 1) * DM + d]));
    }
}

__device__ __forceinline__ void ph_moe1(const Params& p, float* sm, int l, int wg, int nwg) {
    const int* cnt = (const int*)(p.ws + WS_CTL) + l * 16;
    const int* LT = (const int*)(p.ws + WS_LTOK);
    float* T1 = (float*)(p.ws + WS_TMP1); bf16_t* HID = (bf16_t*)(p.ws + WS_HID);
    int off = 0;
    for (int e = 0; e < NE; ++e) {
        const int M = cnt[e];
        float* t1 = T1 + (size_t)off * DE; bf16_t* hid = HID + (size_t)off * DE;
        gemm_naive<bf16_t>(sm, wg, nwg, M, DE, DM, (const bf16_t*)(p.ws + WS_H2), DM, LT + e * LR, 1, p.moe_w1 + ((size_t)(l * NE + e) * DM) * DE, DE,
                           [=](int r, int c, float v) { t1[(size_t)r * DE + c] = v; });
        gemm_naive<bf16_t>(sm, wg, nwg, M, DE, DM, (const bf16_t*)(p.ws + WS_H2), DM, LT + e * LR, 1, p.moe_w3 + ((size_t)(l * NE + e) * DM) * DE, DE,
                           [=](int r, int c, float v) { const float a = t1[(size_t)r * DE + c]; hid[(size_t)r * DE + c] = f2bf(a * sigmoidf_(a) * v); });
        off += (M + 255) & ~255;
    }
}
__device__ __forceinline__ void ph_moe2(const Params& p, float* sm, int l, int wg, int nwg) {
    const int* cnt = (const int*)(p.ws + WS_CTL) + l * 16;
    const int* LT = (const int*)(p.ws + WS_LTOK); const float* LGt = (const float*)(p.ws + WS_LGATE);
    const bf16_t* HID = (const bf16_t*)(p.ws + WS_HID); bf16_t* YS = (bf16_t*)(p.ws + WS_YS);
    int off = 0;
    for (int e = 0; e < NE; ++e) {
        const int M = cnt[e];
        const int* lt = LT + e * LR; const float* lgt = LGt + e * LR;
        gemm_naive<bf16_t>(sm, wg, nwg, M, DM, DE, HID + (size_t)off * DE, DE, nullptr, 0, p.moe_w2 + ((size_t)(l * NE + e) * DE) * DM, DM,
                           [=](int r, int c, float v) { YS[(size_t)lt[r] * DM + c] = f2bf(lgt[r] * v); });
        off += (M + 255) & ~255;
    }
}
__device__ __forceinline__ void ph_combine(const Params& p, int l, int wg, int nwg) {
    const float* MOD = (const float*)(p.ws + WS_MOD);
    const bf16_t* YS = (const bf16_t*)(p.ws + WS_YS);
    const int nrows = (l == 1) ? NLAT : LR;
    for (size_t i = (size_t)wg * blockDim.x + otid(); i < (size_t)nrows * DM; i += (size_t)nwg * blockDim.x) {
        const int r = (int)(i >> 10), d = (int)(i & 1023);
        float* xp = st_row(p, r) + d;
        *xp = *xp + MOD[(l * 9 + mod_row(r)) * 6144 + 5 * DM + d] * (bf2f(YS[(size_t)(2 * r) * DM + d]) + bf2f(YS[(size_t)(2 * r + 1) * DM + d]));
    }
}

#define GAS __attribute__((address_space(1)))
#define XB_TMO      128
#define XB_XCNT(j)  (256  + 64 * (j))
#define XB_XSUB(j)  (1280 + 64 * (j))
#define XB_XGEN(j)  (2304 + 64 * (j))
#define XB_TOP      3328
#define XB_TOPGEN   3392
#define XCD_BAR_WORDS 3456
#define XB_SPIN_CAP (1u << 24)
__device__ __forceinline__ unsigned xb_ld(unsigned* p)              { return __hip_atomic_load(p, __ATOMIC_RELAXED, __HIP_MEMORY_SCOPE_AGENT); }
__device__ __forceinline__ unsigned xb_add(unsigned* p, unsigned v) { return __hip_atomic_fetch_add(p, v, __ATOMIC_RELAXED, __HIP_MEMORY_SCOPE_AGENT); }
__device__ __forceinline__ unsigned xb_xcc_id() { return (unsigned)__builtin_amdgcn_s_getreg((3 << 11) | 20) & 0xFu; }
#define XB_SPIN(cond, bar) do { unsigned _sp = 0; while (cond) { __builtin_amdgcn_s_sleep(1); \
    if ((++_sp & 255u) == 0u) { if (xb_ld(&(bar)[XB_TMO])) break; if (_sp > XB_SPIN_CAP) { atomicAdd(&(bar)[XB_TMO], 1u); break; } } } } while (0)
struct XcdBarrier { unsigned* bar; unsigned x; volatile LAS unsigned* st; };
__device__ __forceinline__ XcdBarrier xcd_barrier_post(unsigned* bar, volatile LAS unsigned* st) {
    XcdBarrier b; b.bar = bar; b.x = xb_xcc_id(); b.st = st;
    if (threadIdx.x == 0) (void)xb_add(&bar[XB_XCNT(b.x)], 1u);
    return b;
}
__device__ __forceinline__ void xcd_barrier_complete(unsigned* bar, unsigned x, unsigned& nloc, unsigned& nx) {
    const unsigned G = gridDim.x * gridDim.y * gridDim.z;
    unsigned sum, cnt, mine, sp = 0u;
    for (;;) {
        sum = 0u; cnt = 0u; mine = 0u;
#pragma unroll
        for (unsigned j = 0; j < 16; ++j) { const unsigned c = xb_ld(&bar[XB_XCNT(j)]); sum += c; cnt += (c > 0u) ? 1u : 0u; mine = (j == x) ? c : mine; }
        if (sum == G) break;
        __builtin_amdgcn_s_sleep(1);
        if ((++sp & 255u) == 0u) { if (xb_ld(&bar[XB_TMO])) break; if (sp > XB_SPIN_CAP) { atomicAdd(&bar[XB_TMO], 1u); break; } }
    }
    nloc = mine > 0u ? mine : 1u; nx = cnt > 0u ? cnt : 1u;
}
__device__ __forceinline__ void xcd_barrier(const XcdBarrier& b) {
    asm volatile("s_waitcnt vmcnt(0)" ::: "memory");
    __syncthreads();
    if (threadIdx.x == 0) {
        unsigned* bar = b.bar;
        __builtin_amdgcn_s_waitcnt(0);
        unsigned nloc = b.st[0], nx = b.st[1];
        if (nloc == 0u) { xcd_barrier_complete(bar, b.x, nloc, nx); b.st[0] = nloc; b.st[1] = nx; }
        const unsigned old = xb_add(&bar[XB_XSUB(b.x)], 1u);
        const unsigned gen = old / nloc;
        if (old + 1u == (gen + 1u) * nloc) {
            __builtin_amdgcn_fence(__ATOMIC_RELEASE, "agent");
            asm volatile("s_waitcnt vmcnt(0)" ::: "memory");
            const unsigned og = xb_add(&bar[XB_TOP], 1u);
            const unsigned tg = og / nx;
            if (og + 1u == (tg + 1u) * nx) xb_add(&bar[XB_TOPGEN], 1u);
            else XB_SPIN(xb_ld(&bar[XB_TOPGEN]) == tg, bar);
            __builtin_amdgcn_fence(__ATOMIC_ACQUIRE, "agent");
            xb_add(&bar[XB_XGEN(b.x)], 1u);
            asm volatile("s_waitcnt vmcnt(0)" ::: "memory");
        } else {
            XB_SPIN(xb_ld(&bar[XB_XGEN(b.x)]) == gen, bar);
            __builtin_amdgcn_fence(__ATOMIC_ACQUIRE, "agent");
            asm volatile("s_waitcnt vmcnt(0)" ::: "memory");
        }
    }
    __syncthreads();
}

__device__ __forceinline__ void xcd_barrier_lean(const XcdBarrier& b) {
    asm volatile("s_waitcnt vmcnt(0)" ::: "memory");
    __syncthreads();
    if (threadIdx.x == 0) {
        unsigned* bar = b.bar;
        __builtin_amdgcn_s_waitcnt(0);
        unsigned nloc = b.st[0], nx = b.st[1];
        const unsigned old = xb_add(&bar[XB_XSUB(b.x)], 1u);
        const unsigned gen = old / nloc;
        if (old + 1u == (gen + 1u) * nloc) {
            __builtin_amdgcn_fence(__ATOMIC_RELEASE, "agent");
            asm volatile("s_waitcnt vmcnt(0)" ::: "memory");
            const unsigned og = xb_add(&bar[XB_TOP], 1u);
            const unsigned tg = og / nx;
            if (og + 1u == (tg + 1u) * nx) xb_add(&bar[XB_TOPGEN], 1u);
            else XB_SPIN(xb_ld(&bar[XB_TOPGEN]) == tg, bar);
            __builtin_amdgcn_fence(__ATOMIC_ACQUIRE, "agent");
            xb_add(&bar[XB_XGEN(b.x)], 1u);
            asm volatile("s_waitcnt vmcnt(0)" ::: "memory");
        } else {
            XB_SPIN(xb_ld(&bar[XB_XGEN(b.x)]) == gen, bar);
            __builtin_amdgcn_fence(__ATOMIC_ACQUIRE, "agent");
            asm volatile("s_waitcnt vmcnt(0)" ::: "memory");
        }
    }
    __syncthreads();
}

constexpr int LDS_BYTES = 147456;
constexpr int MISC_OFF = 147456 - 128;
constexpr int CW_BAR = 4096;

__device__ __forceinline__ int owg(int w) { asm volatile("" : "+s"(w)); return w; }
__device__ __forceinline__ Params load_params() {
    Params r{};
#if defined(__HIP_DEVICE_COMPILE__)
    typedef const __attribute__((address_space(4))) unsigned long long* kq_t;
    kq_t k = (kq_t)__builtin_amdgcn_kernarg_segment_ptr(); asm volatile("" : "+s"(k));
    r.x = (const float*)(const __attribute__((address_space(1))) float*)k[0];
    r.c = (const float*)(const __attribute__((address_space(1))) float*)k[1];
    r.ctx = (const float*)(const __attribute__((address_space(1))) float*)k[2];
    r.c_ctx = (const float*)(const __attribute__((address_space(1))) float*)k[3];
    r.mod_w = (const float*)(const __attribute__((address_space(1))) float*)k[4];
    r.mod_b = (const float*)(const __attribute__((address_space(1))) float*)k[5];
    r.norm1_g = (const float*)(const __attribute__((address_space(1))) float*)k[6];
    r.norm2_g = (const float*)(const __attribute__((address_space(1))) float*)k[7];
    r.w_in = (const float*)(const __attribute__((address_space(1))) float*)k[8];
    r.rw_w0 = (const float*)(const __attribute__((address_space(1))) float*)k[9];
    r.rw_w_lora_b = (const float*)(const __attribute__((address_space(1))) float*)k[10];
    r.rw_a0 = (const float*)(const __attribute__((address_space(1))) float*)k[11];
    r.rw_a_lora_b = (const float*)(const __attribute__((address_space(1))) float*)k[12];
    r.rw_g_lora_b = (const float*)(const __attribute__((address_space(1))) float*)k[13];
    r.rw_k_k = (const float*)(const __attribute__((address_space(1))) float*)k[14];
    r.rw_k_a = (const float*)(const __attribute__((address_space(1))) float*)k[15];
    r.rw_r_k = (const float*)(const __attribute__((address_space(1))) float*)k[16];
    r.rw_ln_g = (const float*)(const __attribute__((address_space(1))) float*)k[17];
    r.rw_ln_b = (const float*)(const __attribute__((address_space(1))) float*)k[18];
    r.na_q_g = (const float*)(const __attribute__((address_space(1))) float*)k[19];
    r.na_k_g = (const float*)(const __attribute__((address_space(1))) float*)k[20];
    r.na_rpb = (const float*)(const __attribute__((address_space(1))) float*)k[21];
    r.proj_a = (const float*)(const __attribute__((address_space(1))) float*)k[22];
    r.proj_b = (const float*)(const __attribute__((address_space(1))) float*)k[23];
    r.w_out = (const float*)(const __attribute__((address_space(1))) float*)k[24];
    r.router_w = (const float*)(const __attribute__((address_space(1))) float*)k[25];
    r.router_bias = (const float*)(const __attribute__((address_space(1))) float*)k[26];
    r.moe_w1 = (const float*)(const __attribute__((address_space(1))) float*)k[27];
    r.moe_w3 = (const float*)(const __attribute__((address_space(1))) float*)k[28];
    r.moe_w2 = (const float*)(const __attribute__((address_space(1))) float*)k[29];
    r.out = (float*)(__attribute__((address_space(1))) float*)k[30]; r.ws = (unsigned char*)(__attribute__((address_space(1))) unsigned char*)k[31];
#endif
    return r;
}
#define PRM(name) const Params name = load_params()
__global__ void __launch_bounds__(512, 2) mega(Params p_unused) {
    extern __shared__ __attribute__((aligned(16))) unsigned char lds[];
    float* sm = (float*)lds;
    volatile LAS unsigned* MISC = (volatile LAS unsigned*)((LAS unsigned char*)lds + MISC_OFF);
    if (threadIdx.x < 32) MISC[threadIdx.x] = 0u;
    __syncthreads();
    { PRM(p); (void)xcd_barrier_post((unsigned*)(p.ws + WS_CTL) + CW_BAR, MISC + 8); }
    const int wg0 = blockIdx.x, nwg = gridDim.x;
#define wg owg(wg0)
#define MKBAR(b_) PRM(pb_); XcdBarrier b_; b_.bar = (unsigned*)(pb_.ws + WS_CTL) + CW_BAR; b_.x = xb_xcc_id(); b_.st = MISC + 8
#define GRID_BAR_FIRST() do { MKBAR(b_); xcd_barrier(b_); } while (0)
#define GRID_BAR() do { MKBAR(b_); xcd_barrier_lean(b_); } while (0)
    { PRM(p); ph_mod2(p, sm, wg, nwg); }
    __syncthreads();
    { PRM(p); ph_convert_dense(p, lds, 0, wg, nwg); } GRID_BAR_FIRST();
    { PRM(p); ph_norm1v(p, wg, nwg); } GRID_BAR();
#define LAYER_BODY(l) do { \
        { PRM(p); ph_win_mfma(p, lds, l, wg, nwg); } GRID_BAR(); \
        { PRM(p); ph_scan_natt(p, lds, l, wg, nwg); } GRID_BAR(); \
        { PRM(p); ph_rwkvout2(p, lds, l, wg, nwg); } GRID_BAR(); \
        { PRM(p); ph_merge_mfma(p, lds, l, wg, nwg); } GRID_BAR(); \
        { PRM(p); ph_wout_mfma(p, lds, l, wg, nwg); } GRID_BAR(); \
        { PRM(p); ph_route2(p, sm, l, wg, nwg); } \
        if (l == 0) { __syncthreads(); PRM(p); ph_convert_dense(p, lds, 1, wg, nwg); } \
        GRID_BAR(); \
        { PRM(p); ph_lists2(p, sm, l, wg, nwg); } GRID_BAR(); \
        { PRM(p); ph_moe1_mfma(p, lds, l, wg, nwg); } \
        { PRM(p); ph_moe2_mfma(p, lds, l, wg, nwg); } GRID_BAR(); \
        { PRM(p); ph_combine_norm(p, l, wg, nwg); } if (l == 0) GRID_BAR(); \
    } while (0)
    LAYER_BODY(0);
    LAYER_BODY(1);
}
#undef wg
__global__ void k_zero(float* o, int n) { int i = blockIdx.x * blockDim.x + threadIdx.x; if (i < n) o[i] = 0.f; }

extern "C" void kernel_launch(void* const* d_in, const int* in_sizes, int n_in, void* d_out, int out_size, void* d_ws, size_t ws_size, hipStream_t stream) {
    static int grid = 0;
    if (grid == 0) {
        int dev = 0, cus = 0, per_cu = 0;
        if (hipGetDevice(&dev) != hipSuccess || hipDeviceGetAttribute(&cus, hipDeviceAttributeMultiprocessorCount, dev) != hipSuccess) { grid = -1; }
        else if (hipFuncSetAttribute((const void*)mega, hipFuncAttributeMaxDynamicSharedMemorySize, LDS_BYTES) != hipSuccess) { grid = -1; }
        else {
            if (hipOccupancyMaxActiveBlocksPerMultiprocessor(&per_cu, (const void*)mega, 512, LDS_BYTES) != hipSuccess || per_cu < 1) { fprintf(stderr, "occupancy query says %d\n", per_cu); }
            (void)hipGetLastError();
            grid = cus;
        }
    }
    if (grid <= 0 || n_in != 30 || ws_size < WS_END || out_size != NLAT * DM) {
        fprintf(stderr, "kernel_launch: unexpected grid %d n_in %d / ws_size %zu / out_size %d\n", grid, n_in, ws_size, out_size);
        hipLaunchKernelGGL(k_zero, dim3((out_size + 255) / 256), dim3(256), 0, stream, (float*)d_out, out_size);
        return;
    }
    Params p{};
    const float** pp = (const float**)&p;
    for (int i = 0; i < 30; ++i) pp[i] = (const float*)d_in[i];
    p.out = (float*)d_out; p.ws = (unsigned char*)d_ws;
    (void)hipMemsetAsync((char*)d_ws + WS_CTL, 0, 65536, stream);
    hipLaunchKernelGGL(mega, dim3(grid), dim3(512), LDS_BYTES, stream, p);
}
```
